# Optimizing an MI355X kernel written in HIP

```python
import math
import jax, jax.numpy as jnp
from jax import lax
import numpy as np

D_MODEL = 2048
BATCH = 2
SEQ = 8192
DEPTH = 2

D_MIX = D_MODEL
D_POOL = D_MIX // 2
D_LRU = D_MIX // 2
POOL_WINDOWS = (2, 4, 8, 16)
POOL_GROUP = D_POOL // len(POOL_WINDOWS)
LRU_BLOCKS = 8
LRU_BLOCK = D_LRU // LRU_BLOCKS
CONV_WIDTH = 4
LRU_C = 8.0
N_HEADS_ATTN = 16
HEAD_DIM = D_MIX // N_HEADS_ATTN
Q_BLOCK = 128
PEER_HEADS = 8
PEER_TOPK = 16
N_KEYS = 128
N_EXPERTS = N_KEYS * N_KEYS
PEER_HALF = 128
PEER_QDIM = 2 * PEER_HALF
PEER_CHUNK = 128
N_EVEN = (DEPTH + 1) // 2
N_ODD = DEPTH // 2
ALPHA = (2.0 * DEPTH) ** 0.25
BETA = (8.0 * DEPTH) ** -0.25
LN_EPS = 1e-5

kernel_name = "hybrid_pool_rglru_fox_peer_deepnorm"


def layer_norm(x, g, b):
    xf = x.astype(jnp.float32)
    mu = jnp.mean(xf, axis=-1, keepdims=True)
    var = jnp.mean(jnp.square(xf - mu), axis=-1, keepdims=True)
    y = (xf - mu) * lax.rsqrt(var + LN_EPS)
    return (y * g.astype(jnp.float32) + b.astype(jnp.float32)).astype(x.dtype)


def multiscale_pool(u, w_pool, pool_scale):
    S = u.shape[1]
    pos = jnp.arange(S)
    uf = u.astype(jnp.float32)
    outs = []
    for g, w in enumerate(POOL_WINDOWS):
        ug = uf[..., g * POOL_GROUP:(g + 1) * POOL_GROUP]
        cs = jnp.cumsum(ug, axis=1)
        cs_lag = jnp.pad(cs, ((0, 0), (w, 0), (0, 0)))[:, :S]
        cnt = jnp.minimum(pos + 1, w).astype(jnp.float32)[None, :, None]
        pooled = (cs - cs_lag) / cnt - ug
        outs.append(jnp.einsum('bsc,cd->bsd', pooled.astype(u.dtype), w_pool[g]))
    return jnp.concatenate(outs, axis=-1) * pool_scale


def causal_conv(x, w, b):
    S = x.shape[1]
    xp = jnp.pad(x, ((0, 0), (CONV_WIDTH - 1, 0), (0, 0)))
    y = b
    for k in range(CONV_WIDTH):
        y = y + xp[:, k:k + S] * w[k]
    return y


def block_diag(x, w, b):
    B_, S_, _ = x.shape
    xb = x.reshape(B_, S_, LRU_BLOCKS, LRU_BLOCK)
    return jnp.einsum('bshi,hij->bshj', xb, w).reshape(B_, S_, D_LRU) + b


def rg_lru(x, w_a, b_a, w_x, b_x, lam):
    xf = x.astype(jnp.float32)
    r_gate = jax.nn.sigmoid(block_diag(x, w_a, b_a).astype(jnp.float32))
    i_gate = jax.nn.sigmoid(block_diag(x, w_x, b_x).astype(jnp.float32))
    log_a = LRU_C * r_gate * jax.nn.log_sigmoid(lam.astype(jnp.float32))
    a = jnp.exp(log_a)
    mult = jnp.sqrt(jnp.maximum(-jnp.expm1(2.0 * log_a), 0.0))
    drive = mult * i_gate * xf

    def combine(lhs, rhs):
        a1, b1 = lhs
        a2, b2 = rhs
        return a1 * a2, a2 * b1 + b2

    _, h = lax.associative_scan(combine, (a, drive), axis=1)
    return h.astype(x.dtype)


def forgetting_attention(q, k, v, log_f):
    B_, S_, H_, Dh = q.shape
    nb = S_ // Q_BLOCK
    F = jnp.cumsum(log_f.astype(jnp.float32), axis=1)
    F_k = jnp.transpose(F, (0, 2, 1))
    q_blocks = q.reshape(B_, nb, Q_BLOCK, H_, Dh).transpose(1, 0, 3, 2, 4)
    F_blocks = F_k.reshape(B_, H_, nb, Q_BLOCK).transpose(2, 0, 1, 3)
    kpos = jnp.arange(S_)
    scale = Dh ** -0.5

    def block(args):
        qi, Fi, bi = args
        s = jnp.einsum('bhqd,bshd->bhqs', qi, k).astype(jnp.float32) * scale
        s = s + Fi[..., None] - F_k[:, :, None, :]
        qpos = bi * Q_BLOCK + jnp.arange(Q_BLOCK)
        mask = kpos[None, :] <= qpos[:, None]
        s = jnp.where(mask, s, -jnp.inf)
        p = jax.nn.softmax(s, axis=-1).astype(v.dtype)
        return jnp.einsum('bhqs,bshd->bqhd', p, v)

    o = lax.map(block, (q_blocks, F_blocks, jnp.arange(nb)))
    return o.transpose(1, 0, 2, 3, 4).reshape(B_, S_, H_ * Dh)


def peer(h, w_q, sub_keys, u_tab, v_tab):
    B_, S_, D_ = h.shape
    q = jnp.einsum('bsd,de->bse', h, w_q).reshape(B_, S_, PEER_HEADS, 2, PEER_HALF)
    sc = jnp.einsum('bshpd,hpnd->bshpn', q, sub_keys).astype(jnp.float32)
    s1, i1 = lax.top_k(sc[..., 0, :], PEER_TOPK)
    s2, i2 = lax.top_k(sc[..., 1, :], PEER_TOPK)
    cand_s = (s1[..., :, None] + s2[..., None, :]).reshape(B_, S_, PEER_HEADS, PEER_TOPK * PEER_TOPK)
    cand_i = (i1[..., :, None] * N_KEYS + i2[..., None, :]).reshape(B_, S_, PEER_HEADS, PEER_TOPK * PEER_TOPK)
    top_s, top_j = lax.top_k(cand_s, PEER_TOPK)
    eidx = jnp.take_along_axis(cand_i, top_j, axis=-1)
    gates = jax.nn.softmax(top_s, axis=-1)
    n_act = PEER_HEADS * PEER_TOPK
    nc = S_ // PEER_CHUNK
    h_c = h.reshape(B_, nc, PEER_CHUNK, D_).transpose(1, 0, 2, 3)
    e_c = eidx.reshape(B_, nc, PEER_CHUNK, n_act).transpose(1, 0, 2, 3)
    g_c = gates.reshape(B_, nc, PEER_CHUNK, n_act).transpose(1, 0, 2, 3).astype(h.dtype)

    def chunk(args):
        hx, ei, gi = args
        u = u_tab[ei]
        vv = v_tab[ei]
        act = jax.nn.gelu(jnp.einsum('bcd,bckd->bck', hx, u)) * gi
        return jnp.einsum('bck,bckd->bcd', act, vv)

    out = lax.map(chunk, (h_c, e_c, g_c))
    return out.transpose(1, 0, 2, 3).reshape(B_, S_, D_)


def even_mixer(h, w_in, w_pool, pool_scale, conv_w, conv_b, w_a, b_a, w_x, b_x, lam, w_out):
    z = jnp.einsum('bsd,de->bse', h, w_in)
    u_pool = z[..., :D_POOL]
    u_lru = z[..., D_POOL:D_POOL + D_LRU]
    u_gate = z[..., D_POOL + D_LRU:]
    y_a = multiscale_pool(u_pool, w_pool, pool_scale)
    y_b = rg_lru(causal_conv(u_lru, conv_w, conv_b), w_a, b_a, w_x, b_x, lam) * jax.nn.gelu(u_gate)
    return jnp.einsum('bse,ed->bsd', jnp.concatenate([y_a, y_b], axis=-1), w_out)


def odd_mixer(h, w_in, b_f, w_out):
    B_, S_, _ = h.shape
    z = jnp.einsum('bsd,de->bse', h, w_in)
    q = z[..., :D_MIX].reshape(B_, S_, N_HEADS_ATTN, HEAD_DIM)
    k = z[..., D_MIX:2 * D_MIX].reshape(B_, S_, N_HEADS_ATTN, HEAD_DIM)
    v = z[..., 2 * D_MIX:3 * D_MIX].reshape(B_, S_, N_HEADS_ATTN, HEAD_DIM)
    log_f = jax.nn.log_sigmoid((z[..., 3 * D_MIX:] + b_f).astype(jnp.float32))
    o = forgetting_attention(q, k, v, log_f)
    return jnp.einsum('bse,ed->bsd', o, w_out)


def setup_inputs(seed: int = 0) -> dict:
    key = jax.random.key(seed)
    ks = jax.random.split(key, 32)
    nrm = lambda k, shape, s: jax.random.normal(k, shape, jnp.float32) * s
    D = D_MODEL
    x = nrm(ks[0], (BATCH, SEQ, D), 1.0)
    c = nrm(ks[1], (BATCH, D), 1.0)
    ada_w = nrm(ks[2], (DEPTH, D, 6 * D), 0.1 * D ** -0.5)
    ada_b = nrm(ks[3], (DEPTH, 6 * D), 0.01)
    ln_g = 1.0 + nrm(ks[4], (DEPTH, 2, D), 0.02)
    ln_b = nrm(ks[5], (DEPTH, 2, D), 0.02)
    peer_wq = nrm(ks[6], (DEPTH, D, PEER_HEADS * PEER_QDIM), D ** -0.5)
    peer_keys = nrm(ks[7], (DEPTH, PEER_HEADS, 2, N_KEYS, PEER_HALF), PEER_HALF ** -0.5)
    peer_u = nrm(ks[8], (DEPTH, N_EXPERTS, D), D ** -0.5)
    peer_v = nrm(ks[9], (DEPTH, N_EXPERTS, D), BETA)
    ev_w_in = nrm(ks[10], (N_EVEN, D, D_POOL + 2 * D_LRU), D ** -0.5)
    ev_w_pool = nrm(ks[11], (N_EVEN, len(POOL_WINDOWS), POOL_GROUP, POOL_GROUP), POOL_GROUP ** -0.5)
    ev_pool_scale = 1.0 + nrm(ks[12], (N_EVEN, D_POOL), 0.1)
    ev_conv_w = nrm(ks[13], (N_EVEN, CONV_WIDTH, D_LRU), CONV_WIDTH ** -0.5)
    ev_conv_b = nrm(ks[14], (N_EVEN, D_LRU), 0.01)
    ev_w_a = nrm(ks[15], (N_EVEN, LRU_BLOCKS, LRU_BLOCK, LRU_BLOCK), LRU_BLOCK ** -0.5)
    ev_b_a = nrm(ks[16], (N_EVEN, D_LRU), 0.01)
    ev_w_x = nrm(ks[17], (N_EVEN, LRU_BLOCKS, LRU_BLOCK, LRU_BLOCK), LRU_BLOCK ** -0.5)
    ev_b_x = nrm(ks[18], (N_EVEN, D_LRU), 0.01)
    a_c = jax.random.uniform(ks[19], (N_EVEN, D_LRU), jnp.float32, 0.9, 0.999)
    a0 = a_c ** (1.0 / LRU_C)
    ev_lam = jnp.log(a0) - jnp.log1p(-a0)
    ev_w_out = nrm(ks[20], (N_EVEN, D_POOL + D_LRU, D), (D_POOL + D_LRU) ** -0.5 * BETA)
    w_qk = nrm(ks[21], (N_ODD, D, 2 * D_MIX), D ** -0.5)
    w_v = nrm(ks[22], (N_ODD, D, D_MIX), D ** -0.5 * BETA)
    w_f = nrm(ks[23], (N_ODD, D, N_HEADS_ATTN), D ** -0.5)
    od_w_in = jnp.concatenate([w_qk, w_v, w_f], axis=-1)
    od_b_f = jax.random.uniform(ks[24], (N_ODD, N_HEADS_ATTN), jnp.float32, 1.0, 5.0)
    od_w_out = nrm(ks[25], (N_ODD, D_MIX, D), D_MIX ** -0.5 * BETA)
    return {"x": x, "c": c, "ada_w": ada_w, "ada_b": ada_b, "ln_g": ln_g, "ln_b": ln_b,
            "peer_wq": peer_wq, "peer_keys": peer_keys, "peer_u": peer_u, "peer_v": peer_v,
            "ev_w_in": ev_w_in, "ev_w_pool": ev_w_pool, "ev_pool_scale": ev_pool_scale,
            "ev_conv_w": ev_conv_w, "ev_conv_b": ev_conv_b, "ev_w_a": ev_w_a, "ev_b_a": ev_b_a,
            "ev_w_x": ev_w_x, "ev_b_x": ev_b_x, "ev_lam": ev_lam, "ev_w_out": ev_w_out,
            "od_w_in": od_w_in, "od_b_f": od_b_f, "od_w_out": od_w_out}


def reference(x, c, ada_w, ada_b, ln_g, ln_b, peer_wq, peer_keys, peer_u, peer_v,
              ev_w_in, ev_w_pool, ev_pool_scale, ev_conv_w, ev_conv_b, ev_w_a, ev_b_a,
              ev_w_x, ev_b_x, ev_lam, ev_w_out, od_w_in, od_b_f, od_w_out):
    c_act = jax.nn.silu(c)
    for l in range(DEPTH):
        mod = (c_act @ ada_w[l] + ada_b[l])[:, None, :]
        sh_m, sc_m, g_m, sh_f, sc_f, g_f = jnp.split(mod, 6, axis=-1)
        h = x * (1.0 + sc_m) + sh_m
        if l % 2 == 0:
            e = l // 2
            y = even_mixer(h, ev_w_in[e], ev_w_pool[e], ev_pool_scale[e], ev_conv_w[e],
                           ev_conv_b[e], ev_w_a[e], ev_b_a[e], ev_w_x[e], ev_b_x[e],
                           ev_lam[e], ev_w_out[e])
        else:
            o = l // 2
            y = odd_mixer(h, od_w_in[o], od_b_f[o], od_w_out[o])
        x = layer_norm(ALPHA * x + (1.0 + g_m) * y, ln_g[l, 0], ln_b[l, 0])
        h = x * (1.0 + sc_f) + sh_f
        y = peer(h, peer_wq[l], peer_keys[l], peer_u[l], peer_v[l])
        x = layer_norm(ALPHA * x + (1.0 + g_f) * y, ln_g[l, 1], ln_b[l, 1])
    return x
```

```cpp
#include <hip/hip_runtime.h>
#include <hip/hip_bf16.h>
#include <hip/hip_cooperative_groups.h>
#include <cstdio>
#include <cstdint>
#include <cmath>
namespace cg = cooperative_groups;
namespace pg8 {
#define PG8_LAS __attribute__((address_space(3)))
typedef unsigned short bf16_t;
typedef short bf16x8 __attribute__((ext_vector_type(8)));
typedef float f32x4 __attribute__((ext_vector_type(4)));
typedef unsigned u32x4 __attribute__((ext_vector_type(4)));
constexpr int BM = 256, BK = 64, HALF = 128, HTB = HALF * BK * 2  , STAGE_BYTES = 8 * HTB, NXCD = 8, WGM = 8;

__host__ __device__ __forceinline__ int lds_byte(int r, int c) { const int st = (r >> 4) * 2 + (c >> 5), rr = r & 15, cc = c & 31, ob = rr * 64 + cc * 2; return st * 1024 + (ob ^ (((ob >> 9) & 1) << 5)); }
__host__ __device__ __forceinline__ void stage_rc(int b, int& R, int& C) { const int st = b / 1024, sb = b % 1024, swz = sb ^ (((sb >> 9) & 1) << 5); R = (st >> 1) * 16 + swz / 64; C = (st & 1) * 32 + (swz % 64) / 2; }
__host__ __device__ __forceinline__ int perm32(int rho) { const int n = rho >> 4, i = rho & 15; return 8 * (i >> 2) + 4 * n + (i & 3); }

struct Unit { int pm, pn; };
struct Gemm { const bf16_t* A; const bf16_t* Bt; int M, N, K, lda, ldb; };

struct StaticOrder {
    int nM, nN, nwg, G, c;
    __host__ __device__ void init(int M, int N, int G_, int c_) { nM = M / BM; nN = N / BM; nwg = nM * nN; G = G_; c = c_; }
    __host__ __device__ bool next(int i, Unit& u) const {
        const long L = (long)i * G + c; if (L >= nwg) return false;
        int wgid = (int)L; { const int q = nwg / NXCD, r = nwg % NXCD, xcd = wgid % NXCD, off = wgid / NXCD; wgid = (xcd < r ? xcd * (q + 1) : r * (q + 1) + (xcd - r) * q) + off; }
        const int nig = WGM * nN, gid = wgid / nig, fm = gid * WGM, gsz = (nM - fm) < WGM ? (nM - fm) : WGM;
        u.pm = fm + ((wgid % nig) % gsz); u.pn = (wgid % nig) / gsz; return true;
    }
    __device__ __forceinline__ void a_ready(const Unit&) const {}
    __device__ __forceinline__ void done(const Unit&) const {}
};

__device__ __forceinline__ unsigned cvt_pk_bf16(float lo, float hi) { typedef float f2_ __attribute__((ext_vector_type(2))); typedef __bf16 b2_ __attribute__((ext_vector_type(2))); const f2_ f = {lo, hi}; return __builtin_bit_cast(unsigned, __builtin_convertvector(f, b2_)); }
typedef float f32x2 __attribute__((ext_vector_type(2)));
__device__ __forceinline__ f32x2 gelu_pk(f32x2 v) {
    const f32x2 av = __builtin_elementwise_abs(v), d = av * 0.2316418882f + 1.0f;
    f32x2 t; t.x = __builtin_amdgcn_rcpf(d.x); t.y = __builtin_amdgcn_rcpf(d.y);
    f32x2 q = t * 0.5307027145f + (-0.7265760135f); q = q * t + 0.7107068705f; q = q * t + (-0.142248368f); q = q * t + 0.127414796f; q = q * t;
    const f32x2 s = (v * v) * (-0.72134752044f);
    f32x2 e; e.x = __builtin_amdgcn_exp2f(s.x); e.y = __builtin_amdgcn_exp2f(s.y);
    const f32x2 m = v * (q * e), r = v - m;
    f32x2 o; o.x = v.x < 0.f ? m.x : r.x; o.y = v.y < 0.f ? m.y : r.y; return o;
}

template <int ACT  > struct EpiBf16 {
    static constexpr bool PERM = true, AFTER_DRAIN = false; static_assert(ACT == 0 || ACT == 1, "EpiBf16: ACT is 0 (none) or 1 (gelu_pk)");
    bf16_t* O; int ldc; const float* bias; int split_cols; size_t split_stride; float scale0;
    __device__ __forceinline__ void operator()(const f32x4 (&acc)[2][2][4][2], const Unit& u, int wr, int wc, int fr, int fq) const {
        const int row0 = u.pm * BM + wr * 64 + fr; int colt = u.pn * BM; bf16_t* base = O;
        float sc = 1.f; if (split_cols) { const int t = colt / split_cols; base += (size_t)t * split_stride; colt -= t * split_cols; if (t == 0) sc = scale0; }
        const int col0 = colt + wc * 32 + 8 * fq, bcol0 = u.pn * BM + wc * 32 + 8 * fq;
        f32x4 bv[2][2];
#pragma unroll
        for (int bj = 0; bj < 2; ++bj)
#pragma unroll
            for (int n = 0; n < 2; ++n) bv[bj][n] = bias ? *(const f32x4*)(bias + bcol0 + bj * HALF + 4 * n) : (f32x4){0.f, 0.f, 0.f, 0.f};
#pragma unroll
        for (int ai = 0; ai < 2; ++ai)
#pragma unroll
            for (int m = 0; m < 4; ++m) { bf16_t* rowp = base + (size_t)(row0 + ai * HALF + m * 16) * ldc + col0;
#pragma unroll
                for (int bj = 0; bj < 2; ++bj) { f32x4 v0 = acc[ai][bj][m][0] + bv[bj][0], v1 = acc[ai][bj][m][1] + bv[bj][1];
                    if (ACT == 1) { f32x2 a = gelu_pk((f32x2){v0[0], v0[1]}), b = gelu_pk((f32x2){v0[2], v0[3]}), c = gelu_pk((f32x2){v1[0], v1[1]}), d = gelu_pk((f32x2){v1[2], v1[3]});
                        v0 = (f32x4){a.x, a.y, b.x, b.y}; v1 = (f32x4){c.x, c.y, d.x, d.y}; }
                    v0 = v0 * sc; v1 = v1 * sc; u32x4 w; w.x = cvt_pk_bf16(v0[0], v0[1]); w.y = cvt_pk_bf16(v0[2], v0[3]); w.z = cvt_pk_bf16(v1[0], v1[1]); w.w = cvt_pk_bf16(v1[2], v1[3]);
                    *(u32x4*)(rowp + bj * HALF) = w; } }
    }
};

template <class Epi, class Sched, bool ALIGN_EPI = false, bool SP2 = false, bool FP8 = false, bool I8 = false>
__device__ __forceinline__ void gemm_phase(PG8_LAS unsigned char* lds, const Gemm g, const Sched& S, const Epi& E, const int tid) {
    const int wid = __builtin_amdgcn_readfirstlane(tid >> 6), lane = tid & 63, wr = wid >> 2, wc = wid & 3, fr = lane & 15, fq = lane >> 4;
    const int K = g.K, nt = K / BK;
    unsigned voffA[2], voffB[2];
#pragma unroll
    for (int i = 0; i < 2; ++i) { int R, C; stage_rc(tid * 16 + i * 8192, R, C); const int Rb = Epi::PERM ? ((R & ~31) + perm32(R & 31)) : R;
        voffA[i] = (unsigned)(R * g.lda + C) * 2u; voffB[i] = (unsigned)(Rb * g.ldb + C) * 2u; }
    const __amdgpu_buffer_rsrc_t rA = __builtin_amdgcn_make_buffer_rsrc((void*)g.A, 0, (int)((size_t)g.M * g.lda * 2), 0x00020000), rB = __builtin_amdgcn_make_buffer_rsrc((void*)g.Bt, 0, (int)((size_t)g.N * g.ldb * 2), 0x00020000);
    const size_t kstep = (size_t)(BK * 2);
    const size_t hstepA = (size_t)HALF * g.lda * 2, hstepB = (size_t)HALF * g.ldb * 2;
    const size_t tstepA = 2 * hstepA, tstepB = 2 * hstepB;
    const unsigned ldsw = (unsigned)wid * 1024u;
    const int aoffk[2] = {FP8 ? lds_byte(wr * 64 + fr, fq * 16) : lds_byte(wr * 64 + fr, fq * 8), FP8 ? lds_byte(wr * 64 + fr, fq * 16 + 8) : lds_byte(wr * 64 + fr, fq * 8) + 1024};
    const int boffk[2] = {FP8 ? lds_byte(wc * 32 + fr, fq * 16) : lds_byte(wc * 32 + fr, fq * 8), FP8 ? lds_byte(wc * 32 + fr, fq * 16 + 8) : lds_byte(wc * 32 + fr, fq * 8) + 1024};
#define PG8_SA(b, h) (((b) * 2 + (h)) * HTB)
#define PG8_SB(b, h) ((4 + (b) * 2 + (h)) * HTB)
#define PG8_STAGE(bufoff, gbase, voff, rs, gorig) do { _Pragma("unroll") for (int _i = 0; _i < 2; ++_i) \
        __builtin_amdgcn_raw_ptr_buffer_load_lds(rs, (PG8_LAS void*)(lds + (bufoff) + ldsw + _i * 8192), 16, (voff)[_i], (unsigned)((const char*)(gbase) - (const char*)(gorig)), 0, 0); } while (0)
#define PG8_LDA(dst, b, h) do { if constexpr (FP8) { _Pragma("unroll") for (int m = 0; m < 4; ++m) dst##8[m] = __builtin_shufflevector(*(const PG8_LAS bf16x8*)(lds + PG8_SA(b, h) + aoffk[0] + m * 2048), *(const PG8_LAS bf16x8*)(lds + PG8_SA(b, h) + aoffk[1] + m * 2048), 0, 1, 2, 3, 4, 5, 6, 7, 8, 9, 10, 11, 12, 13, 14, 15); } \
        else { _Pragma("unroll") for (int m = 0; m < 4; ++m) _Pragma("unroll") for (int k = 0; k < 2; ++k) dst[m][k] = *(const PG8_LAS bf16x8*)(lds + PG8_SA(b, h) + aoffk[k] + m * 2048); } } while (0)
#define PG8_LDB(dst, b, h) do { if constexpr (FP8) { _Pragma("unroll") for (int n = 0; n < 2; ++n) dst##8[n] = __builtin_shufflevector(*(const PG8_LAS bf16x8*)(lds + PG8_SB(b, h) + boffk[0] + n * 2048), *(const PG8_LAS bf16x8*)(lds + PG8_SB(b, h) + boffk[1] + n * 2048), 0, 1, 2, 3, 4, 5, 6, 7, 8, 9, 10, 11, 12, 13, 14, 15); } \
        else { _Pragma("unroll") for (int n = 0; n < 2; ++n) _Pragma("unroll") for (int k = 0; k < 2; ++k) dst[n][k] = *(const PG8_LAS bf16x8*)(lds + PG8_SB(b, h) + boffk[k] + n * 2048); } } while (0)
#define PG8_MMA(ai, bj, At, Bt) do { __builtin_amdgcn_s_setprio(1); _Pragma("unroll") for (int m = 0; m < 4; ++m) _Pragma("unroll") for (int n = 0; n < 2; ++n) { \
        if constexpr (FP8) { typedef int i32x8 __attribute__((ext_vector_type(8))); \
            acc[ai][bj][m][n] = __builtin_amdgcn_mfma_scale_f32_16x16x128_f8f6f4(__builtin_bit_cast(i32x8, Bt##8[n]), __builtin_bit_cast(i32x8, At##8[m]), acc[ai][bj][m][n], 0, 0, 0, 127, 0, 127); } \
        else if constexpr (I8) { typedef int i32x4_ __attribute__((ext_vector_type(4))); _Pragma("unroll") for (int k = 0; k < 2; ++k) \
            acc[ai][bj][m][n] = __builtin_bit_cast(f32x4, __builtin_amdgcn_mfma_i32_16x16x64_i8(__builtin_bit_cast(i32x4_, Bt[n][k]), __builtin_bit_cast(i32x4_, At[m][k]), __builtin_bit_cast(i32x4_, acc[ai][bj][m][n]), 0, 0, 0)); } \
        else { _Pragma("unroll") for (int k = 0; k < 2; ++k) acc[ai][bj][m][n] = __builtin_amdgcn_mfma_f32_16x16x32_bf16(Bt[n][k], At[m][k], acc[ai][bj][m][n], 0, 0, 0); } } \
        __builtin_amdgcn_s_setprio(0); } while (0)
#define PG8_WAIT_V(n) asm volatile("s_waitcnt vmcnt(" #n ")" ::: "memory")
#define PG8_WAIT_L(n) asm volatile("s_waitcnt lgkmcnt(" #n ")" ::: "memory")
#define PG8_BAR __builtin_amdgcn_s_barrier()
#define PG8_SCHED __builtin_amdgcn_sched_barrier(0)
    Unit cur, nxt; int ui = 0;
    if (!S.next(0, cur)) return;
    f32x4 acc[2][2][4][2];
#pragma unroll
    for (int a = 0; a < 2; ++a)
#pragma unroll
        for (int b = 0; b < 2; ++b)
#pragma unroll
            for (int m = 0; m < 4; ++m)
#pragma unroll
                for (int n = 0; n < 2; ++n) acc[a][b][m][n] = (f32x4){0.f, 0.f, 0.f, 0.f};
    bf16x8 At[4][2], B0[2][2], B1[2][2]; typedef short bf16x16 __attribute__((ext_vector_type(16))); bf16x16 At8[4], B08[2], B18[2];
    const char* cA = (const char*)g.A + (size_t)cur.pm * tstepA; const char* cB = (const char*)g.Bt + (size_t)cur.pn * tstepB;
    S.a_ready(cur);
    if constexpr (SP2) {
        PG8_STAGE(PG8_SB(0, 0), cB, voffB, rB, g.Bt); PG8_STAGE(PG8_SB(0, 1), cB + hstepB, voffB, rB, g.Bt); PG8_STAGE(PG8_SA(0, 0), cA, voffA, rA, g.A); PG8_STAGE(PG8_SA(0, 1), cA + hstepA, voffA, rA, g.A);
        if (wr == 1) PG8_BAR;
        PG8_WAIT_V(2); PG8_BAR;
        PG8_STAGE(PG8_SB(1, 0), cB + kstep, voffB, rB, g.Bt); PG8_STAGE(PG8_SA(1, 0), cA + kstep, voffA, rA, g.A); PG8_STAGE(PG8_SB(1, 1), cB + hstepB + kstep, voffB, rB, g.Bt);
        PG8_WAIT_V(6); PG8_BAR;
    } else {
        PG8_STAGE(PG8_SB(0, 0), cB, voffB, rB, g.Bt); PG8_STAGE(PG8_SA(0, 0), cA, voffA, rA, g.A); PG8_STAGE(PG8_SB(0, 1), cB + hstepB, voffB, rB, g.Bt); PG8_STAGE(PG8_SA(0, 1), cA + hstepA, voffA, rA, g.A);
        if (wr == 1) PG8_BAR;
        PG8_WAIT_V(4); PG8_BAR;
        PG8_STAGE(PG8_SB(1, 0), cB + kstep, voffB, rB, g.Bt); PG8_STAGE(PG8_SA(1, 0), cA + kstep, voffA, rA, g.A); PG8_STAGE(PG8_SB(1, 1), cB + hstepB + kstep, voffB, rB, g.Bt);
        PG8_WAIT_V(6); PG8_BAR;
    }
    for (;;) {
        const bool has_next = S.next(ui + 1, nxt);
        const char* nA = has_next ? (const char*)g.A + (size_t)nxt.pm * tstepA : cA; const char* nB = has_next ? (const char*)g.Bt + (size_t)nxt.pn * tstepB : cB;
        for (int t = 0; t < nt; t += 2) {
            const bool last = (t == nt - 2);
            const char* a1 = cA + (size_t)(t + 1) * kstep;
            const char* a2 = last ? nA : cA + (size_t)(t + 2) * kstep; const char* b2 = last ? nB : cB + (size_t)(t + 2) * kstep;
            const char* a3 = a2 + kstep; const char* b3 = b2 + kstep;
            if (last && has_next) S.a_ready(nxt);
            if constexpr (SP2) {
            PG8_LDB(B0, 0, 0); PG8_LDB(B1, 0, 1); PG8_SCHED; PG8_LDA(At, 0, 0); PG8_STAGE(PG8_SA(1, 1), a1 + hstepA, voffA, rA, g.A);
            PG8_WAIT_V(8); PG8_WAIT_L(0); PG8_BAR; PG8_MMA(0, 0, At, B0); PG8_MMA(0, 1, At, B1); PG8_BAR; PG8_SCHED;
            PG8_LDA(At, 0, 1); PG8_STAGE(PG8_SB(0, 0), b2, voffB, rB, g.Bt); PG8_STAGE(PG8_SB(0, 1), b2 + hstepB, voffB, rB, g.Bt); PG8_STAGE(PG8_SA(0, 0), a2, voffA, rA, g.A);
            PG8_WAIT_V(8); PG8_WAIT_L(0); PG8_BAR; PG8_MMA(1, 0, At, B0); PG8_MMA(1, 1, At, B1); PG8_BAR; PG8_SCHED;
            PG8_LDB(B0, 1, 0); PG8_LDB(B1, 1, 1); PG8_SCHED; PG8_LDA(At, 1, 0); PG8_STAGE(PG8_SA(0, 1), a2 + hstepA, voffA, rA, g.A);
            PG8_WAIT_V(8); PG8_WAIT_L(0); PG8_BAR; PG8_MMA(0, 0, At, B0); PG8_MMA(0, 1, At, B1); PG8_BAR; PG8_SCHED;
            PG8_LDA(At, 1, 1); PG8_STAGE(PG8_SB(1, 0), b3, voffB, rB, g.Bt); PG8_STAGE(PG8_SB(1, 1), b3 + hstepB, voffB, rB, g.Bt); PG8_STAGE(PG8_SA(1, 0), a3, voffA, rA, g.A);
            PG8_WAIT_V(8); PG8_WAIT_L(0); PG8_BAR; PG8_MMA(1, 0, At, B0); PG8_MMA(1, 1, At, B1); PG8_BAR; PG8_SCHED;
            } else {
            PG8_LDB(B0, 0, 0); PG8_SCHED; PG8_LDA(At, 0, 0); PG8_STAGE(PG8_SA(1, 1), a1 + hstepA, voffA, rA, g.A);
            PG8_WAIT_L(8); PG8_BAR; PG8_WAIT_L(0); PG8_MMA(0, 0, At, B0); PG8_BAR; PG8_SCHED;
            PG8_LDB(B1, 0, 1); PG8_STAGE(PG8_SB(0, 0), b2, voffB, rB, g.Bt);
            PG8_BAR; PG8_WAIT_L(0); PG8_MMA(0, 1, At, B1); PG8_BAR;
            PG8_LDA(At, 0, 1); PG8_STAGE(PG8_SA(0, 0), a2, voffA, rA, g.A);
            PG8_BAR; PG8_WAIT_L(0); PG8_MMA(1, 0, At, B0); PG8_BAR; PG8_SCHED;
            PG8_STAGE(PG8_SB(0, 1), b2 + hstepB, voffB, rB, g.Bt);
            PG8_WAIT_V(6); PG8_BAR; PG8_MMA(1, 1, At, B1); PG8_BAR;
            PG8_LDB(B0, 1, 0); PG8_SCHED; PG8_LDA(At, 1, 0); PG8_STAGE(PG8_SA(0, 1), a2 + hstepA, voffA, rA, g.A);
            PG8_WAIT_L(8); PG8_BAR; PG8_WAIT_L(0); PG8_MMA(0, 0, At, B0); PG8_BAR; PG8_SCHED;
            PG8_LDB(B1, 1, 1); PG8_STAGE(PG8_SB(1, 0), b3, voffB, rB, g.Bt);
            PG8_BAR; PG8_WAIT_L(0); PG8_MMA(0, 1, At, B1); PG8_BAR;
            PG8_LDA(At, 1, 1); PG8_STAGE(PG8_SA(1, 0), a3, voffA, rA, g.A);
            PG8_BAR; PG8_WAIT_L(0); PG8_MMA(1, 0, At, B0); PG8_BAR; PG8_SCHED;
            PG8_STAGE(PG8_SB(1, 1), b3 + hstepB, voffB, rB, g.Bt);
            PG8_WAIT_V(6); PG8_BAR; PG8_MMA(1, 1, At, B1); PG8_BAR;
            }
        }
        if constexpr (ALIGN_EPI) { if (wr == 0) PG8_BAR; }
        if constexpr (!Epi::AFTER_DRAIN) { E(acc, cur, wr, wc, fr, fq); S.done(cur); }
        if (!has_next) break;
#pragma unroll
        for (int a = 0; a < 2; ++a)
#pragma unroll
            for (int b = 0; b < 2; ++b)
#pragma unroll
                for (int m = 0; m < 4; ++m)
#pragma unroll
                    for (int n = 0; n < 2; ++n) acc[a][b][m][n] = (f32x4){0.f, 0.f, 0.f, 0.f};
        cur = nxt; cA = nA; cB = nB; ++ui;
        if constexpr (ALIGN_EPI) { if (wr == 1) PG8_BAR; }
    }
    PG8_WAIT_V(0);
    if constexpr (!ALIGN_EPI) { if (wr == 0) PG8_BAR; }
    PG8_BAR;
    if constexpr (Epi::AFTER_DRAIN) { E.fused(acc, cur, wr, wc, fr, fq, lds, wid, lane); S.done(cur); }
#undef PG8_SA
#undef PG8_SB
#undef PG8_STAGE
#undef PG8_LDA
#undef PG8_LDB
#undef PG8_MMA
#undef PG8_WAIT_V
#undef PG8_WAIT_L
#undef PG8_BAR
#undef PG8_SCHED
}
}

namespace attn {
constexpr float SCALE = 0.08838834764831845f;
constexpr int D = 128, PITCH = 2048;
constexpr float THR = 8.f; constexpr bool WSKIP = true; constexpr bool O_FP8 = true; constexpr float O8_SCALE = 16.f;
constexpr int NW = 8, QBLK = 32, KVBLK = 64, QB = NW * QBLK;
constexpr int SHM_V = KVBLK * D * 2, SHM_K = KVBLK * D * 2;
constexpr int LDS_BIAS = 2 * SHM_V + 2 * SHM_K + NW * 64 * 4;
constexpr int LDS_BYTES = LDS_BIAS + 2 * 256;
using bf16 = __hip_bfloat16;
typedef short bf16x8 __attribute__((ext_vector_type(8)));
typedef short s16x4 __attribute__((ext_vector_type(4)));
typedef float f32x16 __attribute__((ext_vector_type(16)));
typedef float f32x4 __attribute__((ext_vector_type(4)));
typedef unsigned u32x4 __attribute__((ext_vector_type(4)));
template <class A, class Bt> struct same_t { static constexpr bool v = false; };
template <class A> struct same_t<A, A> { static constexpr bool v = true; };

#define KSWZ(row, colB) ((row) * 256 + ((colB) ^ (((row) & 7) << 4)))
#define SBAR() __builtin_amdgcn_sched_barrier(0)
__device__ __forceinline__ int v_st(int k, int c) { const int kk = (k & ~0xC) | ((k & 4) << 1) | ((k & 8) >> 1); return ((kk >> 3) * 4 + (c >> 5)) * 512 + ((kk & 7) * 32 + (c & 31)) * 2; }
__device__ __forceinline__ int v_rd_base(int lane) { return ((lane & 3) << 3) | (((lane >> 2) & 3) << 6) | (((lane >> 4) & 1) << 5) | (((lane >> 5) & 1) << 8); }
constexpr int v_rd_off(int d0, int ks, int half) { return d0 * 512 + ks * 4096 + half * 2048; }
__device__ __forceinline__ int crow(int r, int hi) { return (r & 3) + 8 * (r >> 2) + 4 * hi; }
__device__ __forceinline__ unsigned cvtpk(float lo, float hi) {
    typedef float f2_ __attribute__((ext_vector_type(2))); typedef __bf16 b2_ __attribute__((ext_vector_type(2))); const f2_ f = {lo, hi}; return __builtin_bit_cast(unsigned, __builtin_convertvector(f, b2_));
}
__device__ __forceinline__ bf16x8 pack8(f32x4 a, f32x4 b) {
    u32x4 w = {cvtpk(a[0], a[1]), cvtpk(a[2], a[3]), cvtpk(b[0], b[1]), cvtpk(b[2], b[3])};
    return *reinterpret_cast<bf16x8*>(&w);
}
template <class T> __device__ __forceinline__ bf16x8 load8(const T* p) {
    if constexpr (same_t<T, float>::v) { return pack8(*(const f32x4*)p, *(const f32x4*)(p + 4)); }
    else { return *reinterpret_cast<const bf16x8*>(p); }
}
__device__ __forceinline__ void mask_tile(f32x16& p0, f32x16& p1, int dq, unsigned W) {
    const float NEG = -__builtin_inff();
#pragma unroll
    for (int r = 0; r < 16; ++r) {
        const int c = (r & 3) + 8 * (r >> 2);
        if ((unsigned)(dq - c) >= W) p0[r] = NEG;
        if ((unsigned)(dq - c - 32) >= W) p1[r] = NEG;
    }
}
constexpr float DEAD_T = 20.f;
__device__ __forceinline__ void partialSM(f32x16& p0, f32x16& p1, float& m_reg, float& mn, float& alpha, bool& dead) {
    float pmax = p0[0]; for (int r = 1; r < 16; ++r) pmax = fmaxf(pmax, p0[r]); for (int r = 0; r < 16; ++r) pmax = fmaxf(pmax, p1[r]);
    { auto rr = __builtin_amdgcn_permlane32_swap(__float_as_uint(pmax), __float_as_uint(pmax), false, false);
      pmax = fmaxf(__uint_as_float(rr[0]), __uint_as_float(rr[1])); }
    constexpr float C2 = 1.4426950408889634f * SCALE;
    dead = __all((pmax - m_reg) * SCALE < -DEAD_T);
    if (dead) { mn = m_reg; alpha = 1.f; return; }
    if (__builtin_expect(__all((pmax - m_reg) * SCALE <= THR), 1)) { mn = m_reg; alpha = 1.f; }
    else { mn = fmaxf(m_reg, pmax); alpha = __builtin_amdgcn_exp2f((m_reg - mn) * C2); m_reg = mn; }
    const float mnL = -mn * C2;
    for (int r = 0; r < 16; ++r) p0[r] = fmaf(p0[r], C2, mnL); for (int r = 0; r < 16; ++r) p1[r] = fmaf(p1[r], C2, mnL);
    for (int r = 0; r < 16; ++r) p0[r] = __builtin_amdgcn_exp2f(p0[r]);
}
__device__ __forceinline__ void finishSM(f32x16& p0, f32x16& p1, float alpha, float& l_reg, bf16x8& pa0, bf16x8& pa1, bf16x8& pa2, bf16x8& pa3) {
    for (int r = 0; r < 16; ++r) p1[r] = __builtin_amdgcn_exp2f(p1[r]);
    float ps = 0; for (int r = 0; r < 16; ++r) ps += p0[r]; for (int r = 0; r < 16; ++r) ps += p1[r];
    { auto rr = __builtin_amdgcn_permlane32_swap(__float_as_uint(ps), __float_as_uint(ps), false, false);
      ps = __uint_as_float(rr[0]) + __uint_as_float(rr[1]); }
    l_reg = l_reg * alpha + ps;
#define PK4(P, B_, OUT) do { unsigned a0 = cvtpk(P[B_+0], P[B_+1]), a1 = cvtpk(P[B_+2], P[B_+3]);                          \
        unsigned b0 = cvtpk(P[B_+4], P[B_+5]), b1 = cvtpk(P[B_+6], P[B_+7]);                                             \
        auto r0 = __builtin_amdgcn_permlane32_swap(a0, b0, false, false); auto r1 = __builtin_amdgcn_permlane32_swap(a1, b1, false, false); \
        u32x4 w = {r0[0], r1[0], r0[1], r1[1]}; OUT = *reinterpret_cast<bf16x8*>(&w); } while (0)
    PK4(p0, 0, pa0); PK4(p0, 8, pa1); PK4(p1, 0, pa2); PK4(p1, 8, pa3);
#undef PK4
}
template <int KB, bool SK>
__device__ __forceinline__ void qkt(f32x16& p0, f32x16& p1, const char* K_lds, int r32, int hi, const bf16x8* qr, bool act) {
    const float* bl = (const float*)(K_lds - 2 * SHM_V + LDS_BIAS + KB * 256) + 4 * hi;
    if (SK && !act) { const float NEG = -__builtin_inff();
#pragma unroll
        for (int r = 0; r < 16; ++r) { p0[r] = NEG; p1[r] = NEG; } return; }
#pragma unroll
    for (int g_ = 0; g_ < 4; ++g_) { const f32x4 b0_ = *(const f32x4*)(bl + 8 * g_), b1_ = *(const f32x4*)(bl + 32 + 8 * g_);
#pragma unroll
        for (int e_ = 0; e_ < 4; ++e_) { p0[4 * g_ + e_] = b0_[e_]; p1[4 * g_ + e_] = b1_[e_]; } }
    const char* kb[4];
#pragma unroll
    for (int dd = 0; dd < 4; ++dd) kb[dd] = K_lds + KB * SHM_K + KSWZ(r32, (dd * 16 + hi * 8) * 2);
#pragma unroll
    for (int d0 = 0; d0 < 8; ++d0) { const char* a = kb[d0 & 3] + (d0 >> 2) * 128;
        bf16x8 b0 = *reinterpret_cast<const bf16x8*>(a);
        bf16x8 b1 = *reinterpret_cast<const bf16x8*>(a + 32 * 256);
        p0 = __builtin_amdgcn_mfma_f32_32x32x16_bf16(b0, qr[d0], p0, 0, 0, 0);
        p1 = __builtin_amdgcn_mfma_f32_32x32x16_bf16(b1, qr[d0], p1, 0, 0, 0); }
}
template <int VB, bool SK>
__device__ __forceinline__ void pv_tile(f32x16* o, int vb0, bf16x8 pa0, bf16x8 pa1, bf16x8 pa2, bf16x8 pa3, bool act) {
    if (SK && !act) return;
#define TRRD(dst, off) asm volatile("ds_read_b64_tr_b16 %0, %1 offset:%2" : "=&v"(dst) : "v"(vb0), "i"(off) : "memory")
#define PV_D0(d0) do { s16x4 l0, l1, l2, l3, h0, h1, h2, h3; constexpr int b_ = VB * SHM_V + v_rd_off(d0, 0, 0);     \
        TRRD(l0, b_); TRRD(h0, b_ + 2048); TRRD(l1, b_ + 4096); TRRD(h1, b_ + 6144); TRRD(l2, b_ + 8192); TRRD(h2, b_ + 10240); TRRD(l3, b_ + 12288); TRRD(h3, b_ + 14336); \
        asm volatile("s_waitcnt lgkmcnt(0)" ::: "memory"); SBAR();                 \
        o[d0] = __builtin_amdgcn_mfma_f32_32x32x16_bf16(pa0, (bf16x8){l0[0], l0[1], l0[2], l0[3], h0[0], h0[1], h0[2], h0[3]}, o[d0], 0, 0, 0);   \
        o[d0] = __builtin_amdgcn_mfma_f32_32x32x16_bf16(pa1, (bf16x8){l1[0], l1[1], l1[2], l1[3], h1[0], h1[1], h1[2], h1[3]}, o[d0], 0, 0, 0);   \
        o[d0] = __builtin_amdgcn_mfma_f32_32x32x16_bf16(pa2, (bf16x8){l2[0], l2[1], l2[2], l2[3], h2[0], h2[1], h2[2], h2[3]}, o[d0], 0, 0, 0);   \
        o[d0] = __builtin_amdgcn_mfma_f32_32x32x16_bf16(pa3, (bf16x8){l3[0], l3[1], l3[2], l3[3], h3[0], h3[1], h3[2], h3[3]}, o[d0], 0, 0, 0); } while (0)
    PV_D0(0); PV_D0(1); PV_D0(2); PV_D0(3);
#undef PV_D0
#undef TRRD
}

template <class TIn, class TOut> struct BlockRef { const TIn* Q; const TIn* K; const TIn* V; TOut* O; const float* Fb; int P0; int jlo; unsigned char* O8; };
template <class TIn> struct Seam {
    bf16x8 qr[8];
    bf16x8 st_v0, st_v1, st_k0, st_k1; f32x4 sf0, sf1, sf2, sf3;
    f32x4 tq[16];
};
__device__ __forceinline__ int swa_jlo(int P0, int W) { const int lowk = P0 - W + 1; return lowk > 0 ? lowk / KVBLK : 0; }
#define ROW(p, k0, rr) ((const TIn*)((const char*)(p) + (unsigned)((((k0) + (rr)) * PITCH + sc) * (int)sizeof(TIn))))
#define VMW() asm volatile("s_waitcnt vmcnt(0)" ::: "memory")
#define VMWN(n) asm volatile("s_waitcnt vmcnt(%0)" :: "i"(n) : "memory")
#define SLOAD_H(Kp, Vp, Fp, bb, k0) do { S.st_v0 = load8<TIn>(ROW(Vp, k0, sr)); S.st_v1 = load8<TIn>(ROW(Vp, k0, 32 + sr));              \
                         S.st_k0 = load8<TIn>(ROW(Kp, k0, sr)); S.st_k1 = load8<TIn>(ROW(Kp, k0, 32 + sr));                          \
                         if (wid == 0) __builtin_amdgcn_global_load_lds((const unsigned*)((Fp) + (k0) + lane), (__attribute__((address_space(3))) unsigned*)(lds + LDS_BIAS + (bb) * 256), 4, 0, 0); } while (0)
#define SWRITE_HK(bf) do { int t_ = tid; asm volatile("" : "+v"(t_)); const int kws_ = KSWZ(t_ >> 4, (t_ & 15) * 16);     \
        *(bf16x8*)(K_lds + (bf) * SHM_K + kws_) = S.st_k0; *(bf16x8*)(K_lds + (bf) * SHM_K + kws_ + 32 * 256) = S.st_k1; } while (0)
#define SWRITE_HV(bf) do { int t_ = tid; asm volatile("" : "+v"(t_)); const int vst0_ = v_st(t_ >> 4, (t_ & 15) * 8), vst1_ = v_st(32 + (t_ >> 4), (t_ & 15) * 8); \
        *(bf16x8*)(V_lds + (bf) * SHM_V + vst0_) = S.st_v0; *(bf16x8*)(V_lds + (bf) * SHM_V + vst1_) = S.st_v1; } while (0)
#define SWRITE_H(bf) do { SWRITE_HV(bf); SWRITE_HK(bf); } while (0)
#define SLOAD_F(p, k0) do { S.sf0 = *(const f32x4*)ROW(p, k0, sr); S.sf1 = *(const f32x4*)(ROW(p, k0, sr) + 4);                \
                            S.sf2 = *(const f32x4*)ROW(p, k0, 32 + sr); S.sf3 = *(const f32x4*)(ROW(p, k0, 32 + sr) + 4); } while (0)
#define SWRITE_KF(bf) do { *(bf16x8*)(K_lds + (bf) * SHM_K + kws) = pack8(S.sf0, S.sf1); *(bf16x8*)(K_lds + (bf) * SHM_K + kws + 32 * 256) = pack8(S.sf2, S.sf3); } while (0)
#define SWRITE_VF(bf) do { *(bf16x8*)(V_lds + (bf) * SHM_V + vst0) = pack8(S.sf0, S.sf1); *(bf16x8*)(V_lds + (bf) * SHM_V + vst1) = pack8(S.sf2, S.sf3); } while (0)
template <class TIn, class TOut>
__device__ __forceinline__ void causal_swa_prime(const BlockRef<TIn, TOut>& cur, int W, char* lds, Seam<TIn>& S, const int tid) {
    constexpr bool F32 = same_t<TIn, float>::v;
    const int wid = __builtin_amdgcn_readfirstlane(tid >> 6), lane = tid & 63, r32 = lane & 31, hi = lane >> 5;
    const int sr = tid >> 4, sc = (tid & 15) * 8, kws = KSWZ(sr, sc * 2); char* K_lds = lds + 2 * SHM_V;
    const int kb0 = ((cur.P0 + QB - 1) / KVBLK) * KVBLK;
    for (int d0 = 0; d0 < 8; ++d0) S.qr[d0] = load8<TIn>(cur.Q + (size_t)(wid * QBLK + r32) * PITCH + d0 * 16 + hi * 8);
    if constexpr (F32) { SLOAD_F((const float*)cur.K, kb0); VMW(); SWRITE_KF(0); SBAR(); SLOAD_F((const float*)cur.V, kb0); }
    else { SLOAD_H(cur.K, cur.V, cur.Fb, 0, kb0); VMW(); SWRITE_HK(0); }
    __syncthreads();
}
template <class TIn, class TOut>
__device__ __forceinline__ void causal_swa_block(const BlockRef<TIn, TOut>& cur, const BlockRef<TIn, TOut>& nxt, int skv, int W, char* lds, Seam<TIn>& S, const int tid) {
    constexpr bool F32 = same_t<TIn, float>::v;
    const int wid = __builtin_amdgcn_readfirstlane(tid >> 6), lane = tid & 63, r32 = lane & 31, hi = lane >> 5;
    const int j_lo = cur.jlo;
    int j_hi = (cur.P0 + QB - 1) / KVBLK + 1; if (j_hi > skv / KVBLK) j_hi = skv / KVBLK;
    const int NT = j_hi - j_lo;
    const int kbn = ((nxt.P0 + QB - 1) / KVBLK) * KVBLK;
    const int qlo = cur.P0 + wid * QBLK, qm = qlo + r32 - 4 * hi;
    char* V_lds = lds; char* K_lds = lds + 2 * SHM_V;
    float* ws = (float*)(lds + 2 * SHM_V + 2 * SHM_K) + wid * 64; float* li_l = ws, * al_l = ws + 32;
    float m_reg = -1e30f, l_reg = 0; f32x16 o[4] = {};
    const int sr = tid >> 4, sc = (tid & 15) * 8, vst0 = v_st(sr, sc), vst1 = v_st(32 + sr, sc), kws = KSWZ(sr, sc * 2);
    const int vb0 = (int)(uintptr_t)V_lds + v_rd_base(lane);
    const TIn* Kh = cur.K; const TIn* Vh = cur.V;
#define RESC(a) do { if (__any((a) < 1.f)) { if (hi == 0) al_l[r32] = (a); asm volatile("s_waitcnt lgkmcnt(0)" ::: "memory");              \
                     for (int d_ = 0; d_ < 4; ++d_) for (int r = 0; r < 16; ++r) o[d_][r] *= al_l[crow(r, hi)]; } } while (0)
#define KBASE(t) ((j_hi - 1 - (t)) * KVBLK)
#define ACT(t) (KBASE(t) <= qlo + QBLK - 1 && KBASE(t) + KVBLK - 1 >= qlo - W + 1)
#define MASKT(P0_, P1_, t) do { const int kb_ = KBASE(t); if ((!SK || ACT(t)) && (kb_ + KVBLK - 1 > qlo || kb_ <= qlo + QBLK - 1 - W)) mask_tile(P0_, P1_, qm - kb_, (unsigned)W); } while (0)
    constexpr int NQL = F32 ? 16 : 8;
    constexpr bool SK = WSKIP && !F32;
#define SEAM_K0() do { VMWN(NQL); if constexpr (F32) { SWRITE_KF(0); SBAR(); SLOAD_F((const float*)nxt.V, kbn); } else { SWRITE_HK(0); } SBAR(); } while (0)
    f32x16 pA0, pA1, pB0, pB1; float mnA, mnB, alA, alB; bf16x8 pa0, pa1, pa2, pa3; bool deadA = false, deadB = false;
    if constexpr (F32) { VMW(); SWRITE_VF(0); SBAR(); } else { SWRITE_HV(0); SBAR(); }
    if (NT > 1) { if constexpr (F32) SLOAD_F((const float*)Kh, KBASE(1)); else SLOAD_H(Kh, Vh, cur.Fb, 1, KBASE(1)); }
    SBAR(); qkt<0, SK>(pA0, pA1, K_lds, r32, hi, S.qr, ACT(0));
    if constexpr (F32) { if (NT > 1) { VMW(); SWRITE_KF(1); SBAR(); SLOAD_F((const float*)Vh, KBASE(1)); } }
    MASKT(pA0, pA1, 0); partialSM(pA0, pA1, m_reg, mnA, alA, deadA);
    if (NT > 1) { VMW(); if constexpr (F32) { SWRITE_VF(1); SBAR(); if (NT > 2) SLOAD_F((const float*)Kh, KBASE(2)); } else SWRITE_H(1); }
    __syncthreads();
#define HALF_STEP(PX0, PX1, mnX, alX, deadX, PY0, PY1, alY, deadY, t, KB, VB, SB) do {                                                      \
        SBAR(); qkt<KB, SK>(PX0, PX1, K_lds, r32, hi, S.qr, ACT(t));                                             \
        if (!deadY) finishSM(PY0, PY1, alY, l_reg, pa0, pa1, pa2, pa3); SBAR();                                               \
        if ((t) + 1 < NT) { if constexpr (F32) { VMW(); SWRITE_KF(SB); SBAR(); SLOAD_F((const float*)Vh, KBASE((t) + 1)); }  \
                            else { SLOAD_H(Kh, Vh, cur.Fb, SB, KBASE((t) + 1)); } SBAR(); }                                               \
        pv_tile<VB, SK>(o, vb0, pa0, pa1, pa2, pa3, ACT((t) - 1) && !deadY); MASKT(PX0, PX1, (t)); partialSM(PX0, PX1, m_reg, mnX, alX, deadX);                                        \
        __syncthreads();                                                                                                      \
        if ((t) + 1 < NT) { VMW(); if constexpr (F32) { SWRITE_VF(SB); SBAR(); if ((t) + 2 < NT) SLOAD_F((const float*)Kh, KBASE((t) + 2)); } \
                            else { SWRITE_H(SB); } }                                                                          \
        RESC(alX); __syncthreads(); } while (0)
    for (int t = 1; t + 1 < NT; t += 2) {
        HALF_STEP(pB0, pB1, mnB, alB, deadB, pA0, pA1, alA, deadA, t, 1, 0, 0);
        HALF_STEP(pA0, pA1, mnA, alA, deadA, pB0, pB1, alB, deadB, t + 1, 0, 1, 1);
    }
    const bool even = (NT & 1) == 0;
    if (even) { SBAR(); qkt<1, SK>(pB0, pB1, K_lds, r32, hi, S.qr, ACT(NT - 1)); SBAR(); }
#define QROW(e) (nxt.Q + (size_t)(wid * QBLK + r32) * PITCH + ((e) >> 1) * 16 + hi * 8 + ((e) & 1) * 4)
    if constexpr (F32) { SLOAD_F((const float*)nxt.K, kbn); SBAR();
#pragma unroll
        for (int e = 0; e < 8; ++e) S.tq[e] = *(const f32x4*)QROW(e); }
    else { SLOAD_H(nxt.K, nxt.V, nxt.Fb, 0, kbn); SBAR();
#pragma unroll
        for (int d0 = 0; d0 < 8; ++d0) S.qr[d0] = load8<TIn>(nxt.Q + (size_t)(wid * QBLK + r32) * PITCH + d0 * 16 + hi * 8); }
    SBAR();
    if (!deadA) finishSM(pA0, pA1, alA, l_reg, pa0, pa1, pa2, pa3); SBAR();
    if constexpr (F32) {
#pragma unroll
        for (int e = 8; e < 16; ++e) S.tq[e] = *(const f32x4*)QROW(e); SBAR(); }
#undef QROW
    pv_tile<0, SK>(o, vb0, pa0, pa1, pa2, pa3, ACT(even ? NT - 2 : NT - 1) && !deadA);
    if (even) { MASKT(pB0, pB1, NT - 1); partialSM(pB0, pB1, m_reg, mnB, alB, deadB); __syncthreads(); RESC(alB);
        if (!deadB) finishSM(pB0, pB1, alB, l_reg, pa0, pa1, pa2, pa3); SBAR(); pv_tile<1, SK>(o, vb0, pa0, pa1, pa2, pa3, ACT(NT - 1) && !deadB); }
    SBAR(); SEAM_K0();
    if (hi == 0) li_l[r32] = l_reg; asm volatile("s_waitcnt lgkmcnt(0)" ::: "memory");
    float rli[16];
#pragma unroll
    for (int r = 0; r < 16; ++r) rli[r] = __builtin_amdgcn_rcpf(li_l[crow(r, hi)]);
    TOut* Ow = cur.O + (size_t)(wid * QBLK) * PITCH;
#pragma unroll
    for (int r = 0; r < 16; ++r) { const int orow = crow(r, hi);
#pragma unroll
        for (int d0 = 0; d0 < 4; ++d0) { const float v = o[d0][r] * rli[r];
            if constexpr (same_t<TOut, float>::v) { Ow[(size_t)orow * PITCH + d0 * 32 + r32] = v; }
            else if constexpr (O_FP8) { const float vs = fminf(fmaxf(v * O8_SCALE, -440.f), 440.f), t1 = __shfl_xor(vs, 1), t2 = __shfl_xor(vs, 2), t3 = __shfl_xor(t1, 2);
                   unsigned w8 = 0u; w8 = __builtin_amdgcn_cvt_pk_fp8_f32(vs, t1, w8, false); w8 = __builtin_amdgcn_cvt_pk_fp8_f32(t2, t3, w8, true);
                   if ((r32 & 3) == 0) *(unsigned*)(cur.O8 + (size_t)(wid * QBLK + orow) * PITCH + d0 * 32 + r32) = w8; }
            else { const float vn = __shfl_xor(v, 1);
                   if ((r32 & 1) == 0) *(unsigned*)(Ow + (size_t)orow * PITCH + d0 * 32 + r32) = cvtpk(v, vn); } } }
    if constexpr (F32) {
#pragma unroll
        for (int d0 = 0; d0 < 8; ++d0) S.qr[d0] = pack8(S.tq[2 * d0], S.tq[2 * d0 + 1]); }
    __syncthreads();
#undef RESC
#undef KBASE
#undef ACT
#undef MASKT
#undef SEAM_K0
#undef HALF_STEP
}
#undef ROW
#undef VMW
#undef VMWN
#undef SLOAD_H
#undef SWRITE_HK
#undef SWRITE_HV
#undef SWRITE_H
#undef SLOAD_F
#undef SWRITE_KF
#undef SWRITE_VF


enum { ORDER_NATURAL = 0, ORDER_REVERSED = 1, ORDER_PAIRED = 2, ORDER_XCD = 4 };
__host__ __device__ inline int swa_nramp(int nqb, int W, int qoff) { const int t = W - 1 - qoff; const int n = t < 0 ? 0 : t / QB + 1; return n > nqb ? nqb : n; }
__host__ __device__ inline int swa_nx(int nqb, int nramp, int order) { return (order & ORDER_PAIRED) ? (nramp + 1) / 2 + (nqb - nramp) : nqb; }
struct SwaItem { int bh, qb0, qb1; };
__device__ __forceinline__ SwaItem swa_decode(int L, int nb, int nh, int nhkv, int nqb, int nx, int nramp, int order) {
    const int G = nh / nhkv; SwaItem it; int x;
    if ((order & ORDER_XCD) && (nb * nhkv) % 8 == 0) { const int xcd = L & 7, k = L >> 3, per = G * nx, gi = k / per, r = k - gi * per;
        it.bh = (gi * 8 + xcd) * G + r / nx; x = r % nx; }
    else { it.bh = L / nx; x = L - it.bh * nx; }
    if (order & ORDER_PAIRED) { const int ns = nqb - nramp;
        if (x < ns) { it.qb0 = it.qb1 = nqb - 1 - x; } else { it.qb0 = x - ns; it.qb1 = nramp - 1 - it.qb0; } }
    else { it.qb0 = it.qb1 = ((order & 3) == ORDER_REVERSED) ? nqb - 1 - x : x; }
    return it;
}

}

namespace pg8 {
struct ListOrder {
    int pm0, n;
    __device__ bool next(int i, Unit& u) const { if (i >= n) return false; u.pm = pm0 + i; u.pn = 0; return true; }
    __device__ __forceinline__ void a_ready(const Unit&) const {}
    __device__ __forceinline__ void done(const Unit&) const {}
};
struct EpiScaleBf16 {
    static constexpr bool PERM = true, AFTER_DRAIN = false;
    unsigned char* O; int ldc; const float* colscale; float os;
    __device__ __forceinline__ void operator()(const f32x4 (&acc)[2][2][4][2], const Unit& u, int wr, int wc, int fr, int fq) const {
        const int row0 = u.pm * BM + wr * 64 + fr; int col0 = u.pn * BM + wc * 32 + 8 * fq; asm volatile("" : "+v"(col0));
        f32x4 sv[2][2];
#pragma unroll
        for (int bj = 0; bj < 2; ++bj)
#pragma unroll
            for (int n = 0; n < 2; ++n) sv[bj][n] = *(const f32x4*)(colscale + col0 + bj * HALF + 4 * n) * os;
#pragma unroll
        for (int ai = 0; ai < 2; ++ai)
#pragma unroll
            for (int m = 0; m < 4; ++m) { unsigned char* rowp = O + (size_t)(row0 + ai * HALF + m * 16) * ldc + col0;
#pragma unroll
                for (int bj = 0; bj < 2; ++bj) { const f32x4 v0 = acc[ai][bj][m][0] * sv[bj][0], v1 = acc[ai][bj][m][1] * sv[bj][1];
                    unsigned w0 = 0u, w1 = 0u;
                    w0 = __builtin_amdgcn_cvt_pk_fp8_f32(fminf(fmaxf(v0[0], -440.f), 440.f), fminf(fmaxf(v0[1], -440.f), 440.f), w0, false); w0 = __builtin_amdgcn_cvt_pk_fp8_f32(fminf(fmaxf(v0[2], -440.f), 440.f), fminf(fmaxf(v0[3], -440.f), 440.f), w0, true);
                    w1 = __builtin_amdgcn_cvt_pk_fp8_f32(fminf(fmaxf(v1[0], -440.f), 440.f), fminf(fmaxf(v1[1], -440.f), 440.f), w1, false); w1 = __builtin_amdgcn_cvt_pk_fp8_f32(fminf(fmaxf(v1[2], -440.f), 440.f), fminf(fmaxf(v1[3], -440.f), 440.f), w1, true);
                    typedef unsigned u32x2_ __attribute__((ext_vector_type(2))); *(u32x2_*)(rowp + bj * HALF) = (u32x2_){w0, w1}; } }
    }
};
struct EpiRowScaleBf16 {
    static constexpr bool PERM = true, AFTER_DRAIN = false;
    bf16_t* O; int ldc; const float* rs; float cs; int split_cols; size_t split_stride;
    __device__ __forceinline__ void operator()(const f32x4 (&acc)[2][2][4][2], const Unit& u, int wr, int wc, int fr, int fq) const {
        int ln_; asm volatile("v_mbcnt_lo_u32_b32 %0, -1, 0\n\tv_mbcnt_hi_u32_b32 %0, -1, %0" : "=v"(ln_));
        (void)fr; (void)fq; const int row0 = u.pm * BM + wr * 64 + (ln_ & 15); int colt = u.pn * BM; bf16_t* base = O;
        if (split_cols) { const int t = colt / split_cols; base += (size_t)t * split_stride; colt -= t * split_cols; }
        const int col0 = colt + wc * 32 + 8 * (ln_ >> 4);
#pragma unroll
        for (int ai = 0; ai < 2; ++ai)
#pragma unroll
            for (int m = 0; m < 4; ++m) { const int row = row0 + ai * HALF + m * 16; const float sc = rs ? rs[row] * cs : cs; bf16_t* rowp = base + (size_t)row * ldc + col0;
#pragma unroll
                for (int bj = 0; bj < 2; ++bj) { const f32x4 v0 = acc[ai][bj][m][0] * sc, v1 = acc[ai][bj][m][1] * sc;
                    u32x4 w; w.x = cvt_pk_bf16(v0[0], v0[1]); w.y = cvt_pk_bf16(v0[2], v0[3]); w.z = cvt_pk_bf16(v1[0], v1[1]); w.w = cvt_pk_bf16(v1[2], v1[3]);
                    *(u32x4*)(rowp + bj * HALF) = w; } }
    }
};
struct EpiI8RowScaleBf16 {
    static constexpr bool PERM = true, AFTER_DRAIN = false;
    bf16_t* O; int ldc; const float* rs; float cs; int split_cols; size_t split_stride;
    __device__ __forceinline__ void operator()(const f32x4 (&acc)[2][2][4][2], const Unit& u, int wr, int wc, int fr, int fq) const {
        int ln_; asm volatile("v_mbcnt_lo_u32_b32 %0, -1, 0\n\tv_mbcnt_hi_u32_b32 %0, -1, %0" : "=v"(ln_));
        (void)fr; (void)fq; const int row0 = u.pm * BM + wr * 64 + (ln_ & 15); int colt = u.pn * BM; bf16_t* base = O;
        if (split_cols) { const int t = colt / split_cols; base += (size_t)t * split_stride; colt -= t * split_cols; }
        const int col0 = colt + wc * 32 + 8 * (ln_ >> 4);
#pragma unroll
        for (int ai = 0; ai < 2; ++ai)
#pragma unroll
            for (int m = 0; m < 4; ++m) { const int row = row0 + ai * HALF + m * 16; const float sc = rs[row] * cs; bf16_t* rowp = base + (size_t)row * ldc + col0;
#pragma unroll
                for (int bj = 0; bj < 2; ++bj) { typedef int i32x4_ __attribute__((ext_vector_type(4))); const i32x4_ i0 = __builtin_bit_cast(i32x4_, acc[ai][bj][m][0]), i1 = __builtin_bit_cast(i32x4_, acc[ai][bj][m][1]);
                    u32x4 w; w.x = cvt_pk_bf16((float)i0[0] * sc, (float)i0[1] * sc); w.y = cvt_pk_bf16((float)i0[2] * sc, (float)i0[3] * sc); w.z = cvt_pk_bf16((float)i1[0] * sc, (float)i1[1] * sc); w.w = cvt_pk_bf16((float)i1[2] * sc, (float)i1[3] * sc);
                    *(u32x4*)(rowp + bj * HALF) = w; } }
    }
};
struct EpiGate {
    static constexpr bool PERM = false, AFTER_DRAIN = false;
    const bf16_t* XC; float* AF; float* DF; const float* b_a; const float* b_x; const float* ls8; int cbase;
    __device__ __forceinline__ void operator()(const f32x4 (&acc)[2][2][4][2], const Unit& u, int wr, int wc, int fr, int fq) const {
        const unsigned row0 = (unsigned)(u.pm * BM + wr * 64 + fr);
#pragma unroll
        for (int n = 0; n < 2; ++n) { unsigned c = (unsigned)(cbase + wc * 32 + 16 * n + 4 * fq); asm volatile("" : "+v"(c));
            const f32x4 ba = *(const f32x4*)(b_a + c), bx = *(const f32x4*)(b_x + c), l8 = *(const f32x4*)(ls8 + c) * 1.4426950408889634f;
#pragma unroll
            for (int ai = 0; ai < 2; ++ai)
#pragma unroll
                for (int m = 0; m < 4; ++m) { const unsigned off = (row0 + ai * HALF + m * 16) * 1024u + c;
                    const f32x4 pr = acc[ai][0][m][n] + ba, pi = acc[ai][1][m][n] + bx;
                    const uint2 xr = *(const uint2*)((const char*)XC + off * 2u);
                    const float xc[4] = {__uint_as_float(xr.x << 16), __uint_as_float(xr.x & 0xffff0000u), __uint_as_float(xr.y << 16), __uint_as_float(xr.y & 0xffff0000u)};
                    u32x4 pw;
#pragma unroll
                    for (int e = 0; e < 4; ++e) { const float r = __builtin_amdgcn_rcpf(1.f + __builtin_amdgcn_exp2f(-1.4426950408889634f * pr[e])), ig = __builtin_amdgcn_rcpf(1.f + __builtin_amdgcn_exp2f(-1.4426950408889634f * pi[e]));
                        const float la = r * l8[e]; const float a = __builtin_amdgcn_exp2f(la); const float mult = __builtin_amdgcn_sqrtf(fmaxf(1.f - a * a, 0.f)); pw[e] = cvt_pk_bf16(la, mult * ig * xc[e]); }
                    *(u32x4*)((char*)AF + off * 4u) = pw; asm volatile("" ::: "memory"); } }
    }
};
}

#define LAS __attribute__((address_space(3)))
typedef unsigned short bf16;
typedef unsigned v4u __attribute__((ext_vector_type(4)));
typedef unsigned v2u __attribute__((ext_vector_type(2)));
typedef float f32x4 __attribute__((ext_vector_type(4)));
typedef float f32x16 __attribute__((ext_vector_type(16)));
typedef short bf16x8 __attribute__((ext_vector_type(8)));

constexpr int NTHREADS = 512, NWAVES = 8;
constexpr int LDS_BYTES = 155648 + 256, LDS_CTL = 155648;
constexpr int BATCH = 2, SEQ = 8192, DM = 2048, M = BATCH * SEQ, NEXP = 16384;
constexpr int NZ = 3072, NQKV = 6144, NODIN = 6160;
constexpr int ROW6 = 1536;
constexpr bool V_FP4 = true;
constexpr int ROWV = V_FP4 ? 1024 : ROW6;
constexpr int ROW4 = 1024;
constexpr float ALPHA = 1.4142135623730951f, LN_EPS = 1e-5f;
constexpr float ATT_SCALE = 0.08838834764831845f;

constexpr size_t MiB = 1u << 20;
constexpr size_t WS_MOD = 1 * MiB;
constexpr size_t WS_LS8 = 1 * MiB + 512 * 1024;
constexpr size_t WS_WIN = 2 * MiB, WS_WOUT = 14 * MiB, WS_WQKV = 22 * MiB, WS_WO = 46 * MiB, WS_WQ0 = 54 * MiB, WS_WQ1 = 62 * MiB;
constexpr size_t WS_KEYS = 70 * MiB, WS_WPOOL = 71 * MiB, WS_WAX = 71 * MiB + 512 * 1024, WS_WF = 72 * MiB;
constexpr size_t WS_FE = 77 * MiB, WS_FP = 77 * MiB + 64 * 1024, WS_KN = 77 * MiB + 128 * 1024, WS_QN = 77 * MiB + 192 * 1024, WS_DN = 77 * MiB + 256 * 1024;
constexpr size_t WS_AG = 73 * MiB, WS_HG = 73 * MiB + 512 * 1024, WS_LF = 74 * MiB, WS_FB = 75 * MiB;
constexpr size_t WS_SU = 76 * MiB, WS_SV = 76 * MiB + 128 * 1024;
constexpr size_t WS_HB8 = 208 * MiB, WS_SA = 79 * MiB;
constexpr float YP_SCALE = 64.f;
constexpr float W8O_SCALE = 2048.f, Y8_SCALE = 16.f;
constexpr size_t WS_YC8 = 240 * MiB;
constexpr float W8_SCALE = 1024.f;
constexpr size_t WS_PART = 400 * MiB;
constexpr size_t WS_AR = 496 * MiB, WS_EQ = 500 * MiB;
constexpr size_t WS_Y = 592 * MiB;
constexpr size_t WS_H6 = 752 * MiB, WS_HS = 785 * MiB;
constexpr size_t WS_TU = 80 * MiB, WS_TV = 144 * MiB;
constexpr size_t WS_HB = 336 * MiB, WS_ZB = 400 * MiB, WS_YC = 592 * MiB, WS_YB = 656 * MiB, WS_X1 = 720 * MiB, WS_H2 = 848 * MiB, WS_QP = 912 * MiB;
constexpr size_t WS_EI = 976 * MiB, WS_GT = 984 * MiB, WS_END = 992 * MiB;
constexpr size_t WS_AF = WS_H2, WS_DF = WS_QP;
constexpr size_t WS_PO = WS_YB, WS_XC = WS_YB + 32 * MiB;

struct Args { const float* in[24]; float* out; unsigned char* ws; int ph_lo, ph_hi; };

__device__ __forceinline__ float bf_lo(unsigned u) { return __uint_as_float(u << 16); }
__device__ __forceinline__ float bf_hi(unsigned u) { return __uint_as_float(u & 0xffff0000u); }
__device__ __forceinline__ unsigned pk2(float lo, float hi) { return pg8::cvt_pk_bf16(lo, hi); }
__device__ __forceinline__ unsigned pk2c(float lo, float hi) { typedef float f2_ __attribute__((ext_vector_type(2))); typedef __bf16 b2_ __attribute__((ext_vector_type(2))); const f2_ f = {lo, hi}; return __builtin_bit_cast(unsigned, __builtin_convertvector(f, b2_)); }
#define SWZ_XOR_(v, m) __uint_as_float((unsigned)__builtin_amdgcn_ds_swizzle((int)__float_as_uint(v), ((m) << 10) | 0x1f))
__device__ __forceinline__ float wave_sum(float v) {
    v += SWZ_XOR_(v, 1); v += SWZ_XOR_(v, 2); v += SWZ_XOR_(v, 4); v += SWZ_XOR_(v, 8); v += SWZ_XOR_(v, 16);
    const auto rr = __builtin_amdgcn_permlane32_swap(__float_as_uint(v), __float_as_uint(v), false, false);
    return __uint_as_float(rr[0]) + __uint_as_float(rr[1]);
}
__device__ __forceinline__ float wave_max(float v) {
    v = fmaxf(v, SWZ_XOR_(v, 1)); v = fmaxf(v, SWZ_XOR_(v, 2)); v = fmaxf(v, SWZ_XOR_(v, 4)); v = fmaxf(v, SWZ_XOR_(v, 8)); v = fmaxf(v, SWZ_XOR_(v, 16));
    const auto rr = __builtin_amdgcn_permlane32_swap(__float_as_uint(v), __float_as_uint(v), false, false);
    return fmaxf(__uint_as_float(rr[0]), __uint_as_float(rr[1]));
}
__device__ __forceinline__ float gelu_tanh(float x) { const float y = 0.7978845608028654f * (x + 0.044715f * x * x * x); return x * __builtin_amdgcn_rcpf(1.f + __builtin_amdgcn_exp2f(-2.8853900817779268f * y)); }
#define LDS_WAIT() asm volatile("s_waitcnt lgkmcnt(0)" ::: "memory")
__device__ __forceinline__ int lane_id() { int l; asm volatile("v_mbcnt_lo_u32_b32 %0, -1, 0\n\tv_mbcnt_hi_u32_b32 %0, -1, %0" : "=v"(l)); return l; }


#define XB_TMO      128
#define XB_XCNT(j)  (256  + 64 * (j))
#define XB_XSUB(j)  (1280 + 64 * (j))
#define XB_XGEN(j)  (2304 + 64 * (j))
#define XB_TOP      3328
#define XB_TOPGEN   3392
#define XCD_BAR_WORDS 3456
#define XB_SPIN_CAP (1u << 22)
__device__ __forceinline__ unsigned xb_ld(unsigned* p)              { return __hip_atomic_load(p, __ATOMIC_RELAXED, __HIP_MEMORY_SCOPE_AGENT); }
__device__ __forceinline__ unsigned xb_add(unsigned* p, unsigned v) { return __hip_atomic_fetch_add(p, v, __ATOMIC_RELAXED, __HIP_MEMORY_SCOPE_AGENT); }
__device__ __forceinline__ unsigned xb_xcc_id() { return (unsigned)__builtin_amdgcn_s_getreg((3 << 11) | 20) & 0xFu; }
#define XB_SPIN(cond, bar) do { unsigned _sp = 0; while (cond) { __builtin_amdgcn_s_sleep(1); \
    if ((++_sp & 255u) == 0u) { if (xb_ld(&(bar)[XB_TMO])) break; if (_sp > XB_SPIN_CAP) { atomicAdd(&(bar)[XB_TMO], 1u); break; } } } } while (0)
struct XcdBarrier { unsigned* bar; unsigned x; volatile LAS unsigned* st; };
__device__ __forceinline__ XcdBarrier xcd_barrier_post(unsigned* bar, volatile LAS unsigned* st, bool t0) {
    XcdBarrier b; b.bar = bar; b.x = xb_xcc_id(); b.st = st;
    if (t0) { st[2] = xb_add(&bar[XB_XCNT(b.x)], 1u); st[3] = b.x; }
    return b;
}
__device__ __forceinline__ void xcd_barrier_complete(unsigned* bar, unsigned x, unsigned& nloc, unsigned& nx) {
    const unsigned G = gridDim.x * gridDim.y * gridDim.z;
    unsigned sum, cnt, mine, sp = 0u;
    for (;;) {
        sum = 0u; cnt = 0u; mine = 0u;
#pragma unroll
        for (unsigned j = 0; j < 16; ++j) { const unsigned c = xb_ld(&bar[XB_XCNT(j)]); sum += c; cnt += (c > 0u) ? 1u : 0u; mine = (j == x) ? c : mine; }
        if (sum == G) break;
        __builtin_amdgcn_s_sleep(1);
        if ((++sp & 255u) == 0u) { if (xb_ld(&bar[XB_TMO])) break; if (sp > XB_SPIN_CAP) { atomicAdd(&bar[XB_TMO], 1u); break; } }
    }
    nloc = mine > 0u ? mine : 1u; nx = cnt > 0u ? cnt : 1u;
}
__device__ __forceinline__ void xcd_barrier(const XcdBarrier& b, bool t0) {
    asm volatile("s_waitcnt vmcnt(0)" ::: "memory");
    __syncthreads();
    if (t0) {
        unsigned* bar = b.bar;
        __builtin_amdgcn_s_waitcnt(0);
        unsigned nloc = b.st[0], nx = b.st[1];
        if (nloc == 0u) { xcd_barrier_complete(bar, b.x, nloc, nx); b.st[0] = nloc; b.st[1] = nx; }
        const unsigned old = xb_add(&bar[XB_XSUB(b.x)], 1u);
        const unsigned gen = old / nloc;
        if (old + 1u == (gen + 1u) * nloc) {
            __builtin_amdgcn_fence(__ATOMIC_RELEASE, "agent");
            asm volatile("s_waitcnt vmcnt(0)" ::: "memory");
            const unsigned og = xb_add(&bar[XB_TOP], 1u);
            const unsigned tg = og / nx;
            if (og + 1u == (tg + 1u) * nx) xb_add(&bar[XB_TOPGEN], 1u);
            else XB_SPIN(xb_ld(&bar[XB_TOPGEN]) == tg, bar);
            __builtin_amdgcn_fence(__ATOMIC_ACQUIRE, "agent");
            xb_add(&bar[XB_XGEN(b.x)], 1u);
            asm volatile("s_waitcnt vmcnt(0)" ::: "memory");
        } else {
            XB_SPIN(xb_ld(&bar[XB_XGEN(b.x)]) == gen, bar);
            __builtin_amdgcn_fence(__ATOMIC_ACQUIRE, "agent");
            asm volatile("s_waitcnt vmcnt(0)" ::: "memory");
        }
    }
    __syncthreads();
}

__device__ __forceinline__ void transpose_item(const float* W, int ldw, int nblk, bf16* WT, int K, LAS float* scr, int item, int lane) {
    const int kb = item / nblk, nb = item % nblk, k0 = 64 * kb, n0 = 32 * nb;
#pragma unroll 8
    for (int i = 0; i < 32; ++i) { const int kk = 2 * i + (lane >> 5); scr[kk * 33 + (lane & 31)] = W[(size_t)(k0 + kk) * ldw + n0 + (lane & 31)]; }
    LDS_WAIT(); asm volatile("" ::: "memory");
    const int c = lane & 7;
#pragma unroll
    for (int j = 0; j < 4; ++j) { const int n = (lane >> 3) + 8 * j; const LAS float* s = scr + (8 * c) * 33 + n;
        v4u o; o.x = pk2(s[0 * 33], s[1 * 33]); o.y = pk2(s[2 * 33], s[3 * 33]); o.z = pk2(s[4 * 33], s[5 * 33]); o.w = pk2(s[6 * 33], s[7 * 33]);
        *(v4u*)(WT + (size_t)(n0 + n) * K + k0 + 8 * c) = o; }
    LDS_WAIT(); asm volatile("" ::: "memory");
}
__device__ __forceinline__ unsigned pk4_i8(float a, float b, float c, float d) {
    const int ia = (int)rintf(fminf(fmaxf(a, -127.f), 127.f)), ib = (int)rintf(fminf(fmaxf(b, -127.f), 127.f)), ic = (int)rintf(fminf(fmaxf(c, -127.f), 127.f)), id = (int)rintf(fminf(fmaxf(d, -127.f), 127.f));
    return ((unsigned)ia & 0xffu) | (((unsigned)ib & 0xffu) << 8) | (((unsigned)ic & 0xffu) << 16) | ((unsigned)id << 24);
}
__device__ __forceinline__ void transpose_item_i8(const float* W, int ldw, int nblk, unsigned char* WT, int K, LAS float* scr, int item, int lane, float wscale) {
    const int kb = item / nblk, nb = item % nblk, k0 = 64 * kb, n0 = 32 * nb;
#pragma unroll 8
    for (int i = 0; i < 32; ++i) { const int kk = 2 * i + (lane >> 5); scr[kk * 33 + (lane & 31)] = W[(size_t)(k0 + kk) * ldw + n0 + (lane & 31)] * wscale; }
    LDS_WAIT(); asm volatile("" ::: "memory");
    const int c = lane & 7;
#pragma unroll
    for (int j = 0; j < 4; ++j) { const int n = (lane >> 3) + 8 * j; const LAS float* sp = scr + (8 * c) * 33 + n;
        *(v2u*)(WT + (size_t)(n0 + n) * K + k0 + 8 * c) = (v2u){pk4_i8(sp[0 * 33], sp[1 * 33], sp[2 * 33], sp[3 * 33]), pk4_i8(sp[4 * 33], sp[5 * 33], sp[6 * 33], sp[7 * 33])}; }
    LDS_WAIT(); asm volatile("" ::: "memory");
}
__device__ __forceinline__ float cl8(float x) { return fminf(fmaxf(x, -440.f), 440.f); }
__device__ __forceinline__ unsigned pk4_fp8(float a, float b, float c, float d) { unsigned w = 0u; w = __builtin_amdgcn_cvt_pk_fp8_f32(cl8(a), cl8(b), w, false); w = __builtin_amdgcn_cvt_pk_fp8_f32(cl8(c), cl8(d), w, true); return w; }
__device__ __forceinline__ void transpose_item8(const float* W, int ldw, int nblk, unsigned char* WT, int K, LAS float* scr, int item, int lane, float wscale = W8_SCALE) {
    const int kb = item / nblk, nb = item % nblk, k0 = 64 * kb, n0 = 32 * nb;
#pragma unroll 8
    for (int i = 0; i < 32; ++i) { const int kk = 2 * i + (lane >> 5); scr[kk * 33 + (lane & 31)] = W[(size_t)(k0 + kk) * ldw + n0 + (lane & 31)] * wscale; }
    LDS_WAIT(); asm volatile("" ::: "memory");
    const int c = lane & 7;
#pragma unroll
    for (int j = 0; j < 4; ++j) { const int n = (lane >> 3) + 8 * j; const LAS float* sp = scr + (8 * c) * 33 + n; unsigned w0 = 0u, w1 = 0u;
        w0 = __builtin_amdgcn_cvt_pk_fp8_f32(cl8(sp[0 * 33]), cl8(sp[1 * 33]), w0, false); w0 = __builtin_amdgcn_cvt_pk_fp8_f32(cl8(sp[2 * 33]), cl8(sp[3 * 33]), w0, true);
        w1 = __builtin_amdgcn_cvt_pk_fp8_f32(cl8(sp[4 * 33]), cl8(sp[5 * 33]), w1, false); w1 = __builtin_amdgcn_cvt_pk_fp8_f32(cl8(sp[6 * 33]), cl8(sp[7 * 33]), w1, true);
        *(v2u*)(WT + (size_t)(n0 + n) * K + k0 + 8 * c) = (v2u){w0, w1}; }
    LDS_WAIT(); asm volatile("" ::: "memory");
}
__device__ __forceinline__ void convert_item(const float* src, bf16* dst, size_t item, int lane) {
    const size_t base = item * 4096 + (size_t)lane * 8;
#pragma unroll
    for (int j = 0; j < 8; ++j) { const f32x4 a = *(const f32x4*)(src + base + j * 512), b = *(const f32x4*)(src + base + j * 512 + 4);
        v4u o; o.x = pk2(a[0], a[1]); o.y = pk2(a[2], a[3]); o.z = pk2(b[0], b[1]); o.w = pk2(b[2], b[3]);
        *(v4u*)(dst + base + j * 512) = o; }
}
__device__ __forceinline__ void fp8_row_item(const float* src, unsigned char* dst, float* scale, int row, int lane) {
    const float* p = src + (size_t)row * DM + 4 * lane; f32x4 v[8]; float mx = 0.f;
#pragma unroll
    for (int j = 0; j < 8; ++j) { v[j] = *(const f32x4*)(p + 256 * j); mx = fmaxf(mx, fmaxf(fmaxf(fabsf(v[j][0]), fabsf(v[j][1])), fmaxf(fabsf(v[j][2]), fabsf(v[j][3])))); }
    mx = fmaxf(wave_max(mx), 1e-30f); const float inv = 240.f / mx;
    unsigned* q = (unsigned*)(dst + (size_t)row * DM) + lane;
#pragma unroll
    for (int j = 0; j < 8; ++j) { unsigned w = 0u; w = __builtin_amdgcn_cvt_pk_fp8_f32(v[j][0] * inv, v[j][1] * inv, w, false); w = __builtin_amdgcn_cvt_pk_fp8_f32(v[j][2] * inv, v[j][3] * inv, w, true); q[64 * j] = w; }
    if (lane == 0) scale[row] = mx * (1.f / 240.f);
}
typedef float f32x16_t __attribute__((ext_vector_type(16)));
typedef float f32x32_t __attribute__((ext_vector_type(32)));
typedef unsigned u32x6_t __attribute__((ext_vector_type(6)));
typedef unsigned u32x3_t __attribute__((ext_vector_type(3)));
__device__ __forceinline__ void fp6_pack_block(const float (&v)[32], u32x6_t& p, unsigned& ebyte) {
    float mx = 0.f;
#pragma unroll
    for (int i = 0; i < 32; ++i) mx = fmaxf(mx, fabsf(v[i]));
    int ex = (int)((__float_as_uint(mx * (1.f / 7.5f)) + 0x7fffffu) >> 23) - 127; ex = ex < -126 ? -126 : (ex > 127 ? 127 : ex);
    const float inv = __uint_as_float((unsigned)(127 - ex) << 23);
    f32x16_t a, b;
#pragma unroll
    for (int i = 0; i < 16; ++i) { a[i] = v[2 * i] * inv; b[i] = v[2 * i + 1] * inv; }
    p = __builtin_amdgcn_cvt_scalef32_2xpk16_fp6_f32(a, b, 1.0f); ebyte = (unsigned)(ex + 127);
}
__device__ __forceinline__ void fp6_row_item(const float* src, unsigned char* dst, float* sdst, int row, int lane) {
    const float* p = src + (size_t)row * DM + 4 * lane; float v[32]; float mx = 0.f;
#pragma unroll
    for (int j = 0; j < 8; ++j) { const f32x4 x = *(const f32x4*)(p + 256 * j); v[4 * j] = x[0]; v[4 * j + 1] = x[1]; v[4 * j + 2] = x[2]; v[4 * j + 3] = x[3]; }
#pragma unroll
    for (int i = 0; i < 32; ++i) mx = fmaxf(mx, fabsf(v[i]));
    mx = fmaxf(wave_max(mx), 1e-30f);
    const float inv = 7.5f / mx;
    f32x16_t a, b;
#pragma unroll
    for (int i = 0; i < 16; ++i) { a[i] = v[2 * i] * inv; b[i] = v[2 * i + 1] * inv; }
    const u32x6_t pk = __builtin_amdgcn_cvt_scalef32_2xpk16_fp6_f32(a, b, 1.0f);
    unsigned char* q = dst + (size_t)row * ROW6;
    *(v4u*)(q + 16 * lane) = (v4u){pk[0], pk[1], pk[2], pk[3]}; *(v2u*)(q + 1024 + 8 * lane) = (v2u){pk[4], pk[5]};
    if (lane == 0) sdst[row] = mx * (1.f / 7.5f);
}
template <bool VORD>
__device__ __forceinline__ void fp4_row_item(const float* src, unsigned char* dst, float* sdst, int row, int lane) {
    const float* p = src + (size_t)row * DM + (VORD ? 32 : 8) * lane; float v[32]; float ss = 0.f;
    if constexpr (VORD) {
#pragma unroll
        for (int j = 0; j < 8; ++j) { const f32x4 x = *(const f32x4*)(p + 4 * j); v[4 * j] = x[0]; v[4 * j + 1] = x[1]; v[4 * j + 2] = x[2]; v[4 * j + 3] = x[3]; } }
    else
#pragma unroll
    for (int j = 0; j < 4; ++j) { const f32x4 x = *(const f32x4*)(p + 512 * j), y = *(const f32x4*)(p + 512 * j + 4); v[8 * j] = x[0]; v[8 * j + 1] = x[1]; v[8 * j + 2] = x[2]; v[8 * j + 3] = x[3]; v[8 * j + 4] = y[0]; v[8 * j + 5] = y[1]; v[8 * j + 6] = y[2]; v[8 * j + 7] = y[3]; }
#pragma unroll
    for (int i = 0; i < 32; ++i) ss += v[i] * v[i];
    const float sc = fmaxf(0.5f * sqrtf(wave_sum(ss) * (1.f / DM)), 1e-30f), inv = 1.f / sc;
    unsigned w[4] = {0u, 0u, 0u, 0u};
#pragma unroll
    for (int d = 0; d < 4; ++d) {
        w[d] = __builtin_amdgcn_cvt_scalef32_pk_fp4_f32(w[d], v[8 * d] * inv, v[8 * d + 1] * inv, 1.0f, 0);
        w[d] = __builtin_amdgcn_cvt_scalef32_pk_fp4_f32(w[d], v[8 * d + 2] * inv, v[8 * d + 3] * inv, 1.0f, 1);
        w[d] = __builtin_amdgcn_cvt_scalef32_pk_fp4_f32(w[d], v[8 * d + 4] * inv, v[8 * d + 5] * inv, 1.0f, 2);
        w[d] = __builtin_amdgcn_cvt_scalef32_pk_fp4_f32(w[d], v[8 * d + 6] * inv, v[8 * d + 7] * inv, 1.0f, 3); }
    unsigned char* q = dst + (size_t)(row / NEXP) * NEXP * ROW4 + ((size_t)(lane >> 3) * NEXP + (size_t)(row % NEXP)) * 128 + 16 * (lane & 7);
    *(v4u*)q = (v4u){w[0], w[1], w[2], w[3]};
    if (lane == 0) sdst[row] = sc;
}
__device__ __forceinline__ void ph_prologue(const Args& a, LAS unsigned char* lds, int tid, int lane, int wave) {
    unsigned char* ws = a.ws;
    if (blockIdx.x < 192) {
        LAS float* cact = (LAS float*)lds;
        LAS float* red = (LAS float*)(lds + 16384);
        for (int i = tid; i < 2 * DM; i += NTHREADS) { const float cv = a.in[1][i]; cact[i] = cv / (1.f + __expf(-cv)); }
        __syncthreads();
        const int item = blockIdx.x, l = item / 96, col0 = (item % 96) * 128, rsub = lane >> 5, c4 = lane & 31;
        const float* W = a.in[2] + (size_t)l * DM * 12288 + col0 + 4 * c4;
        f32x4 acc0 = {0.f, 0.f, 0.f, 0.f}, acc1 = {0.f, 0.f, 0.f, 0.f};
#pragma unroll 8
        for (int i = 0; i < 128; ++i) { const int k = wave * 256 + 2 * i + rsub; const f32x4 w = *(const f32x4*)(W + (size_t)k * 12288);
            acc0 += w * cact[k]; acc1 += w * cact[DM + k]; }
#pragma unroll
        for (int e = 0; e < 4; ++e) { acc0[e] += __shfl_xor(acc0[e], 32); acc1[e] += __shfl_xor(acc1[e], 32); }
        if (rsub == 0) {
#pragma unroll
            for (int e = 0; e < 4; ++e) { red[(wave * 2 + 0) * 128 + 4 * c4 + e] = acc0[e]; red[(wave * 2 + 1) * 128 + 4 * c4 + e] = acc1[e]; } }
        __syncthreads();
        if (tid < 256) { const int b = tid >> 7, col = tid & 127; float s = 0.f;
#pragma unroll
            for (int w8 = 0; w8 < 8; ++w8) s += red[(w8 * 2 + b) * 128 + col];
            s += a.in[3][l * 12288 + col0 + col];
            ((float*)(ws + WS_MOD))[(size_t)(l * 2 + b) * 12288 + col0 + col] = s; }
        __syncthreads();
    }
    LAS float* scr = (LAS float*)(lds + wave * 16384);
    const int gw = blockIdx.x * NWAVES + wave, NGW = gridDim.x * NWAVES;
    constexpr int I_WIN = 32 * 96, I_SQ = 32 * 64, I_QKV = 32 * 192, I_POOL = 4 * 32, I_AX = 16 * 8, I_WF = 16, I_KEYS = 128, I_TAB = 2 * NEXP, I_LS = 1;
    constexpr int NITEMS = I_WIN + 4 * I_SQ + I_QKV + I_POOL + I_AX + I_WF + I_KEYS + 2 * I_TAB + I_LS;
    for (int it = gw; it < NITEMS; it += NGW) {
        int r = it;
        if (r < 2 * I_TAB) { if (r < I_TAB) fp4_row_item<false>(a.in[8], ws + WS_TU, (float*)(ws + WS_SU), r, lane); else if constexpr (V_FP4) fp4_row_item<true>(a.in[9], ws + WS_TV, (float*)(ws + WS_SV), r - I_TAB, lane); else fp6_row_item(a.in[9], ws + WS_TV, (float*)(ws + WS_SV), r - I_TAB, lane); continue; } r -= 2 * I_TAB;
        if (r < I_WIN) { transpose_item_i8(a.in[10], NZ, 96, ws + WS_WIN, DM, scr, r, lane, W8_SCALE); continue; } r -= I_WIN;
        if (r < I_SQ) { transpose_item8(a.in[20], DM, 64, ws + WS_WOUT, DM, scr, r, lane, W8O_SCALE); continue; } r -= I_SQ;
        if (r < I_QKV) { transpose_item8(a.in[21], NODIN, 192, ws + WS_WQKV, DM, scr, r, lane); continue; } r -= I_QKV;
        if (r < I_SQ) { transpose_item8(a.in[23], DM, 64, ws + WS_WO, DM, scr, r, lane, W8O_SCALE); continue; } r -= I_SQ;
        if (r < I_SQ) { transpose_item_i8(a.in[6], DM, 64, ws + WS_WQ0, DM, scr, r, lane, W8_SCALE); continue; } r -= I_SQ;
        if (r < I_SQ) { transpose_item_i8(a.in[6] + (size_t)DM * DM, DM, 64, ws + WS_WQ1, DM, scr, r, lane, W8_SCALE); continue; } r -= I_SQ;
        if (r < I_POOL) { const int g = r >> 5; transpose_item(a.in[11] + g * 65536, 256, 8, (bf16*)(ws + WS_WPOOL) + g * 65536, 256, scr, r & 31, lane); continue; } r -= I_POOL;
        if (r < I_AX) { const int h = r >> 4, which = (r >> 3) & 1;
            transpose_item(a.in[which ? 17 : 15] + h * 16384, 128, 4, (bf16*)(ws + WS_WAX) + h * 32768 + which * 16384, 128, scr, r & 7, lane); continue; } r -= I_AX;
        if (r < I_WF) { bf16* WF = (bf16*)(ws + WS_WF);
            for (int k = lane; k < DM; k += 64) { const float v = a.in[21][(size_t)k * NODIN + NQKV + r]; WF[r * DM + k] = (bf16)(pk2(v, v) & 0xffffu); } continue; } r -= I_WF;
        if (r < I_KEYS) { convert_item(a.in[7], (bf16*)(ws + WS_KEYS), (size_t)r, lane); continue; } r -= I_KEYS;
        { float* LS8 = (float*)(ws + WS_LS8);
            for (int cch = lane; cch < 1024; cch += 64) { const float x = a.in[19][cch]; LS8[cch] = 8.f * (fminf(x, 0.f) - log1pf(__expf(-fabsf(x)))); } }
    }
}

__device__ __forceinline__ void ph_modulate(const float* src, const float* mod_l  , int sh_off, int sc_off, bf16* dst, unsigned char* dst8, float* rs, int lane, int wave) {
    const int gw = blockIdx.x * NWAVES + wave, NGW = gridDim.x * NWAVES;
    int cur_b = -1; f32x4 scv[8], shv[8];
    for (int t = gw; t < M; t += NGW) {
        const int b = t >> 13;
        if (b != cur_b) { cur_b = b; const float* mb = mod_l + b * 12288;
#pragma unroll
            for (int j = 0; j < 8; ++j) { scv[j] = *(const f32x4*)(mb + sc_off + 4 * lane + 256 * j) + 1.f; shv[j] = *(const f32x4*)(mb + sh_off + 4 * lane + 256 * j); } }
        const float* xr = src + (size_t)t * DM + 4 * lane; bf16* dr = dst + (size_t)t * DM + 4 * lane; f32x4 v[8]; float mx = 0.f;
#pragma unroll
        for (int j = 0; j < 8; ++j) { v[j] = *(const f32x4*)(xr + 256 * j) * scv[j] + shv[j]; uint2 o; o.x = pk2(v[j][0], v[j][1]); o.y = pk2(v[j][2], v[j][3]); *(uint2*)(dr + 256 * j) = o;
            mx = fmaxf(mx, fmaxf(fmaxf(fabsf(v[j][0]), fabsf(v[j][1])), fmaxf(fabsf(v[j][2]), fabsf(v[j][3])))); }
        mx = fmaxf(wave_max(mx), 1e-30f); const float inv = 127.f / mx; unsigned* q8 = (unsigned*)(dst8 + (size_t)t * DM) + lane;
#pragma unroll
        for (int j = 0; j < 8; ++j) q8[64 * j] = pk4_i8(v[j][0] * inv, v[j][1] * inv, v[j][2] * inv, v[j][3] * inv);
        if (lane == 0) rs[t] = mx * (1.f / 127.f);
    }
}

__device__ __forceinline__ void ld8(const bf16* p, float (&v)[8]) { const v4u u = *(const v4u*)p; v[0] = bf_lo(u.x); v[1] = bf_hi(u.x); v[2] = bf_lo(u.y); v[3] = bf_hi(u.y); v[4] = bf_lo(u.z); v[5] = bf_hi(u.z); v[6] = bf_lo(u.w); v[7] = bf_hi(u.w); }
__device__ __forceinline__ void st8(bf16* p, const float (&v)[8]) { v4u o; o.x = pk2(v[0], v[1]); o.y = pk2(v[2], v[3]); o.z = pk2(v[4], v[5]); o.w = pk2(v[6], v[7]); *(v4u*)p = o; }
__device__ __forceinline__ void ph_poolconv(const Args& a, int lane, int wave) {
    const bf16* Z = (const bf16*)(a.ws + WS_ZB); bf16* PO = (bf16*)(a.ws + WS_PO); bf16* XC = (bf16*)(a.ws + WS_XC);
    const int gw = blockIdx.x * NWAVES + wave, NGW = gridDim.x * NWAVES;
    for (int item = gw; item < 2048; item += NGW) {
        const int which = item & 3, t0 = (item >> 2) * 32, pos0 = t0 & (SEQ - 1);
        if (which < 2) {
            const int c = which * 512 + lane * 8, w = 2 << (c >> 8);
            float sum[8] = {0.f, 0.f, 0.f, 0.f, 0.f, 0.f, 0.f, 0.f};
            for (int s = 1; s < 16; ++s) if (s < w && pos0 - s >= 0) { float v[8]; ld8(Z + (size_t)(t0 - s) * NZ + c, v);
#pragma unroll
                for (int e = 0; e < 8; ++e) sum[e] += v[e]; }
            for (int i = 0; i < 32; ++i) { const int t = t0 + i, pos = pos0 + i; float cur[8], o[8]; ld8(Z + (size_t)t * NZ + c, cur);
                const float inv = 1.f / (float)(pos + 1 < w ? pos + 1 : w);
#pragma unroll
                for (int e = 0; e < 8; ++e) { sum[e] += cur[e]; o[e] = sum[e] * inv - cur[e]; }
                st8(PO + (size_t)t * 1024 + c, o);
                if (pos - w + 1 >= 0) { float old[8]; ld8(Z + (size_t)(t - w + 1) * NZ + c, old);
#pragma unroll
                    for (int e = 0; e < 8; ++e) sum[e] -= old[e]; } }
        } else {
            const int c = (which - 2) * 512 + lane * 8; const bf16* zc = Z + 1024 + c;
            float w0[8], w1[8], w2[8], w3[8], bb[8], x3[8], x2[8], x1[8];
#pragma unroll
            for (int e = 0; e < 8; ++e) { w0[e] = a.in[13][0 * 1024 + c + e]; w1[e] = a.in[13][1 * 1024 + c + e]; w2[e] = a.in[13][2 * 1024 + c + e]; w3[e] = a.in[13][3 * 1024 + c + e]; bb[e] = a.in[14][c + e]; x3[e] = 0.f; x2[e] = 0.f; x1[e] = 0.f; }
            if (pos0 >= 3) ld8(zc + (size_t)(t0 - 3) * NZ, x3);
            if (pos0 >= 2) ld8(zc + (size_t)(t0 - 2) * NZ, x2);
            if (pos0 >= 1) ld8(zc + (size_t)(t0 - 1) * NZ, x1);
            for (int i = 0; i < 32; ++i) { const int t = t0 + i; float x0[8], o[8]; ld8(zc + (size_t)t * NZ, x0);
#pragma unroll
                for (int e = 0; e < 8; ++e) { o[e] = bb[e] + w0[e] * x3[e] + w1[e] * x2[e] + w2[e] * x1[e] + w3[e] * x0[e]; x3[e] = x2[e]; x2[e] = x1[e]; x1[e] = x0[e]; }
                st8(XC + (size_t)t * 1024 + c, o); }
        }
    }
}

__device__ __forceinline__ void ph_scan_agg(const Args& a, int tid) {
    const unsigned* AD = (const unsigned*)(a.ws + WS_AF);
    float* AG = (float*)(a.ws + WS_AG); float* HG = (float*)(a.ws + WS_HG);
    for (int w = blockIdx.x; w < 256; w += gridDim.x) {
        const int st = w >> 1, c = (w & 1) * 512 + tid; const size_t base = (size_t)st * 128 * 1024 + c;
        float LA = 0.f, H = 0.f;
#pragma unroll 32
        for (int i = 0; i < 128; ++i) { const unsigned pw = AD[base + (size_t)i * 1024]; const float la = bf_lo(pw), dv = bf_hi(pw); H = __builtin_amdgcn_exp2f(la) * H + dv; LA += la; }
        AG[st * 1024 + c] = __builtin_amdgcn_exp2f(LA); HG[st * 1024 + c] = H;
    }
}
__device__ __forceinline__ void ph_scan_fin(const Args& a, int tid) {
    const unsigned* AD = (const unsigned*)(a.ws + WS_AF);
    const float* AG = (const float*)(a.ws + WS_AG); const float* HG = (const float*)(a.ws + WS_HG);
    const bf16* Z = (const bf16*)(a.ws + WS_ZB); unsigned char* YC8 = a.ws + WS_YC8;
    for (int w = blockIdx.x; w < 256; w += gridDim.x) {
        const int st = w >> 1, c = (w & 1) * 512 + tid, sin = st & 63, sb = st - sin; const size_t base = (size_t)st * 128 * 1024 + c;
        float h = 0.f;
#pragma unroll 8
        for (int s = 0; s < sin; ++s) h = AG[(sb + s) * 1024 + c] * h + HG[(sb + s) * 1024 + c];
#pragma unroll 16
        for (int i = 0; i < 128; ++i) { const size_t t = (size_t)st * 128 + i; const unsigned pw = AD[base + (size_t)i * 1024];
            h = __builtin_amdgcn_exp2f(bf_lo(pw)) * h + bf_hi(pw); const float gt = __uint_as_float((unsigned)Z[t * NZ + 2048 + c] << 16);
            YC8[t * DM + 1024 + c] = (unsigned char)(pk4_fp8(h * gelu_tanh(gt) * Y8_SCALE, 0.f, 0.f, 0.f) & 0xffu); }
    }
}

template <bool RES_MOD>
__device__ __forceinline__ void ph_ln(const bf16* Y, const float* Xin, const bf16* HBres, const float* mod_res, const float* mod_l, const float* lng, const float* lnb, bf16* H2, unsigned char* H28, float* SH, unsigned char* H6, float* HS, int lane, int wave) {
    const int gw = blockIdx.x * NWAVES + wave, NGW = gridDim.x * NWAVES;
    v4u yc[4]; f32x4 xc[8]; v4u rc[4];
    { const size_t ro = (size_t)gw * DM + 8 * lane;
#pragma unroll
      for (int j = 0; j < 4; ++j) { yc[j] = *(const v4u*)(Y + ro + 512 * j);
          if constexpr (RES_MOD) rc[j] = *(const v4u*)(HBres + ro + 512 * j); else { xc[2 * j] = *(const f32x4*)(Xin + ro + 512 * j); xc[2 * j + 1] = *(const f32x4*)(Xin + ro + 512 * j + 4); } } }
#pragma unroll 1
    for (int t = gw; t < M; t += NGW) {
        const int b = t >> 13; const float* mb = mod_l + b * 12288; const size_t ro = (size_t)t * DM + 8 * lane;
        int ln = lane; asm volatile("" : "+v"(ln));
        const int tn = t + NGW < M ? t + NGW : t; const size_t rn = (size_t)tn * DM + 8 * lane;
        v4u yn[4]; f32x4 xn[8]; v4u rn4[4];
#pragma unroll
        for (int j = 0; j < 4; ++j) { yn[j] = *(const v4u*)(Y + rn + 512 * j);
            if constexpr (RES_MOD) rn4[j] = *(const v4u*)(HBres + rn + 512 * j); else { xn[2 * j] = *(const f32x4*)(Xin + rn + 512 * j); xn[2 * j + 1] = *(const f32x4*)(Xin + rn + 512 * j + 4); } }
        float v[32];
#pragma unroll
        for (int j = 0; j < 4; ++j) { const v4u u = yc[j]; const float y8[8] = {bf_lo(u.x), bf_hi(u.x), bf_lo(u.y), bf_hi(u.y), bf_lo(u.z), bf_hi(u.z), bf_lo(u.w), bf_hi(u.w)};
            f32x4 xa, xb;
            if constexpr (RES_MOD) { const v4u r = rc[j]; const float* mr = mod_res + b * 12288 + 8 * ln + 512 * j;
                const f32x4 sa = *(const f32x4*)(mr + 2048), sb = *(const f32x4*)(mr + 2048 + 4), ha = *(const f32x4*)(mr), hb = *(const f32x4*)(mr + 4);
                const float r8[8] = {bf_lo(r.x), bf_hi(r.x), bf_lo(r.y), bf_hi(r.y), bf_lo(r.z), bf_hi(r.z), bf_lo(r.w), bf_hi(r.w)};
#pragma unroll
                for (int e = 0; e < 4; ++e) { xa[e] = (r8[e] - ha[e]) * __builtin_amdgcn_rcpf(1.f + sa[e]); xb[e] = (r8[4 + e] - hb[e]) * __builtin_amdgcn_rcpf(1.f + sb[e]); } }
            else { xa = xc[2 * j]; xb = xc[2 * j + 1]; }
            const f32x4 ga = *(const f32x4*)(mb + 4096 + 8 * ln + 512 * j), gb = *(const f32x4*)(mb + 4096 + 8 * ln + 512 * j + 4);
#pragma unroll
            for (int e = 0; e < 4; ++e) { v[8 * j + e] = ALPHA * xa[e] + (1.f + ga[e]) * y8[e]; v[8 * j + 4 + e] = ALPHA * xb[e] + (1.f + gb[e]) * y8[4 + e]; } }
        float s = 0.f;
#pragma unroll
        for (int e = 0; e < 32; ++e) s += v[e];
        const float mean = wave_sum(s) * (1.f / DM); float q = 0.f;
#pragma unroll
        for (int e = 0; e < 32; ++e) { v[e] -= mean; q += v[e] * v[e]; }
        const float rstd = rsqrtf(wave_sum(q) * (1.f / DM) + LN_EPS); float hmx = 0.f;
#pragma unroll
        for (int j = 0; j < 4; ++j) { const int co = 8 * ln + 512 * j;
            const f32x4 la = *(const f32x4*)(lng + co), lb = *(const f32x4*)(lng + co + 4), ba = *(const f32x4*)(lnb + co), bb = *(const f32x4*)(lnb + co + 4);
            const f32x4 sa = *(const f32x4*)(mb + 8192 + co), sb = *(const f32x4*)(mb + 8192 + co + 4), ha = *(const f32x4*)(mb + 6144 + co), hb = *(const f32x4*)(mb + 6144 + co + 4);
            float h8[8];
#pragma unroll
            for (int e = 0; e < 4; ++e) { const float na = v[8 * j + e] * rstd * la[e] + ba[e], nb = v[8 * j + 4 + e] * rstd * lb[e] + bb[e];
                h8[e] = na * (1.f + sa[e]) + ha[e]; h8[4 + e] = nb * (1.f + sb[e]) + hb[e]; }
            st8(H2 + ro + 512 * j, h8);
#pragma unroll
            for (int e = 0; e < 8; ++e) { v[8 * j + e] = h8[e]; hmx = fmaxf(hmx, fabsf(h8[e])); } }
        hmx = fmaxf(wave_max(hmx), 1e-30f); const float inv = 127.f / hmx;
#pragma unroll
        for (int j = 0; j < 4; ++j) *(v2u*)(H28 + ro + 512 * j) = (v2u){pk4_i8(v[8 * j] * inv, v[8 * j + 1] * inv, v[8 * j + 2] * inv, v[8 * j + 3] * inv), pk4_i8(v[8 * j + 4] * inv, v[8 * j + 5] * inv, v[8 * j + 6] * inv, v[8 * j + 7] * inv)};
        if (lane == 0) SH[t] = hmx * (1.f / 127.f);
        { const float inv6 = 7.5f / hmx; f32x16_t pa, pb;
#pragma unroll
          for (int i = 0; i < 16; ++i) { pa[i] = v[2 * i] * inv6; pb[i] = v[2 * i + 1] * inv6; }
          const u32x6_t pk = __builtin_amdgcn_cvt_scalef32_2xpk16_fp6_f32(pa, pb, 1.0f); unsigned char* hq = H6 + (size_t)t * 1536;
          *(v4u*)(hq + 16 * lane) = (v4u){pk[0], pk[1], pk[2], pk[3]}; *(v2u*)(hq + 1024 + 8 * lane) = (v2u){pk[4], pk[5]};
          if (lane == 0) HS[t] = hmx * (1.f / 7.5f); }
#pragma unroll
        for (int j = 0; j < 4; ++j) { yc[j] = yn[j]; if constexpr (RES_MOD) rc[j] = rn4[j]; else { xc[2 * j] = xn[2 * j]; xc[2 * j + 1] = xn[2 * j + 1]; } }
    }
}

__device__ __forceinline__ unsigned mono(float f) { const unsigned u = __float_as_uint(f); return (u & 0x80000000u) ? ~u : (u | 0x80000000u); }
__device__ __forceinline__ float unmono(unsigned u) { return __uint_as_float((u & 0x80000000u) ? (u & 0x7fffffffu) : ~u); }
__device__ __forceinline__ unsigned umax_(unsigned a, unsigned b) { return a > b ? a : b; }
__device__ __forceinline__ unsigned umin_(unsigned a, unsigned b) { return a < b ? a : b; }
template <bool DESC> __device__ __forceinline__ void bsort16(unsigned (&k)[16]) {
#pragma unroll
    for (int size = 2; size <= 16; size <<= 1)
#pragma unroll
        for (int stride = size >> 1; stride > 0; stride >>= 1)
#pragma unroll
            for (int i = 0; i < 16; ++i) { const int j = i ^ stride;
                if (j > i) { const bool first_max = (((i & size) == 0) == DESC); const unsigned hi = umax_(k[i], k[j]), lo = umin_(k[i], k[j]); k[i] = first_max ? hi : lo; k[j] = first_max ? lo : hi; } }
}
template <bool DESC> __device__ __forceinline__ void bmerge16(unsigned (&k)[16]) {
#pragma unroll
    for (int stride = 8; stride > 0; stride >>= 1)
#pragma unroll
        for (int i = 0; i < 16; ++i) { const int j = i ^ stride;
            if (j > i) { const unsigned hi = umax_(k[i], k[j]), lo = umin_(k[i], k[j]); k[i] = DESC ? hi : lo; k[j] = DESC ? lo : hi; } }
}
__device__ __forceinline__ void top16_of_64(const unsigned (&k)[64], unsigned (&o)[16]) {
    unsigned g0[16], g1[16], g2[16], g3[16];
#pragma unroll
    for (int i = 0; i < 16; ++i) { g0[i] = k[i]; g1[i] = k[16 + i]; g2[i] = k[32 + i]; g3[i] = k[48 + i]; }
    bsort16<true>(g0); bsort16<false>(g1); bsort16<true>(g2); bsort16<false>(g3);
#pragma unroll
    for (int i = 0; i < 16; ++i) { g0[i] = umax_(g0[i], g1[i]); g2[i] = umax_(g2[i], g3[i]); }
    bmerge16<true>(g0); bmerge16<false>(g2);
#pragma unroll
    for (int i = 0; i < 16; ++i) o[i] = umax_(g0[i], g2[i]);
    bmerge16<true>(o);
}
__device__ __forceinline__ int swz16(int row, int cb) { return cb ^ ((row & 15) << 4); }
__device__ __forceinline__ void ph_topk(const Args& a, int layer, LAS unsigned char* lds, int tid, int lane, int wave) {
    const bf16* QP = (const bf16*)(a.ws + WS_QP); const bf16* KEYS = (const bf16*)(a.ws + WS_KEYS) + (size_t)layer * 8 * 2 * 128 * 128;
    int* EI = (int*)(a.ws + WS_EI); float* GT = (float*)(a.ws + WS_GT); const float* SVl = (const float*)(a.ws + WS_SV) + layer * NEXP;
    LAS unsigned char* kt = lds;
    LAS unsigned* lists = (LAS unsigned*)(lds + 65536 + wave * 4096);
    const int r32 = lane & 31, hi = lane >> 5, h = blockIdx.x & 7, wgr = blockIdx.x >> 3, nwgh = gridDim.x >> 3;
    { const bf16* kh = KEYS + (size_t)h * 2 * 128 * 128;
#pragma unroll
      for (int i = 0; i < 8; ++i) { const int ch = tid + i * NTHREADS, row = ch >> 4, cb = (ch & 15) * 16;
          *(LAS v4u*)(kt + row * 256 + swz16(row, cb)) = *(const v4u*)(kh + (size_t)row * 128 + (cb >> 1)); } }
    __syncthreads();
    if (wgr < nwgh) {
#pragma unroll 1
    for (int u = wgr * NWAVES + wave; u < M / 32; u += nwgh * NWAVES) {
        const int t0 = u * 32; const bf16* qrow = QP + (size_t)(t0 + r32) * DM + h * 256 + 8 * hi;
        unsigned LL[2][16];
#pragma unroll
        for (int p = 0; p < 2; ++p) {
            bf16x8 bq[8];
#pragma unroll
            for (int sI = 0; sI < 8; ++sI) bq[sI] = *(const bf16x8*)(qrow + p * 128 + 16 * sI);
            f32x16 acc[4];
#pragma unroll
            for (int blk = 0; blk < 4; ++blk)
#pragma unroll
                for (int e = 0; e < 16; ++e) acc[blk][e] = 0.f;
#pragma unroll
            for (int sI = 0; sI < 8; ++sI)
#pragma unroll
                for (int blk = 0; blk < 4; ++blk) { const int krow = p * 128 + blk * 32 + r32;
                    const bf16x8 ak = *(const LAS bf16x8*)(kt + krow * 256 + swz16(krow, (16 * sI + 8 * hi) * 2));
                    acc[blk] = __builtin_amdgcn_mfma_f32_32x32x16_bf16(ak, bq[sI], acc[blk], 0, 0, 0); }
            unsigned kk[64], o[16];
#pragma unroll
            for (int blk = 0; blk < 4; ++blk)
#pragma unroll
                for (int e = 0; e < 16; ++e) { const int n = 32 * blk + (e & 3) + 8 * (e >> 2) + 4 * hi; kk[blk * 16 + e] = (mono(acc[blk][e]) & ~127u) | (unsigned)(127 - n); }
            top16_of_64(kk, o);
#pragma unroll
            for (int i = 0; i < 16; ++i) LL[p][i] = umax_(o[i], (unsigned)__shfl_xor((int)o[15 - i], 32));
            bmerge16<true>(LL[p]);
            if (hi == 0) { LAS v4u* lp = (LAS v4u*)(lists + (p * 32 + r32) * 16);
#pragma unroll
                for (int i = 0; i < 4; ++i) lp[i] = (v4u){LL[p][4 * i], LL[p][4 * i + 1], LL[p][4 * i + 2], LL[p][4 * i + 3]}; }
        }
        unsigned tk[16];
        { float f1[16], f2[16];
#pragma unroll
          for (int i = 0; i < 16; ++i) { f1[i] = unmono(LL[0][i] & ~127u); f2[i] = unmono(LL[1][i] & ~127u); }
          unsigned cd[32];
          {
            cd[0] = hi ? ((mono(f1[2] + f2[1]) & ~255u) | 222u) : ((mono(f1[0] + f2[0]) & ~255u) | 255u);
            cd[1] = hi ? ((mono(f1[2] + f2[2]) & ~255u) | 221u) : ((mono(f1[0] + f2[1]) & ~255u) | 254u);
            cd[2] = hi ? ((mono(f1[2] + f2[3]) & ~255u) | 220u) : ((mono(f1[0] + f2[2]) & ~255u) | 253u);
            cd[3] = hi ? ((mono(f1[2] + f2[4]) & ~255u) | 219u) : ((mono(f1[0] + f2[3]) & ~255u) | 252u);
            cd[4] = hi ? ((mono(f1[3] + f2[0]) & ~255u) | 207u) : ((mono(f1[0] + f2[4]) & ~255u) | 251u);
            cd[5] = hi ? ((mono(f1[3] + f2[1]) & ~255u) | 206u) : ((mono(f1[0] + f2[5]) & ~255u) | 250u);
            cd[6] = hi ? ((mono(f1[3] + f2[2]) & ~255u) | 205u) : ((mono(f1[0] + f2[6]) & ~255u) | 249u);
            cd[7] = hi ? ((mono(f1[3] + f2[3]) & ~255u) | 204u) : ((mono(f1[0] + f2[7]) & ~255u) | 248u);
            cd[8] = hi ? ((mono(f1[4] + f2[0]) & ~255u) | 191u) : ((mono(f1[0] + f2[8]) & ~255u) | 247u);
            cd[9] = hi ? ((mono(f1[4] + f2[1]) & ~255u) | 190u) : ((mono(f1[0] + f2[9]) & ~255u) | 246u);
            cd[10] = hi ? ((mono(f1[4] + f2[2]) & ~255u) | 189u) : ((mono(f1[0] + f2[10]) & ~255u) | 245u);
            cd[11] = hi ? ((mono(f1[5] + f2[0]) & ~255u) | 175u) : ((mono(f1[0] + f2[11]) & ~255u) | 244u);
            cd[12] = hi ? ((mono(f1[5] + f2[1]) & ~255u) | 174u) : ((mono(f1[0] + f2[12]) & ~255u) | 243u);
            cd[13] = hi ? ((mono(f1[6] + f2[0]) & ~255u) | 159u) : ((mono(f1[0] + f2[13]) & ~255u) | 242u);
            cd[14] = hi ? ((mono(f1[6] + f2[1]) & ~255u) | 158u) : ((mono(f1[0] + f2[14]) & ~255u) | 241u);
            cd[15] = hi ? ((mono(f1[7] + f2[0]) & ~255u) | 143u) : ((mono(f1[0] + f2[15]) & ~255u) | 240u);
            cd[16] = hi ? ((mono(f1[7] + f2[1]) & ~255u) | 142u) : ((mono(f1[1] + f2[0]) & ~255u) | 239u);
            cd[17] = hi ? ((mono(f1[8] + f2[0]) & ~255u) | 127u) : ((mono(f1[1] + f2[1]) & ~255u) | 238u);
            cd[18] = hi ? ((mono(f1[9] + f2[0]) & ~255u) | 111u) : ((mono(f1[1] + f2[2]) & ~255u) | 237u);
            cd[19] = hi ? ((mono(f1[10] + f2[0]) & ~255u) | 95u) : ((mono(f1[1] + f2[3]) & ~255u) | 236u);
            cd[20] = hi ? ((mono(f1[11] + f2[0]) & ~255u) | 79u) : ((mono(f1[1] + f2[4]) & ~255u) | 235u);
            cd[21] = hi ? ((mono(f1[12] + f2[0]) & ~255u) | 63u) : ((mono(f1[1] + f2[5]) & ~255u) | 234u);
            cd[22] = hi ? ((mono(f1[13] + f2[0]) & ~255u) | 47u) : ((mono(f1[1] + f2[6]) & ~255u) | 233u);
            cd[23] = hi ? ((mono(f1[14] + f2[0]) & ~255u) | 31u) : ((mono(f1[1] + f2[7]) & ~255u) | 232u);
            cd[24] = hi ? ((mono(f1[15] + f2[0]) & ~255u) | 15u) : ((mono(f1[2] + f2[0]) & ~255u) | 223u);
            cd[25] = 0u;
            cd[26] = 0u;
            cd[27] = 0u;
            cd[28] = 0u;
            cd[29] = 0u;
            cd[30] = 0u;
            cd[31] = 0u;
          }
          unsigned g0[16], g1[16];
#pragma unroll
          for (int i = 0; i < 16; ++i) { g0[i] = cd[i]; g1[i] = cd[16 + i]; }
          bsort16<true>(g0); bsort16<false>(g1);
#pragma unroll
          for (int i = 0; i < 16; ++i) g0[i] = umax_(g0[i], g1[i]);
          bmerge16<true>(g0);
#pragma unroll
          for (int i = 0; i < 16; ++i) tk[i] = umax_(g0[i], (unsigned)__shfl_xor((int)g0[15 - i], 32));
          bmerge16<true>(tk); }
        float ev[16]; const float m0 = unmono(tk[0] & ~255u); float den = 0.f;
#pragma unroll
        for (int k = 0; k < 16; ++k) { ev[k] = __expf(unmono(tk[k] & ~255u) - m0); den += ev[k]; }
        const float rden = 1.f / den;
        const LAS unsigned* L1 = lists + r32 * 16; const LAS unsigned* L2 = lists + (32 + r32) * 16;
        int ei[16];
#pragma unroll
        for (int k = 0; k < 16; ++k) { const int id = 255 - (int)(tk[k] & 255u), i = id >> 4, j = id & 15;
            const int n1 = 127 - (int)(L1[i] & 127u), n2 = 127 - (int)(L2[j] & 127u); ei[k] = n1 * 128 + n2; }
        if (hi == 0) { int* ep = EI + (size_t)(t0 + r32) * 128 + h * 16;
#pragma unroll
            for (int k = 0; k < 4; ++k) *(int4*)(ep + 4 * k) = make_int4(ei[4 * k], ei[4 * k + 1], ei[4 * k + 2], ei[4 * k + 3]); }
        else { float* gp = GT + (size_t)(t0 + r32) * 128 + h * 16; float gg[16];
#pragma unroll
            for (int k = 0; k < 16; ++k) gg[k] = ev[k] * rden * SVl[ei[k]];
#pragma unroll
            for (int k = 0; k < 4; ++k) *(f32x4*)(gp + 4 * k) = (f32x4){gg[4 * k], gg[4 * k + 1], gg[4 * k + 2], gg[4 * k + 3]}; }
    } }
    __syncthreads();
}

typedef int i32x8_t __attribute__((ext_vector_type(8)));
__device__ __forceinline__ void peer_slice(const Args& a, volatile LAS unsigned* st, int& x, int& rank, int& nrank) {
    const unsigned* bar = (const unsigned*)a.ws; nrank = (int)(gridDim.x >> 3); bool uni = (gridDim.x & 7u) == 0u;
#pragma unroll
    for (int j = 0; j < 16; ++j) { const unsigned c = __hip_atomic_load(&bar[XB_XCNT(j)], __ATOMIC_RELAXED, __HIP_MEMORY_SCOPE_AGENT); uni = uni && (c == (j < 8 ? (unsigned)nrank : 0u)); }
    if (uni) { x = (int)st[3]; rank = (int)st[2]; } else { x = (int)(blockIdx.x & 7u); rank = (int)(blockIdx.x >> 3); }
    x = __builtin_amdgcn_readfirstlane(x); rank = __builtin_amdgcn_readfirstlane(rank);
}
__device__ __forceinline__ void ph_peer_u(const Args& a, int layer, volatile LAS unsigned* st, LAS unsigned char* lds, int lane, int wave) {
    int x, rank, nrank; peer_slice(a, st, x, rank, nrank); const int m16 = lane & 15, kc = lane >> 4, r8 = lane >> 3, sg = lane & 7;
    const unsigned char* TUb = a.ws + WS_TU + (size_t)layer * NEXP * ROW4 + (size_t)x * NEXP * 128;
    const unsigned char* H6 = a.ws + WS_H6 + 16 * (8 * x + kc); const int* EI = (const int*)(a.ws + WS_EI) + lane; bf16* PART = (bf16*)(a.ws + WS_PART) + x * 128 + 32 * kc;
    if (rank >= nrank) return;
    const int t0 = rank * NWAVES + wave, ts = nrank * NWAVES, nt = (M - t0 + ts - 1) / ts;
    LAS unsigned char* ub = lds + wave * 2304; LAS unsigned char* ubw = ub + r8 * 144 + 16 * sg; const LAS unsigned char* ubr = ub + m16 * 144 + 16 * kc;
    v4u U[8][2]; v4u ha[2], han[2]; v2u hb[2], hbn[2]; int en0 = 0, en1 = 0;
#pragma unroll
    for (int g = 0; g < 8; ++g) { U[g][0] = (v4u){0u, 0u, 0u, 0u}; U[g][1] = U[g][0]; }
    ha[0] = ha[1] = (v4u){0u, 0u, 0u, 0u}; hb[0] = hb[1] = (v2u){0u, 0u};
#pragma unroll 1
    for (int k = -2; k < nt; ++k) {
        const int k2 = k + 2 < nt ? k + 2 : nt - 1, k1 = k + 1 < nt ? (k + 1 < 0 ? 0 : k + 1) : nt - 1;
        const size_t tn2 = (size_t)(t0 + ts * k2), tn1 = (size_t)(t0 + ts * k1);
        const int enn0 = EI[tn2 * 128], enn1 = EI[tn2 * 128 + 64];
        { const unsigned char* hp = H6 + tn1 * 1536;
#pragma unroll
          for (int i = 0; i < 2; ++i) { han[i] = *(const v4u*)(hp + 64 * i); hbn[i] = *(const v2u*)(hp + 1024 - 8 * (8 * x + kc) + 32 * i); } }
        bf16* pp = PART + (size_t)(t0 + ts * (k < 0 ? 0 : k)) * 1024; unsigned pv0 = 0u, pv1 = 0u;
#pragma unroll
        for (int g = 0; g < 8; ++g) {
            { f32x4 acc = {0.f, 0.f, 0.f, 0.f};
                if (k >= 0) {
                    *(LAS v4u*)ubw = U[g][0]; *(LAS v4u*)(ubw + 8 * 144) = U[g][1];
#pragma unroll
                    for (int i = 0; i < 2; ++i) { const v4u uu = *(const LAS v4u*)(ubr + 64 * i); const i32x8_t A8 = {(int)uu.x, (int)uu.y, (int)uu.z, (int)uu.w, 0, 0, 0, 0};
                        const i32x8_t B8 = {(int)ha[i].x, (int)ha[i].y, (int)ha[i].z, (int)ha[i].w, (int)hb[i].x, (int)hb[i].y, 0, 0};
                        acc = __builtin_amdgcn_mfma_scale_f32_16x16x128_f8f6f4(A8, B8, acc, 4, 2, 0, 127, 0, 127); } }
                if ((g & 1) == 0) { pv0 = pk2c(acc[0], acc[1]); pv1 = pk2c(acc[2], acc[3]); }
                else if (m16 == 0) *(v4u*)(pp + 4 * (g - 1)) = (v4u){pv0, pv1, pk2c(acc[0], acc[1]), pk2c(acc[2], acc[3])}; }
#pragma unroll
            for (int j = 0; j < 2; ++j) { const int em = __shfl(g < 4 ? en0 : en1, (g & 3) * 16 + 8 * j + r8); U[g][j] = *(const v4u*)(TUb + (unsigned)(em * 128 + 16 * sg)); }
            __builtin_amdgcn_sched_barrier(0);
        }
#pragma unroll
        for (int i = 0; i < 2; ++i) { ha[i] = han[i]; hb[i] = hbn[i]; }
        en0 = enn0; en1 = enn1;
    }
}
__device__ __forceinline__ void ph_peer_coef(const Args& a, int layer, LAS unsigned char* lds, int lane, int wave) {
    const int p0 = 16 * ((lane >> 1) & 7) + 4 * (lane >> 4) + 2 * (lane & 1);
    const int* EI = (const int*)(a.ws + WS_EI) + p0; const float* GT = (const float*)(a.ws + WS_GT) + p0; const unsigned* PART = (const unsigned*)(a.ws + WS_PART) + lane;
    const float* SU = (const float*)(a.ws + WS_SU) + layer * NEXP; const float* HS = (const float*)(a.ws + WS_HS);
    unsigned char* AR = a.ws + WS_AR; int* EQ = (int*)(a.ws + WS_EQ) + (p0 & 7) * 16 + (p0 >> 3);
    LAS float* CFL = (LAS float*)(lds + wave * 1024);
    const int gw = blockIdx.x * NWAVES + wave, NGW = gridDim.x * NWAVES;
#pragma unroll 1
    for (int t = gw; t < M; t += NGW) {
        const size_t tt = (size_t)t; const int2 ee = *(const int2*)(EI + tt * 128); const float2 gg = *(const float2*)(GT + tt * 128); const float hs = HS[t];
        unsigned P[8];
#pragma unroll
        for (int xx = 0; xx < 8; ++xx) P[xx] = PART[(tt * 8 + xx) * 64];
        const float s0 = SU[ee.x], s1 = SU[ee.y];
        const float d0 = ((bf_lo(P[0]) + bf_lo(P[1])) + (bf_lo(P[2]) + bf_lo(P[3]))) + ((bf_lo(P[4]) + bf_lo(P[5])) + (bf_lo(P[6]) + bf_lo(P[7])));
        const float d1 = ((bf_hi(P[0]) + bf_hi(P[1])) + (bf_hi(P[2]) + bf_hi(P[3]))) + ((bf_hi(P[4]) + bf_hi(P[5])) + (bf_hi(P[6]) + bf_hi(P[7])));
        const float c0 = gelu_tanh(d0 * hs * s0) * gg.x, c1 = gelu_tanh(d1 * hs * s1) * gg.y;
        EQ[tt * 128] = ee.x * 128; EQ[tt * 128 + 16] = ee.y * 128;
        const float cmx = fmaxf(wave_max(fmaxf(fabsf(c0), fabsf(c1))), 1e-30f), csc = 7.5f / cmx;
        CFL[p0] = c0 * csc; CFL[p0 + 1] = c1 * csc;
        f32x16_t pa, pb;
#pragma unroll
        for (int i = 0; i < 8; ++i) { const f32x4 c4 = *(const LAS f32x4*)(CFL + 32 * (lane & 3) + 4 * i); pa[2 * i] = c4[0]; pb[2 * i] = c4[1]; pa[2 * i + 1] = c4[2]; pb[2 * i + 1] = c4[3]; }
        const u32x6_t ph = __builtin_amdgcn_cvt_scalef32_2xpk16_fp6_f32(pa, pb, 1.0f);
        if (lane < 4) { unsigned char* rp = AR + tt * 128 + 32 * lane; *(v4u*)rp = (v4u){ph[0], ph[1], ph[2], ph[3]}; *(v4u*)(rp + 16) = (v4u){ph[4], ph[5], __float_as_uint(cmx * (1.f / 7.5f)), 0u}; }
    }
}
__device__ __forceinline__ void ph_peer_v(const Args& a, int layer, volatile LAS unsigned* st, LAS unsigned char* lds, int lane, int wave) {
    int x, rank, nrank; peer_slice(a, st, x, rank, nrank); const int q = lane >> 3, sg = lane & 7, n16 = lane & 15, kc = lane >> 4;
    const unsigned char* TVb = a.ws + WS_TV + (size_t)layer * NEXP * ROWV + (size_t)x * NEXP * 128;
    const int* EQ = (const int*)(a.ws + WS_EQ) + q * 16; const unsigned char* AR = a.ws + WS_AR + 32 * kc;
    if (rank >= nrank) return;
    const int t0 = rank * NWAVES + wave, ts = nrank * NWAVES, nt = (M - t0 + ts - 1) / ts;
    constexpr int VS = 144;
    LAS unsigned char* img = lds + wave * (128 * VS);
    LAS unsigned char* iw = img + q * VS + 16 * sg;
    const LAS unsigned char* ir = img + (32 * kc + n16) * VS;
    typedef int v2i_ __attribute__((ext_vector_type(2)));
    int inv16, ncol; bool tr_ok;
    { *(LAS v2u*)(ir) = (v2u){0x11111111u * (unsigned)n16, 0x11111111u * (unsigned)n16};
      const v2i_ ra = __builtin_amdgcn_ds_read_tr4_b64_v2i32((LAS v2i_*)ir);
      *(LAS v2u*)(ir) = (v2u){0x76543210u, 0xfedcba98u};
      const v2i_ rb = __builtin_amdgcn_ds_read_tr4_b64_v2i32((LAS v2i_*)ir);
      const unsigned r0 = (unsigned)__builtin_amdgcn_readfirstlane(ra.x), r1 = (unsigned)__builtin_amdgcn_readfirstlane(ra.y);
      ncol = rb.x & 15; inv16 = 0; unsigned seen = 0u;
#pragma unroll
      for (int e = 0; e < 16; ++e) { const int rr = (int)(((e < 8 ? r0 : r1) >> (4 * (e & 7))) & 15u); if (rr == n16) inv16 = e; seen |= 1u << rr; }
      bool ok = (unsigned)ra.x == r0 && (unsigned)ra.y == r1 && (unsigned)rb.x == 0x11111111u * (unsigned)ncol && (unsigned)rb.y == 0x11111111u * (unsigned)ncol && seen == 0xffffu;
      unsigned cols = 0u;
#pragma unroll
      for (int i = 0; i < 16; ++i) cols |= 1u << (__shfl(ncol, i) & 15);
      ok = ok && cols == 0xffffu;
      ok = ok && r0 == 0x76543210u && r1 == 0xfedcba98u && ncol == n16;
      tr_ok = __all(ok); }
    unsigned char* Y4 = a.ws + WS_Y + 256 * x + 4 * lane;
    (void)inv16;
    v4u W[16];
#pragma unroll
    for (int i = 0; i < 16; ++i) W[i] = (v4u){0u, 0u, 0u, 0u};
    v4u epn[4], ar0 = {0u, 0u, 0u, 0u}, ar1 = ar0;
#pragma unroll
    for (int j = 0; j < 4; ++j) epn[j] = (v4u){0u, 0u, 0u, 0u};
#pragma unroll 1
    for (int k = -2; k < nt; ++k) {
        const int k2 = k + 2 < nt ? k + 2 : nt - 1, k1 = k + 1 < nt ? (k + 1 < 0 ? 0 : k + 1) : nt - 1; const size_t tn2 = (size_t)(t0 + ts * k2), tn1 = (size_t)(t0 + ts * k1);
        v4u epnn[4];
#pragma unroll
        for (int j = 0; j < 4; ++j) epnn[j] = *(const v4u*)(EQ + tn2 * 128 + 4 * j);
        const v4u arn0 = *(const v4u*)(AR + tn1 * 128), arn1 = *(const v4u*)(AR + tn1 * 128 + 16);
        int ep[16];
#pragma unroll
        for (int j = 0; j < 4; ++j) { ep[4 * j] = (int)epn[j].x; ep[4 * j + 1] = (int)epn[j].y; ep[4 * j + 2] = (int)epn[j].z; ep[4 * j + 3] = (int)epn[j].w; }
        __builtin_amdgcn_sched_barrier(0);
#pragma unroll
        for (int i = 0; i < 16; ++i) {
            *(LAS v4u*)(iw + 8 * i * VS) = W[i];
            W[i] = *(const v4u*)(TVb + (unsigned)(ep[i] + 16 * sg));
            __builtin_amdgcn_sched_barrier(0);
        }
        float yv[16];
#pragma unroll
        for (int j = 0; j < 16; ++j) yv[j] = 0.f;
        if (k >= 0) {
            i32x8_t A8 = {(int)ar0.x, (int)ar0.y, (int)ar0.z, (int)ar0.w, (int)ar1.x, (int)ar1.y, 0, 0};
            if (n16 != 0) A8 = (i32x8_t){0, 0, 0, 0, 0, 0, 0, 0};
            const float ysc = __uint_as_float(ar1.z);
#pragma unroll
            for (int j = 0; j < 16; ++j) {
                const v2i_ b0 = __builtin_amdgcn_ds_read_tr4_b64_v2i32((LAS v2i_*)(ir + 8 * j)), b1 = __builtin_amdgcn_ds_read_tr4_b64_v2i32((LAS v2i_*)(ir + 16 * VS + 8 * j));
                const i32x8_t B8 = {b0.x, b0.y, b1.x, b1.y, 0, 0, 0, 0};
                const f32x4 acc = __builtin_amdgcn_mfma_scale_f32_16x16x128_f8f6f4(A8, B8, (f32x4){0.f, 0.f, 0.f, 0.f}, 2, 4, 0, 127, 0, 127);
                yv[j] = acc[0] * ysc; }
        }
        if (!tr_ok) { _Pragma("unroll") for (int j = 0; j < 16; ++j) yv[j] = __builtin_nanf(""); }
        { LAS float* yl = (LAS float*)img;
          if (kc == 0) {
#pragma unroll
              for (int j = 0; j < 16; ++j) yl[16 * j + ncol] = yv[j]; }
          const f32x4 y4 = *(const LAS f32x4*)(yl + 4 * lane);
          *(unsigned*)(Y4 + (size_t)(t0 + ts * (k < 0 ? 0 : k)) * DM) = pk4_fp8(y4[0] * YP_SCALE, y4[1] * YP_SCALE, y4[2] * YP_SCALE, y4[3] * YP_SCALE); }
        ar0 = arn0; ar1 = arn1;
#pragma unroll
        for (int j = 0; j < 4; ++j) epn[j] = epnn[j];
    }
}
template <bool FINAL>
__device__ __forceinline__ void ph_peer_ln(const Args& a, const float* mod_l, const float* mod_next, const float* lng, const float* lnb, int lane, int wave) {
    const bf16* H2 = (const bf16*)(a.ws + WS_H2); bf16* HB = (bf16*)(a.ws + WS_HB); const unsigned char* Y = a.ws + WS_Y;
    const int gw = blockIdx.x * NWAVES + wave, NGW = gridDim.x * NWAVES;
#pragma unroll 1
    for (int t = gw; t < M; t += NGW) {
        const int b = t >> 13;
        float out[32];
        { unsigned lo0 = (unsigned)lane * 4u; asm volatile("" : "+v"(lo0)); const unsigned char* yrow = Y + (size_t)t * DM;
#pragma unroll
          for (int j = 0; j < 8; ++j) { const unsigned yw = *(const unsigned*)(yrow + lo0 + 256 * j); const auto ya = __builtin_amdgcn_cvt_pk_f32_fp8((int)yw, false), yb = __builtin_amdgcn_cvt_pk_f32_fp8((int)yw, true);
              out[4 * j] = ya[0] * (1.f / YP_SCALE); out[4 * j + 1] = ya[1] * (1.f / YP_SCALE); out[4 * j + 2] = yb[0] * (1.f / YP_SCALE); out[4 * j + 3] = yb[1] * (1.f / YP_SCALE); } }
        unsigned lo = (unsigned)lane * 16u; asm volatile("" : "+v"(lo));
        const char* mb = (const char*)(mod_l + b * 12288); const char* h2row = (const char*)(H2 + (size_t)t * DM);
#define LD4_(base, j_) (*(const f32x4*)((const char*)(base) + lo + 1024 * (j_)))
#pragma unroll
        for (int j = 0; j < 8; ++j) { const v2u hw = *(const v2u*)(h2row + (lo >> 1) + 512 * j); const float h4[4] = {bf_lo(hw.x), bf_hi(hw.x), bf_lo(hw.y), bf_hi(hw.y)};
            const f32x4 ga = LD4_(mb + 10240 * 4, j), sf = LD4_(mb + 8192 * 4, j), hf = LD4_(mb + 6144 * 4, j);
#pragma unroll
            for (int e = 0; e < 4; ++e) { const float x1 = (h4[e] - hf[e]) * __builtin_amdgcn_rcpf(1.f + sf[e]); out[4 * j + e] = ALPHA * x1 + (1.f + ga[e]) * out[4 * j + e]; } }
        float s = 0.f;
#pragma unroll
        for (int e = 0; e < 32; ++e) s += out[e];
        const float mean = wave_sum(s) * (1.f / DM); float q2 = 0.f;
#pragma unroll
        for (int e = 0; e < 32; ++e) { out[e] -= mean; q2 += out[e] * out[e]; }
        const float rstd = rsqrtf(wave_sum(q2) * (1.f / DM) + LN_EPS);
        const char* mn = (const char*)(mod_next + b * 12288); char* orow = (char*)(a.out + (size_t)t * DM); char* hrow = (char*)(HB + (size_t)t * DM);
        float hmx = 0.f; (void)hmx;
#pragma unroll
        for (int j = 0; j < 8; ++j) { const f32x4 la = LD4_(lng, j), ba = LD4_(lnb, j); f32x4 na;
#pragma unroll
            for (int e = 0; e < 4; ++e) na[e] = out[4 * j + e] * rstd * la[e] + ba[e];
            if constexpr (FINAL) *(f32x4*)(orow + lo + 1024 * j) = na;
            else { const f32x4 sa = LD4_(mn + 2048 * 4, j), ha = LD4_(mn, j);
#pragma unroll
                for (int e = 0; e < 4; ++e) { const float hn = na[e] * (1.f + sa[e]) + ha[e]; out[4 * j + e] = hn; hmx = fmaxf(hmx, fabsf(hn)); }
                *(v2u*)(hrow + (lo >> 1) + 512 * j) = (v2u){pk2(out[4 * j], out[4 * j + 1]), pk2(out[4 * j + 2], out[4 * j + 3])}; } }
        if constexpr (!FINAL) {
            hmx = fmaxf(wave_max(hmx), 1e-30f); const float inv8 = 240.f / hmx; unsigned char* h8row = a.ws + WS_HB8 + (size_t)t * DM;
#pragma unroll
            for (int j = 0; j < 8; ++j) { unsigned w = 0u; w = __builtin_amdgcn_cvt_pk_fp8_f32(out[4 * j] * inv8, out[4 * j + 1] * inv8, w, false); w = __builtin_amdgcn_cvt_pk_fp8_f32(out[4 * j + 2] * inv8, out[4 * j + 3] * inv8, w, true);
                *(unsigned*)(h8row + (lo >> 2) + 256 * j) = w; }
            if (lane == 0) ((float*)(a.ws + WS_SA))[t] = hmx * (1.f / 240.f); }
#undef LD4_
    }
}

__device__ __forceinline__ void ph_forget(const Args& a, LAS unsigned char* lds, int lane, int wave) {
    const bf16* HB = (const bf16*)(a.ws + WS_HB); const bf16* WF = (const bf16*)(a.ws + WS_WF); float* LF = (float*)(a.ws + WS_LF);
    const int m16 = lane & 15, kc = lane >> 4, kh = wave & 1;
    LAS f32x4* xch = (LAS f32x4*)lds;
    for (int base = blockIdx.x * (NWAVES / 2); base < M / 16; base += gridDim.x * (NWAVES / 2)) {
        const int item = base + (wave >> 1); const bool live = item < M / 16;
        const int t0 = (live ? item : 0) * 16; f32x4 acc = {0.f, 0.f, 0.f, 0.f};
        const bf16* ap = HB + (size_t)(t0 + m16) * DM + 8 * kc + 1024 * kh; const bf16* bp = WF + (size_t)m16 * DM + 8 * kc + 1024 * kh;
#pragma unroll 16
        for (int s = 0; s < 32; ++s) { const bf16x8 av = *(const bf16x8*)(ap + 32 * s), bv = *(const bf16x8*)(bp + 32 * s); acc = __builtin_amdgcn_mfma_f32_16x16x32_bf16(av, bv, acc, 0, 0, 0); }
        xch[wave * 64 + lane] = acc;
        __syncthreads();
        if (kh == 0 && live) { const f32x4 oth = xch[(wave + 1) * 64 + lane]; const float bfv = a.in[22][m16]; f32x4 o;
#pragma unroll
            for (int r = 0; r < 4; ++r) { const float x = acc[r] + oth[r] + bfv; o[r] = fminf(x, 0.f) - log1pf(__expf(-fabsf(x))); }
            const int t = t0 + 4 * kc, b = t >> 13, pos = t & (SEQ - 1);
            *(f32x4*)(LF + (size_t)(b * 16 + m16) * SEQ + pos) = o; }
        __syncthreads();
    }
}
__device__ __forceinline__ void ph_cumsum(const Args& a, int lane, int wave) {
    const float* LF = (const float*)(a.ws + WS_LF); float* FB = (float*)(a.ws + WS_FB);
    float* FE = (float*)(a.ws + WS_FE); float* FP = (float*)(a.ws + WS_FP);
    const int gw = blockIdx.x * NWAVES + wave, NGW = gridDim.x * NWAVES;
    const int sidx = NGW >= 1056 ? gw - 1024 : gw;
    for (int seq = sidx; seq >= 0 && seq < 32; seq += NGW) {
        const float* src = LF + (size_t)seq * SEQ + lane * 128; float* dst = FB + (size_t)seq * SEQ + lane * 128;
        f32x4 vv[32];
#pragma unroll
        for (int i = 0; i < 32; ++i) vv[i] = *(const f32x4*)(src + 4 * i);
        float s = 0.f;
#pragma unroll
        for (int i = 0; i < 32; ++i) s += (vv[i][0] + vv[i][1]) + (vv[i][2] + vv[i][3]);
        float inc = s;
#pragma unroll
        for (int o = 1; o < 64; o <<= 1) { const float n = __shfl_up(inc, o); if (lane >= o) inc += n; }
        float run = inc - s;
#pragma unroll
        for (int i = 0; i < 32; ++i) { const f32x4 v = vv[i]; f32x4 o;
            run += v[0]; o[0] = run; run += v[1]; o[1] = run; run += v[2]; o[2] = run; run += v[3]; o[3] = run;
            if (i == 0 && (lane & 1) == 0) FP[seq * 32 + (lane >> 1)] = -o[0];
            if (i == 15) FE[seq * 128 + 2 * lane] = -o[3];
            if (i == 31) FE[seq * 128 + 2 * lane + 1] = -o[3];
            *(f32x4*)(dst + 4 * i) = o * (-1.f / ATT_SCALE); }
    }
    const bf16* QK = (const bf16*)(a.ws + WS_ZB);
    for (int item = gw; item < 1024; item += NGW) {
        const int seq = item >> 5, blk = item & 31, b = seq >> 4, h = seq & 15;
        const bf16* qb = QK + ((size_t)b * SEQ + (size_t)blk * 256) * DM + h * 128 + 8 * (lane & 15); const bf16* kb = qb + (size_t)M * DM;
        float mq = 0.f, mk = 0.f, md = 3.0e38f;
#pragma unroll 8
        for (int r = 0; r < 64; ++r) { const size_t ro = (size_t)(4 * r + (lane >> 4)) * DM; float vq[8], vk[8]; ld8(qb + ro, vq); ld8(kb + ro, vk);
            float sq = 0.f, sk = 0.f, sd = 0.f;
#pragma unroll
            for (int e = 0; e < 8; ++e) { sq += vq[e] * vq[e]; sk += vk[e] * vk[e]; sd += vq[e] * vk[e]; }
            sq += SWZ_XOR_(sq, 1); sk += SWZ_XOR_(sk, 1); sd += SWZ_XOR_(sd, 1); sq += SWZ_XOR_(sq, 2); sk += SWZ_XOR_(sk, 2); sd += SWZ_XOR_(sd, 2);
            sq += SWZ_XOR_(sq, 4); sk += SWZ_XOR_(sk, 4); sd += SWZ_XOR_(sd, 4); sq += SWZ_XOR_(sq, 8); sk += SWZ_XOR_(sk, 8); sd += SWZ_XOR_(sd, 8);
            mq = fmaxf(mq, sq); mk = fmaxf(mk, sk); md = fminf(md, sd); }
        mq = wave_max(mq); mk = wave_max(mk); md = -wave_max(-md);
        if (lane == 0) { ((float*)(a.ws + WS_QN))[seq * 32 + blk] = mq; ((float*)(a.ws + WS_KN))[seq * 32 + blk] = mk; ((float*)(a.ws + WS_DN))[seq * 32 + blk] = md; }
    }
}

constexpr float SKIP_T = 20.f;
__device__ __forceinline__ attn::BlockRef<__hip_bfloat16, __hip_bfloat16> attn_mkref(int L, const __hip_bfloat16* Q, const __hip_bfloat16* K, const __hip_bfloat16* V, __hip_bfloat16* O, const unsigned char* ws, int lane) {
    const int qb = 31 - (L >> 5), seq = L & 31, b = seq >> 4, h = seq & 15;
    attn::BlockRef<__hip_bfloat16, __hip_bfloat16> r; const size_t rowq = (size_t)b * SEQ + (size_t)qb * attn::QB, row0 = (size_t)b * SEQ;
    r.Q = Q + rowq * DM + h * 128; r.O = O + rowq * DM + h * 128; r.K = K + row0 * DM + h * 128; r.V = V + row0 * DM + h * 128; r.Fb = (const float*)(ws + WS_FB) + (size_t)seq * SEQ; r.P0 = qb * attn::QB; r.O8 = (unsigned char*)ws + WS_YC8 + rowq * DM + h * 128;
    const char* FE = (const char*)((const float*)(ws + WS_FE) + seq * 128); const char* KN = (const char*)((const float*)(ws + WS_KN) + seq * 32);
    unsigned l4 = (unsigned)lane * 4u; asm volatile("" : "+v"(l4));
    const float kn = wave_max((lane & 31) <= qb ? *(const float*)(KN + (l4 & 124u)) : 0.f), qn = ((const float*)(ws + WS_QN))[seq * 32 + qb], fp = ((const float*)(ws + WS_FP))[seq * 32 + qb];
    const float dn = ((const float*)(ws + WS_DN))[seq * 32 + qb];
    const float tgt = fp - (SKIP_T + (sqrtf(qn * kn) * 1.0001f - dn) * ATT_SCALE);
    const int cnt = __popcll(__ballot(*(const float*)(FE + l4) <= tgt)) + __popcll(__ballot(*(const float*)(FE + 256 + l4) <= tgt));
    r.jlo = cnt < 4 * qb ? cnt : 4 * qb;
    return r;
}
__device__ __forceinline__ void ph_attention(const Args& a, char* lds, const int tid) {
    using namespace attn;
    typedef __hip_bfloat16 T;
    const T* Q = (const T*)(a.ws + WS_ZB); const T* K = Q + (size_t)M * DM; const T* V = K + (size_t)M * DM; T* O = (T*)(a.ws + WS_YC);
    unsigned* ctr = (unsigned*)(a.ws + 32768);
    volatile int* nextw = (volatile int*)(lds + attn::LDS_BYTES);
    const int lane = tid & 63, total = 1024;
    int L = blockIdx.x; if (L >= total) return;
    BlockRef<T, T> cur = attn_mkref(L, Q, K, V, O, a.ws, lane);
    Seam<T> S;
    causal_swa_prime<T, T>(cur, SEQ, lds, S, tid);
    for (;;) {
        if (tid == 0) *nextw = (int)gridDim.x + (int)__hip_atomic_fetch_add(ctr, 1u, __ATOMIC_RELAXED, __HIP_MEMORY_SCOPE_AGENT);
        __syncthreads();
        const int Ln = __builtin_amdgcn_readfirstlane(*nextw); const bool last = Ln >= total;
        const BlockRef<T, T> nxt = last ? cur : attn_mkref(Ln, Q, K, V, O, a.ws, lane);
        causal_swa_block<T, T>(cur, nxt, SEQ, SEQ, lds, S, tid);
        if (last) break;
        cur = nxt; L = Ln;
    }
}

__global__ void __launch_bounds__(NTHREADS, 2) mk_fwd(Args a) {
    extern __shared__ __attribute__((aligned(16))) unsigned char lds_raw[];
    cg::grid_group grid = cg::this_grid();
    LAS unsigned char* lds = (LAS unsigned char*)lds_raw;
    const int wave = __builtin_amdgcn_readfirstlane((int)threadIdx.x >> 6);
    unsigned char* ws = a.ws;
    const float* MOD = (const float*)(ws + WS_MOD);
    const int lo = a.ph_lo, hi = a.ph_hi;
    XcdBarrier bar;
    { const int l0 = lane_id(); volatile LAS unsigned* st = (volatile LAS unsigned*)(lds + LDS_CTL);
      if (wave == 0 && l0 == 0) { st[0] = 0u; st[1] = 0u; }
      __syncthreads();
      bar.bar = (unsigned*)ws; bar.x = xb_xcc_id(); bar.st = st;
      if (lo == 0) { if (blockIdx.x == 0) { unsigned* z = (unsigned*)ws; const int t_ = wave * 64 + l0;
#pragma unroll 1
              for (int i = t_; i < 4096; i += NTHREADS) __hip_atomic_store(z + i, 0u, __ATOMIC_RELAXED, __HIP_MEMORY_SCOPE_AGENT);
              if (t_ == 0) __hip_atomic_store(z + 8192, 0u, __ATOMIC_RELAXED, __HIP_MEMORY_SCOPE_AGENT); } }
      else if (wave == 0 && l0 == 0) { st[2] = xb_add(&bar.bar[XB_XCNT(bar.x)], 1u); st[3] = bar.x; } }
    int ph = 0;
#define PHASE_BEGIN if (ph >= lo && ph < hi) { const int lane = lane_id(), tid = wave * 64 + lane; (void)tid; (void)lane;
#define TID tid
#define PHASE_END   if (ph + 1 < hi) { if (ph == 0) { grid.sync(); if (wave == 0 && lane_id() == 0) { bar.st[2] = xb_add(&bar.bar[XB_XCNT(bar.x)], 1u); bar.st[3] = bar.x; } } else xcd_barrier(bar, wave == 0 && lane_id() == 0);     } } ++ph;
    bf16* HB = (bf16*)(ws + WS_HB); bf16* ZB = (bf16*)(ws + WS_ZB); bf16* YC = (bf16*)(ws + WS_YC); bf16* YB = (bf16*)(ws + WS_YB);
    float* X1 = (float*)(ws + WS_X1); bf16* H2 = (bf16*)(ws + WS_H2); bf16* QP = (bf16*)(ws + WS_QP);

    PHASE_BEGIN ph_prologue(a, lds, tid, lane, wave); PHASE_END
    PHASE_BEGIN ph_modulate(a.in[0], MOD, 0, 2048, HB, ws + WS_HB8, (float*)(ws + WS_SA), lane, wave); PHASE_END
    PHASE_BEGIN { pg8::Gemm g{(const bf16*)(ws + WS_HB8), (const bf16*)(ws + WS_WIN), M, NZ, DM / 2, DM / 2, DM / 2}; pg8::StaticOrder S; S.init(M, NZ, gridDim.x, blockIdx.x);
        pg8::EpiI8RowScaleBf16 E{ZB, NZ, (const float*)(ws + WS_SA), 1.f / W8_SCALE, 0, 0}; pg8::gemm_phase<pg8::EpiI8RowScaleBf16, pg8::StaticOrder, true, true, false, true>(lds, g, S, E, TID); } PHASE_END
    PHASE_BEGIN ph_poolconv(a, lane, wave); PHASE_END
    PHASE_BEGIN {
        if (gridDim.x == 256) {
            { const int gq = blockIdx.x >> 6, pm = blockIdx.x & 63;
              pg8::Gemm g{(const bf16*)(ws + WS_PO) + gq * 256, (const bf16*)(ws + WS_WPOOL) + gq * 65536, M, 256, 256, 1024, 256}; pg8::ListOrder S{pm, 1};
              pg8::EpiScaleBf16 E{ws + WS_YC8 + gq * 256, DM, a.in[12] + gq * 256, Y8_SCALE}; pg8::gemm_phase<pg8::EpiScaleBf16, pg8::ListOrder, false, true>(lds, g, S, E, TID); }
            { const int hb = blockIdx.x >> 5, pm0 = (blockIdx.x & 31) * 2;
              int kg = 128; asm volatile("" : "+s"(kg));
              pg8::Gemm g{(const bf16*)(ws + WS_XC) + hb * 128, (const bf16*)(ws + WS_WAX) + hb * 32768, M, 256, kg, 1024, 128}; pg8::ListOrder S{pm0, 2};
              pg8::EpiGate E{(const bf16*)(ws + WS_XC), (float*)(ws + WS_AF), (float*)(ws + WS_DF), a.in[16], a.in[18], (const float*)(ws + WS_LS8), hb * 128};
              pg8::gemm_phase<pg8::EpiGate, pg8::ListOrder, false, false>(lds, g, S, E, wave * 64 + lane_id());
              asm volatile("s_waitcnt vmcnt(0)" ::: "memory"); __syncthreads();
              { const int t_ = wave * 64 + lane_id(), st = pm0 * 2 + (t_ >> 7), c = hb * 128 + (t_ & 127); const unsigned* AD = (const unsigned*)(ws + WS_AF) + (size_t)st * 128 * 1024 + c;
                float LA = 0.f, H = 0.f;
#pragma unroll 32
                for (int i = 0; i < 128; ++i) { const unsigned pw = AD[(size_t)i * 1024]; const float la = bf_lo(pw), dv = bf_hi(pw); H = __builtin_amdgcn_exp2f(la) * H + dv; LA += la; }
                ((float*)(ws + WS_AG))[st * 1024 + c] = __builtin_amdgcn_exp2f(LA); ((float*)(ws + WS_HG))[st * 1024 + c] = H; } }
        } } PHASE_END
    PHASE_BEGIN ph_scan_fin(a, tid); PHASE_END
    PHASE_BEGIN { pg8::Gemm g{(const bf16*)(ws + WS_YC8), (const bf16*)(ws + WS_WOUT), M, DM, DM / 2, DM / 2, DM / 2}; pg8::StaticOrder S; S.init(M, DM, gridDim.x, blockIdx.x);
        pg8::EpiRowScaleBf16 E{YB, DM, nullptr, 1.f / (W8O_SCALE * Y8_SCALE), 0, 0}; pg8::gemm_phase<pg8::EpiRowScaleBf16, pg8::StaticOrder, true, true, true>(lds, g, S, E, TID); } PHASE_END
    PHASE_BEGIN ph_ln<true>(YB, nullptr, HB, MOD, MOD, a.in[4], a.in[5], H2, ws + WS_X1, (float*)(ws + WS_X1 + 64 * MiB), ws + WS_H6, (float*)(ws + WS_HS), lane, wave); PHASE_END
    PHASE_BEGIN { pg8::Gemm g{(const bf16*)(ws + WS_X1), (const bf16*)(ws + WS_WQ0), M, DM, DM / 2, DM / 2, DM / 2}; pg8::StaticOrder S; S.init(M, DM, gridDim.x, blockIdx.x);
        pg8::EpiI8RowScaleBf16 E{QP, DM, (const float*)(ws + WS_X1 + 64 * MiB), 1.f / W8_SCALE, 0, 0}; pg8::gemm_phase<pg8::EpiI8RowScaleBf16, pg8::StaticOrder, true, true, false, true>(lds, g, S, E, TID); } PHASE_END
    PHASE_BEGIN ph_topk(a, 0, lds, tid, lane, wave); PHASE_END
    PHASE_BEGIN ph_peer_u(a, 0, (volatile LAS unsigned*)(lds + LDS_CTL), lds, lane, wave); PHASE_END
    PHASE_BEGIN ph_peer_coef(a, 0, lds, lane, wave); PHASE_END
    PHASE_BEGIN ph_peer_v(a, 0, (volatile LAS unsigned*)(lds + LDS_CTL), lds, lane, wave); PHASE_END
    PHASE_BEGIN ph_peer_ln<false>(a, MOD, MOD + 2 * 12288, a.in[4] + DM, a.in[5] + DM, lane, wave); PHASE_END
    PHASE_BEGIN { pg8::Gemm g{(const bf16*)(ws + WS_HB8), (const bf16*)(ws + WS_WQKV), M, NQKV, DM / 2, DM / 2, DM / 2}; pg8::StaticOrder S; S.init(M, NQKV, gridDim.x, blockIdx.x);
        pg8::EpiRowScaleBf16 E{ZB, DM, (const float*)(ws + WS_SA), 1.f / W8_SCALE, DM, (size_t)M * DM}; pg8::gemm_phase<pg8::EpiRowScaleBf16, pg8::StaticOrder, true, true, true>(lds, g, S, E, TID);
        ph_forget(a, lds, lane, wave); } PHASE_END
    PHASE_BEGIN ph_cumsum(a, lane, wave); PHASE_END
    PHASE_BEGIN ph_attention(a, (char*)lds_raw, TID); PHASE_END
    PHASE_BEGIN { pg8::Gemm g{(const bf16*)(ws + WS_YC8), (const bf16*)(ws + WS_WO), M, DM, DM / 2, DM / 2, DM / 2}; pg8::StaticOrder S; S.init(M, DM, gridDim.x, blockIdx.x);
        pg8::EpiRowScaleBf16 E{YB, DM, nullptr, 1.f / (W8O_SCALE * attn::O8_SCALE), 0, 0}; pg8::gemm_phase<pg8::EpiRowScaleBf16, pg8::StaticOrder, true, true, true>(lds, g, S, E, TID); } PHASE_END
    PHASE_BEGIN ph_ln<true>(YB, nullptr, HB, MOD + 2 * 12288, MOD + 2 * 12288, a.in[4] + 2 * DM, a.in[5] + 2 * DM, H2, ws + WS_X1, (float*)(ws + WS_X1 + 64 * MiB), ws + WS_H6, (float*)(ws + WS_HS), lane, wave); PHASE_END
    PHASE_BEGIN { pg8::Gemm g{(const bf16*)(ws + WS_X1), (const bf16*)(ws + WS_WQ1), M, DM, DM / 2, DM / 2, DM / 2}; pg8::StaticOrder S; S.init(M, DM, gridDim.x, blockIdx.x);
        pg8::EpiI8RowScaleBf16 E{QP, DM, (const float*)(ws + WS_X1 + 64 * MiB), 1.f / W8_SCALE, 0, 0}; pg8::gemm_phase<pg8::EpiI8RowScaleBf16, pg8::StaticOrder, true, true, false, true>(lds, g, S, E, TID); } PHASE_END
    PHASE_BEGIN ph_topk(a, 1, lds, tid, lane, wave); PHASE_END
    PHASE_BEGIN ph_peer_u(a, 1, (volatile LAS unsigned*)(lds + LDS_CTL), lds, lane, wave); PHASE_END
    PHASE_BEGIN ph_peer_coef(a, 1, lds, lane, wave); PHASE_END
    PHASE_BEGIN ph_peer_v(a, 1, (volatile LAS unsigned*)(lds + LDS_CTL), lds, lane, wave); PHASE_END
    PHASE_BEGIN ph_peer_ln<true>(a, MOD + 2 * 12288, MOD, a.in[4] + 3 * DM, a.in[5] + 3 * DM, lane, wave); PHASE_END
#undef PHASE_BEGIN
#undef TID
#undef PHASE_END
}
constexpr int N_PHASES = 25;

extern "C" void kernel_launch(void* const* d_in, const int* in_sizes, int n_in, void* d_out, int out_size, void* d_ws, size_t ws_size, hipStream_t stream) {
    static int grid = 0;
    if (grid == 0) {
        int dev = 0, cus = 0, per_cu = 0;
        if (n_in != 24 || out_size != M * DM || ws_size < WS_END) { fprintf(stderr, "kernel_launch: unexpected shapes (n_in %d, out %d, ws %zu)\n", n_in, out_size, ws_size); grid = -1; return; }
        (void)hipGetDevice(&dev);
        (void)hipDeviceGetAttribute(&cus, hipDeviceAttributeMultiprocessorCount, dev);
        (void)hipFuncSetAttribute((const void*)mk_fwd, hipFuncAttributeMaxDynamicSharedMemorySize, LDS_BYTES);
        (void)hipOccupancyMaxActiveBlocksPerMultiprocessor(&per_cu, (const void*)mk_fwd, NTHREADS, LDS_BYTES);
        if (per_cu < 1) { fprintf(stderr, "kernel_launch: occupancy query reports %d blocks per CU\n", per_cu); grid = -1; return; }
        grid = cus;
        if (grid != 256) fprintf(stderr, "kernel_launch: %d CUs; phase 4 is written for 256 workgroups\n", grid);
    }
    if (grid < 0) return;
#ifdef MK_SPLIT
    if (hipMemsetAsync(d_ws, 0, 65536, stream) != hipSuccess) { fprintf(stderr, "kernel_launch: hipMemsetAsync failed\n"); return; }
#endif
    Args a{};
    for (int i = 0; i < 24; ++i) a.in[i] = (const float*)d_in[i];
    a.out = (float*)d_out; a.ws = (unsigned char*)d_ws;
#ifndef MK_SPLIT
    a.ph_lo = 0; a.ph_hi = N_PHASES;
    void* args[] = {&a};
    hipError_t e = hipLaunchCooperativeKernel((const void*)mk_fwd, dim3(grid), dim3(NTHREADS), args, LDS_BYTES, stream);
    if (e != hipSuccess) fprintf(stderr, "cooperative launch failed: %s (grid %d)\n", hipGetErrorString(e), grid);
#else
    for (int p = 0; p < N_PHASES; ++p) { a.ph_lo = p; a.ph_hi = p + 1; void* args[] = {&a};
        hipError_t e = hipLaunchCooperativeKernel((const void*)mk_fwd, dim3(grid), dim3(NTHREADS), args, LDS_BYTES, stream);
        if (e != hipSuccess) { fprintf(stderr, "launch %d failed: %s\n", p, hipGetErrorString(e)); break; } }
#endif
}
```

```cpp
#include <hip/hip_runtime.h>
#include <hip/hip_bf16.h>
#include <hip/hip_cooperative_groups.h>
#include <cstdio>
#include <cstdint>
#include <cmath>
namespace cg = cooperative_groups;
namespace pg8 {
#define PG8_LAS __attribute__((address_space(3)))
typedef unsigned short bf16_t;
typedef short bf16x8 __attribute__((ext_vector_type(8)));
typedef float f32x4 __attribute__((ext_vector_type(4)));
typedef unsigned u32x4 __attribute__((ext_vector_type(4)));
constexpr int BM = 256, BK = 64, HALF = 128, HTB = HALF * BK * 2  , STAGE_BYTES = 8 * HTB, NXCD = 8, WGM = 8;

__host__ __device__ __forceinline__ int lds_byte(int r, int c) { const int st = (r >> 4) * 2 + (c >> 5), rr = r & 15, cc = c & 31, ob = rr * 64 + cc * 2; return st * 1024 + (ob ^ (((ob >> 9) & 1) << 5)); }
__host__ __device__ __forceinline__ void stage_rc(int b, int& R, int& C) { const int st = b / 1024, sb = b % 1024, swz = sb ^ (((sb >> 9) & 1) << 5); R = (st >> 1) * 16 + swz / 64; C = (st & 1) * 32 + (swz % 64) / 2; }
__host__ __device__ __forceinline__ int perm32(int rho) { const int n = rho >> 4, i = rho & 15; return 8 * (i >> 2) + 4 * n + (i & 3); }

struct Unit { int pm, pn; };
struct Gemm { const bf16_t* A; const bf16_t* Bt; int M, N, K, lda, ldb; };

struct StaticOrder {
    int nM, nN, nwg, G, c;
    __host__ __device__ void init(int M, int N, int G_, int c_) { nM = M / BM; nN = N / BM; nwg = nM * nN; G = G_; c = c_; }
    __host__ __device__ bool next(int i, Unit& u) const {
        const long L = (long)i * G + c; if (L >= nwg) return false;
        int wgid = (int)L; { const int q = nwg / NXCD, r = nwg % NXCD, xcd = wgid % NXCD, off = wgid / NXCD; wgid = (xcd < r ? xcd * (q + 1) : r * (q + 1) + (xcd - r) * q) + off; }
        const int nig = WGM * nN, gid = wgid / nig, fm = gid * WGM, gsz = (nM - fm) < WGM ? (nM - fm) : WGM;
        u.pm = fm + ((wgid % nig) % gsz); u.pn = (wgid % nig) / gsz; return true;
    }
    __device__ __forceinline__ void a_ready(const Unit&) const {}
    __device__ __forceinline__ void done(const Unit&) const {}
};

__device__ __forceinline__ unsigned cvt_pk_bf16(float lo, float hi) { typedef float f2_ __attribute__((ext_vector_type(2))); typedef __bf16 b2_ __attribute__((ext_vector_type(2))); const f2_ f = {lo, hi}; return __builtin_bit_cast(unsigned, __builtin_convertvector(f, b2_)); }
typedef float f32x2 __attribute__((ext_vector_type(2)));
__device__ __forceinline__ f32x2 gelu_pk(f32x2 v) {
    const f32x2 av = __builtin_elementwise_abs(v), d = av * 0.2316418882f + 1.0f;
    f32x2 t; t.x = __builtin_amdgcn_rcpf(d.x); t.y = __builtin_amdgcn_rcpf(d.y);
    f32x2 q = t * 0.5307027145f + (-0.7265760135f); q = q * t + 0.7107068705f; q = q * t + (-0.142248368f); q = q * t + 0.127414796f; q = q * t;
    const f32x2 s = (v * v) * (-0.72134752044f);
    f32x2 e; e.x = __builtin_amdgcn_exp2f(s.x); e.y = __builtin_amdgcn_exp2f(s.y);
    const f32x2 m = v * (q * e), r = v - m;
    f32x2 o; o.x = v.x < 0.f ? m.x : r.x; o.y = v.y < 0.f ? m.y : r.y; return o;
}

template <int ACT  > struct EpiBf16 {
    static constexpr bool PERM = true, AFTER_DRAIN = false; static_assert(ACT == 0 || ACT == 1, "EpiBf16: ACT is 0 (none) or 1 (gelu_pk)");
    bf16_t* O; int ldc; const float* bias; int split_cols; size_t split_stride; float scale0;
    __device__ __forceinline__ void operator()(const f32x4 (&acc)[2][2][4][2], const Unit& u, int wr, int wc, int fr, int fq) const {
        const int row0 = u.pm * BM + wr * 64 + fr; int colt = u.pn * BM; bf16_t* base = O;
        float sc = 1.f; if (split_cols) { const int t = colt / split_cols; base += (size_t)t * split_stride; colt -= t * split_cols; if (t == 0) sc = scale0; }
        const int col0 = colt + wc * 32 + 8 * fq, bcol0 = u.pn * BM + wc * 32 + 8 * fq;
        f32x4 bv[2][2];
#pragma unroll
        for (int bj = 0; bj < 2; ++bj)
#pragma unroll
            for (int n = 0; n < 2; ++n) bv[bj][n] = bias ? *(const f32x4*)(bias + bcol0 + bj * HALF + 4 * n) : (f32x4){0.f, 0.f, 0.f, 0.f};
#pragma unroll
        for (int ai = 0; ai < 2; ++ai)
#pragma unroll
            for (int m = 0; m < 4; ++m) { bf16_t* rowp = base + (size_t)(row0 + ai * HALF + m * 16) * ldc + col0;
#pragma unroll
                for (int bj = 0; bj < 2; ++bj) { f32x4 v0 = acc[ai][bj][m][0] + bv[bj][0], v1 = acc[ai][bj][m][1] + bv[bj][1];
                    if (ACT == 1) { f32x2 a = gelu_pk((f32x2){v0[0], v0[1]}), b = gelu_pk((f32x2){v0[2], v0[3]}), c = gelu_pk((f32x2){v1[0], v1[1]}), d = gelu_pk((f32x2){v1[2], v1[3]});
                        v0 = (f32x4){a.x, a.y, b.x, b.y}; v1 = (f32x4){c.x, c.y, d.x, d.y}; }
                    v0 = v0 * sc; v1 = v1 * sc; u32x4 w; w.x = cvt_pk_bf16(v0[0], v0[1]); w.y = cvt_pk_bf16(v0[2], v0[3]); w.z = cvt_pk_bf16(v1[0], v1[1]); w.w = cvt_pk_bf16(v1[2], v1[3]);
                    *(u32x4*)(rowp + bj * HALF) = w; } }
    }
};

template <class Epi, class Sched, bool ALIGN_EPI = false, bool SP2 = false, bool FP8 = false, bool I8 = false>
__device__ __forceinline__ void gemm_phase(PG8_LAS unsigned char* lds, const Gemm g, const Sched& S, const Epi& E, const int tid) {
    const int wid = __builtin_amdgcn_readfirstlane(tid >> 6), lane = tid & 63, wr = wid >> 2, wc = wid & 3, fr = lane & 15, fq = lane >> 4;
    const int K = g.K, nt = K / BK;
    unsigned voffA[2], voffB[2];
#pragma unroll
    for (int i = 0; i < 2; ++i) { int R, C; stage_rc(tid * 16 + i * 8192, R, C); const int Rb = Epi::PERM ? ((R & ~31) + perm32(R & 31)) : R;
        voffA[i] = (unsigned)(R * g.lda + C) * 2u; voffB[i] = (unsigned)(Rb * g.ldb + C) * 2u; }
    const __amdgpu_buffer_rsrc_t rA = __builtin_amdgcn_make_buffer_rsrc((void*)g.A, 0, (int)((size_t)g.M * g.lda * 2), 0x00020000), rB = __builtin_amdgcn_make_buffer_rsrc((void*)g.Bt, 0, (int)((size_t)g.N * g.ldb * 2), 0x00020000);
    const size_t kstep = (size_t)(BK * 2);
    const size_t hstepA = (size_t)HALF * g.lda * 2, hstepB = (size_t)HALF * g.ldb * 2;
    const size_t tstepA = 2 * hstepA, tstepB = 2 * hstepB;
    const unsigned ldsw = (unsigned)wid * 1024u;
    const int aoffk[2] = {FP8 ? lds_byte(wr * 64 + fr, fq * 16) : lds_byte(wr * 64 + fr, fq * 8), FP8 ? lds_byte(wr * 64 + fr, fq * 16 + 8) : lds_byte(wr * 64 + fr, fq * 8) + 1024};
    const int boffk[2] = {FP8 ? lds_byte(wc * 32 + fr, fq * 16) : lds_byte(wc * 32 + fr, fq * 8), FP8 ? lds_byte(wc * 32 + fr, fq * 16 + 8) : lds_byte(wc * 32 + fr, fq * 8) + 1024};
#define PG8_SA(b, h) (((b) * 2 + (h)) * HTB)
#define PG8_SB(b, h) ((4 + (b) * 2 + (h)) * HTB)
#define PG8_STAGE(bufoff, gbase, voff, rs, gorig) do { _Pragma("unroll") for (int _i = 0; _i < 2; ++_i) \
        __builtin_amdgcn_raw_ptr_buffer_load_lds(rs, (PG8_LAS void*)(lds + (bufoff) + ldsw + _i * 8192), 16, (voff)[_i], (unsigned)((const char*)(gbase) - (const char*)(gorig)), 0, 0); } while (0)
#define PG8_LDA(dst, b, h) do { if constexpr (FP8) { _Pragma("unroll") for (int m = 0; m < 4; ++m) dst##8[m] = __builtin_shufflevector(*(const PG8_LAS bf16x8*)(lds + PG8_SA(b, h) + aoffk[0] + m * 2048), *(const PG8_LAS bf16x8*)(lds + PG8_SA(b, h) + aoffk[1] + m * 2048), 0, 1, 2, 3, 4, 5, 6, 7, 8, 9, 10, 11, 12, 13, 14, 15); } \
        else { _Pragma("unroll") for (int m = 0; m < 4; ++m) _Pragma("unroll") for (int k = 0; k < 2; ++k) dst[m][k] = *(const PG8_LAS bf16x8*)(lds + PG8_SA(b, h) + aoffk[k] + m * 2048); } } while (0)
#define PG8_LDB(dst, b, h) do { if constexpr (FP8) { _Pragma("unroll") for (int n = 0; n < 2; ++n) dst##8[n] = __builtin_shufflevector(*(const PG8_LAS bf16x8*)(lds + PG8_SB(b, h) + boffk[0] + n * 2048), *(const PG8_LAS bf16x8*)(lds + PG8_SB(b, h) + boffk[1] + n * 2048), 0, 1, 2, 3, 4, 5, 6, 7, 8, 9, 10, 11, 12, 13, 14, 15); } \
        else { _Pragma("unroll") for (int n = 0; n < 2; ++n) _Pragma("unroll") for (int k = 0; k < 2; ++k) dst[n][k] = *(const PG8_LAS bf16x8*)(lds + PG8_SB(b, h) + boffk[k] + n * 2048); } } while (0)
#define PG8_MMA(ai, bj, At, Bt) do { __builtin_amdgcn_s_setprio(1); _Pragma("unroll") for (int m = 0; m < 4; ++m) _Pragma("unroll") for (int n = 0; n < 2; ++n) { \
        if constexpr (FP8) { typedef int i32x8 __attribute__((ext_vector_type(8))); \
            acc[ai][bj][m][n] = __builtin_amdgcn_mfma_scale_f32_16x16x128_f8f6f4(__builtin_bit_cast(i32x8, Bt##8[n]), __builtin_bit_cast(i32x8, At##8[m]), acc[ai][bj][m][n], 0, 0, 0, 127, 0, 127); } \
        else if constexpr (I8) { typedef int i32x4_ __attribute__((ext_vector_type(4))); _Pragma("unroll") for (int k = 0; k < 2; ++k) \
            acc[ai][bj][m][n] = __builtin_bit_cast(f32x4, __builtin_amdgcn_mfma_i32_16x16x64_i8(__builtin_bit_cast(i32x4_, Bt[n][k]), __builtin_bit_cast(i32x4_, At[m][k]), __builtin_bit_cast(i32x4_, acc[ai][bj][m][n]), 0, 0, 0)); } \
        else { _Pragma("unroll") for (int k = 0; k < 2; ++k) acc[ai][bj][m][n] = __builtin_amdgcn_mfma_f32_16x16x32_bf16(Bt[n][k], At[m][k], acc[ai][bj][m][n], 0, 0, 0); } } \
        __builtin_amdgcn_s_setprio(0); } while (0)
#define PG8_WAIT_V(n) asm volatile("s_waitcnt vmcnt(" #n ")" ::: "memory")
#define PG8_WAIT_L(n) asm volatile("s_waitcnt lgkmcnt(" #n ")" ::: "memory")
#define PG8_BAR __builtin_amdgcn_s_barrier()
#define PG8_SCHED __builtin_amdgcn_sched_barrier(0)
    Unit cur, nxt; int ui = 0;
    if (!S.next(0, cur)) return;
    f32x4 acc[2][2][4][2];
#pragma unroll
    for (int a = 0; a < 2; ++a)
#pragma unroll
        for (int b = 0; b < 2; ++b)
#pragma unroll
            for (int m = 0; m < 4; ++m)
#pragma unroll
                for (int n = 0; n < 2; ++n) acc[a][b][m][n] = (f32x4){0.f, 0.f, 0.f, 0.f};
    bf16x8 At[4][2], B0[2][2], B1[2][2]; typedef short bf16x16 __attribute__((ext_vector_type(16))); bf16x16 At8[4], B08[2], B18[2];
    const char* cA = (const char*)g.A + (size_t)cur.pm * tstepA; const char* cB = (const char*)g.Bt + (size_t)cur.pn * tstepB;
    S.a_ready(cur);
    if constexpr (SP2) {
        PG8_STAGE(PG8_SB(0, 0), cB, voffB, rB, g.Bt); PG8_STAGE(PG8_SB(0, 1), cB + hstepB, voffB, rB, g.Bt); PG8_STAGE(PG8_SA(0, 0), cA, voffA, rA, g.A); PG8_STAGE(PG8_SA(0, 1), cA + hstepA, voffA, rA, g.A);
        if (wr == 1) PG8_BAR;
        PG8_WAIT_V(2); PG8_BAR;
        PG8_STAGE(PG8_SB(1, 0), cB + kstep, voffB, rB, g.Bt); PG8_STAGE(PG8_SA(1, 0), cA + kstep, voffA, rA, g.A); PG8_STAGE(PG8_SB(1, 1), cB + hstepB + kstep, voffB, rB, g.Bt);
        PG8_WAIT_V(6); PG8_BAR;
    } else {
        PG8_STAGE(PG8_SB(0, 0), cB, voffB, rB, g.Bt); PG8_STAGE(PG8_SA(0, 0), cA, voffA, rA, g.A); PG8_STAGE(PG8_SB(0, 1), cB + hstepB, voffB, rB, g.Bt); PG8_STAGE(PG8_SA(0, 1), cA + hstepA, voffA, rA, g.A);
        if (wr == 1) PG8_BAR;
        PG8_WAIT_V(4); PG8_BAR;
        PG8_STAGE(PG8_SB(1, 0), cB + kstep, voffB, rB, g.Bt); PG8_STAGE(PG8_SA(1, 0), cA + kstep, voffA, rA, g.A); PG8_STAGE(PG8_SB(1, 1), cB + hstepB + kstep, voffB, rB, g.Bt);
        PG8_WAIT_V(6); PG8_BAR;
    }
    for (;;) {
        const bool has_next = S.next(ui + 1, nxt);
        const char* nA = has_next ? (const char*)g.A + (size_t)nxt.pm * tstepA : cA; const char* nB = has_next ? (const char*)g.Bt + (size_t)nxt.pn * tstepB : cB;
        for (int t = 0; t < nt; t += 2) {
            const bool last = (t == nt - 2);
            const char* a1 = cA + (size_t)(t + 1) * kstep;
            const char* a2 = last ? nA : cA + (size_t)(t + 2) * kstep; const char* b2 = last ? nB : cB + (size_t)(t + 2) * kstep;
            const char* a3 = a2 + kstep; const char* b3 = b2 + kstep;
            if (last && has_next) S.a_ready(nxt);
            if constexpr (SP2) {
            PG8_LDB(B0, 0, 0); PG8_LDB(B1, 0, 1); PG8_SCHED; PG8_LDA(At, 0, 0); PG8_STAGE(PG8_SA(1, 1), a1 + hstepA, voffA, rA, g.A);
            PG8_WAIT_V(8); PG8_WAIT_L(0); PG8_BAR; PG8_MMA(0, 0, At, B0); PG8_MMA(0, 1, At, B1); PG8_BAR; PG8_SCHED;
            PG8_LDA(At, 0, 1); PG8_STAGE(PG8_SB(0, 0), b2, voffB, rB, g.Bt); PG8_STAGE(PG8_SB(0, 1), b2 + hstepB, voffB, rB, g.Bt); PG8_STAGE(PG8_SA(0, 0), a2, voffA, rA, g.A);
            PG8_WAIT_V(8); PG8_WAIT_L(0); PG8_BAR; PG8_MMA(1, 0, At, B0); PG8_MMA(1, 1, At, B1); PG8_BAR; PG8_SCHED;
            PG8_LDB(B0, 1, 0); PG8_LDB(B1, 1, 1); PG8_SCHED; PG8_LDA(At, 1, 0); PG8_STAGE(PG8_SA(0, 1), a2 + hstepA, voffA, rA, g.A);
            PG8_WAIT_V(8); PG8_WAIT_L(0); PG8_BAR; PG8_MMA(0, 0, At, B0); PG8_MMA(0, 1, At, B1); PG8_BAR; PG8_SCHED;
            PG8_LDA(At, 1, 1); PG8_STAGE(PG8_SB(1, 0), b3, voffB, rB, g.Bt); PG8_STAGE(PG8_SB(1, 1), b3 + hstepB, voffB, rB, g.Bt); PG8_STAGE(PG8_SA(1, 0), a3, voffA, rA, g.A);
            PG8_WAIT_V(8); PG8_WAIT_L(0); PG8_BAR; PG8_MMA(1, 0, At, B0); PG8_MMA(1, 1, At, B1); PG8_BAR; PG8_SCHED;
            } else {
            PG8_LDB(B0, 0, 0); PG8_SCHED; PG8_LDA(At, 0, 0); PG8_STAGE(PG8_SA(1, 1), a1 + hstepA, voffA, rA, g.A);
            PG8_WAIT_L(8); PG8_BAR; PG8_WAIT_L(0); PG8_MMA(0, 0, At, B0); PG8_BAR; PG8_SCHED;
            PG8_LDB(B1, 0, 1); PG8_STAGE(PG8_SB(0, 0), b2, voffB, rB, g.Bt);
            PG8_BAR; PG8_WAIT_L(0); PG8_MMA(0, 1, At, B1); PG8_BAR;
            PG8_LDA(At, 0, 1); PG8_STAGE(PG8_SA(0, 0), a2, voffA, rA, g.A);
            PG8_BAR; PG8_WAIT_L(0); PG8_MMA(1, 0, At, B0); PG8_BAR; PG8_SCHED;
            PG8_STAGE(PG8_SB(0, 1), b2 + hstepB, voffB, rB, g.Bt);
            PG8_WAIT_V(6); PG8_BAR; PG8_MMA(1, 1, At, B1); PG8_BAR;
            PG8_LDB(B0, 1, 0); PG8_SCHED; PG8_LDA(At, 1, 0); PG8_STAGE(PG8_SA(0, 1), a2 + hstepA, voffA, rA, g.A);
            PG8_WAIT_L(8); PG8_BAR; PG8_WAIT_L(0); PG8_MMA(0, 0, At, B0); PG8_BAR; PG8_SCHED;
            PG8_LDB(B1, 1, 1); PG8_STAGE(PG8_SB(1, 0), b3, voffB, rB, g.Bt);
            PG8_BAR; PG8_WAIT_L(0); PG8_MMA(0, 1, At, B1); PG8_BAR;
            PG8_LDA(At, 1, 1); PG8_STAGE(PG8_SA(1, 0), a3, voffA, rA, g.A);
            PG8_BAR; PG8_WAIT_L(0); PG8_MMA(1, 0, At, B0); PG8_BAR; PG8_SCHED;
            PG8_STAGE(PG8_SB(1, 1), b3 + hstepB, voffB, rB, g.Bt);
            PG8_WAIT_V(6); PG8_BAR; PG8_MMA(1, 1, At, B1); PG8_BAR;
            }
        }
        if constexpr (ALIGN_EPI) { if (wr == 0) PG8_BAR; }
        if constexpr (!Epi::AFTER_DRAIN) { E(acc, cur, wr, wc, fr, fq); S.done(cur); }
        if (!has_next) break;
#pragma unroll
        for (int a = 0; a < 2; ++a)
#pragma unroll
            for (int b = 0; b < 2; ++b)
#pragma unroll
                for (int m = 0; m < 4; ++m)
#pragma unroll
                    for (int n = 0; n < 2; ++n) acc[a][b][m][n] = (f32x4){0.f, 0.f, 0.f, 0.f};
        cur = nxt; cA = nA; cB = nB; ++ui;
        if constexpr (ALIGN_EPI) { if (wr == 1) PG8_BAR; }
    }
    PG8_WAIT_V(0);
    if constexpr (!ALIGN_EPI) { if (wr == 0) PG8_BAR; }
    PG8_BAR;
    if constexpr (Epi::AFTER_DRAIN) { E.fused(acc, cur, wr, wc, fr, fq, lds, wid, lane); S.done(cur); }
#undef PG8_SA
#undef PG8_SB
#undef PG8_STAGE
#undef PG8_LDA
#undef PG8_LDB
#undef PG8_MMA
#undef PG8_WAIT_V
#undef PG8_WAIT_L
#undef PG8_BAR
#undef PG8_SCHED
}
}

namespace attn {
constexpr float SCALE = 0.08838834764831845f;
constexpr int D = 128, PITCH = 2048;
constexpr float THR = 8.f; constexpr bool WSKIP = true; constexpr bool O_FP8 = true; constexpr float O8_SCALE = 16.f;
constexpr int NW = 8, QBLK = 32, KVBLK = 64, QB = NW * QBLK;
constexpr int SHM_V = KVBLK * D * 2, SHM_K = KVBLK * D * 2;
constexpr int LDS_BIAS = 2 * SHM_V + 2 * SHM_K + NW * 64 * 4;
constexpr int LDS_BYTES = LDS_BIAS + 2 * 256;
using bf16 = __hip_bfloat16;
typedef short bf16x8 __attribute__((ext_vector_type(8)));
typedef short s16x4 __attribute__((ext_vector_type(4)));
typedef float f32x16 __attribute__((ext_vector_type(16)));
typedef float f32x4 __attribute__((ext_vector_type(4)));
typedef unsigned u32x4 __attribute__((ext_vector_type(4)));
template <class A, class Bt> struct same_t { static constexpr bool v = false; };
template <class A> struct same_t<A, A> { static constexpr bool v = true; };

#define KSWZ(row, colB) ((row) * 256 + ((colB) ^ (((row) & 7) << 4)))
#define SBAR() __builtin_amdgcn_sched_barrier(0)
__device__ __forceinline__ int v_st(int k, int c) { const int kk = (k & ~0xC) | ((k & 4) << 1) | ((k & 8) >> 1); return ((kk >> 3) * 4 + (c >> 5)) * 512 + ((kk & 7) * 32 + (c & 31)) * 2; }
__device__ __forceinline__ int v_rd_base(int lane) { return ((lane & 3) << 3) | (((lane >> 2) & 3) << 6) | (((lane >> 4) & 1) << 5) | (((lane >> 5) & 1) << 8); }
constexpr int v_rd_off(int d0, int ks, int half) { return d0 * 512 + ks * 4096 + half * 2048; }
__device__ __forceinline__ int crow(int r, int hi) { return (r & 3) + 8 * (r >> 2) + 4 * hi; }
__device__ __forceinline__ unsigned cvtpk(float lo, float hi) {
    typedef float f2_ __attribute__((ext_vector_type(2))); typedef __bf16 b2_ __attribute__((ext_vector_type(2))); const f2_ f = {lo, hi}; return __builtin_bit_cast(unsigned, __builtin_convertvector(f, b2_));
}
__device__ __forceinline__ bf16x8 pack8(f32x4 a, f32x4 b) {
    u32x4 w = {cvtpk(a[0], a[1]), cvtpk(a[2], a[3]), cvtpk(b[0], b[1]), cvtpk(b[2], b[3])};
    return *reinterpret_cast<bf16x8*>(&w);
}
template <class T> __device__ __forceinline__ bf16x8 load8(const T* p) {
    if constexpr (same_t<T, float>::v) { return pack8(*(const f32x4*)p, *(const f32x4*)(p + 4)); }
    else { return *reinterpret_cast<const bf16x8*>(p); }
}
__device__ __forceinline__ void mask_tile(f32x16& p0, f32x16& p1, int dq, unsigned W) {
    const float NEG = -__builtin_inff();
#pragma unroll
    for (int r = 0; r < 16; ++r) {
        const int c = (r & 3) + 8 * (r >> 2);
        if ((unsigned)(dq - c) >= W) p0[r] = NEG;
        if ((unsigned)(dq - c - 32) >= W) p1[r] = NEG;
    }
}
constexpr float DEAD_T = 20.f;
__device__ __forceinline__ void partialSM(f32x16& p0, f32x16& p1, float& m_reg, float& mn, float& alpha, bool& dead) {
    float pmax = p0[0]; for (int r = 1; r < 16; ++r) pmax = fmaxf(pmax, p0[r]); for (int r = 0; r < 16; ++r) pmax = fmaxf(pmax, p1[r]);
    { auto rr = __builtin_amdgcn_permlane32_swap(__float_as_uint(pmax), __float_as_uint(pmax), false, false);
      pmax = fmaxf(__uint_as_float(rr[0]), __uint_as_float(rr[1])); }
    constexpr float C2 = 1.4426950408889634f * SCALE;
    dead = __all((pmax - m_reg) * SCALE < -DEAD_T);
    if (dead) { mn = m_reg; alpha = 1.f; return; }
    if (__builtin_expect(__all((pmax - m_reg) * SCALE <= THR), 1)) { mn = m_reg; alpha = 1.f; }
    else { mn = fmaxf(m_reg, pmax); alpha = __builtin_amdgcn_exp2f((m_reg - mn) * C2); m_reg = mn; }
    const float mnL = -mn * C2;
    for (int r = 0; r < 16; ++r) p0[r] = fmaf(p0[r], C2, mnL); for (int r = 0; r < 16; ++r) p1[r] = fmaf(p1[r], C2, mnL);
    for (int r = 0; r < 16; ++r) p0[r] = __builtin_amdgcn_exp2f(p0[r]);
}
__device__ __forceinline__ void finishSM(f32x16& p0, f32x16& p1, float alpha, float& l_reg, bf16x8& pa0, bf16x8& pa1, bf16x8& pa2, bf16x8& pa3) {
    for (int r = 0; r < 16; ++r) p1[r] = __builtin_amdgcn_exp2f(p1[r]);
    float ps = 0; for (int r = 0; r < 16; ++r) ps += p0[r]; for (int r = 0; r < 16; ++r) ps += p1[r];
    { auto rr = __builtin_amdgcn_permlane32_swap(__float_as_uint(ps), __float_as_uint(ps), false, false);
      ps = __uint_as_float(rr[0]) + __uint_as_float(rr[1]); }
    l_reg = l_reg * alpha + ps;
#define PK4(P, B_, OUT) do { unsigned a0 = cvtpk(P[B_+0], P[B_+1]), a1 = cvtpk(P[B_+2], P[B_+3]);                          \
        unsigned b0 = cvtpk(P[B_+4], P[B_+5]), b1 = cvtpk(P[B_+6], P[B_+7]);                                             \
        auto r0 = __builtin_amdgcn_permlane32_swap(a0, b0, false, false); auto r1 = __builtin_amdgcn_permlane32_swap(a1, b1, false, false); \
        u32x4 w = {r0[0], r1[0], r0[1], r1[1]}; OUT = *reinterpret_cast<bf16x8*>(&w); } while (0)
    PK4(p0, 0, pa0); PK4(p0, 8, pa1); PK4(p1, 0, pa2); PK4(p1, 8, pa3);
#undef PK4
}
template <int KB, bool SK>
__device__ __forceinline__ void qkt(f32x16& p0, f32x16& p1, const char* K_lds, int r32, int hi, const bf16x8* qr, bool act) {
    const float* bl = (const float*)(K_lds - 2 * SHM_V + LDS_BIAS + KB * 256) + 4 * hi;
    if (SK && !act) { const float NEG = -__builtin_inff();
#pragma unroll
        for (int r = 0; r < 16; ++r) { p0[r] = NEG; p1[r] = NEG; } return; }
#pragma unroll
    for (int g_ = 0; g_ < 4; ++g_) { const f32x4 b0_ = *(const f32x4*)(bl + 8 * g_), b1_ = *(const f32x4*)(bl + 32 + 8 * g_);
#pragma unroll
        for (int e_ = 0; e_ < 4; ++e_) { p0[4 * g_ + e_] = b0_[e_]; p1[4 * g_ + e_] = b1_[e_]; } }
    const char* kb[4];
#pragma unroll
    for (int dd = 0; dd < 4; ++dd) kb[dd] = K_lds + KB * SHM_K + KSWZ(r32, (dd * 16 + hi * 8) * 2);
#pragma unroll
    for (int d0 = 0; d0 < 8; ++d0) { const char* a = kb[d0 & 3] + (d0 >> 2) * 128;
        bf16x8 b0 = *reinterpret_cast<const bf16x8*>(a);
        bf16x8 b1 = *reinterpret_cast<const bf16x8*>(a + 32 * 256);
        p0 = __builtin_amdgcn_mfma_f32_32x32x16_bf16(b0, qr[d0], p0, 0, 0, 0);
        p1 = __builtin_amdgcn_mfma_f32_32x32x16_bf16(b1, qr[d0], p1, 0, 0, 0); }
}
template <int VB, bool SK>
__device__ __forceinline__ void pv_tile(f32x16* o, int vb0, bf16x8 pa0, bf16x8 pa1, bf16x8 pa2, bf16x8 pa3, bool act) {
    if (SK && !act) return;
#define TRRD(dst, off) asm volatile("ds_read_b64_tr_b16 %0, %1 offset:%2" : "=&v"(dst) : "v"(vb0), "i"(off) : "memory")
#define PV_D0(d0) do { s16x4 l0, l1, l2, l3, h0, h1, h2, h3; constexpr int b_ = VB * SHM_V + v_rd_off(d0, 0, 0);     \
        TRRD(l0, b_); TRRD(h0, b_ + 2048); TRRD(l1, b_ + 4096); TRRD(h1, b_ + 6144); TRRD(l2, b_ + 8192); TRRD(h2, b_ + 10240); TRRD(l3, b_ + 12288); TRRD(h3, b_ + 14336); \
        asm volatile("s_waitcnt lgkmcnt(0)" ::: "memory"); SBAR();                 \
        o[d0] = __builtin_amdgcn_mfma_f32_32x32x16_bf16(pa0, (bf16x8){l0[0], l0[1], l0[2], l0[3], h0[0], h0[1], h0[2], h0[3]}, o[d0], 0, 0, 0);   \
        o[d0] = __builtin_amdgcn_mfma_f32_32x32x16_bf16(pa1, (bf16x8){l1[0], l1[1], l1[2], l1[3], h1[0], h1[1], h1[2], h1[3]}, o[d0], 0, 0, 0);   \
        o[d0] = __builtin_amdgcn_mfma_f32_32x32x16_bf16(pa2, (bf16x8){l2[0], l2[1], l2[2], l2[3], h2[0], h2[1], h2[2], h2[3]}, o[d0], 0, 0, 0);   \
        o[d0] = __builtin_amdgcn_mfma_f32_32x32x16_bf16(pa3, (bf16x8){l3[0], l3[1], l3[2], l3[3], h3[0], h3[1], h3[2], h3[3]}, o[d0], 0, 0, 0); } while (0)
    PV_D0(0); PV_D0(1); PV_D0(2); PV_D0(3);
#undef PV_D0
#undef TRRD
}

template <class TIn, class TOut> struct BlockRef { const TIn* Q; const TIn* K; const TIn* V; TOut* O; const float* Fb; int P0; int jlo; unsigned char* O8; };
template <class TIn> struct Seam {
    bf16x8 qr[8];
    bf16x8 st_v0, st_v1, st_k0, st_k1; f32x4 sf0, sf1, sf2, sf3;
    f32x4 tq[16];
};
__device__ __forceinline__ int swa_jlo(int P0, int W) { const int lowk = P0 - W + 1; return lowk > 0 ? lowk / KVBLK : 0; }
#define ROW(p, k0, rr) ((const TIn*)((const char*)(p) + (unsigned)((((k0) + (rr)) * PITCH + sc) * (int)sizeof(TIn))))
#define VMW() asm volatile("s_waitcnt vmcnt(0)" ::: "memory")
#define VMWN(n) asm volatile("s_waitcnt vmcnt(%0)" :: "i"(n) : "memory")
#define SLOAD_H(Kp, Vp, Fp, bb, k0) do { S.st_v0 = load8<TIn>(ROW(Vp, k0, sr)); S.st_v1 = load8<TIn>(ROW(Vp, k0, 32 + sr));              \
                         S.st_k0 = load8<TIn>(ROW(Kp, k0, sr)); S.st_k1 = load8<TIn>(ROW(Kp, k0, 32 + sr));                          \
                         if (wid == 0) __builtin_amdgcn_global_load_lds((const unsigned*)((Fp) + (k0) + lane), (__attribute__((address_space(3))) unsigned*)(lds + LDS_BIAS + (bb) * 256), 4, 0, 0); } while (0)
#define SWRITE_HK(bf) do { int t_ = tid; asm volatile("" : "+v"(t_)); const int kws_ = KSWZ(t_ >> 4, (t_ & 15) * 16);     \
        *(bf16x8*)(K_lds + (bf) * SHM_K + kws_) = S.st_k0; *(bf16x8*)(K_lds + (bf) * SHM_K + kws_ + 32 * 256) = S.st_k1; } while (0)
#define SWRITE_HV(bf) do { int t_ = tid; asm volatile("" : "+v"(t_)); const int vst0_ = v_st(t_ >> 4, (t_ & 15) * 8), vst1_ = v_st(32 + (t_ >> 4), (t_ & 15) * 8); \
        *(bf16x8*)(V_lds + (bf) * SHM_V + vst0_) = S.st_v0; *(bf16x8*)(V_lds + (bf) * SHM_V + vst1_) = S.st_v1; } while (0)
#define SWRITE_H(bf) do { SWRITE_HV(bf); SWRITE_HK(bf); } while (0)
#define SLOAD_F(p, k0) do { S.sf0 = *(const f32x4*)ROW(p, k0, sr); S.sf1 = *(const f32x4*)(ROW(p, k0, sr) + 4);                \
                            S.sf2 = *(const f32x4*)ROW(p, k0, 32 + sr); S.sf3 = *(const f32x4*)(ROW(p, k0, 32 + sr) + 4); } while (0)
#define SWRITE_KF(bf) do { *(bf16x8*)(K_lds + (bf) * SHM_K + kws) = pack8(S.sf0, S.sf1); *(bf16x8*)(K_lds + (bf) * SHM_K + kws + 32 * 256) = pack8(S.sf2, S.sf3); } while (0)
#define SWRITE_VF(bf) do { *(bf16x8*)(V_lds + (bf) * SHM_V + vst0) = pack8(S.sf0, S.sf1); *(bf16x8*)(V_lds + (bf) * SHM_V + vst1) = pack8(S.sf2, S.sf3); } while (0)
template <class TIn, class TOut>
__device__ __forceinline__ void causal_swa_prime(const BlockRef<TIn, TOut>& cur, int W, char* lds, Seam<TIn>& S, const int tid) {
    constexpr bool F32 = same_t<TIn, float>::v;
    const int wid = __builtin_amdgcn_readfirstlane(tid >> 6), lane = tid & 63, r32 = lane & 31, hi = lane >> 5;
    const int sr = tid >> 4, sc = (tid & 15) * 8, kws = KSWZ(sr, sc * 2); char* K_lds = lds + 2 * SHM_V;
    const int kb0 = ((cur.P0 + QB - 1) / KVBLK) * KVBLK;
    for (int d0 = 0; d0 < 8; ++d0) S.qr[d0] = load8<TIn>(cur.Q + (size_t)(wid * QBLK + r32) * PITCH + d0 * 16 + hi * 8);
    if constexpr (F32) { SLOAD_F((const float*)cur.K, kb0); VMW(); SWRITE_KF(0); SBAR(); SLOAD_F((const float*)cur.V, kb0); }
    else { SLOAD_H(cur.K, cur.V, cur.Fb, 0, kb0); VMW(); SWRITE_HK(0); }
    __syncthreads();
}
template <class TIn, class TOut>
__device__ __forceinline__ void causal_swa_block(const BlockRef<TIn, TOut>& cur, const BlockRef<TIn, TOut>& nxt, int skv, int W, char* lds, Seam<TIn>& S, const int tid) {
    constexpr bool F32 = same_t<TIn, float>::v;
    const int wid = __builtin_amdgcn_readfirstlane(tid >> 6), lane = tid & 63, r32 = lane & 31, hi = lane >> 5;
    const int j_lo = cur.jlo;
    int j_hi = (cur.P0 + QB - 1) / KVBLK + 1; if (j_hi > skv / KVBLK) j_hi = skv / KVBLK;
    const int NT = j_hi - j_lo;
    const int kbn = ((nxt.P0 + QB - 1) / KVBLK) * KVBLK;
    const int qlo = cur.P0 + wid * QBLK, qm = qlo + r32 - 4 * hi;
    char* V_lds = lds; char* K_lds = lds + 2 * SHM_V;
    float* ws = (float*)(lds + 2 * SHM_V + 2 * SHM_K) + wid * 64; float* li_l = ws, * al_l = ws + 32;
    float m_reg = -1e30f, l_reg = 0; f32x16 o[4] = {};
    const int sr = tid >> 4, sc = (tid & 15) * 8, vst0 = v_st(sr, sc), vst1 = v_st(32 + sr, sc), kws = KSWZ(sr, sc * 2);
    const int vb0 = (int)(uintptr_t)V_lds + v_rd_base(lane);
    const TIn* Kh = cur.K; const TIn* Vh = cur.V;
#define RESC(a) do { if (__any((a) < 1.f)) { if (hi == 0) al_l[r32] = (a); asm volatile("s_waitcnt lgkmcnt(0)" ::: "memory");              \
                     for (int d_ = 0; d_ < 4; ++d_) for (int r = 0; r < 16; ++r) o[d_][r] *= al_l[crow(r, hi)]; } } while (0)
#define KBASE(t) ((j_hi - 1 - (t)) * KVBLK)
#define ACT(t) (KBASE(t) <= qlo + QBLK - 1 && KBASE(t) + KVBLK - 1 >= qlo - W + 1)
#define MASKT(P0_, P1_, t) do { const int kb_ = KBASE(t); if ((!SK || ACT(t)) && (kb_ + KVBLK - 1 > qlo || kb_ <= qlo + QBLK - 1 - W)) mask_tile(P0_, P1_, qm - kb_, (unsigned)W); } while (0)
    constexpr int NQL = F32 ? 16 : 8;
    constexpr bool SK = WSKIP && !F32;
#define SEAM_K0() do { VMWN(NQL); if constexpr (F32) { SWRITE_KF(0); SBAR(); SLOAD_F((const float*)nxt.V, kbn); } else { SWRITE_HK(0); } SBAR(); } while (0)
    f32x16 pA0, pA1, pB0, pB1; float mnA, mnB, alA, alB; bf16x8 pa0, pa1, pa2, pa3; bool deadA = false, deadB = false;
    if constexpr (F32) { VMW(); SWRITE_VF(0); SBAR(); } else { SWRITE_HV(0); SBAR(); }
    if (NT > 1) { if constexpr (F32) SLOAD_F((const float*)Kh, KBASE(1)); else SLOAD_H(Kh, Vh, cur.Fb, 1, KBASE(1)); }
    SBAR(); qkt<0, SK>(pA0, pA1, K_lds, r32, hi, S.qr, ACT(0));
    if constexpr (F32) { if (NT > 1) { VMW(); SWRITE_KF(1); SBAR(); SLOAD_F((const float*)Vh, KBASE(1)); } }
    MASKT(pA0, pA1, 0); partialSM(pA0, pA1, m_reg, mnA, alA, deadA);
    if (NT > 1) { VMW(); if constexpr (F32) { SWRITE_VF(1); SBAR(); if (NT > 2) SLOAD_F((const float*)Kh, KBASE(2)); } else SWRITE_H(1); }
    __syncthreads();
#define HALF_STEP(PX0, PX1, mnX, alX, deadX, PY0, PY1, alY, deadY, t, KB, VB, SB) do {                                                      \
        SBAR(); qkt<KB, SK>(PX0, PX1, K_lds, r32, hi, S.qr, ACT(t));                                             \
        if (!deadY) finishSM(PY0, PY1, alY, l_reg, pa0, pa1, pa2, pa3); SBAR();                                               \
        if ((t) + 1 < NT) { if constexpr (F32) { VMW(); SWRITE_KF(SB); SBAR(); SLOAD_F((const float*)Vh, KBASE((t) + 1)); }  \
                            else { SLOAD_H(Kh, Vh, cur.Fb, SB, KBASE((t) + 1)); } SBAR(); }                                               \
        pv_tile<VB, SK>(o, vb0, pa0, pa1, pa2, pa3, ACT((t) - 1) && !deadY); MASKT(PX0, PX1, (t)); partialSM(PX0, PX1, m_reg, mnX, alX, deadX);                                        \
        __syncthreads();                                                                                                      \
        if ((t) + 1 < NT) { VMW(); if constexpr (F32) { SWRITE_VF(SB); SBAR(); if ((t) + 2 < NT) SLOAD_F((const float*)Kh, KBASE((t) + 2)); } \
                            else { SWRITE_H(SB); } }                                                                          \
        RESC(alX); __syncthreads(); } while (0)
    for (int t = 1; t + 1 < NT; t += 2) {
        HALF_STEP(pB0, pB1, mnB, alB, deadB, pA0, pA1, alA, deadA, t, 1, 0, 0);
        HALF_STEP(pA0, pA1, mnA, alA, deadA, pB0, pB1, alB, deadB, t + 1, 0, 1, 1);
    }
    const bool even = (NT & 1) == 0;
    if (even) { SBAR(); qkt<1, SK>(pB0, pB1, K_lds, r32, hi, S.qr, ACT(NT - 1)); SBAR(); }
#define QROW(e) (nxt.Q + (size_t)(wid * QBLK + r32) * PITCH + ((e) >> 1) * 16 + hi * 8 + ((e) & 1) * 4)
    if constexpr (F32) { SLOAD_F((const float*)nxt.K, kbn); SBAR();
#pragma unroll
        for (int e = 0; e < 8; ++e) S.tq[e] = *(const f32x4*)QROW(e); }
    else { SLOAD_H(nxt.K, nxt.V, nxt.Fb, 0, kbn); SBAR();
#pragma unroll
        for (int d0 = 0; d0 < 8; ++d0) S.qr[d0] = load8<TIn>(nxt.Q + (size_t)(wid * QBLK + r32) * PITCH + d0 * 16 + hi * 8); }
    SBAR();
    if (!deadA) finishSM(pA0, pA1, alA, l_reg, pa0, pa1, pa2, pa3); SBAR();
    if constexpr (F32) {
#pragma unroll
        for (int e = 8; e < 16; ++e) S.tq[e] = *(const f32x4*)QROW(e); SBAR(); }
#undef QROW
    pv_tile<0, SK>(o, vb0, pa0, pa1, pa2, pa3, ACT(even ? NT - 2 : NT - 1) && !deadA);
    if (even) { MASKT(pB0, pB1, NT - 1); partialSM(pB0, pB1, m_reg, mnB, alB, deadB); __syncthreads(); RESC(alB);
        if (!deadB) finishSM(pB0, pB1, alB, l_reg, pa0, pa1, pa2, pa3); SBAR(); pv_tile<1, SK>(o, vb0, pa0, pa1, pa2, pa3, ACT(NT - 1) && !deadB); }
    SBAR(); SEAM_K0();
    if (hi == 0) li_l[r32] = l_reg; asm volatile("s_waitcnt lgkmcnt(0)" ::: "memory");
    float rli[16];
#pragma unroll
    for (int r = 0; r < 16; ++r) rli[r] = __builtin_amdgcn_rcpf(li_l[crow(r, hi)]);
    TOut* Ow = cur.O + (size_t)(wid * QBLK) * PITCH;
#pragma unroll
    for (int r = 0; r < 16; ++r) { const int orow = crow(r, hi);
#pragma unroll
        for (int d0 = 0; d0 < 4; ++d0) { const float v = o[d0][r] * rli[r];
            if constexpr (same_t<TOut, float>::v) { Ow[(size_t)orow * PITCH + d0 * 32 + r32] = v; }
            else if constexpr (O_FP8) { const float vs = fminf(fmaxf(v * O8_SCALE, -440.f), 440.f), t1 = __shfl_xor(vs, 1), t2 = __shfl_xor(vs, 2), t3 = __shfl_xor(t1, 2);
                   unsigned w8 = 0u; w8 = __builtin_amdgcn_cvt_pk_fp8_f32(vs, t1, w8, false); w8 = __builtin_amdgcn_cvt_pk_fp8_f32(t2, t3, w8, true);
                   if ((r32 & 3) == 0) *(unsigned*)(cur.O8 + (size_t)(wid * QBLK + orow) * PITCH + d0 * 32 + r32) = w8; }
            else { const float vn = __shfl_xor(v, 1);
                   if ((r32 & 1) == 0) *(unsigned*)(Ow + (size_t)orow * PITCH + d0 * 32 + r32) = cvtpk(v, vn); } } }
    if constexpr (F32) {
#pragma unroll
        for (int d0 = 0; d0 < 8; ++d0) S.qr[d0] = pack8(S.tq[2 * d0], S.tq[2 * d0 + 1]); }
    __syncthreads();
#undef RESC
#undef KBASE
#undef ACT
#undef MASKT
#undef SEAM_K0
#undef HALF_STEP
}
#undef ROW
#undef VMW
#undef VMWN
#undef SLOAD_H
#undef SWRITE_HK
#undef SWRITE_HV
#undef SWRITE_H
#undef SLOAD_F
#undef SWRITE_KF
#undef SWRITE_VF


enum { ORDER_NATURAL = 0, ORDER_REVERSED = 1, ORDER_PAIRED = 2, ORDER_XCD = 4 };
__host__ __device__ inline int swa_nramp(int nqb, int W, int qoff) { const int t = W - 1 - qoff; const int n = t < 0 ? 0 : t / QB + 1; return n > nqb ? nqb : n; }
__host__ __device__ inline int swa_nx(int nqb, int nramp, int order) { return (order & ORDER_PAIRED) ? (nramp + 1) / 2 + (nqb - nramp) : nqb; }
struct SwaItem { int bh, qb0, qb1; };
__device__ __forceinline__ SwaItem swa_decode(int L, int nb, int nh, int nhkv, int nqb, int nx, int nramp, int order) {
    const int G = nh / nhkv; SwaItem it; int x;
    if ((order & ORDER_XCD) && (nb * nhkv) % 8 == 0) { const int xcd = L & 7, k = L >> 3, per = G * nx, gi = k / per, r = k - gi * per;
        it.bh = (gi * 8 + xcd) * G + r / nx; x = r % nx; }
    else { it.bh = L / nx; x = L - it.bh * nx; }
    if (order & ORDER_PAIRED) { const int ns = nqb - nramp;
        if (x < ns) { it.qb0 = it.qb1 = nqb - 1 - x; } else { it.qb0 = x - ns; it.qb1 = nramp - 1 - it.qb0; } }
    else { it.qb0 = it.qb1 = ((order & 3) == ORDER_REVERSED) ? nqb - 1 - x : x; }
    return it;
}

}

namespace pg8 {
struct ListOrder {
    int pm0, n;
    __device__ bool next(int i, Unit& u) const { if (i >= n) return false; u.pm = pm0 + i; u.pn = 0; return true; }
    __device__ __forceinline__ void a_ready(const Unit&) const {}
    __device__ __forceinline__ void done(const Unit&) const {}
};
struct EpiScaleBf16 {
    static constexpr bool PERM = true, AFTER_DRAIN = false;
    unsigned char* O; int ldc; const float* colscale; float os;
    __device__ __forceinline__ void operator()(const f32x4 (&acc)[2][2][4][2], const Unit& u, int wr, int wc, int fr, int fq) const {
        const int row0 = u.pm * BM + wr * 64 + fr; int col0 = u.pn * BM + wc * 32 + 8 * fq; asm volatile("" : "+v"(col0));
        f32x4 sv[2][2];
#pragma unroll
        for (int bj = 0; bj < 2; ++bj)
#pragma unroll
            for (int n = 0; n < 2; ++n) sv[bj][n] = *(const f32x4*)(colscale + col0 + bj * HALF + 4 * n) * os;
#pragma unroll
        for (int ai = 0; ai < 2; ++ai)
#pragma unroll
            for (int m = 0; m < 4; ++m) { unsigned char* rowp = O + (size_t)(row0 + ai * HALF + m * 16) * ldc + col0;
#pragma unroll
                for (int bj = 0; bj < 2; ++bj) { const f32x4 v0 = acc[ai][bj][m][0] * sv[bj][0], v1 = acc[ai][bj][m][1] * sv[bj][1];
                    unsigned w0 = 0u, w1 = 0u;
                    w0 = __builtin_amdgcn_cvt_pk_fp8_f32(fminf(fmaxf(v0[0], -440.f), 440.f), fminf(fmaxf(v0[1], -440.f), 440.f), w0, false); w0 = __builtin_amdgcn_cvt_pk_fp8_f32(fminf(fmaxf(v0[2], -440.f), 440.f), fminf(fmaxf(v0[3], -440.f), 440.f), w0, true);
                    w1 = __builtin_amdgcn_cvt_pk_fp8_f32(fminf(fmaxf(v1[0], -440.f), 440.f), fminf(fmaxf(v1[1], -440.f), 440.f), w1, false); w1 = __builtin_amdgcn_cvt_pk_fp8_f32(fminf(fmaxf(v1[2], -440.f), 440.f), fminf(fmaxf(v1[3], -440.f), 440.f), w1, true);
                    typedef unsigned u32x2_ __attribute__((ext_vector_type(2))); *(u32x2_*)(rowp + bj * HALF) = (u32x2_){w0, w1}; } }
    }
};
struct EpiRowScaleBf16 {
    static constexpr bool PERM = true, AFTER_DRAIN = false;
    bf16_t* O; int ldc; const float* rs; float cs; int split_cols; size_t split_stride;
    __device__ __forceinline__ void operator()(const f32x4 (&acc)[2][2][4][2], const Unit& u, int wr, int wc, int fr, int fq) const {
        int ln_; asm volatile("v_mbcnt_lo_u32_b32 %0, -1, 0\n\tv_mbcnt_hi_u32_b32 %0, -1, %0" : "=v"(ln_));
        (void)fr; (void)fq; const int row0 = u.pm * BM + wr * 64 + (ln_ & 15); int colt = u.pn * BM; bf16_t* base = O;
        if (split_cols) { const int t = colt / split_cols; base += (size_t)t * split_stride; colt -= t * split_cols; }
        const int col0 = colt + wc * 32 + 8 * (ln_ >> 4);
#pragma unroll
        for (int ai = 0; ai < 2; ++ai)
#pragma unroll
            for (int m = 0; m < 4; ++m) { const int row = row0 + ai * HALF + m * 16; const float sc = rs ? rs[row] * cs : cs; bf16_t* rowp = base + (size_t)row * ldc + col0;
#pragma unroll
                for (int bj = 0; bj < 2; ++bj) { const f32x4 v0 = acc[ai][bj][m][0] * sc, v1 = acc[ai][bj][m][1] * sc;
                    u32x4 w; w.x = cvt_pk_bf16(v0[0], v0[1]); w.y = cvt_pk_bf16(v0[2], v0[3]); w.z = cvt_pk_bf16(v1[0], v1[1]); w.w = cvt_pk_bf16(v1[2], v1[3]);
                    *(u32x4*)(rowp + bj * HALF) = w; } }
    }
};
struct EpiI8RowScaleBf16 {
    static constexpr bool PERM = true, AFTER_DRAIN = false;
    bf16_t* O; int ldc; const float* rs; float cs; int split_cols; size_t split_stride;
    __device__ __forceinline__ void operator()(const f32x4 (&acc)[2][2][4][2], const Unit& u, int wr, int wc, int fr, int fq) const {
        int ln_; asm volatile("v_mbcnt_lo_u32_b32 %0, -1, 0\n\tv_mbcnt_hi_u32_b32 %0, -1, %0" : "=v"(ln_));
        (void)fr; (void)fq; const int row0 = u.pm * BM + wr * 64 + (ln_ & 15); int colt = u.pn * BM; bf16_t* base = O;
        if (split_cols) { const int t = colt / split_cols; base += (size_t)t * split_stride; colt -= t * split_cols; }
        const int col0 = colt + wc * 32 + 8 * (ln_ >> 4);
#pragma unroll
        for (int ai = 0; ai < 2; ++ai)
#pragma unroll
            for (int m = 0; m < 4; ++m) { const int row = row0 + ai * HALF + m * 16; const float sc = rs[row] * cs; bf16_t* rowp = base + (size_t)row * ldc + col0;
#pragma unroll
                for (int bj = 0; bj < 2; ++bj) { typedef int i32x4_ __attribute__((ext_vector_type(4))); const i32x4_ i0 = __builtin_bit_cast(i32x4_, acc[ai][bj][m][0]), i1 = __builtin_bit_cast(i32x4_, acc[ai][bj][m][1]);
                    u32x4 w; w.x = cvt_pk_bf16((float)i0[0] * sc, (float)i0[1] * sc); w.y = cvt_pk_bf16((float)i0[2] * sc, (float)i0[3] * sc); w.z = cvt_pk_bf16((float)i1[0] * sc, (float)i1[1] * sc); w.w = cvt_pk_bf16((float)i1[2] * sc, (float)i1[3] * sc);
                    *(u32x4*)(rowp + bj * HALF) = w; } }
    }
};
struct EpiGate {
    static constexpr bool PERM = false, AFTER_DRAIN = false;
    const bf16_t* XC; float* AF; float* DF; const float* b_a; const float* b_x; const float* ls8; int cbase;
    __device__ __forceinline__ void operator()(const f32x4 (&acc)[2][2][4][2], const Unit& u, int wr, int wc, int fr, int fq) const {
        const unsigned row0 = (unsigned)(u.pm * BM + wr * 64 + fr);
#pragma unroll
        for (int n = 0; n < 2; ++n) { unsigned c = (unsigned)(cbase + wc * 32 + 16 * n + 4 * fq); asm volatile("" : "+v"(c));
            const f32x4 ba = *(const f32x4*)(b_a + c), bx = *(const f32x4*)(b_x + c), l8 = *(const f32x4*)(ls8 + c) * 1.4426950408889634f;
#pragma unroll
            for (int ai = 0; ai < 2; ++ai)
#pragma unroll
                for (int m = 0; m < 4; ++m) { const unsigned off = (row0 + ai * HALF + m * 16) * 1024u + c;
                    const f32x4 pr = acc[ai][0][m][n] + ba, pi = acc[ai][1][m][n] + bx;
                    const uint2 xr = *(const uint2*)((const char*)XC + off * 2u);
                    const float xc[4] = {__uint_as_float(xr.x << 16), __uint_as_float(xr.x & 0xffff0000u), __uint_as_float(xr.y << 16), __uint_as_float(xr.y & 0xffff0000u)};
                    u32x4 pw;
#pragma unroll
                    for (int e = 0; e < 4; ++e) { const float r = __builtin_amdgcn_rcpf(1.f + __builtin_amdgcn_exp2f(-1.4426950408889634f * pr[e])), ig = __builtin_amdgcn_rcpf(1.f + __builtin_amdgcn_exp2f(-1.4426950408889634f * pi[e]));
                        const float la = r * l8[e]; const float a = __builtin_amdgcn_exp2f(la); const float mult = __builtin_amdgcn_sqrtf(fmaxf(1.f - a * a, 0.f)); pw[e] = cvt_pk_bf16(la, mult * ig * xc[e]); }
                    *(u32x4*)((char*)AF + off * 4u) = pw; asm volatile("" ::: "memory"); } }
    }
};
}

#define LAS __attribute__((address_space(3)))
typedef unsigned short bf16;
typedef unsigned v4u __attribute__((ext_vector_type(4)));
typedef unsigned v2u __attribute__((ext_vector_type(2)));
typedef float f32x4 __attribute__((ext_vector_type(4)));
typedef float f32x16 __attribute__((ext_vector_type(16)));
typedef short bf16x8 __attribute__((ext_vector_type(8)));

constexpr int NTHREADS = 512, NWAVES = 8;
constexpr int LDS_BYTES = 155648 + 256, LDS_CTL = 155648;
constexpr int BATCH = 2, SEQ = 8192, DM = 2048, M = BATCH * SEQ, NEXP = 16384;
constexpr int NZ = 3072, NQKV = 6144, NODIN = 6160;
constexpr int ROW6 = 1536;
constexpr bool V_FP4 = true;
constexpr int ROWV = V_FP4 ? 1024 : ROW6;
constexpr int ROW4 = 1024;
constexpr float ALPHA = 1.4142135623730951f, LN_EPS = 1e-5f;
constexpr float ATT_SCALE = 0.08838834764831845f;

constexpr size_t MiB = 1u << 20;
constexpr size_t WS_MOD = 1 * MiB;
constexpr size_t WS_LS8 = 1 * MiB + 512 * 1024;
constexpr size_t WS_WIN = 2 * MiB, WS_WOUT = 14 * MiB, WS_WQKV = 22 * MiB, WS_WO = 46 * MiB, WS_WQ0 = 54 * MiB, WS_WQ1 = 62 * MiB;
constexpr size_t WS_KEYS = 70 * MiB, WS_WPOOL = 71 * MiB, WS_WAX = 71 * MiB + 512 * 1024, WS_WF = 72 * MiB;
constexpr size_t WS_FE = 77 * MiB, WS_FP = 77 * MiB + 64 * 1024, WS_KN = 77 * MiB + 128 * 1024, WS_QN = 77 * MiB + 192 * 1024, WS_DN = 77 * MiB + 256 * 1024;
constexpr size_t WS_AG = 73 * MiB, WS_HG = 73 * MiB + 512 * 1024, WS_LF = 74 * MiB, WS_FB = 75 * MiB;
constexpr size_t WS_SU = 76 * MiB, WS_SV = 76 * MiB + 128 * 1024;
constexpr size_t WS_HB8 = 208 * MiB, WS_SA = 79 * MiB;
constexpr float YP_SCALE = 64.f;
constexpr float W8O_SCALE = 2048.f, Y8_SCALE = 16.f;
constexpr size_t WS_YC8 = 240 * MiB;
constexpr float W8_SCALE = 1024.f;
constexpr size_t WS_PART = 400 * MiB;
constexpr size_t WS_AR = 496 * MiB, WS_EQ = 500 * MiB;
constexpr size_t WS_Y = 592 * MiB;
constexpr size_t WS_H6 = 752 * MiB, WS_HS = 785 * MiB;
constexpr size_t WS_TU = 80 * MiB, WS_TV = 144 * MiB;
constexpr size_t WS_HB = 336 * MiB, WS_ZB = 400 * MiB, WS_YC = 592 * MiB, WS_YB = 656 * MiB, WS_X1 = 720 * MiB, WS_H2 = 848 * MiB, WS_QP = 912 * MiB;
constexpr size_t WS_EI = 976 * MiB, WS_GT = 984 * MiB, WS_END = 992 * MiB;
constexpr size_t WS_AF = WS_H2, WS_DF = WS_QP;
constexpr size_t WS_PO = WS_YB, WS_XC = WS_YB + 32 * MiB;

struct Args { const float* in[24]; float* out; unsigned char* ws; int ph_lo, ph_hi; };

__device__ __forceinline__ float bf_lo(unsigned u) { return __uint_as_float(u << 16); }
__device__ __forceinline__ float bf_hi(unsigned u) { return __uint_as_float(u & 0xffff0000u); }
__device__ __forceinline__ unsigned pk2(float lo, float hi) { return pg8::cvt_pk_bf16(lo, hi); }
__device__ __forceinline__ unsigned pk2c(float lo, float hi) { typedef float f2_ __attribute__((ext_vector_type(2))); typedef __bf16 b2_ __attribute__((ext_vector_type(2))); const f2_ f = {lo, hi}; return __builtin_bit_cast(unsigned, __builtin_convertvector(f, b2_)); }
#define SWZ_XOR_(v, m) __uint_as_float((unsigned)__builtin_amdgcn_ds_swizzle((int)__float_as_uint(v), ((m) << 10) | 0x1f))
__device__ __forceinline__ float wave_sum(float v) {
    v += SWZ_XOR_(v, 1); v += SWZ_XOR_(v, 2); v += SWZ_XOR_(v, 4); v += SWZ_XOR_(v, 8); v += SWZ_XOR_(v, 16);
    const auto rr = __builtin_amdgcn_permlane32_swap(__float_as_uint(v), __float_as_uint(v), false, false);
    return __uint_as_float(rr[0]) + __uint_as_float(rr[1]);
}
__device__ __forceinline__ float wave_max(float v) {
    v = fmaxf(v, SWZ_XOR_(v, 1)); v = fmaxf(v, SWZ_XOR_(v, 2)); v = fmaxf(v, SWZ_XOR_(v, 4)); v = fmaxf(v, SWZ_XOR_(v, 8)); v = fmaxf(v, SWZ_XOR_(v, 16));
    const auto rr = __builtin_amdgcn_permlane32_swap(__float_as_uint(v), __float_as_uint(v), false, false);
    return fmaxf(__uint_as_float(rr[0]), __uint_as_float(rr[1]));
}
__device__ __forceinline__ float gelu_tanh(float x) { const float y = 0.7978845608028654f * (x + 0.044715f * x * x * x); return x * __builtin_amdgcn_rcpf(1.f + __builtin_amdgcn_exp2f(-2.8853900817779268f * y)); }
#define LDS_WAIT() asm volatile("s_waitcnt lgkmcnt(0)" ::: "memory")
__device__ __forceinline__ int lane_id() { int l; asm volatile("v_mbcnt_lo_u32_b32 %0, -1, 0\n\tv_mbcnt_hi_u32_b32 %0, -1, %0" : "=v"(l)); return l; }


#define XB_TMO      128
#define XB_XCNT(j)  (256  + 64 * (j))
#define XB_XSUB(j)  (1280 + 64 * (j))
#define XB_XGEN(j)  (2304 + 64 * (j))
#define XB_TOP      3328
#define XB_TOPGEN   3392
#define XCD_BAR_WORDS 3456
#define XB_SPIN_CAP (1u << 22)
__device__ __forceinline__ unsigned xb_ld(unsigned* p)              { return __hip_atomic_load(p, __ATOMIC_RELAXED, __HIP_MEMORY_SCOPE_AGENT); }
__device__ __forceinline__ unsigned xb_add(unsigned* p, unsigned v) { return __hip_atomic_fetch_add(p, v, __ATOMIC_RELAXED, __HIP_MEMORY_SCOPE_AGENT); }
__device__ __forceinline__ unsigned xb_xcc_id() { return (unsigned)__builtin_amdgcn_s_getreg((3 << 11) | 20) & 0xFu; }
#define XB_SPIN(cond, bar) do { unsigned _sp = 0; while (cond) { __builtin_amdgcn_s_sleep(1); \
    if ((++_sp & 255u) == 0u) { if (xb_ld(&(bar)[XB_TMO])) break; if (_sp > XB_SPIN_CAP) { atomicAdd(&(bar)[XB_TMO], 1u); break; } } } } while (0)
struct XcdBarrier { unsigned* bar; unsigned x; volatile LAS unsigned* st; };
__device__ __forceinline__ XcdBarrier xcd_barrier_post(unsigned* bar, volatile LAS unsigned* st, bool t0) {
    XcdBarrier b; b.bar = bar; b.x = xb_xcc_id(); b.st = st;
    if (t0) { st[2] = xb_add(&bar[XB_XCNT(b.x)], 1u); st[3] = b.x; }
    return b;
}
__device__ __forceinline__ void xcd_barrier_complete(unsigned* bar, unsigned x, unsigned& nloc, unsigned& nx) {
    const unsigned G = gridDim.x * gridDim.y * gridDim.z;
    unsigned sum, cnt, mine, sp = 0u;
    for (;;) {
        sum = 0u; cnt = 0u; mine = 0u;
#pragma unroll
        for (unsigned j = 0; j < 16; ++j) { const unsigned c = xb_ld(&bar[XB_XCNT(j)]); sum += c; cnt += (c > 0u) ? 1u : 0u; mine = (j == x) ? c : mine; }
        if (sum == G) break;
        __builtin_amdgcn_s_sleep(1);
        if ((++sp & 255u) == 0u) { if (xb_ld(&bar[XB_TMO])) break; if (sp > XB_SPIN_CAP) { atomicAdd(&bar[XB_TMO], 1u); break; } }
    }
    nloc = mine > 0u ? mine : 1u; nx = cnt > 0u ? cnt : 1u;
}
__device__ __forceinline__ void xcd_barrier(const XcdBarrier& b, bool t0) {
    asm volatile("s_waitcnt vmcnt(0)" ::: "memory");
    __syncthreads();
    if (t0) {
        unsigned* bar = b.bar;
        __builtin_amdgcn_s_waitcnt(0);
        unsigned nloc = b.st[0], nx = b.st[1];
        if (nloc == 0u) { xcd_barrier_complete(bar, b.x, nloc, nx); b.st[0] = nloc; b.st[1] = nx; }
        const unsigned old = xb_add(&bar[XB_XSUB(b.x)], 1u);
        const unsigned gen = old / nloc;
        if (old + 1u == (gen + 1u) * nloc) {
            __builtin_amdgcn_fence(__ATOMIC_RELEASE, "agent");
            asm volatile("s_waitcnt vmcnt(0)" ::: "memory");
            const unsigned og = xb_add(&bar[XB_TOP], 1u);
            const unsigned tg = og / nx;
            if (og + 1u == (tg + 1u) * nx) xb_add(&bar[XB_TOPGEN], 1u);
            else XB_SPIN(xb_ld(&bar[XB_TOPGEN]) == tg, bar);
            __builtin_amdgcn_fence(__ATOMIC_ACQUIRE, "agent");
            xb_add(&bar[XB_XGEN(b.x)], 1u);
            asm volatile("s_waitcnt vmcnt(0)" ::: "memory");
        } else {
            XB_SPIN(xb_ld(&bar[XB_XGEN(b.x)]) == gen, bar);
            __builtin_amdgcn_fence(__ATOMIC_ACQUIRE, "agent");
            asm volatile("s_waitcnt vmcnt(0)" ::: "memory");
        }
    }
    __syncthreads();
}

__device__ __forceinline__ void transpose_item(const float* W, int ldw, int nblk, bf16* WT, int K, LAS float* scr, int item, int lane) {
    const int kb = item / nblk, nb = item % nblk, k0 = 64 * kb, n0 = 32 * nb;
#pragma unroll 8
    for (int i = 0; i < 32; ++i) { const int kk = 2 * i + (lane >> 5); scr[kk * 33 + (lane & 31)] = W[(size_t)(k0 + kk) * ldw + n0 + (lane & 31)]; }
    LDS_WAIT(); asm volatile("" ::: "memory");
    const int c = lane & 7;
#pragma unroll
    for (int j = 0; j < 4; ++j) { const int n = (lane >> 3) + 8 * j; const LAS float* s = scr + (8 * c) * 33 + n;
        v4u o; o.x = pk2(s[0 * 33], s[1 * 33]); o.y = pk2(s[2 * 33], s[3 * 33]); o.z = pk2(s[4 * 33], s[5 * 33]); o.w = pk2(s[6 * 33], s[7 * 33]);
        *(v4u*)(WT + (size_t)(n0 + n) * K + k0 + 8 * c) = o; }
    LDS_WAIT(); asm volatile("" ::: "memory");
}
__device__ __forceinline__ unsigned pk4_i8(float a, float b, float c, float d) {
    const int ia = (int)rintf(fminf(fmaxf(a, -127.f), 127.f)), ib = (int)rintf(fminf(fmaxf(b, -127.f), 127.f)), ic = (int)rintf(fminf(fmaxf(c, -127.f), 127.f)), id = (int)rintf(fminf(fmaxf(d, -127.f), 127.f));
    return ((unsigned)ia & 0xffu) | (((unsigned)ib & 0xffu) << 8) | (((unsigned)ic & 0xffu) << 16) | ((unsigned)id << 24);
}
__device__ __forceinline__ void transpose_item_i8(const float* W, int ldw, int nblk, unsigned char* WT, int K, LAS float* scr, int item, int lane, float wscale) {
    const int kb = item / nblk, nb = item % nblk, k0 = 64 * kb, n0 = 32 * nb;
#pragma unroll 8
    for (int i = 0; i < 32; ++i) { const int kk = 2 * i + (lane >> 5); scr[kk * 33 + (lane & 31)] = W[(size_t)(k0 + kk) * ldw + n0 + (lane & 31)] * wscale; }
    LDS_WAIT(); asm volatile("" ::: "memory");
    const int c = lane & 7;
#pragma unroll
    for (int j = 0; j < 4; ++j) { const int n = (lane >> 3) + 8 * j; const LAS float* sp = scr + (8 * c) * 33 + n;
        *(v2u*)(WT + (size_t)(n0 + n) * K + k0 + 8 * c) = (v2u){pk4_i8(sp[0 * 33], sp[1 * 33], sp[2 * 33], sp[3 * 33]), pk4_i8(sp[4 * 33], sp[5 * 33], sp[6 * 33], sp[7 * 33])}; }
    LDS_WAIT(); asm volatile("" ::: "memory");
}
__device__ __forceinline__ float cl8(float x) { return fminf(fmaxf(x, -440.f), 440.f); }
__device__ __forceinline__ unsigned pk4_fp8(float a, float b, float c, float d) { unsigned w = 0u; w = __builtin_amdgcn_cvt_pk_fp8_f32(cl8(a), cl8(b), w, false); w = __builtin_amdgcn_cvt_pk_fp8_f32(cl8(c), cl8(d), w, true); return w; }
__device__ __forceinline__ void transpose_item8(const float* W, int ldw, int nblk, unsigned char* WT, int K, LAS float* scr, int item, int lane, float wscale = W8_SCALE) {
    const int kb = item / nblk, nb = item % nblk, k0 = 64 * kb, n0 = 32 * nb;
#pragma unroll 8
    for (int i = 0; i < 32; ++i) { const int kk = 2 * i + (lane >> 5); scr[kk * 33 + (lane & 31)] = W[(size_t)(k0 + kk) * ldw + n0 + (lane & 31)] * wscale; }
    LDS_WAIT(); asm volatile("" ::: "memory");
    const int c = lane & 7;
#pragma unroll
    for (int j = 0; j < 4; ++j) { const int n = (lane >> 3) + 8 * j; const LAS float* sp = scr + (8 * c) * 33 + n; unsigned w0 = 0u, w1 = 0u;
        w0 = __builtin_amdgcn_cvt_pk_fp8_f32(cl8(sp[0 * 33]), cl8(sp[1 * 33]), w0, false); w0 = __builtin_amdgcn_cvt_pk_fp8_f32(cl8(sp[2 * 33]), cl8(sp[3 * 33]), w0, true);
        w1 = __builtin_amdgcn_cvt_pk_fp8_f32(cl8(sp[4 * 33]), cl8(sp[5 * 33]), w1, false); w1 = __builtin_amdgcn_cvt_pk_fp8_f32(cl8(sp[6 * 33]), cl8(sp[7 * 33]), w1, true);
        *(v2u*)(WT + (size_t)(n0 + n) * K + k0 + 8 * c) = (v2u){w0, w1}; }
    LDS_WAIT(); asm volatile("" ::: "memory");
}
__device__ __forceinline__ void convert_item(const float* src, bf16* dst, size_t item, int lane) {
    const size_t base = item * 4096 + (size_t)lane * 8;
#pragma unroll
    for (int j = 0; j < 8; ++j) { const f32x4 a = *(const f32x4*)(src + base + j * 512), b = *(const f32x4*)(src + base + j * 512 + 4);
        v4u o; o.x = pk2(a[0], a[1]); o.y = pk2(a[2], a[3]); o.z = pk2(b[0], b[1]); o.w = pk2(b[2], b[3]);
        *(v4u*)(dst + base + j * 512) = o; }
}
__device__ __forceinline__ void fp8_row_item(const float* src, unsigned char* dst, float* scale, int row, int lane) {
    const float* p = src + (size_t)row * DM + 4 * lane; f32x4 v[8]; float mx = 0.f;
#pragma unroll
    for (int j = 0; j < 8; ++j) { v[j] = *(const f32x4*)(p + 256 * j); mx = fmaxf(mx, fmaxf(fmaxf(fabsf(v[j][0]), fabsf(v[j][1])), fmaxf(fabsf(v[j][2]), fabsf(v[j][3])))); }
    mx = fmaxf(wave_max(mx), 1e-30f); const float inv = 240.f / mx;
    unsigned* q = (unsigned*)(dst + (size_t)row * DM) + lane;
#pragma unroll
    for (int j = 0; j < 8; ++j) { unsigned w = 0u; w = __builtin_amdgcn_cvt_pk_fp8_f32(v[j][0] * inv, v[j][1] * inv, w, false); w = __builtin_amdgcn_cvt_pk_fp8_f32(v[j][2] * inv, v[j][3] * inv, w, true); q[64 * j] = w; }
    if (lane == 0) scale[row] = mx * (1.f / 240.f);
}
typedef float f32x16_t __attribute__((ext_vector_type(16)));
typedef float f32x32_t __attribute__((ext_vector_type(32)));
typedef unsigned u32x6_t __attribute__((ext_vector_type(6)));
typedef unsigned u32x3_t __attribute__((ext_vector_type(3)));
__device__ __forceinline__ void fp6_pack_block(const float (&v)[32], u32x6_t& p, unsigned& ebyte) {
    float mx = 0.f;
#pragma unroll
    for (int i = 0; i < 32; ++i) mx = fmaxf(mx, fabsf(v[i]));
    int ex = (int)((__float_as_uint(mx * (1.f / 7.5f)) + 0x7fffffu) >> 23) - 127; ex = ex < -126 ? -126 : (ex > 127 ? 127 : ex);
    const float inv = __uint_as_float((unsigned)(127 - ex) << 23);
    f32x16_t a, b;
#pragma unroll
    for (int i = 0; i < 16; ++i) { a[i] = v[2 * i] * inv; b[i] = v[2 * i + 1] * inv; }
    p = __builtin_amdgcn_cvt_scalef32_2xpk16_fp6_f32(a, b, 1.0f); ebyte = (unsigned)(ex + 127);
}
__device__ __forceinline__ void fp6_row_item(const float* src, unsigned char* dst, float* sdst, int row, int lane) {
    const float* p = src + (size_t)row * DM + 4 * lane; float v[32]; float mx = 0.f;
#pragma unroll
    for (int j = 0; j < 8; ++j) { const f32x4 x = *(const f32x4*)(p + 256 * j); v[4 * j] = x[0]; v[4 * j + 1] = x[1]; v[4 * j + 2] = x[2]; v[4 * j + 3] = x[3]; }
#pragma unroll
    for (int i = 0; i < 32; ++i) mx = fmaxf(mx, fabsf(v[i]));
    mx = fmaxf(wave_max(mx), 1e-30f);
    const float inv = 7.5f / mx;
    f32x16_t a, b;
#pragma unroll
    for (int i = 0; i < 16; ++i) { a[i] = v[2 * i] * inv; b[i] = v[2 * i + 1] * inv; }
    const u32x6_t pk = __builtin_amdgcn_cvt_scalef32_2xpk16_fp6_f32(a, b, 1.0f);
    unsigned char* q = dst + (size_t)row * ROW6;
    *(v4u*)(q + 16 * lane) = (v4u){pk[0], pk[1], pk[2], pk[3]}; *(v2u*)(q + 1024 + 8 * lane) = (v2u){pk[4], pk[5]};
    if (lane == 0) sdst[row] = mx * (1.f / 7.5f);
}
template <bool VORD>
__device__ __forceinline__ void fp4_row_item(const float* src, unsigned char* dst, float* sdst, int row, int lane) {
    const float* p = src + (size_t)row * DM + (VORD ? 4 : 8) * lane; float v[32]; float ss = 0.f;
    if constexpr (VORD) {
#pragma unroll
        for (int j = 0; j < 8; ++j) { const f32x4 x = *(const f32x4*)(p + 256 * j); v[4 * j] = x[0]; v[4 * j + 1] = x[1]; v[4 * j + 2] = x[2]; v[4 * j + 3] = x[3]; } }
    else
#pragma unroll
    for (int j = 0; j < 4; ++j) { const f32x4 x = *(const f32x4*)(p + 512 * j), y = *(const f32x4*)(p + 512 * j + 4); v[8 * j] = x[0]; v[8 * j + 1] = x[1]; v[8 * j + 2] = x[2]; v[8 * j + 3] = x[3]; v[8 * j + 4] = y[0]; v[8 * j + 5] = y[1]; v[8 * j + 6] = y[2]; v[8 * j + 7] = y[3]; }
#pragma unroll
    for (int i = 0; i < 32; ++i) ss += v[i] * v[i];
    const float sc = fmaxf(0.5f * sqrtf(wave_sum(ss) * (1.f / DM)), 1e-30f), inv = 1.f / sc;
    unsigned w[4] = {0u, 0u, 0u, 0u};
#pragma unroll
    for (int d = 0; d < 4; ++d) {
        w[d] = __builtin_amdgcn_cvt_scalef32_pk_fp4_f32(w[d], v[8 * d] * inv, v[8 * d + 1] * inv, 1.0f, 0);
        w[d] = __builtin_amdgcn_cvt_scalef32_pk_fp4_f32(w[d], v[8 * d + 2] * inv, v[8 * d + 3] * inv, 1.0f, 1);
        w[d] = __builtin_amdgcn_cvt_scalef32_pk_fp4_f32(w[d], v[8 * d + 4] * inv, v[8 * d + 5] * inv, 1.0f, 2);
        w[d] = __builtin_amdgcn_cvt_scalef32_pk_fp4_f32(w[d], v[8 * d + 6] * inv, v[8 * d + 7] * inv, 1.0f, 3); }
    if constexpr (VORD) {
        unsigned char* q = dst + (size_t)(row / NEXP) * NEXP * ROW4 + (size_t)(row % NEXP) * 128 + 2 * lane;
#pragma unroll
        for (int j = 0; j < 8; ++j) *(unsigned short*)(q + (size_t)j * NEXP * 128) = (unsigned short)((w[j >> 1] >> (16 * (j & 1))) & 0xffffu);
    } else {
        unsigned char* q = dst + (size_t)(row / NEXP) * NEXP * ROW4 + ((size_t)(lane >> 3) * NEXP + (size_t)(row % NEXP)) * 128 + 16 * (lane & 7);
        *(v4u*)q = (v4u){w[0], w[1], w[2], w[3]}; }
    if (lane == 0) sdst[row] = sc;
}
__device__ __forceinline__ void ph_prologue(const Args& a, LAS unsigned char* lds, int tid, int lane, int wave) {
    unsigned char* ws = a.ws;
    if (blockIdx.x < 192) {
        LAS float* cact = (LAS float*)lds;
        LAS float* red = (LAS float*)(lds + 16384);
        for (int i = tid; i < 2 * DM; i += NTHREADS) { const float cv = a.in[1][i]; cact[i] = cv / (1.f + __expf(-cv)); }
        __syncthreads();
        const int item = blockIdx.x, l = item / 96, col0 = (item % 96) * 128, rsub = lane >> 5, c4 = lane & 31;
        const float* W = a.in[2] + (size_t)l * DM * 12288 + col0 + 4 * c4;
        f32x4 acc0 = {0.f, 0.f, 0.f, 0.f}, acc1 = {0.f, 0.f, 0.f, 0.f};
#pragma unroll 8
        for (int i = 0; i < 128; ++i) { const int k = wave * 256 + 2 * i + rsub; const f32x4 w = *(const f32x4*)(W + (size_t)k * 12288);
            acc0 += w * cact[k]; acc1 += w * cact[DM + k]; }
#pragma unroll
        for (int e = 0; e < 4; ++e) { acc0[e] += __shfl_xor(acc0[e], 32); acc1[e] += __shfl_xor(acc1[e], 32); }
        if (rsub == 0) {
#pragma unroll
            for (int e = 0; e < 4; ++e) { red[(wave * 2 + 0) * 128 + 4 * c4 + e] = acc0[e]; red[(wave * 2 + 1) * 128 + 4 * c4 + e] = acc1[e]; } }
        __syncthreads();
        if (tid < 256) { const int b = tid >> 7, col = tid & 127; float s = 0.f;
#pragma unroll
            for (int w8 = 0; w8 < 8; ++w8) s += red[(w8 * 2 + b) * 128 + col];
            s += a.in[3][l * 12288 + col0 + col];
            ((float*)(ws + WS_MOD))[(size_t)(l * 2 + b) * 12288 + col0 + col] = s; }
        __syncthreads();
    }
    LAS float* scr = (LAS float*)(lds + wave * 16384);
    const int gw = blockIdx.x * NWAVES + wave, NGW = gridDim.x * NWAVES;
    constexpr int I_WIN = 32 * 96, I_SQ = 32 * 64, I_QKV = 32 * 192, I_POOL = 4 * 32, I_AX = 16 * 8, I_WF = 16, I_KEYS = 128, I_TAB = 2 * NEXP, I_LS = 1;
    constexpr int NITEMS = I_WIN + 4 * I_SQ + I_QKV + I_POOL + I_AX + I_WF + I_KEYS + 2 * I_TAB + I_LS;
    for (int it = gw; it < NITEMS; it += NGW) {
        int r = it;
        if (r < 2 * I_TAB) { if (r < I_TAB) fp4_row_item<false>(a.in[8], ws + WS_TU, (float*)(ws + WS_SU), r, lane); else if constexpr (V_FP4) fp4_row_item<true>(a.in[9], ws + WS_TV, (float*)(ws + WS_SV), r - I_TAB, lane); else fp6_row_item(a.in[9], ws + WS_TV, (float*)(ws + WS_SV), r - I_TAB, lane); continue; } r -= 2 * I_TAB;
        if (r < I_WIN) { transpose_item_i8(a.in[10], NZ, 96, ws + WS_WIN, DM, scr, r, lane, W8_SCALE); continue; } r -= I_WIN;
        if (r < I_SQ) { transpose_item8(a.in[20], DM, 64, ws + WS_WOUT, DM, scr, r, lane, W8O_SCALE); continue; } r -= I_SQ;
        if (r < I_QKV) { transpose_item8(a.in[21], NODIN, 192, ws + WS_WQKV, DM, scr, r, lane); continue; } r -= I_QKV;
        if (r < I_SQ) { transpose_item8(a.in[23], DM, 64, ws + WS_WO, DM, scr, r, lane, W8O_SCALE); continue; } r -= I_SQ;
        if (r < I_SQ) { transpose_item_i8(a.in[6], DM, 64, ws + WS_WQ0, DM, scr, r, lane, W8_SCALE); continue; } r -= I_SQ;
        if (r < I_SQ) { transpose_item_i8(a.in[6] + (size_t)DM * DM, DM, 64, ws + WS_WQ1, DM, scr, r, lane, W8_SCALE); continue; } r -= I_SQ;
        if (r < I_POOL) { const int g = r >> 5; transpose_item(a.in[11] + g * 65536, 256, 8, (bf16*)(ws + WS_WPOOL) + g * 65536, 256, scr, r & 31, lane); continue; } r -= I_POOL;
        if (r < I_AX) { const int h = r >> 4, which = (r >> 3) & 1;
            transpose_item(a.in[which ? 17 : 15] + h * 16384, 128, 4, (bf16*)(ws + WS_WAX) + h * 32768 + which * 16384, 128, scr, r & 7, lane); continue; } r -= I_AX;
        if (r < I_WF) { bf16* WF = (bf16*)(ws + WS_WF);
            for (int k = lane; k < DM; k += 64) { const float v = a.in[21][(size_t)k * NODIN + NQKV + r]; WF[r * DM + k] = (bf16)(pk2(v, v) & 0xffffu); } continue; } r -= I_WF;
        if (r < I_KEYS) { convert_item(a.in[7], (bf16*)(ws + WS_KEYS), (size_t)r, lane); continue; } r -= I_KEYS;
        { float* LS8 = (float*)(ws + WS_LS8);
            for (int cch = lane; cch < 1024; cch += 64) { const float x = a.in[19][cch]; LS8[cch] = 8.f * (fminf(x, 0.f) - log1pf(__expf(-fabsf(x)))); } }
    }
}

__device__ __forceinline__ void ph_modulate(const float* src, const float* mod_l  , int sh_off, int sc_off, bf16* dst, unsigned char* dst8, float* rs, int lane, int wave) {
    const int gw = blockIdx.x * NWAVES + wave, NGW = gridDim.x * NWAVES;
    int cur_b = -1; f32x4 scv[8], shv[8];
    for (int t = gw; t < M; t += NGW) {
        const int b = t >> 13;
        if (b != cur_b) { cur_b = b; const float* mb = mod_l + b * 12288;
#pragma unroll
            for (int j = 0; j < 8; ++j) { scv[j] = *(const f32x4*)(mb + sc_off + 4 * lane + 256 * j) + 1.f; shv[j] = *(const f32x4*)(mb + sh_off + 4 * lane + 256 * j); } }
        const float* xr = src + (size_t)t * DM + 4 * lane; bf16* dr = dst + (size_t)t * DM + 4 * lane; f32x4 v[8]; float mx = 0.f;
#pragma unroll
        for (int j = 0; j < 8; ++j) { v[j] = *(const f32x4*)(xr + 256 * j) * scv[j] + shv[j]; uint2 o; o.x = pk2(v[j][0], v[j][1]); o.y = pk2(v[j][2], v[j][3]); *(uint2*)(dr + 256 * j) = o;
            mx = fmaxf(mx, fmaxf(fmaxf(fabsf(v[j][0]), fabsf(v[j][1])), fmaxf(fabsf(v[j][2]), fabsf(v[j][3])))); }
        mx = fmaxf(wave_max(mx), 1e-30f); const float inv = 127.f / mx; unsigned* q8 = (unsigned*)(dst8 + (size_t)t * DM) + lane;
#pragma unroll
        for (int j = 0; j < 8; ++j) q8[64 * j] = pk4_i8(v[j][0] * inv, v[j][1] * inv, v[j][2] * inv, v[j][3] * inv);
        if (lane == 0) rs[t] = mx * (1.f / 127.f);
    }
}

__device__ __forceinline__ void ld8(const bf16* p, float (&v)[8]) { const v4u u = *(const v4u*)p; v[0] = bf_lo(u.x); v[1] = bf_hi(u.x); v[2] = bf_lo(u.y); v[3] = bf_hi(u.y); v[4] = bf_lo(u.z); v[5] = bf_hi(u.z); v[6] = bf_lo(u.w); v[7] = bf_hi(u.w); }
__device__ __forceinline__ void st8(bf16* p, const float (&v)[8]) { v4u o; o.x = pk2(v[0], v[1]); o.y = pk2(v[2], v[3]); o.z = pk2(v[4], v[5]); o.w = pk2(v[6], v[7]); *(v4u*)p = o; }
__device__ __forceinline__ void ph_poolconv(const Args& a, int lane, int wave) {
    const bf16* Z = (const bf16*)(a.ws + WS_ZB); bf16* PO = (bf16*)(a.ws + WS_PO); bf16* XC = (bf16*)(a.ws + WS_XC);
    const int gw = blockIdx.x * NWAVES + wave, NGW = gridDim.x * NWAVES;
    for (int item = gw; item < 2048; item += NGW) {
        const int which = item & 3, t0 = (item >> 2) * 32, pos0 = t0 & (SEQ - 1);
        if (which < 2) {
            const int c = which * 512 + lane * 8, w = 2 << (c >> 8);
            float sum[8] = {0.f, 0.f, 0.f, 0.f, 0.f, 0.f, 0.f, 0.f};
            for (int s = 1; s < 16; ++s) if (s < w && pos0 - s >= 0) { float v[8]; ld8(Z + (size_t)(t0 - s) * NZ + c, v);
#pragma unroll
                for (int e = 0; e < 8; ++e) sum[e] += v[e]; }
            for (int i = 0; i < 32; ++i) { const int t = t0 + i, pos = pos0 + i; float cur[8], o[8]; ld8(Z + (size_t)t * NZ + c, cur);
                const float inv = 1.f / (float)(pos + 1 < w ? pos + 1 : w);
#pragma unroll
                for (int e = 0; e < 8; ++e) { sum[e] += cur[e]; o[e] = sum[e] * inv - cur[e]; }
                st8(PO + (size_t)t * 1024 + c, o);
                if (pos - w + 1 >= 0) { float old[8]; ld8(Z + (size_t)(t - w + 1) * NZ + c, old);
#pragma unroll
                    for (int e = 0; e < 8; ++e) sum[e] -= old[e]; } }
        } else {
            const int c = (which - 2) * 512 + lane * 8; const bf16* zc = Z + 1024 + c;
            float w0[8], w1[8], w2[8], w3[8], bb[8], x3[8], x2[8], x1[8];
#pragma unroll
            for (int e = 0; e < 8; ++e) { w0[e] = a.in[13][0 * 1024 + c + e]; w1[e] = a.in[13][1 * 1024 + c + e]; w2[e] = a.in[13][2 * 1024 + c + e]; w3[e] = a.in[13][3 * 1024 + c + e]; bb[e] = a.in[14][c + e]; x3[e] = 0.f; x2[e] = 0.f; x1[e] = 0.f; }
            if (pos0 >= 3) ld8(zc + (size_t)(t0 - 3) * NZ, x3);
            if (pos0 >= 2) ld8(zc + (size_t)(t0 - 2) * NZ, x2);
            if (pos0 >= 1) ld8(zc + (size_t)(t0 - 1) * NZ, x1);
            for (int i = 0; i < 32; ++i) { const int t = t0 + i; float x0[8], o[8]; ld8(zc + (size_t)t * NZ, x0);
#pragma unroll
                for (int e = 0; e < 8; ++e) { o[e] = bb[e] + w0[e] * x3[e] + w1[e] * x2[e] + w2[e] * x1[e] + w3[e] * x0[e]; x3[e] = x2[e]; x2[e] = x1[e]; x1[e] = x0[e]; }
                st8(XC + (size_t)t * 1024 + c, o); }
        }
    }
}

__device__ __forceinline__ void ph_scan_agg(const Args& a, int tid) {
    const unsigned* AD = (const unsigned*)(a.ws + WS_AF);
    float* AG = (float*)(a.ws + WS_AG); float* HG = (float*)(a.ws + WS_HG);
    for (int w = blockIdx.x; w < 256; w += gridDim.x) {
        const int st = w >> 1, c = (w & 1) * 512 + tid; const size_t base = (size_t)st * 128 * 1024 + c;
        float LA = 0.f, H = 0.f;
#pragma unroll 32
        for (int i = 0; i < 128; ++i) { const unsigned pw = AD[base + (size_t)i * 1024]; const float la = bf_lo(pw), dv = bf_hi(pw); H = __builtin_amdgcn_exp2f(la) * H + dv; LA += la; }
        AG[st * 1024 + c] = __builtin_amdgcn_exp2f(LA); HG[st * 1024 + c] = H;
    }
}
__device__ __forceinline__ void ph_scan_fin(const Args& a, int tid) {
    const unsigned* AD = (const unsigned*)(a.ws + WS_AF);
    const float* AG = (const float*)(a.ws + WS_AG); const float* HG = (const float*)(a.ws + WS_HG);
    const bf16* Z = (const bf16*)(a.ws + WS_ZB); unsigned char* YC8 = a.ws + WS_YC8;
    for (int w = blockIdx.x; w < 256; w += gridDim.x) {
        const int st = w >> 1, c = (w & 1) * 512 + tid, sin = st & 63, sb = st - sin; const size_t base = (size_t)st * 128 * 1024 + c;
        float h = 0.f;
#pragma unroll 8
        for (int s = 0; s < sin; ++s) h = AG[(sb + s) * 1024 + c] * h + HG[(sb + s) * 1024 + c];
#pragma unroll 16
        for (int i = 0; i < 128; ++i) { const size_t t = (size_t)st * 128 + i; const unsigned pw = AD[base + (size_t)i * 1024];
            h = __builtin_amdgcn_exp2f(bf_lo(pw)) * h + bf_hi(pw); const float gt = __uint_as_float((unsigned)Z[t * NZ + 2048 + c] << 16);
            YC8[t * DM + 1024 + c] = (unsigned char)(pk4_fp8(h * gelu_tanh(gt) * Y8_SCALE, 0.f, 0.f, 0.f) & 0xffu); }
    }
}

template <bool RES_MOD>
__device__ __forceinline__ void ph_ln(const bf16* Y, const float* Xin, const bf16* HBres, const float* mod_res, const float* mod_l, const float* lng, const float* lnb, bf16* H2, unsigned char* H28, float* SH, unsigned char* H6, float* HS, int lane, int wave) {
    const int gw = blockIdx.x * NWAVES + wave, NGW = gridDim.x * NWAVES;
    v4u yc[4]; f32x4 xc[8]; v4u rc[4];
    { const size_t ro = (size_t)gw * DM + 8 * lane;
#pragma unroll
      for (int j = 0; j < 4; ++j) { yc[j] = *(const v4u*)(Y + ro + 512 * j);
          if constexpr (RES_MOD) rc[j] = *(const v4u*)(HBres + ro + 512 * j); else { xc[2 * j] = *(const f32x4*)(Xin + ro + 512 * j); xc[2 * j + 1] = *(const f32x4*)(Xin + ro + 512 * j + 4); } } }
#pragma unroll 1
    for (int t = gw; t < M; t += NGW) {
        const int b = t >> 13; const float* mb = mod_l + b * 12288; const size_t ro = (size_t)t * DM + 8 * lane;
        int ln = lane; asm volatile("" : "+v"(ln));
        const int tn = t + NGW < M ? t + NGW : t; const size_t rn = (size_t)tn * DM + 8 * lane;
        v4u yn[4]; f32x4 xn[8]; v4u rn4[4];
#pragma unroll
        for (int j = 0; j < 4; ++j) { yn[j] = *(const v4u*)(Y + rn + 512 * j);
            if constexpr (RES_MOD) rn4[j] = *(const v4u*)(HBres + rn + 512 * j); else { xn[2 * j] = *(const f32x4*)(Xin + rn + 512 * j); xn[2 * j + 1] = *(const f32x4*)(Xin + rn + 512 * j + 4); } }
        float v[32];
#pragma unroll
        for (int j = 0; j < 4; ++j) { const v4u u = yc[j]; const float y8[8] = {bf_lo(u.x), bf_hi(u.x), bf_lo(u.y), bf_hi(u.y), bf_lo(u.z), bf_hi(u.z), bf_lo(u.w), bf_hi(u.w)};
            f32x4 xa, xb;
            if constexpr (RES_MOD) { const v4u r = rc[j]; const float* mr = mod_res + b * 12288 + 8 * ln + 512 * j;
                const f32x4 sa = *(const f32x4*)(mr + 2048), sb = *(const f32x4*)(mr + 2048 + 4), ha = *(const f32x4*)(mr), hb = *(const f32x4*)(mr + 4);
                const float r8[8] = {bf_lo(r.x), bf_hi(r.x), bf_lo(r.y), bf_hi(r.y), bf_lo(r.z), bf_hi(r.z), bf_lo(r.w), bf_hi(r.w)};
#pragma unroll
                for (int e = 0; e < 4; ++e) { xa[e] = (r8[e] - ha[e]) * __builtin_amdgcn_rcpf(1.f + sa[e]); xb[e] = (r8[4 + e] - hb[e]) * __builtin_amdgcn_rcpf(1.f + sb[e]); } }
            else { xa = xc[2 * j]; xb = xc[2 * j + 1]; }
            const f32x4 ga = *(const f32x4*)(mb + 4096 + 8 * ln + 512 * j), gb = *(const f32x4*)(mb + 4096 + 8 * ln + 512 * j + 4);
#pragma unroll
            for (int e = 0; e < 4; ++e) { v[8 * j + e] = ALPHA * xa[e] + (1.f + ga[e]) * y8[e]; v[8 * j + 4 + e] = ALPHA * xb[e] + (1.f + gb[e]) * y8[4 + e]; } }
        float s = 0.f;
#pragma unroll
        for (int e = 0; e < 32; ++e) s += v[e];
        const float mean = wave_sum(s) * (1.f / DM); float q = 0.f;
#pragma unroll
        for (int e = 0; e < 32; ++e) { v[e] -= mean; q += v[e] * v[e]; }
        const float rstd = rsqrtf(wave_sum(q) * (1.f / DM) + LN_EPS); float hmx = 0.f;
#pragma unroll
        for (int j = 0; j < 4; ++j) { const int co = 8 * ln + 512 * j;
            const f32x4 la = *(const f32x4*)(lng + co), lb = *(const f32x4*)(lng + co + 4), ba = *(const f32x4*)(lnb + co), bb = *(const f32x4*)(lnb + co + 4);
            const f32x4 sa = *(const f32x4*)(mb + 8192 + co), sb = *(const f32x4*)(mb + 8192 + co + 4), ha = *(const f32x4*)(mb + 6144 + co), hb = *(const f32x4*)(mb + 6144 + co + 4);
            float h8[8];
#pragma unroll
            for (int e = 0; e < 4; ++e) { const float na = v[8 * j + e] * rstd * la[e] + ba[e], nb = v[8 * j + 4 + e] * rstd * lb[e] + bb[e];
                h8[e] = na * (1.f + sa[e]) + ha[e]; h8[4 + e] = nb * (1.f + sb[e]) + hb[e]; }
            st8(H2 + ro + 512 * j, h8);
#pragma unroll
            for (int e = 0; e < 8; ++e) { v[8 * j + e] = h8[e]; hmx = fmaxf(hmx, fabsf(h8[e])); } }
        hmx = fmaxf(wave_max(hmx), 1e-30f); const float inv = 127.f / hmx;
#pragma unroll
        for (int j = 0; j < 4; ++j) *(v2u*)(H28 + ro + 512 * j) = (v2u){pk4_i8(v[8 * j] * inv, v[8 * j + 1] * inv, v[8 * j + 2] * inv, v[8 * j + 3] * inv), pk4_i8(v[8 * j + 4] * inv, v[8 * j + 5] * inv, v[8 * j + 6] * inv, v[8 * j + 7] * inv)};
        if (lane == 0) SH[t] = hmx * (1.f / 127.f);
        { const float inv6 = 7.5f / hmx; f32x16_t pa, pb;
#pragma unroll
          for (int i = 0; i < 16; ++i) { pa[i] = v[2 * i] * inv6; pb[i] = v[2 * i + 1] * inv6; }
          const u32x6_t pk = __builtin_amdgcn_cvt_scalef32_2xpk16_fp6_f32(pa, pb, 1.0f); unsigned char* hq = H6 + (size_t)t * 1536;
          *(v4u*)(hq + 16 * lane) = (v4u){pk[0], pk[1], pk[2], pk[3]}; *(v2u*)(hq + 1024 + 8 * lane) = (v2u){pk[4], pk[5]};
          if (lane == 0) HS[t] = hmx * (1.f / 7.5f); }
#pragma unroll
        for (int j = 0; j < 4; ++j) { yc[j] = yn[j]; if constexpr (RES_MOD) rc[j] = rn4[j]; else { xc[2 * j] = xn[2 * j]; xc[2 * j + 1] = xn[2 * j + 1]; } }
    }
}

__device__ __forceinline__ unsigned mono(float f) { const unsigned u = __float_as_uint(f); return (u & 0x80000000u) ? ~u : (u | 0x80000000u); }
__device__ __forceinline__ float unmono(unsigned u) { return __uint_as_float((u & 0x80000000u) ? (u & 0x7fffffffu) : ~u); }
__device__ __forceinline__ unsigned umax_(unsigned a, unsigned b) { return a > b ? a : b; }
__device__ __forceinline__ unsigned umin_(unsigned a, unsigned b) { return a < b ? a : b; }
template <bool DESC> __device__ __forceinline__ void bsort16(unsigned (&k)[16]) {
#pragma unroll
    for (int size = 2; size <= 16; size <<= 1)
#pragma unroll
        for (int stride = size >> 1; stride > 0; stride >>= 1)
#pragma unroll
            for (int i = 0; i < 16; ++i) { const int j = i ^ stride;
                if (j > i) { const bool first_max = (((i & size) == 0) == DESC); const unsigned hi = umax_(k[i], k[j]), lo = umin_(k[i], k[j]); k[i] = first_max ? hi : lo; k[j] = first_max ? lo : hi; } }
}
template <bool DESC> __device__ __forceinline__ void bmerge16(unsigned (&k)[16]) {
#pragma unroll
    for (int stride = 8; stride > 0; stride >>= 1)
#pragma unroll
        for (int i = 0; i < 16; ++i) { const int j = i ^ stride;
            if (j > i) { const unsigned hi = umax_(k[i], k[j]), lo = umin_(k[i], k[j]); k[i] = DESC ? hi : lo; k[j] = DESC ? lo : hi; } }
}
__device__ __forceinline__ void top16_of_64(const unsigned (&k)[64], unsigned (&o)[16]) {
    unsigned g0[16], g1[16], g2[16], g3[16];
#pragma unroll
    for (int i = 0; i < 16; ++i) { g0[i] = k[i]; g1[i] = k[16 + i]; g2[i] = k[32 + i]; g3[i] = k[48 + i]; }
    bsort16<true>(g0); bsort16<false>(g1); bsort16<true>(g2); bsort16<false>(g3);
#pragma unroll
    for (int i = 0; i < 16; ++i) { g0[i] = umax_(g0[i], g1[i]); g2[i] = umax_(g2[i], g3[i]); }
    bmerge16<true>(g0); bmerge16<false>(g2);
#pragma unroll
    for (int i = 0; i < 16; ++i) o[i] = umax_(g0[i], g2[i]);
    bmerge16<true>(o);
}
__device__ __forceinline__ int swz16(int row, int cb) { return cb ^ ((row & 15) << 4); }
__device__ __forceinline__ void ph_topk(const Args& a, int layer, LAS unsigned char* lds, int tid, int lane, int wave) {
    const bf16* QP = (const bf16*)(a.ws + WS_QP); const bf16* KEYS = (const bf16*)(a.ws + WS_KEYS) + (size_t)layer * 8 * 2 * 128 * 128;
    int* EI = (int*)(a.ws + WS_EI); float* GT = (float*)(a.ws + WS_GT); const float* SVl = (const float*)(a.ws + WS_SV) + layer * NEXP;
    LAS unsigned char* kt = lds;
    LAS unsigned* lists = (LAS unsigned*)(lds + 65536 + wave * 4096);
    const int r32 = lane & 31, hi = lane >> 5, h = blockIdx.x & 7, wgr = blockIdx.x >> 3, nwgh = gridDim.x >> 3;
    { const bf16* kh = KEYS + (size_t)h * 2 * 128 * 128;
#pragma unroll
      for (int i = 0; i < 8; ++i) { const int ch = tid + i * NTHREADS, row = ch >> 4, cb = (ch & 15) * 16;
          *(LAS v4u*)(kt + row * 256 + swz16(row, cb)) = *(const v4u*)(kh + (size_t)row * 128 + (cb >> 1)); } }
    __syncthreads();
    if (wgr < nwgh) {
#pragma unroll 1
    for (int u = wgr * NWAVES + wave; u < M / 32; u += nwgh * NWAVES) {
        const int t0 = u * 32; const bf16* qrow = QP + (size_t)(t0 + r32) * DM + h * 256 + 8 * hi;
        unsigned LL[2][16];
#pragma unroll
        for (int p = 0; p < 2; ++p) {
            bf16x8 bq[8];
#pragma unroll
            for (int sI = 0; sI < 8; ++sI) bq[sI] = *(const bf16x8*)(qrow + p * 128 + 16 * sI);
            f32x16 acc[4];
#pragma unroll
            for (int blk = 0; blk < 4; ++blk)
#pragma unroll
                for (int e = 0; e < 16; ++e) acc[blk][e] = 0.f;
#pragma unroll
            for (int sI = 0; sI < 8; ++sI)
#pragma unroll
                for (int blk = 0; blk < 4; ++blk) { const int krow = p * 128 + blk * 32 + r32;
                    const bf16x8 ak = *(const LAS bf16x8*)(kt + krow * 256 + swz16(krow, (16 * sI + 8 * hi) * 2));
                    acc[blk] = __builtin_amdgcn_mfma_f32_32x32x16_bf16(ak, bq[sI], acc[blk], 0, 0, 0); }
            unsigned kk[64], o[16];
#pragma unroll
            for (int blk = 0; blk < 4; ++blk)
#pragma unroll
                for (int e = 0; e < 16; ++e) { const int n = 32 * blk + (e & 3) + 8 * (e >> 2) + 4 * hi; kk[blk * 16 + e] = (mono(acc[blk][e]) & ~127u) | (unsigned)(127 - n); }
            top16_of_64(kk, o);
#pragma unroll
            for (int i = 0; i < 16; ++i) LL[p][i] = umax_(o[i], (unsigned)__shfl_xor((int)o[15 - i], 32));
            bmerge16<true>(LL[p]);
            if (hi == 0) { LAS v4u* lp = (LAS v4u*)(lists + (p * 32 + r32) * 16);
#pragma unroll
                for (int i = 0; i < 4; ++i) lp[i] = (v4u){LL[p][4 * i], LL[p][4 * i + 1], LL[p][4 * i + 2], LL[p][4 * i + 3]}; }
        }
        unsigned tk[16];
        { float f1[16], f2[16];
#pragma unroll
          for (int i = 0; i < 16; ++i) { f1[i] = unmono(LL[0][i] & ~127u); f2[i] = unmono(LL[1][i] & ~127u); }
          unsigned cd[32];
          {
            cd[0] = hi ? ((mono(f1[2] + f2[1]) & ~255u) | 222u) : ((mono(f1[0] + f2[0]) & ~255u) | 255u);
            cd[1] = hi ? ((mono(f1[2] + f2[2]) & ~255u) | 221u) : ((mono(f1[0] + f2[1]) & ~255u) | 254u);
            cd[2] = hi ? ((mono(f1[2] + f2[3]) & ~255u) | 220u) : ((mono(f1[0] + f2[2]) & ~255u) | 253u);
            cd[3] = hi ? ((mono(f1[2] + f2[4]) & ~255u) | 219u) : ((mono(f1[0] + f2[3]) & ~255u) | 252u);
            cd[4] = hi ? ((mono(f1[3] + f2[0]) & ~255u) | 207u) : ((mono(f1[0] + f2[4]) & ~255u) | 251u);
            cd[5] = hi ? ((mono(f1[3] + f2[1]) & ~255u) | 206u) : ((mono(f1[0] + f2[5]) & ~255u) | 250u);
            cd[6] = hi ? ((mono(f1[3] + f2[2]) & ~255u) | 205u) : ((mono(f1[0] + f2[6]) & ~255u) | 249u);
            cd[7] = hi ? ((mono(f1[3] + f2[3]) & ~255u) | 204u) : ((mono(f1[0] + f2[7]) & ~255u) | 248u);
            cd[8] = hi ? ((mono(f1[4] + f2[0]) & ~255u) | 191u) : ((mono(f1[0] + f2[8]) & ~255u) | 247u);
            cd[9] = hi ? ((mono(f1[4] + f2[1]) & ~255u) | 190u) : ((mono(f1[0] + f2[9]) & ~255u) | 246u);
            cd[10] = hi ? ((mono(f1[4] + f2[2]) & ~255u) | 189u) : ((mono(f1[0] + f2[10]) & ~255u) | 245u);
            cd[11] = hi ? ((mono(f1[5] + f2[0]) & ~255u) | 175u) : ((mono(f1[0] + f2[11]) & ~255u) | 244u);
            cd[12] = hi ? ((mono(f1[5] + f2[1]) & ~255u) | 174u) : ((mono(f1[0] + f2[12]) & ~255u) | 243u);
            cd[13] = hi ? ((mono(f1[6] + f2[0]) & ~255u) | 159u) : ((mono(f1[0] + f2[13]) & ~255u) | 242u);
            cd[14] = hi ? ((mono(f1[6] + f2[1]) & ~255u) | 158u) : ((mono(f1[0] + f2[14]) & ~255u) | 241u);
            cd[15] = hi ? ((mono(f1[7] + f2[0]) & ~255u) | 143u) : ((mono(f1[0] + f2[15]) & ~255u) | 240u);
            cd[16] = hi ? ((mono(f1[7] + f2[1]) & ~255u) | 142u) : ((mono(f1[1] + f2[0]) & ~255u) | 239u);
            cd[17] = hi ? ((mono(f1[8] + f2[0]) & ~255u) | 127u) : ((mono(f1[1] + f2[1]) & ~255u) | 238u);
            cd[18] = hi ? ((mono(f1[9] + f2[0]) & ~255u) | 111u) : ((mono(f1[1] + f2[2]) & ~255u) | 237u);
            cd[19] = hi ? ((mono(f1[10] + f2[0]) & ~255u) | 95u) : ((mono(f1[1] + f2[3]) & ~255u) | 236u);
            cd[20] = hi ? ((mono(f1[11] + f2[0]) & ~255u) | 79u) : ((mono(f1[1] + f2[4]) & ~255u) | 235u);
            cd[21] = hi ? ((mono(f1[12] + f2[0]) & ~255u) | 63u) : ((mono(f1[1] + f2[5]) & ~255u) | 234u);
            cd[22] = hi ? ((mono(f1[13] + f2[0]) & ~255u) | 47u) : ((mono(f1[1] + f2[6]) & ~255u) | 233u);
            cd[23] = hi ? ((mono(f1[14] + f2[0]) & ~255u) | 31u) : ((mono(f1[1] + f2[7]) & ~255u) | 232u);
            cd[24] = hi ? ((mono(f1[15] + f2[0]) & ~255u) | 15u) : ((mono(f1[2] + f2[0]) & ~255u) | 223u);
            cd[25] = 0u;
            cd[26] = 0u;
            cd[27] = 0u;
            cd[28] = 0u;
            cd[29] = 0u;
            cd[30] = 0u;
            cd[31] = 0u;
          }
          unsigned g0[16], g1[16];
#pragma unroll
          for (int i = 0; i < 16; ++i) { g0[i] = cd[i]; g1[i] = cd[16 + i]; }
          bsort16<true>(g0); bsort16<false>(g1);
#pragma unroll
          for (int i = 0; i < 16; ++i) g0[i] = umax_(g0[i], g1[i]);
          bmerge16<true>(g0);
#pragma unroll
          for (int i = 0; i < 16; ++i) tk[i] = umax_(g0[i], (unsigned)__shfl_xor((int)g0[15 - i], 32));
          bmerge16<true>(tk); }
        float ev[16]; const float m0 = unmono(tk[0] & ~255u); float den = 0.f;
#pragma unroll
        for (int k = 0; k < 16; ++k) { ev[k] = __expf(unmono(tk[k] & ~255u) - m0); den += ev[k]; }
        const float rden = 1.f / den;
        const LAS unsigned* L1 = lists + r32 * 16; const LAS unsigned* L2 = lists + (32 + r32) * 16;
        int ei[16];
#pragma unroll
        for (int k = 0; k < 16; ++k) { const int id = 255 - (int)(tk[k] & 255u), i = id >> 4, j = id & 15;
            const int n1 = 127 - (int)(L1[i] & 127u), n2 = 127 - (int)(L2[j] & 127u); ei[k] = n1 * 128 + n2; }
        if (hi == 0) { int* ep = EI + (size_t)(t0 + r32) * 128 + h * 16;
#pragma unroll
            for (int k = 0; k < 4; ++k) *(int4*)(ep + 4 * k) = make_int4(ei[4 * k], ei[4 * k + 1], ei[4 * k + 2], ei[4 * k + 3]); }
        else { float* gp = GT + (size_t)(t0 + r32) * 128 + h * 16; float gg[16];
#pragma unroll
            for (int k = 0; k < 16; ++k) gg[k] = ev[k] * rden * SVl[ei[k]];
#pragma unroll
            for (int k = 0; k < 4; ++k) *(f32x4*)(gp + 4 * k) = (f32x4){gg[4 * k], gg[4 * k + 1], gg[4 * k + 2], gg[4 * k + 3]}; }
    } }
    __syncthreads();
}

typedef int i32x8_t __attribute__((ext_vector_type(8)));
__device__ __forceinline__ void peer_slice(const Args& a, volatile LAS unsigned* st, int& x, int& rank, int& nrank) {
    const unsigned* bar = (const unsigned*)a.ws; nrank = (int)(gridDim.x >> 3); bool uni = (gridDim.x & 7u) == 0u;
#pragma unroll
    for (int j = 0; j < 16; ++j) { const unsigned c = __hip_atomic_load(&bar[XB_XCNT(j)], __ATOMIC_RELAXED, __HIP_MEMORY_SCOPE_AGENT); uni = uni && (c == (j < 8 ? (unsigned)nrank : 0u)); }
    if (uni) { x = (int)st[3]; rank = (int)st[2]; } else { x = (int)(blockIdx.x & 7u); rank = (int)(blockIdx.x >> 3); }
    x = __builtin_amdgcn_readfirstlane(x); rank = __builtin_amdgcn_readfirstlane(rank);
}
__device__ __forceinline__ void ph_peer_u(const Args& a, int layer, volatile LAS unsigned* st, LAS unsigned char* lds, int lane, int wave) {
    int x, rank, nrank; peer_slice(a, st, x, rank, nrank); const int m16 = lane & 15, kc = lane >> 4, r8 = lane >> 3, sg = lane & 7;
    const unsigned char* TUb = a.ws + WS_TU + (size_t)layer * NEXP * ROW4 + (size_t)x * NEXP * 128;
    const unsigned char* H6 = a.ws + WS_H6 + 16 * (8 * x + kc); const int* EI = (const int*)(a.ws + WS_EI) + lane; bf16* PART = (bf16*)(a.ws + WS_PART) + x * 128 + 32 * kc;
    if (rank >= nrank) return;
    const int t0 = rank * NWAVES + wave, ts = nrank * NWAVES, nt = (M - t0 + ts - 1) / ts;
    LAS unsigned char* ub = lds + wave * 2304; LAS unsigned char* ubw = ub + r8 * 144 + 16 * sg; const LAS unsigned char* ubr = ub + m16 * 144 + 16 * kc;
    v4u U[8][2]; v4u ha[2], han[2]; v2u hb[2], hbn[2]; int en0 = 0, en1 = 0;
#pragma unroll
    for (int g = 0; g < 8; ++g) { U[g][0] = (v4u){0u, 0u, 0u, 0u}; U[g][1] = U[g][0]; }
    ha[0] = ha[1] = (v4u){0u, 0u, 0u, 0u}; hb[0] = hb[1] = (v2u){0u, 0u};
#pragma unroll 1
    for (int k = -2; k < nt; ++k) {
        const int k2 = k + 2 < nt ? k + 2 : nt - 1, k1 = k + 1 < nt ? (k + 1 < 0 ? 0 : k + 1) : nt - 1;
        const size_t tn2 = (size_t)(t0 + ts * k2), tn1 = (size_t)(t0 + ts * k1);
        const int enn0 = EI[tn2 * 128], enn1 = EI[tn2 * 128 + 64];
        { const unsigned char* hp = H6 + tn1 * 1536;
#pragma unroll
          for (int i = 0; i < 2; ++i) { han[i] = *(const v4u*)(hp + 64 * i); hbn[i] = *(const v2u*)(hp + 1024 - 8 * (8 * x + kc) + 32 * i); } }
        bf16* pp = PART + (size_t)(t0 + ts * (k < 0 ? 0 : k)) * 1024; unsigned pv0 = 0u, pv1 = 0u;
#pragma unroll
        for (int g = 0; g < 8; ++g) {
            { f32x4 acc = {0.f, 0.f, 0.f, 0.f};
                if (k >= 0) {
                    *(LAS v4u*)ubw = U[g][0]; *(LAS v4u*)(ubw + 8 * 144) = U[g][1];
#pragma unroll
                    for (int i = 0; i < 2; ++i) { const v4u uu = *(const LAS v4u*)(ubr + 64 * i); const i32x8_t A8 = {(int)uu.x, (int)uu.y, (int)uu.z, (int)uu.w, 0, 0, 0, 0};
                        const i32x8_t B8 = {(int)ha[i].x, (int)ha[i].y, (int)ha[i].z, (int)ha[i].w, (int)hb[i].x, (int)hb[i].y, 0, 0};
                        acc = __builtin_amdgcn_mfma_scale_f32_16x16x128_f8f6f4(A8, B8, acc, 4, 2, 0, 127, 0, 127); } }
                if ((g & 1) == 0) { pv0 = pk2c(acc[0], acc[1]); pv1 = pk2c(acc[2], acc[3]); }
                else if (m16 == 0) *(v4u*)(pp + 4 * (g - 1)) = (v4u){pv0, pv1, pk2c(acc[0], acc[1]), pk2c(acc[2], acc[3])}; }
#pragma unroll
            for (int j = 0; j < 2; ++j) { const int em = __shfl(g < 4 ? en0 : en1, (g & 3) * 16 + 8 * j + r8); U[g][j] = *(const v4u*)(TUb + (unsigned)(em * 128 + 16 * sg)); }
            __builtin_amdgcn_sched_barrier(0);
        }
#pragma unroll
        for (int i = 0; i < 2; ++i) { ha[i] = han[i]; hb[i] = hbn[i]; }
        en0 = enn0; en1 = enn1;
    }
}
__device__ __forceinline__ void ph_peer_coef(const Args& a, int layer, LAS unsigned char* lds, int lane, int wave) {
    const int p0 = 16 * ((lane >> 1) & 7) + 4 * (lane >> 4) + 2 * (lane & 1);
    const int* EI = (const int*)(a.ws + WS_EI) + p0; const float* GT = (const float*)(a.ws + WS_GT) + p0; const unsigned* PART = (const unsigned*)(a.ws + WS_PART) + lane;
    const float* SU = (const float*)(a.ws + WS_SU) + layer * NEXP; const float* HS = (const float*)(a.ws + WS_HS);
    unsigned char* AR = a.ws + WS_AR; int* EQ = (int*)(a.ws + WS_EQ) + (p0 & 7) * 16 + (p0 >> 3);
    LAS float* CFL = (LAS float*)(lds + wave * 1024);
    const int gw = blockIdx.x * NWAVES + wave, NGW = gridDim.x * NWAVES;
#pragma unroll 1
    for (int t = gw; t < M; t += NGW) {
        const size_t tt = (size_t)t; const int2 ee = *(const int2*)(EI + tt * 128); const float2 gg = *(const float2*)(GT + tt * 128); const float hs = HS[t];
        unsigned P[8];
#pragma unroll
        for (int xx = 0; xx < 8; ++xx) P[xx] = PART[(tt * 8 + xx) * 64];
        const float s0 = SU[ee.x], s1 = SU[ee.y];
        const float d0 = ((bf_lo(P[0]) + bf_lo(P[1])) + (bf_lo(P[2]) + bf_lo(P[3]))) + ((bf_lo(P[4]) + bf_lo(P[5])) + (bf_lo(P[6]) + bf_lo(P[7])));
        const float d1 = ((bf_hi(P[0]) + bf_hi(P[1])) + (bf_hi(P[2]) + bf_hi(P[3]))) + ((bf_hi(P[4]) + bf_hi(P[5])) + (bf_hi(P[6]) + bf_hi(P[7])));
        const float c0 = gelu_tanh(d0 * hs * s0) * gg.x, c1 = gelu_tanh(d1 * hs * s1) * gg.y;
        EQ[tt * 128] = ee.x * 128; EQ[tt * 128 + 16] = ee.y * 128;
        const float cmx = fmaxf(wave_max(fmaxf(fabsf(c0), fabsf(c1))), 1e-30f), csc = 7.5f / cmx;
        CFL[p0] = c0 * csc; CFL[p0 + 1] = c1 * csc;
        f32x16_t pa, pb;
#pragma unroll
        for (int i = 0; i < 8; ++i) { const f32x4 c4 = *(const LAS f32x4*)(CFL + 32 * (lane & 3) + 4 * i); pa[2 * i] = c4[0]; pb[2 * i] = c4[1]; pa[2 * i + 1] = c4[2]; pb[2 * i + 1] = c4[3]; }
        const u32x6_t ph = __builtin_amdgcn_cvt_scalef32_2xpk16_fp6_f32(pa, pb, 1.0f);
        if (lane < 4) { unsigned char* rp = AR + tt * 128 + 32 * lane; *(v4u*)rp = (v4u){ph[0], ph[1], ph[2], ph[3]}; *(v4u*)(rp + 16) = (v4u){ph[4], ph[5], __float_as_uint(cmx * (1.f / 7.5f)), 0u}; }
    }
}
__device__ __forceinline__ void ph_peer_v(const Args& a, int layer, volatile LAS unsigned* st, LAS unsigned char* lds, int lane, int wave) {
    int x, rank, nrank; peer_slice(a, st, x, rank, nrank); const int q = lane >> 3, sg = lane & 7, n16 = lane & 15, kc = lane >> 4;
    const unsigned char* TVb = a.ws + WS_TV + (size_t)layer * NEXP * ROWV + (size_t)x * NEXP * 128;
    const int* EQ = (const int*)(a.ws + WS_EQ) + q * 16; const unsigned char* AR = a.ws + WS_AR + 32 * kc;
    if (rank >= nrank) return;
    const int t0 = rank * NWAVES + wave, ts = nrank * NWAVES, nt = (M - t0 + ts - 1) / ts;
    constexpr int VS = 144;
    LAS unsigned char* img = lds + wave * (128 * VS);
    LAS unsigned char* iw = img + q * VS + 16 * sg;
    const LAS unsigned char* ir = img + (32 * kc + n16) * VS;
    typedef int v2i_ __attribute__((ext_vector_type(2)));
    int inv16, ncol; bool tr_ok;
    { *(LAS v2u*)(ir) = (v2u){0x11111111u * (unsigned)n16, 0x11111111u * (unsigned)n16};
      const v2i_ ra = __builtin_amdgcn_ds_read_tr4_b64_v2i32((LAS v2i_*)ir);
      *(LAS v2u*)(ir) = (v2u){0x76543210u, 0xfedcba98u};
      const v2i_ rb = __builtin_amdgcn_ds_read_tr4_b64_v2i32((LAS v2i_*)ir);
      const unsigned r0 = (unsigned)__builtin_amdgcn_readfirstlane(ra.x), r1 = (unsigned)__builtin_amdgcn_readfirstlane(ra.y);
      ncol = rb.x & 15; inv16 = 0; unsigned seen = 0u;
#pragma unroll
      for (int e = 0; e < 16; ++e) { const int rr = (int)(((e < 8 ? r0 : r1) >> (4 * (e & 7))) & 15u); if (rr == n16) inv16 = e; seen |= 1u << rr; }
      bool ok = (unsigned)ra.x == r0 && (unsigned)ra.y == r1 && (unsigned)rb.x == 0x11111111u * (unsigned)ncol && (unsigned)rb.y == 0x11111111u * (unsigned)ncol && seen == 0xffffu;
      unsigned cols = 0u;
#pragma unroll
      for (int i = 0; i < 16; ++i) cols |= 1u << (__shfl(ncol, i) & 15);
      ok = ok && cols == 0xffffu;
      ok = ok && r0 == 0x76543210u && r1 == 0xfedcba98u && ncol == n16;
      tr_ok = __all(ok); }
    unsigned char* Y4 = a.ws + WS_Y + 256 * x + 4 * lane;
    (void)inv16;
    v4u W[16];
#pragma unroll
    for (int i = 0; i < 16; ++i) W[i] = (v4u){0u, 0u, 0u, 0u};
    v4u epn[4], ar0 = {0u, 0u, 0u, 0u}, ar1 = ar0;
#pragma unroll
    for (int j = 0; j < 4; ++j) epn[j] = (v4u){0u, 0u, 0u, 0u};
#pragma unroll 1
    for (int k = -2; k < nt; ++k) {
        const int k2 = k + 2 < nt ? k + 2 : nt - 1, k1 = k + 1 < nt ? (k + 1 < 0 ? 0 : k + 1) : nt - 1; const size_t tn2 = (size_t)(t0 + ts * k2), tn1 = (size_t)(t0 + ts * k1);
        v4u epnn[4];
#pragma unroll
        for (int j = 0; j < 4; ++j) epnn[j] = *(const v4u*)(EQ + tn2 * 128 + 4 * j);
        const v4u arn0 = *(const v4u*)(AR + tn1 * 128), arn1 = *(const v4u*)(AR + tn1 * 128 + 16);
        int ep[16];
#pragma unroll
        for (int j = 0; j < 4; ++j) { ep[4 * j] = (int)epn[j].x; ep[4 * j + 1] = (int)epn[j].y; ep[4 * j + 2] = (int)epn[j].z; ep[4 * j + 3] = (int)epn[j].w; }
        __builtin_amdgcn_sched_barrier(0);
#pragma unroll
        for (int i = 0; i < 16; ++i) {
            *(LAS v4u*)(iw + 8 * i * VS) = W[i];
            W[i] = *(const v4u*)(TVb + (unsigned)(ep[i] + 16 * sg));
            __builtin_amdgcn_sched_barrier(0);
        }
        float yv[16];
#pragma unroll
        for (int j = 0; j < 16; ++j) yv[j] = 0.f;
        if (k >= 0) {
            i32x8_t A8 = {(int)ar0.x, (int)ar0.y, (int)ar0.z, (int)ar0.w, (int)ar1.x, (int)ar1.y, 0, 0};
            if (n16 != 0) A8 = (i32x8_t){0, 0, 0, 0, 0, 0, 0, 0};
            const float ysc = __uint_as_float(ar1.z);
#pragma unroll
            for (int j = 0; j < 16; ++j) {
                const v2i_ b0 = __builtin_amdgcn_ds_read_tr4_b64_v2i32((LAS v2i_*)(ir + 8 * j)), b1 = __builtin_amdgcn_ds_read_tr4_b64_v2i32((LAS v2i_*)(ir + 16 * VS + 8 * j));
                const i32x8_t B8 = {b0.x, b0.y, b1.x, b1.y, 0, 0, 0, 0};
                const f32x4 acc = __builtin_amdgcn_mfma_scale_f32_16x16x128_f8f6f4(A8, B8, (f32x4){0.f, 0.f, 0.f, 0.f}, 2, 4, 0, 127, 0, 127);
                yv[j] = acc[0] * ysc; }
        }
        if (!tr_ok) { _Pragma("unroll") for (int j = 0; j < 16; ++j) yv[j] = __builtin_nanf(""); }
        { LAS float* yl = (LAS float*)img;
          if (kc == 0) {
#pragma unroll
              for (int j = 0; j < 16; ++j) yl[16 * j + ncol] = yv[j]; }
          const f32x4 y4 = *(const LAS f32x4*)(yl + 4 * lane);
          *(unsigned*)(Y4 + (size_t)(t0 + ts * (k < 0 ? 0 : k)) * DM) = pk4_fp8(y4[0] * YP_SCALE, y4[1] * YP_SCALE, y4[2] * YP_SCALE, y4[3] * YP_SCALE); }
        ar0 = arn0; ar1 = arn1;
#pragma unroll
        for (int j = 0; j < 4; ++j) epn[j] = epnn[j];
    }
}
template <bool FINAL>
__device__ __forceinline__ void ph_peer_ln(const Args& a, const float* mod_l, const float* mod_next, const float* lng, const float* lnb, int lane, int wave) {
    const bf16* H2 = (const bf16*)(a.ws + WS_H2); bf16* HB = (bf16*)(a.ws + WS_HB); const unsigned char* Y = a.ws + WS_Y;
    const int gw = blockIdx.x * NWAVES + wave, NGW = gridDim.x * NWAVES;
#pragma unroll 1
    for (int t = gw; t < M; t += NGW) {
        const int b = t >> 13;
        float out[32];
        { unsigned lo0 = (unsigned)lane * 4u; asm volatile("" : "+v"(lo0)); const unsigned char* yrow = Y + (size_t)t * DM;
#pragma unroll
          for (int j = 0; j < 8; ++j) { const unsigned yw = *(const unsigned*)(yrow + lo0 + 256 * j); const auto ya = __builtin_amdgcn_cvt_pk_f32_fp8((int)yw, false), yb = __builtin_amdgcn_cvt_pk_f32_fp8((int)yw, true);
              out[4 * j] = ya[0] * (1.f / YP_SCALE); out[4 * j + 1] = ya[1] * (1.f / YP_SCALE); out[4 * j + 2] = yb[0] * (1.f / YP_SCALE); out[4 * j + 3] = yb[1] * (1.f / YP_SCALE); } }
        unsigned lo = (unsigned)lane * 16u; asm volatile("" : "+v"(lo));
        const char* mb = (const char*)(mod_l + b * 12288); const char* h2row = (const char*)(H2 + (size_t)t * DM);
#define LD4_(base, j_) (*(const f32x4*)((const char*)(base) + lo + 1024 * (j_)))
#pragma unroll
        for (int j = 0; j < 8; ++j) { const v2u hw = *(const v2u*)(h2row + (lo >> 1) + 512 * j); const float h4[4] = {bf_lo(hw.x), bf_hi(hw.x), bf_lo(hw.y), bf_hi(hw.y)};
            const f32x4 ga = LD4_(mb + 10240 * 4, j), sf = LD4_(mb + 8192 * 4, j), hf = LD4_(mb + 6144 * 4, j);
#pragma unroll
            for (int e = 0; e < 4; ++e) { const float x1 = (h4[e] - hf[e]) * __builtin_amdgcn_rcpf(1.f + sf[e]); out[4 * j + e] = ALPHA * x1 + (1.f + ga[e]) * out[4 * j + e]; } }
        float s = 0.f;
#pragma unroll
        for (int e = 0; e < 32; ++e) s += out[e];
        const float mean = wave_sum(s) * (1.f / DM); float q2 = 0.f;
#pragma unroll
        for (int e = 0; e < 32; ++e) { out[e] -= mean; q2 += out[e] * out[e]; }
        const float rstd = rsqrtf(wave_sum(q2) * (1.f / DM) + LN_EPS);
        const char* mn = (const char*)(mod_next + b * 12288); char* orow = (char*)(a.out + (size_t)t * DM); char* hrow = (char*)(HB + (size_t)t * DM);
        float hmx = 0.f; (void)hmx;
#pragma unroll
        for (int j = 0; j < 8; ++j) { const f32x4 la = LD4_(lng, j), ba = LD4_(lnb, j); f32x4 na;
#pragma unroll
            for (int e = 0; e < 4; ++e) na[e] = out[4 * j + e] * rstd * la[e] + ba[e];
            if constexpr (FINAL) *(f32x4*)(orow + lo + 1024 * j) = na;
            else { const f32x4 sa = LD4_(mn + 2048 * 4, j), ha = LD4_(mn, j);
#pragma unroll
                for (int e = 0; e < 4; ++e) { const float hn = na[e] * (1.f + sa[e]) + ha[e]; out[4 * j + e] = hn; hmx = fmaxf(hmx, fabsf(hn)); }
                *(v2u*)(hrow + (lo >> 1) + 512 * j) = (v2u){pk2(out[4 * j], out[4 * j + 1]), pk2(out[4 * j + 2], out[4 * j + 3])}; } }
        if constexpr (!FINAL) {
            hmx = fmaxf(wave_max(hmx), 1e-30f); const float inv8 = 240.f / hmx; unsigned char* h8row = a.ws + WS_HB8 + (size_t)t * DM;
#pragma unroll
            for (int j = 0; j < 8; ++j) { unsigned w = 0u; w = __builtin_amdgcn_cvt_pk_fp8_f32(out[4 * j] * inv8, out[4 * j + 1] * inv8, w, false); w = __builtin_amdgcn_cvt_pk_fp8_f32(out[4 * j + 2] * inv8, out[4 * j + 3] * inv8, w, true);
                *(unsigned*)(h8row + (lo >> 2) + 256 * j) = w; }
            if (lane == 0) ((float*)(a.ws + WS_SA))[t] = hmx * (1.f / 240.f); }
#undef LD4_
    }
}

__device__ __forceinline__ void ph_forget(const Args& a, LAS unsigned char* lds, int lane, int wave) {
    const bf16* HB = (const bf16*)(a.ws + WS_HB); const bf16* WF = (const bf16*)(a.ws + WS_WF); float* LF = (float*)(a.ws + WS_LF);
    const int m16 = lane & 15, kc = lane >> 4, kh = wave & 1;
    LAS f32x4* xch = (LAS f32x4*)lds;
    for (int base = blockIdx.x * (NWAVES / 2); base < M / 16; base += gridDim.x * (NWAVES / 2)) {
        const int item = base + (wave >> 1); const bool live = item < M / 16;
        const int t0 = (live ? item : 0) * 16; f32x4 acc = {0.f, 0.f, 0.f, 0.f};
        const bf16* ap = HB + (size_t)(t0 + m16) * DM + 8 * kc + 1024 * kh; const bf16* bp = WF + (size_t)m16 * DM + 8 * kc + 1024 * kh;
#pragma unroll 16
        for (int s = 0; s < 32; ++s) { const bf16x8 av = *(const bf16x8*)(ap + 32 * s), bv = *(const bf16x8*)(bp + 32 * s); acc = __builtin_amdgcn_mfma_f32_16x16x32_bf16(av, bv, acc, 0, 0, 0); }
        xch[wave * 64 + lane] = acc;
        __syncthreads();
        if (kh == 0 && live) { const f32x4 oth = xch[(wave + 1) * 64 + lane]; const float bfv = a.in[22][m16]; f32x4 o;
#pragma unroll
            for (int r = 0; r < 4; ++r) { const float x = acc[r] + oth[r] + bfv; o[r] = fminf(x, 0.f) - log1pf(__expf(-fabsf(x))); }
            const int t = t0 + 4 * kc, b = t >> 13, pos = t & (SEQ - 1);
            *(f32x4*)(LF + (size_t)(b * 16 + m16) * SEQ + pos) = o; }
        __syncthreads();
    }
}
__device__ __forceinline__ void ph_cumsum(const Args& a, int lane, int wave) {
    const float* LF = (const float*)(a.ws + WS_LF); float* FB = (float*)(a.ws + WS_FB);
    float* FE = (float*)(a.ws + WS_FE); float* FP = (float*)(a.ws + WS_FP);
    const int gw = blockIdx.x * NWAVES + wave, NGW = gridDim.x * NWAVES;
    const int sidx = NGW >= 1056 ? gw - 1024 : gw;
    for (int seq = sidx; seq >= 0 && seq < 32; seq += NGW) {
        const float* src = LF + (size_t)seq * SEQ + lane * 128; float* dst = FB + (size_t)seq * SEQ + lane * 128;
        f32x4 vv[32];
#pragma unroll
        for (int i = 0; i < 32; ++i) vv[i] = *(const f32x4*)(src + 4 * i);
        float s = 0.f;
#pragma unroll
        for (int i = 0; i < 32; ++i) s += (vv[i][0] + vv[i][1]) + (vv[i][2] + vv[i][3]);
        float inc = s;
#pragma unroll
        for (int o = 1; o < 64; o <<= 1) { const float n = __shfl_up(inc, o); if (lane >= o) inc += n; }
        float run = inc - s;
#pragma unroll
        for (int i = 0; i < 32; ++i) { const f32x4 v = vv[i]; f32x4 o;
            run += v[0]; o[0] = run; run += v[1]; o[1] = run; run += v[2]; o[2] = run; run += v[3]; o[3] = run;
            if (i == 0 && (lane & 1) == 0) FP[seq * 32 + (lane >> 1)] = -o[0];
            if (i == 15) FE[seq * 128 + 2 * lane] = -o[3];
            if (i == 31) FE[seq * 128 + 2 * lane + 1] = -o[3];
            *(f32x4*)(dst + 4 * i) = o * (-1.f / ATT_SCALE); }
    }
    const bf16* QK = (const bf16*)(a.ws + WS_ZB);
    for (int item = gw; item < 1024; item += NGW) {
        const int seq = item >> 5, blk = item & 31, b = seq >> 4, h = seq & 15;
        const bf16* qb = QK + ((size_t)b * SEQ + (size_t)blk * 256) * DM + h * 128 + 8 * (lane & 15); const bf16* kb = qb + (size_t)M * DM;
        float mq = 0.f, mk = 0.f, md = 3.0e38f;
#pragma unroll 8
        for (int r = 0; r < 64; ++r) { const size_t ro = (size_t)(4 * r + (lane >> 4)) * DM; float vq[8], vk[8]; ld8(qb + ro, vq); ld8(kb + ro, vk);
            float sq = 0.f, sk = 0.f, sd = 0.f;
#pragma unroll
            for (int e = 0; e < 8; ++e) { sq += vq[e] * vq[e]; sk += vk[e] * vk[e]; sd += vq[e] * vk[e]; }
            sq += SWZ_XOR_(sq, 1); sk += SWZ_XOR_(sk, 1); sd += SWZ_XOR_(sd, 1); sq += SWZ_XOR_(sq, 2); sk += SWZ_XOR_(sk, 2); sd += SWZ_XOR_(sd, 2);
            sq += SWZ_XOR_(sq, 4); sk += SWZ_XOR_(sk, 4); sd += SWZ_XOR_(sd, 4); sq += SWZ_XOR_(sq, 8); sk += SWZ_XOR_(sk, 8); sd += SWZ_XOR_(sd, 8);
            mq = fmaxf(mq, sq); mk = fmaxf(mk, sk); md = fminf(md, sd); }
        mq = wave_max(mq); mk = wave_max(mk); md = -wave_max(-md);
        if (lane == 0) { ((float*)(a.ws + WS_QN))[seq * 32 + blk] = mq; ((float*)(a.ws + WS_KN))[seq * 32 + blk] = mk; ((float*)(a.ws + WS_DN))[seq * 32 + blk] = md; }
    }
}

constexpr float SKIP_T = 20.f;
__device__ __forceinline__ attn::BlockRef<__hip_bfloat16, __hip_bfloat16> attn_mkref(int L, const __hip_bfloat16* Q, const __hip_bfloat16* K, const __hip_bfloat16* V, __hip_bfloat16* O, const unsigned char* ws, int lane) {
    const int qb = 31 - (L >> 5), seq = L & 31, b = seq >> 4, h = seq & 15;
    attn::BlockRef<__hip_bfloat16, __hip_bfloat16> r; const size_t rowq = (size_t)b * SEQ + (size_t)qb * attn::QB, row0 = (size_t)b * SEQ;
    r.Q = Q + rowq * DM + h * 128; r.O = O + rowq * DM + h * 128; r.K = K + row0 * DM + h * 128; r.V = V + row0 * DM + h * 128; r.Fb = (const float*)(ws + WS_FB) + (size_t)seq * SEQ; r.P0 = qb * attn::QB; r.O8 = (unsigned char*)ws + WS_YC8 + rowq * DM + h * 128;
    const char* FE = (const char*)((const float*)(ws + WS_FE) + seq * 128); const char* KN = (const char*)((const float*)(ws + WS_KN) + seq * 32);
    unsigned l4 = (unsigned)lane * 4u; asm volatile("" : "+v"(l4));
    const float kn = wave_max((lane & 31) <= qb ? *(const float*)(KN + (l4 & 124u)) : 0.f), qn = ((const float*)(ws + WS_QN))[seq * 32 + qb], fp = ((const float*)(ws + WS_FP))[seq * 32 + qb];
    const float dn = ((const float*)(ws + WS_DN))[seq * 32 + qb];
    const float tgt = fp - (SKIP_T + (sqrtf(qn * kn) * 1.0001f - dn) * ATT_SCALE);
    const int cnt = __popcll(__ballot(*(const float*)(FE + l4) <= tgt)) + __popcll(__ballot(*(const float*)(FE + 256 + l4) <= tgt));
    r.jlo = cnt < 4 * qb ? cnt : 4 * qb;
    return r;
}
__device__ __forceinline__ void ph_attention(const Args& a, char* lds, const int tid) {
    using namespace attn;
    typedef __hip_bfloat16 T;
    const T* Q = (const T*)(a.ws + WS_ZB); const T* K = Q + (size_t)M * DM; const T* V = K + (size_t)M * DM; T* O = (T*)(a.ws + WS_YC);
    unsigned* ctr = (unsigned*)(a.ws + 32768);
    volatile int* nextw = (volatile int*)(lds + attn::LDS_BYTES);
    const int lane = tid & 63, total = 1024;
    int L = blockIdx.x; if (L >= total) return;
    BlockRef<T, T> cur = attn_mkref(L, Q, K, V, O, a.ws, lane);
    Seam<T> S;
    causal_swa_prime<T, T>(cur, SEQ, lds, S, tid);
    for (;;) {
        if (tid == 0) *nextw = (int)gridDim.x + (int)__hip_atomic_fetch_add(ctr, 1u, __ATOMIC_RELAXED, __HIP_MEMORY_SCOPE_AGENT);
        __syncthreads();
        const int Ln = __builtin_amdgcn_readfirstlane(*nextw); const bool last = Ln >= total;
        const BlockRef<T, T> nxt = last ? cur : attn_mkref(Ln, Q, K, V, O, a.ws, lane);
        causal_swa_block<T, T>(cur, nxt, SEQ, SEQ, lds, S, tid);
        if (last) break;
        cur = nxt; L = Ln;
    }
}

__global__ void __launch_bounds__(NTHREADS, 2) mk_fwd(Args a) {
    extern __shared__ __attribute__((aligned(16))) unsigned char lds_raw[];
    cg::grid_group grid = cg::this_grid();
    LAS unsigned char* lds = (LAS unsigned char*)lds_raw;
    const int wave = __builtin_amdgcn_readfirstlane((int)threadIdx.x >> 6);
    unsigned char* ws = a.ws;
    const float* MOD = (const float*)(ws + WS_MOD);
    const int lo = a.ph_lo, hi = a.ph_hi;
    XcdBarrier bar;
    { const int l0 = lane_id(); volatile LAS unsigned* st = (volatile LAS unsigned*)(lds + LDS_CTL);
      if (wave == 0 && l0 == 0) { st[0] = 0u; st[1] = 0u; }
      __syncthreads();
      bar.bar = (unsigned*)ws; bar.x = xb_xcc_id(); bar.st = st;
      if (lo == 0) { if (blockIdx.x == 0) { unsigned* z = (unsigned*)ws; const int t_ = wave * 64 + l0;
#pragma unroll 1
              for (int i = t_; i < 4096; i += NTHREADS) __hip_atomic_store(z + i, 0u, __ATOMIC_RELAXED, __HIP_MEMORY_SCOPE_AGENT);
              if (t_ == 0) __hip_atomic_store(z + 8192, 0u, __ATOMIC_RELAXED, __HIP_MEMORY_SCOPE_AGENT); } }
      else if (wave == 0 && l0 == 0) { st[2] = xb_add(&bar.bar[XB_XCNT(bar.x)], 1u); st[3] = bar.x; } }
    int ph = 0;
#define PHASE_BEGIN if (ph >= lo && ph < hi) { const int lane = lane_id(), tid = wave * 64 + lane; (void)tid; (void)lane;
#define TID tid
#define PHASE_END   if (ph + 1 < hi) { if (ph == 0) { grid.sync(); if (wave == 0 && lane_id() == 0) { bar.st[2] = xb_add(&bar.bar[XB_XCNT(bar.x)], 1u); bar.st[3] = bar.x; } } else xcd_barrier(bar, wave == 0 && lane_id() == 0);     } } ++ph;
    bf16* HB = (bf16*)(ws + WS_HB); bf16* ZB = (bf16*)(ws + WS_ZB); bf16* YC = (bf16*)(ws + WS_YC); bf16* YB = (bf16*)(ws + WS_YB);
    float* X1 = (float*)(ws + WS_X1); bf16* H2 = (bf16*)(ws + WS_H2); bf16* QP = (bf16*)(ws + WS_QP);

    PHASE_BEGIN ph_prologue(a, lds, tid, lane, wave); PHASE_END
    PHASE_BEGIN ph_modulate(a.in[0], MOD, 0, 2048, HB, ws + WS_HB8, (float*)(ws + WS_SA), lane, wave); PHASE_END
    PHASE_BEGIN { pg8::Gemm g{(const bf16*)(ws + WS_HB8), (const bf16*)(ws + WS_WIN), M, NZ, DM / 2, DM / 2, DM / 2}; pg8::StaticOrder S; S.init(M, NZ, gridDim.x, blockIdx.x);
        pg8::EpiI8RowScaleBf16 E{ZB, NZ, (const float*)(ws + WS_SA), 1.f / W8_SCALE, 0, 0}; pg8::gemm_phase<pg8::EpiI8RowScaleBf16, pg8::StaticOrder, true, true, false, true>(lds, g, S, E, TID); } PHASE_END
    PHASE_BEGIN ph_poolconv(a, lane, wave); PHASE_END
    PHASE_BEGIN {
        if (gridDim.x == 256) {
            { const int gq = blockIdx.x >> 6, pm = blockIdx.x & 63;
              pg8::Gemm g{(const bf16*)(ws + WS_PO) + gq * 256, (const bf16*)(ws + WS_WPOOL) + gq * 65536, M, 256, 256, 1024, 256}; pg8::ListOrder S{pm, 1};
              pg8::EpiScaleBf16 E{ws + WS_YC8 + gq * 256, DM, a.in[12] + gq * 256, Y8_SCALE}; pg8::gemm_phase<pg8::EpiScaleBf16, pg8::ListOrder, false, true>(lds, g, S, E, TID); }
            { const int hb = blockIdx.x >> 5, pm0 = (blockIdx.x & 31) * 2;
              int kg = 128; asm volatile("" : "+s"(kg));
              pg8::Gemm g{(const bf16*)(ws + WS_XC) + hb * 128, (const bf16*)(ws + WS_WAX) + hb * 32768, M, 256, kg, 1024, 128}; pg8::ListOrder S{pm0, 2};
              pg8::EpiGate E{(const bf16*)(ws + WS_XC), (float*)(ws + WS_AF), (float*)(ws + WS_DF), a.in[16], a.in[18], (const float*)(ws + WS_LS8), hb * 128};
              pg8::gemm_phase<pg8::EpiGate, pg8::ListOrder, false, false>(lds, g, S, E, wave * 64 + lane_id()); }
        } } PHASE_END
    PHASE_BEGIN ph_scan_agg(a, tid); PHASE_END
    PHASE_BEGIN ph_scan_fin(a, tid); PHASE_END
    PHASE_BEGIN { pg8::Gemm g{(const bf16*)(ws + WS_YC8), (const bf16*)(ws + WS_WOUT), M, DM, DM / 2, DM / 2, DM / 2}; pg8::StaticOrder S; S.init(M, DM, gridDim.x, blockIdx.x);
        pg8::EpiRowScaleBf16 E{YB, DM, nullptr, 1.f / (W8O_SCALE * Y8_SCALE), 0, 0}; pg8::gemm_phase<pg8::EpiRowScaleBf16, pg8::StaticOrder, true, true, true>(lds, g, S, E, TID); } PHASE_END
    PHASE_BEGIN ph_ln<true>(YB, nullptr, HB, MOD, MOD, a.in[4], a.in[5], H2, ws + WS_X1, (float*)(ws + WS_X1 + 64 * MiB), ws + WS_H6, (float*)(ws + WS_HS), lane, wave); PHASE_END
    PHASE_BEGIN { pg8::Gemm g{(const bf16*)(ws + WS_X1), (const bf16*)(ws + WS_WQ0), M, DM, DM / 2, DM / 2, DM / 2}; pg8::StaticOrder S; S.init(M, DM, gridDim.x, blockIdx.x);
        pg8::EpiI8RowScaleBf16 E{QP, DM, (const float*)(ws + WS_X1 + 64 * MiB), 1.f / W8_SCALE, 0, 0}; pg8::gemm_phase<pg8::EpiI8RowScaleBf16, pg8::StaticOrder, true, true, false, true>(lds, g, S, E, TID); } PHASE_END
    PHASE_BEGIN ph_topk(a, 0, lds, tid, lane, wave); PHASE_END
    PHASE_BEGIN ph_peer_u(a, 0, (volatile LAS unsigned*)(lds + LDS_CTL), lds, lane, wave); PHASE_END
    PHASE_BEGIN ph_peer_coef(a, 0, lds, lane, wave); PHASE_END
    PHASE_BEGIN ph_peer_v(a, 0, (volatile LAS unsigned*)(lds + LDS_CTL), lds, lane, wave); PHASE_END
    PHASE_BEGIN ph_peer_ln<false>(a, MOD, MOD + 2 * 12288, a.in[4] + DM, a.in[5] + DM, lane, wave); PHASE_END
    PHASE_BEGIN { pg8::Gemm g{(const bf16*)(ws + WS_HB8), (const bf16*)(ws + WS_WQKV), M, NQKV, DM / 2, DM / 2, DM / 2}; pg8::StaticOrder S; S.init(M, NQKV, gridDim.x, blockIdx.x);
        pg8::EpiRowScaleBf16 E{ZB, DM, (const float*)(ws + WS_SA), 1.f / W8_SCALE, DM, (size_t)M * DM}; pg8::gemm_phase<pg8::EpiRowScaleBf16, pg8::StaticOrder, true, true, true>(lds, g, S, E, TID);
        ph_forget(a, lds, lane, wave); } PHASE_END
    PHASE_BEGIN ph_cumsum(a, lane, wave); PHASE_END
    PHASE_BEGIN ph_attention(a, (char*)lds_raw, TID); PHASE_END
    PHASE_BEGIN { pg8::Gemm g{(const bf16*)(ws + WS_YC8), (const bf16*)(ws + WS_WO), M, DM, DM / 2, DM / 2, DM / 2}; pg8::StaticOrder S; S.init(M, DM, gridDim.x, blockIdx.x);
        pg8::EpiRowScaleBf16 E{YB, DM, nullptr, 1.f / (W8O_SCALE * attn::O8_SCALE), 0, 0}; pg8::gemm_phase<pg8::EpiRowScaleBf16, pg8::StaticOrder, true, true, true>(lds, g, S, E, TID); } PHASE_END
    PHASE_BEGIN ph_ln<true>(YB, nullptr, HB, MOD + 2 * 12288, MOD + 2 * 12288, a.in[4] + 2 * DM, a.in[5] + 2 * DM, H2, ws + WS_X1, (float*)(ws + WS_X1 + 64 * MiB), ws + WS_H6, (float*)(ws + WS_HS), lane, wave); PHASE_END
    PHASE_BEGIN { pg8::Gemm g{(const bf16*)(ws + WS_X1), (const bf16*)(ws + WS_WQ1), M, DM, DM / 2, DM / 2, DM / 2}; pg8::StaticOrder S; S.init(M, DM, gridDim.x, blockIdx.x);
        pg8::EpiI8RowScaleBf16 E{QP, DM, (const float*)(ws + WS_X1 + 64 * MiB), 1.f / W8_SCALE, 0, 0}; pg8::gemm_phase<pg8::EpiI8RowScaleBf16, pg8::StaticOrder, true, true, false, true>(lds, g, S, E, TID); } PHASE_END
    PHASE_BEGIN ph_topk(a, 1, lds, tid, lane, wave); PHASE_END
    PHASE_BEGIN ph_peer_u(a, 1, (volatile LAS unsigned*)(lds + LDS_CTL), lds, lane, wave); PHASE_END
    PHASE_BEGIN ph_peer_coef(a, 1, lds, lane, wave); PHASE_END
    PHASE_BEGIN ph_peer_v(a, 1, (volatile LAS unsigned*)(lds + LDS_CTL), lds, lane, wave); PHASE_END
    PHASE_BEGIN ph_peer_ln<true>(a, MOD + 2 * 12288, MOD, a.in[4] + 3 * DM, a.in[5] + 3 * DM, lane, wave); PHASE_END
#undef PHASE_BEGIN
#undef TID
#undef PHASE_END
}
constexpr int N_PHASES = 26;

extern "C" void kernel_launch(void* const* d_in, const int* in_sizes, int n_in, void* d_out, int out_size, void* d_ws, size_t ws_size, hipStream_t stream) {
    static int grid = 0;
    if (grid == 0) {
        int dev = 0, cus = 0, per_cu = 0;
        if (n_in != 24 || out_size != M * DM || ws_size < WS_END) { fprintf(stderr, "kernel_launch: unexpected shapes (n_in %d, out %d, ws %zu)\n", n_in, out_size, ws_size); grid = -1; return; }
        (void)hipGetDevice(&dev);
        (void)hipDeviceGetAttribute(&cus, hipDeviceAttributeMultiprocessorCount, dev);
        (void)hipFuncSetAttribute((const void*)mk_fwd, hipFuncAttributeMaxDynamicSharedMemorySize, LDS_BYTES);
        (void)hipOccupancyMaxActiveBlocksPerMultiprocessor(&per_cu, (const void*)mk_fwd, NTHREADS, LDS_BYTES);
        if (per_cu < 1) { fprintf(stderr, "kernel_launch: occupancy query reports %d blocks per CU\n", per_cu); grid = -1; return; }
        grid = cus;
        if (grid != 256) fprintf(stderr, "kernel_launch: %d CUs; phase 4 is written for 256 workgroups\n", grid);
    }
    if (grid < 0) return;
#ifdef MK_SPLIT
    if (hipMemsetAsync(d_ws, 0, 65536, stream) != hipSuccess) { fprintf(stderr, "kernel_launch: hipMemsetAsync failed\n"); return; }
#endif
    Args a{};
    for (int i = 0; i < 24; ++i) a.in[i] = (const float*)d_in[i];
    a.out = (float*)d_out; a.ws = (unsigned char*)d_ws;
#ifndef MK_SPLIT
    a.ph_lo = 0; a.ph_hi = N_PHASES;
    void* args[] = {&a};
    hipError_t e = hipLaunchCooperativeKernel((const void*)mk_fwd, dim3(grid), dim3(NTHREADS), args, LDS_BYTES, stream);
    if (e != hipSuccess) fprintf(stderr, "cooperative launch failed: %s (grid %d)\n", hipGetErrorString(e), grid);
#else
    for (int p = 0; p < N_PHASES; ++p) { a.ph_lo = p; a.ph_hi = p + 1; void* args[] = {&a};
        hipError_t e = hipLaunchCooperativeKernel((const void*)mk_fwd, dim3(grid), dim3(NTHREADS), args, LDS_BYTES, stream);
        if (e != hipSuccess) { fprintf(stderr, "launch %d failed: %s\n", p, hipGetErrorString(e)); break; } }
#endif
}
```

```cpp
#include <hip/hip_runtime.h>
#include <hip/hip_bf16.h>
#include <hip/hip_cooperative_groups.h>
#include <cstdio>
#include <cstdint>
#include <cmath>
namespace cg = cooperative_groups;
namespace pg8 {
#define PG8_LAS __attribute__((address_space(3)))
typedef unsigned short bf16_t;
typedef short bf16x8 __attribute__((ext_vector_type(8)));
typedef float f32x4 __attribute__((ext_vector_type(4)));
typedef unsigned u32x4 __attribute__((ext_vector_type(4)));
constexpr int BM = 256, BK = 64, HALF = 128, HTB = HALF * BK * 2  , STAGE_BYTES = 8 * HTB, NXCD = 8, WGM = 8;

__host__ __device__ __forceinline__ int lds_byte(int r, int c) { const int st = (r >> 4) * 2 + (c >> 5), rr = r & 15, cc = c & 31, ob = rr * 64 + cc * 2; return st * 1024 + (ob ^ (((ob >> 9) & 1) << 5)); }
__host__ __device__ __forceinline__ void stage_rc(int b, int& R, int& C) { const int st = b / 1024, sb = b % 1024, swz = sb ^ (((sb >> 9) & 1) << 5); R = (st >> 1) * 16 + swz / 64; C = (st & 1) * 32 + (swz % 64) / 2; }
__host__ __device__ __forceinline__ int perm32(int rho) { const int n = rho >> 4, i = rho & 15; return 8 * (i >> 2) + 4 * n + (i & 3); }

struct Unit { int pm, pn; };
struct Gemm { const bf16_t* A; const bf16_t* Bt; int M, N, K, lda, ldb; };

struct StaticOrder {
    int nM, nN, nwg, G, c;
    __host__ __device__ void init(int M, int N, int G_, int c_) { nM = M / BM; nN = N / BM; nwg = nM * nN; G = G_; c = c_; }
    __host__ __device__ bool next(int i, Unit& u) const {
        const long L = (long)i * G + c; if (L >= nwg) return false;
        int wgid = (int)L; { const int q = nwg / NXCD, r = nwg % NXCD, xcd = wgid % NXCD, off = wgid / NXCD; wgid = (xcd < r ? xcd * (q + 1) : r * (q + 1) + (xcd - r) * q) + off; }
        const int nig = WGM * nN, gid = wgid / nig, fm = gid * WGM, gsz = (nM - fm) < WGM ? (nM - fm) : WGM;
        u.pm = fm + ((wgid % nig) % gsz); u.pn = (wgid % nig) / gsz; return true;
    }
    __device__ __forceinline__ void a_ready(const Unit&) const {}
    __device__ __forceinline__ void done(const Unit&) const {}
};

__device__ __forceinline__ unsigned cvt_pk_bf16(float lo, float hi) { typedef float f2_ __attribute__((ext_vector_type(2))); typedef __bf16 b2_ __attribute__((ext_vector_type(2))); const f2_ f = {lo, hi}; return __builtin_bit_cast(unsigned, __builtin_convertvector(f, b2_)); }
typedef float f32x2 __attribute__((ext_vector_type(2)));
__device__ __forceinline__ f32x2 gelu_pk(f32x2 v) {
    const f32x2 av = __builtin_elementwise_abs(v), d = av * 0.2316418882f + 1.0f;
    f32x2 t; t.x = __builtin_amdgcn_rcpf(d.x); t.y = __builtin_amdgcn_rcpf(d.y);
    f32x2 q = t * 0.5307027145f + (-0.7265760135f); q = q * t + 0.7107068705f; q = q * t + (-0.142248368f); q = q * t + 0.127414796f; q = q * t;
    const f32x2 s = (v * v) * (-0.72134752044f);
    f32x2 e; e.x = __builtin_amdgcn_exp2f(s.x); e.y = __builtin_amdgcn_exp2f(s.y);
    const f32x2 m = v * (q * e), r = v - m;
    f32x2 o; o.x = v.x < 0.f ? m.x : r.x; o.y = v.y < 0.f ? m.y : r.y; return o;
}

template <int ACT  > struct EpiBf16 {
    static constexpr bool PERM = true, AFTER_DRAIN = false; static_assert(ACT == 0 || ACT == 1, "EpiBf16: ACT is 0 (none) or 1 (gelu_pk)");
    bf16_t* O; int ldc; const float* bias; int split_cols; size_t split_stride; float scale0;
    __device__ __forceinline__ void operator()(const f32x4 (&acc)[2][2][4][2], const Unit& u, int wr, int wc, int fr, int fq) const {
        const int row0 = u.pm * BM + wr * 64 + fr; int colt = u.pn * BM; bf16_t* base = O;
        float sc = 1.f; if (split_cols) { const int t = colt / split_cols; base += (size_t)t * split_stride; colt -= t * split_cols; if (t == 0) sc = scale0; }
        const int col0 = colt + wc * 32 + 8 * fq, bcol0 = u.pn * BM + wc * 32 + 8 * fq;
        f32x4 bv[2][2];
#pragma unroll
        for (int bj = 0; bj < 2; ++bj)
#pragma unroll
            for (int n = 0; n < 2; ++n) bv[bj][n] = bias ? *(const f32x4*)(bias + bcol0 + bj * HALF + 4 * n) : (f32x4){0.f, 0.f, 0.f, 0.f};
#pragma unroll
        for (int ai = 0; ai < 2; ++ai)
#pragma unroll
            for (int m = 0; m < 4; ++m) { bf16_t* rowp = base + (size_t)(row0 + ai * HALF + m * 16) * ldc + col0;
#pragma unroll
                for (int bj = 0; bj < 2; ++bj) { f32x4 v0 = acc[ai][bj][m][0] + bv[bj][0], v1 = acc[ai][bj][m][1] + bv[bj][1];
                    if (ACT == 1) { f32x2 a = gelu_pk((f32x2){v0[0], v0[1]}), b = gelu_pk((f32x2){v0[2], v0[3]}), c = gelu_pk((f32x2){v1[0], v1[1]}), d = gelu_pk((f32x2){v1[2], v1[3]});
                        v0 = (f32x4){a.x, a.y, b.x, b.y}; v1 = (f32x4){c.x, c.y, d.x, d.y}; }
                    v0 = v0 * sc; v1 = v1 * sc; u32x4 w; w.x = cvt_pk_bf16(v0[0], v0[1]); w.y = cvt_pk_bf16(v0[2], v0[3]); w.z = cvt_pk_bf16(v1[0], v1[1]); w.w = cvt_pk_bf16(v1[2], v1[3]);
                    *(u32x4*)(rowp + bj * HALF) = w; } }
    }
};

template <class Epi, class Sched, bool ALIGN_EPI = false, bool SP2 = false, bool FP8 = false, bool I8 = false>
__device__ __forceinline__ void gemm_phase(PG8_LAS unsigned char* lds, const Gemm g, const Sched& S, const Epi& E, const int tid) {
    const int wid = __builtin_amdgcn_readfirstlane(tid >> 6), lane = tid & 63, wr = wid >> 2, wc = wid & 3, fr = lane & 15, fq = lane >> 4;
    const int K = g.K, nt = K / BK;
    unsigned voffA[2], voffB[2];
#pragma unroll
    for (int i = 0; i < 2; ++i) { int R, C; stage_rc(tid * 16 + i * 8192, R, C); const int Rb = Epi::PERM ? ((R & ~31) + perm32(R & 31)) : R;
        voffA[i] = (unsigned)(R * g.lda + C) * 2u; voffB[i] = (unsigned)(Rb * g.ldb + C) * 2u; }
    const __amdgpu_buffer_rsrc_t rA = __builtin_amdgcn_make_buffer_rsrc((void*)g.A, 0, (int)((size_t)g.M * g.lda * 2), 0x00020000), rB = __builtin_amdgcn_make_buffer_rsrc((void*)g.Bt, 0, (int)((size_t)g.N * g.ldb * 2), 0x00020000);
    const size_t kstep = (size_t)(BK * 2);
    const size_t hstepA = (size_t)HALF * g.lda * 2, hstepB = (size_t)HALF * g.ldb * 2;
    const size_t tstepA = 2 * hstepA, tstepB = 2 * hstepB;
    const unsigned ldsw = (unsigned)wid * 1024u;
    const int aoffk[2] = {FP8 ? lds_byte(wr * 64 + fr, fq * 16) : lds_byte(wr * 64 + fr, fq * 8), FP8 ? lds_byte(wr * 64 + fr, fq * 16 + 8) : lds_byte(wr * 64 + fr, fq * 8) + 1024};
    const int boffk[2] = {FP8 ? lds_byte(wc * 32 + fr, fq * 16) : lds_byte(wc * 32 + fr, fq * 8), FP8 ? lds_byte(wc * 32 + fr, fq * 16 + 8) : lds_byte(wc * 32 + fr, fq * 8) + 1024};
#define PG8_SA(b, h) (((b) * 2 + (h)) * HTB)
#define PG8_SB(b, h) ((4 + (b) * 2 + (h)) * HTB)
#define PG8_STAGE(bufoff, gbase, voff, rs, gorig) do { _Pragma("unroll") for (int _i = 0; _i < 2; ++_i) \
        __builtin_amdgcn_raw_ptr_buffer_load_lds(rs, (PG8_LAS void*)(lds + (bufoff) + ldsw + _i * 8192), 16, (voff)[_i], (unsigned)((const char*)(gbase) - (const char*)(gorig)), 0, 0); } while (0)
#define PG8_LDA(dst, b, h) do { if constexpr (FP8) { _Pragma("unroll") for (int m = 0; m < 4; ++m) dst##8[m] = __builtin_shufflevector(*(const PG8_LAS bf16x8*)(lds + PG8_SA(b, h) + aoffk[0] + m * 2048), *(const PG8_LAS bf16x8*)(lds + PG8_SA(b, h) + aoffk[1] + m * 2048), 0, 1, 2, 3, 4, 5, 6, 7, 8, 9, 10, 11, 12, 13, 14, 15); } \
        else { _Pragma("unroll") for (int m = 0; m < 4; ++m) _Pragma("unroll") for (int k = 0; k < 2; ++k) dst[m][k] = *(const PG8_LAS bf16x8*)(lds + PG8_SA(b, h) + aoffk[k] + m * 2048); } } while (0)
#define PG8_LDB(dst, b, h) do { if constexpr (FP8) { _Pragma("unroll") for (int n = 0; n < 2; ++n) dst##8[n] = __builtin_shufflevector(*(const PG8_LAS bf16x8*)(lds + PG8_SB(b, h) + boffk[0] + n * 2048), *(const PG8_LAS bf16x8*)(lds + PG8_SB(b, h) + boffk[1] + n * 2048), 0, 1, 2, 3, 4, 5, 6, 7, 8, 9, 10, 11, 12, 13, 14, 15); } \
        else { _Pragma("unroll") for (int n = 0; n < 2; ++n) _Pragma("unroll") for (int k = 0; k < 2; ++k) dst[n][k] = *(const PG8_LAS bf16x8*)(lds + PG8_SB(b, h) + boffk[k] + n * 2048); } } while (0)
#define PG8_MMA(ai, bj, At, Bt) do { __builtin_amdgcn_s_setprio(1); _Pragma("unroll") for (int m = 0; m < 4; ++m) _Pragma("unroll") for (int n = 0; n < 2; ++n) { \
        if constexpr (FP8) { typedef int i32x8 __attribute__((ext_vector_type(8))); \
            acc[ai][bj][m][n] = __builtin_amdgcn_mfma_scale_f32_16x16x128_f8f6f4(__builtin_bit_cast(i32x8, Bt##8[n]), __builtin_bit_cast(i32x8, At##8[m]), acc[ai][bj][m][n], 0, 0, 0, 127, 0, 127); } \
        else if constexpr (I8) { typedef int i32x4_ __attribute__((ext_vector_type(4))); _Pragma("unroll") for (int k = 0; k < 2; ++k) \
            acc[ai][bj][m][n] = __builtin_bit_cast(f32x4, __builtin_amdgcn_mfma_i32_16x16x64_i8(__builtin_bit_cast(i32x4_, Bt[n][k]), __builtin_bit_cast(i32x4_, At[m][k]), __builtin_bit_cast(i32x4_, acc[ai][bj][m][n]), 0, 0, 0)); } \
        else { _Pragma("unroll") for (int k = 0; k < 2; ++k) acc[ai][bj][m][n] = __builtin_amdgcn_mfma_f32_16x16x32_bf16(Bt[n][k], At[m][k], acc[ai][bj][m][n], 0, 0, 0); } } \
        __builtin_amdgcn_s_setprio(0); } while (0)
#define PG8_WAIT_V(n) asm volatile("s_waitcnt vmcnt(" #n ")" ::: "memory")
#define PG8_WAIT_L(n) asm volatile("s_waitcnt lgkmcnt(" #n ")" ::: "memory")
#define PG8_BAR __builtin_amdgcn_s_barrier()
#define PG8_SCHED __builtin_amdgcn_sched_barrier(0)
    Unit cur, nxt; int ui = 0;
    if (!S.next(0, cur)) return;
    f32x4 acc[2][2][4][2];
#pragma unroll
    for (int a = 0; a < 2; ++a)
#pragma unroll
        for (int b = 0; b < 2; ++b)
#pragma unroll
            for (int m = 0; m < 4; ++m)
#pragma unroll
                for (int n = 0; n < 2; ++n) acc[a][b][m][n] = (f32x4){0.f, 0.f, 0.f, 0.f};
    bf16x8 At[4][2], B0[2][2], B1[2][2]; typedef short bf16x16 __attribute__((ext_vector_type(16))); bf16x16 At8[4], B08[2], B18[2];
    const char* cA = (const char*)g.A + (size_t)cur.pm * tstepA; const char* cB = (const char*)g.Bt + (size_t)cur.pn * tstepB;
    S.a_ready(cur);
    if constexpr (SP2) {
        PG8_STAGE(PG8_SB(0, 0), cB, voffB, rB, g.Bt); PG8_STAGE(PG8_SB(0, 1), cB + hstepB, voffB, rB, g.Bt); PG8_STAGE(PG8_SA(0, 0), cA, voffA, rA, g.A); PG8_STAGE(PG8_SA(0, 1), cA + hstepA, voffA, rA, g.A);
        if (wr == 1) PG8_BAR;
        PG8_WAIT_V(2); PG8_BAR;
        PG8_STAGE(PG8_SB(1, 0), cB + kstep, voffB, rB, g.Bt); PG8_STAGE(PG8_SA(1, 0), cA + kstep, voffA, rA, g.A); PG8_STAGE(PG8_SB(1, 1), cB + hstepB + kstep, voffB, rB, g.Bt);
        PG8_WAIT_V(6); PG8_BAR;
    } else {
        PG8_STAGE(PG8_SB(0, 0), cB, voffB, rB, g.Bt); PG8_STAGE(PG8_SA(0, 0), cA, voffA, rA, g.A); PG8_STAGE(PG8_SB(0, 1), cB + hstepB, voffB, rB, g.Bt); PG8_STAGE(PG8_SA(0, 1), cA + hstepA, voffA, rA, g.A);
        if (wr == 1) PG8_BAR;
        PG8_WAIT_V(4); PG8_BAR;
        PG8_STAGE(PG8_SB(1, 0), cB + kstep, voffB, rB, g.Bt); PG8_STAGE(PG8_SA(1, 0), cA + kstep, voffA, rA, g.A); PG8_STAGE(PG8_SB(1, 1), cB + hstepB + kstep, voffB, rB, g.Bt);
        PG8_WAIT_V(6); PG8_BAR;
    }
    for (;;) {
        const bool has_next = S.next(ui + 1, nxt);
        const char* nA = has_next ? (const char*)g.A + (size_t)nxt.pm * tstepA : cA; const char* nB = has_next ? (const char*)g.Bt + (size_t)nxt.pn * tstepB : cB;
        for (int t = 0; t < nt; t += 2) {
            const bool last = (t == nt - 2);
            const char* a1 = cA + (size_t)(t + 1) * kstep;
            const char* a2 = last ? nA : cA + (size_t)(t + 2) * kstep; const char* b2 = last ? nB : cB + (size_t)(t + 2) * kstep;
            const char* a3 = a2 + kstep; const char* b3 = b2 + kstep;
            if (last && has_next) S.a_ready(nxt);
            if constexpr (SP2) {
            PG8_LDB(B0, 0, 0); PG8_LDB(B1, 0, 1); PG8_SCHED; PG8_LDA(At, 0, 0); PG8_STAGE(PG8_SA(1, 1), a1 + hstepA, voffA, rA, g.A);
            PG8_WAIT_V(8); PG8_WAIT_L(0); PG8_BAR; PG8_MMA(0, 0, At, B0); PG8_MMA(0, 1, At, B1); PG8_BAR; PG8_SCHED;
            PG8_LDA(At, 0, 1); PG8_STAGE(PG8_SB(0, 0), b2, voffB, rB, g.Bt); PG8_STAGE(PG8_SB(0, 1), b2 + hstepB, voffB, rB, g.Bt); PG8_STAGE(PG8_SA(0, 0), a2, voffA, rA, g.A);
            PG8_WAIT_V(8); PG8_WAIT_L(0); PG8_BAR; PG8_MMA(1, 0, At, B0); PG8_MMA(1, 1, At, B1); PG8_BAR; PG8_SCHED;
            PG8_LDB(B0, 1, 0); PG8_LDB(B1, 1, 1); PG8_SCHED; PG8_LDA(At, 1, 0); PG8_STAGE(PG8_SA(0, 1), a2 + hstepA, voffA, rA, g.A);
            PG8_WAIT_V(8); PG8_WAIT_L(0); PG8_BAR; PG8_MMA(0, 0, At, B0); PG8_MMA(0, 1, At, B1); PG8_BAR; PG8_SCHED;
            PG8_LDA(At, 1, 1); PG8_STAGE(PG8_SB(1, 0), b3, voffB, rB, g.Bt); PG8_STAGE(PG8_SB(1, 1), b3 + hstepB, voffB, rB, g.Bt); PG8_STAGE(PG8_SA(1, 0), a3, voffA, rA, g.A);
            PG8_WAIT_V(8); PG8_WAIT_L(0); PG8_BAR; PG8_MMA(1, 0, At, B0); PG8_MMA(1, 1, At, B1); PG8_BAR; PG8_SCHED;
            } else {
            PG8_LDB(B0, 0, 0); PG8_SCHED; PG8_LDA(At, 0, 0); PG8_STAGE(PG8_SA(1, 1), a1 + hstepA, voffA, rA, g.A);
            PG8_WAIT_L(8); PG8_BAR; PG8_WAIT_L(0); PG8_MMA(0, 0, At, B0); PG8_BAR; PG8_SCHED;
            PG8_LDB(B1, 0, 1); PG8_STAGE(PG8_SB(0, 0), b2, voffB, rB, g.Bt);
            PG8_BAR; PG8_WAIT_L(0); PG8_MMA(0, 1, At, B1); PG8_BAR;
            PG8_LDA(At, 0, 1); PG8_STAGE(PG8_SA(0, 0), a2, voffA, rA, g.A);
            PG8_BAR; PG8_WAIT_L(0); PG8_MMA(1, 0, At, B0); PG8_BAR; PG8_SCHED;
            PG8_STAGE(PG8_SB(0, 1), b2 + hstepB, voffB, rB, g.Bt);
            PG8_WAIT_V(6); PG8_BAR; PG8_MMA(1, 1, At, B1); PG8_BAR;
            PG8_LDB(B0, 1, 0); PG8_SCHED; PG8_LDA(At, 1, 0); PG8_STAGE(PG8_SA(0, 1), a2 + hstepA, voffA, rA, g.A);
            PG8_WAIT_L(8); PG8_BAR; PG8_WAIT_L(0); PG8_MMA(0, 0, At, B0); PG8_BAR; PG8_SCHED;
            PG8_LDB(B1, 1, 1); PG8_STAGE(PG8_SB(1, 0), b3, voffB, rB, g.Bt);
            PG8_BAR; PG8_WAIT_L(0); PG8_MMA(0, 1, At, B1); PG8_BAR;
            PG8_LDA(At, 1, 1); PG8_STAGE(PG8_SA(1, 0), a3, voffA, rA, g.A);
            PG8_BAR; PG8_WAIT_L(0); PG8_MMA(1, 0, At, B0); PG8_BAR; PG8_SCHED;
            PG8_STAGE(PG8_SB(1, 1), b3 + hstepB, voffB, rB, g.Bt);
            PG8_WAIT_V(6); PG8_BAR; PG8_MMA(1, 1, At, B1); PG8_BAR;
            }
        }
        if constexpr (ALIGN_EPI) { if (wr == 0) PG8_BAR; }
        if constexpr (!Epi::AFTER_DRAIN) { E(acc, cur, wr, wc, fr, fq); S.done(cur); }
        if (!has_next) break;
#pragma unroll
        for (int a = 0; a < 2; ++a)
#pragma unroll
            for (int b = 0; b < 2; ++b)
#pragma unroll
                for (int m = 0; m < 4; ++m)
#pragma unroll
                    for (int n = 0; n < 2; ++n) acc[a][b][m][n] = (f32x4){0.f, 0.f, 0.f, 0.f};
        cur = nxt; cA = nA; cB = nB; ++ui;
        if constexpr (ALIGN_EPI) { if (wr == 1) PG8_BAR; }
    }
    PG8_WAIT_V(0);
    if constexpr (!ALIGN_EPI) { if (wr == 0) PG8_BAR; }
    PG8_BAR;
    if constexpr (Epi::AFTER_DRAIN) { E.fused(acc, cur, wr, wc, fr, fq, lds, wid, lane); S.done(cur); }
#undef PG8_SA
#undef PG8_SB
#undef PG8_STAGE
#undef PG8_LDA
#undef PG8_LDB
#undef PG8_MMA
#undef PG8_WAIT_V
#undef PG8_WAIT_L
#undef PG8_BAR
#undef PG8_SCHED
}
}

namespace attn {
constexpr float SCALE = 0.08838834764831845f;
constexpr int D = 128, PITCH = 2048;
constexpr float THR = 8.f; constexpr bool WSKIP = true; constexpr bool O_FP8 = true; constexpr float O8_SCALE = 16.f;
constexpr int NW = 8, QBLK = 32, KVBLK = 64, QB = NW * QBLK;
constexpr int SHM_V = KVBLK * D * 2, SHM_K = KVBLK * D * 2;
constexpr int LDS_BIAS = 2 * SHM_V + 2 * SHM_K + NW * 64 * 4;
constexpr int LDS_BYTES = LDS_BIAS + 2 * 256;
using bf16 = __hip_bfloat16;
typedef short bf16x8 __attribute__((ext_vector_type(8)));
typedef short s16x4 __attribute__((ext_vector_type(4)));
typedef float f32x16 __attribute__((ext_vector_type(16)));
typedef float f32x4 __attribute__((ext_vector_type(4)));
typedef unsigned u32x4 __attribute__((ext_vector_type(4)));
template <class A, class Bt> struct same_t { static constexpr bool v = false; };
template <class A> struct same_t<A, A> { static constexpr bool v = true; };

#define KSWZ(row, colB) ((row) * 256 + ((colB) ^ (((row) & 7) << 4)))
#define SBAR() __builtin_amdgcn_sched_barrier(0)
__device__ __forceinline__ int v_st(int k, int c) { const int kk = (k & ~0xC) | ((k & 4) << 1) | ((k & 8) >> 1); return ((kk >> 3) * 4 + (c >> 5)) * 512 + ((kk & 7) * 32 + (c & 31)) * 2; }
__device__ __forceinline__ int v_rd_base(int lane) { return ((lane & 3) << 3) | (((lane >> 2) & 3) << 6) | (((lane >> 4) & 1) << 5) | (((lane >> 5) & 1) << 8); }
constexpr int v_rd_off(int d0, int ks, int half) { return d0 * 512 + ks * 4096 + half * 2048; }
__device__ __forceinline__ int crow(int r, int hi) { return (r & 3) + 8 * (r >> 2) + 4 * hi; }
__device__ __forceinline__ unsigned cvtpk(float lo, float hi) {
    typedef float f2_ __attribute__((ext_vector_type(2))); typedef __bf16 b2_ __attribute__((ext_vector_type(2))); const f2_ f = {lo, hi}; return __builtin_bit_cast(unsigned, __builtin_convertvector(f, b2_));
}
__device__ __forceinline__ bf16x8 pack8(f32x4 a, f32x4 b) {
    u32x4 w = {cvtpk(a[0], a[1]), cvtpk(a[2], a[3]), cvtpk(b[0], b[1]), cvtpk(b[2], b[3])};
    return *reinterpret_cast<bf16x8*>(&w);
}
template <class T> __device__ __forceinline__ bf16x8 load8(const T* p) {
    if constexpr (same_t<T, float>::v) { return pack8(*(const f32x4*)p, *(const f32x4*)(p + 4)); }
    else { return *reinterpret_cast<const bf16x8*>(p); }
}
__device__ __forceinline__ void mask_tile(f32x16& p0, f32x16& p1, int dq, unsigned W) {
    const float NEG = -__builtin_inff();
#pragma unroll
    for (int r = 0; r < 16; ++r) {
        const int c = (r & 3) + 8 * (r >> 2);
        if ((unsigned)(dq - c) >= W) p0[r] = NEG;
        if ((unsigned)(dq - c - 32) >= W) p1[r] = NEG;
    }
}
constexpr float DEAD_T = 20.f;
__device__ __forceinline__ void partialSM(f32x16& p0, f32x16& p1, float& m_reg, float& mn, float& alpha, bool& dead) {
    float pmax = p0[0]; for (int r = 1; r < 16; ++r) pmax = fmaxf(pmax, p0[r]); for (int r = 0; r < 16; ++r) pmax = fmaxf(pmax, p1[r]);
    { auto rr = __builtin_amdgcn_permlane32_swap(__float_as_uint(pmax), __float_as_uint(pmax), false, false);
      pmax = fmaxf(__uint_as_float(rr[0]), __uint_as_float(rr[1])); }
    constexpr float C2 = 1.4426950408889634f * SCALE;
    dead = __all((pmax - m_reg) * SCALE < -DEAD_T);
    if (dead) { mn = m_reg; alpha = 1.f; return; }
    if (__builtin_expect(__all((pmax - m_reg) * SCALE <= THR), 1)) { mn = m_reg; alpha = 1.f; }
    else { mn = fmaxf(m_reg, pmax); alpha = __builtin_amdgcn_exp2f((m_reg - mn) * C2); m_reg = mn; }
    const float mnL = -mn * C2;
    for (int r = 0; r < 16; ++r) p0[r] = fmaf(p0[r], C2, mnL); for (int r = 0; r < 16; ++r) p1[r] = fmaf(p1[r], C2, mnL);
    for (int r = 0; r < 16; ++r) p0[r] = __builtin_amdgcn_exp2f(p0[r]);
}
__device__ __forceinline__ void finishSM(f32x16& p0, f32x16& p1, float alpha, float& l_reg, bf16x8& pa0, bf16x8& pa1, bf16x8& pa2, bf16x8& pa3) {
    for (int r = 0; r < 16; ++r) p1[r] = __builtin_amdgcn_exp2f(p1[r]);
    float ps = 0; for (int r = 0; r < 16; ++r) ps += p0[r]; for (int r = 0; r < 16; ++r) ps += p1[r];
    { auto rr = __builtin_amdgcn_permlane32_swap(__float_as_uint(ps), __float_as_uint(ps), false, false);
      ps = __uint_as_float(rr[0]) + __uint_as_float(rr[1]); }
    l_reg = l_reg * alpha + ps;
#define PK4(P, B_, OUT) do { unsigned a0 = cvtpk(P[B_+0], P[B_+1]), a1 = cvtpk(P[B_+2], P[B_+3]);                          \
        unsigned b0 = cvtpk(P[B_+4], P[B_+5]), b1 = cvtpk(P[B_+6], P[B_+7]);                                             \
        auto r0 = __builtin_amdgcn_permlane32_swap(a0, b0, false, false); auto r1 = __builtin_amdgcn_permlane32_swap(a1, b1, false, false); \
        u32x4 w = {r0[0], r1[0], r0[1], r1[1]}; OUT = *reinterpret_cast<bf16x8*>(&w); } while (0)
    PK4(p0, 0, pa0); PK4(p0, 8, pa1); PK4(p1, 0, pa2); PK4(p1, 8, pa3);
#undef PK4
}
template <int KB, bool SK>
__device__ __forceinline__ void qkt(f32x16& p0, f32x16& p1, const char* K_lds, int r32, int hi, const bf16x8* qr, bool act) {
    const float* bl = (const float*)(K_lds - 2 * SHM_V + LDS_BIAS + KB * 256) + 4 * hi;
    if (SK && !act) { const float NEG = -__builtin_inff();
#pragma unroll
        for (int r = 0; r < 16; ++r) { p0[r] = NEG; p1[r] = NEG; } return; }
#pragma unroll
    for (int g_ = 0; g_ < 4; ++g_) { const f32x4 b0_ = *(const f32x4*)(bl + 8 * g_), b1_ = *(const f32x4*)(bl + 32 + 8 * g_);
#pragma unroll
        for (int e_ = 0; e_ < 4; ++e_) { p0[4 * g_ + e_] = b0_[e_]; p1[4 * g_ + e_] = b1_[e_]; } }
    const char* kb[4];
#pragma unroll
    for (int dd = 0; dd < 4; ++dd) kb[dd] = K_lds + KB * SHM_K + KSWZ(r32, (dd * 16 + hi * 8) * 2);
#pragma unroll
    for (int d0 = 0; d0 < 8; ++d0) { const char* a = kb[d0 & 3] + (d0 >> 2) * 128;
        bf16x8 b0 = *reinterpret_cast<const bf16x8*>(a);
        bf16x8 b1 = *reinterpret_cast<const bf16x8*>(a + 32 * 256);
        p0 = __builtin_amdgcn_mfma_f32_32x32x16_bf16(b0, qr[d0], p0, 0, 0, 0);
        p1 = __builtin_amdgcn_mfma_f32_32x32x16_bf16(b1, qr[d0], p1, 0, 0, 0); }
}
template <int VB, bool SK>
__device__ __forceinline__ void pv_tile(f32x16* o, int vb0, bf16x8 pa0, bf16x8 pa1, bf16x8 pa2, bf16x8 pa3, bool act) {
    if (SK && !act) return;
#define TRRD(dst, off) asm volatile("ds_read_b64_tr_b16 %0, %1 offset:%2" : "=&v"(dst) : "v"(vb0), "i"(off) : "memory")
#define PV_D0(d0) do { s16x4 l0, l1, l2, l3, h0, h1, h2, h3; constexpr int b_ = VB * SHM_V + v_rd_off(d0, 0, 0);     \
        TRRD(l0, b_); TRRD(h0, b_ + 2048); TRRD(l1, b_ + 4096); TRRD(h1, b_ + 6144); TRRD(l2, b_ + 8192); TRRD(h2, b_ + 10240); TRRD(l3, b_ + 12288); TRRD(h3, b_ + 14336); \
        asm volatile("s_waitcnt lgkmcnt(0)" ::: "memory"); SBAR();                 \
        o[d0] = __builtin_amdgcn_mfma_f32_32x32x16_bf16(pa0, (bf16x8){l0[0], l0[1], l0[2], l0[3], h0[0], h0[1], h0[2], h0[3]}, o[d0], 0, 0, 0);   \
        o[d0] = __builtin_amdgcn_mfma_f32_32x32x16_bf16(pa1, (bf16x8){l1[0], l1[1], l1[2], l1[3], h1[0], h1[1], h1[2], h1[3]}, o[d0], 0, 0, 0);   \
        o[d0] = __builtin_amdgcn_mfma_f32_32x32x16_bf16(pa2, (bf16x8){l2[0], l2[1], l2[2], l2[3], h2[0], h2[1], h2[2], h2[3]}, o[d0], 0, 0, 0);   \
        o[d0] = __builtin_amdgcn_mfma_f32_32x32x16_bf16(pa3, (bf16x8){l3[0], l3[1], l3[2], l3[3], h3[0], h3[1], h3[2], h3[3]}, o[d0], 0, 0, 0); } while (0)
    PV_D0(0); PV_D0(1); PV_D0(2); PV_D0(3);
#undef PV_D0
#undef TRRD
}

template <class TIn, class TOut> struct BlockRef { const TIn* Q; const TIn* K; const TIn* V; TOut* O; const float* Fb; int P0; int jlo; unsigned char* O8; };
template <class TIn> struct Seam {
    bf16x8 qr[8];
    bf16x8 st_v0, st_v1, st_k0, st_k1; f32x4 sf0, sf1, sf2, sf3;
    f32x4 tq[16];
};
__device__ __forceinline__ int swa_jlo(int P0, int W) { const int lowk = P0 - W + 1; return lowk > 0 ? lowk / KVBLK : 0; }
#define ROW(p, k0, rr) ((const TIn*)((const char*)(p) + (unsigned)((((k0) + (rr)) * PITCH + sc) * (int)sizeof(TIn))))
#define VMW() asm volatile("s_waitcnt vmcnt(0)" ::: "memory")
#define VMWN(n) asm volatile("s_waitcnt vmcnt(%0)" :: "i"(n) : "memory")
#define SLOAD_H(Kp, Vp, Fp, bb, k0) do { S.st_v0 = load8<TIn>(ROW(Vp, k0, sr)); S.st_v1 = load8<TIn>(ROW(Vp, k0, 32 + sr));              \
                         S.st_k0 = load8<TIn>(ROW(Kp, k0, sr)); S.st_k1 = load8<TIn>(ROW(Kp, k0, 32 + sr));                          \
                         if (wid == 0) __builtin_amdgcn_global_load_lds((const unsigned*)((Fp) + (k0) + lane), (__attribute__((address_space(3))) unsigned*)(lds + LDS_BIAS + (bb) * 256), 4, 0, 0); } while (0)
#define SWRITE_HK(bf) do { int t_ = tid; asm volatile("" : "+v"(t_)); const int kws_ = KSWZ(t_ >> 4, (t_ & 15) * 16);     \
        *(bf16x8*)(K_lds + (bf) * SHM_K + kws_) = S.st_k0; *(bf16x8*)(K_lds + (bf) * SHM_K + kws_ + 32 * 256) = S.st_k1; } while (0)
#define SWRITE_HV(bf) do { int t_ = tid; asm volatile("" : "+v"(t_)); const int vst0_ = v_st(t_ >> 4, (t_ & 15) * 8), vst1_ = v_st(32 + (t_ >> 4), (t_ & 15) * 8); \
        *(bf16x8*)(V_lds + (bf) * SHM_V + vst0_) = S.st_v0; *(bf16x8*)(V_lds + (bf) * SHM_V + vst1_) = S.st_v1; } while (0)
#define SWRITE_H(bf) do { SWRITE_HV(bf); SWRITE_HK(bf); } while (0)
#define SLOAD_F(p, k0) do { S.sf0 = *(const f32x4*)ROW(p, k0, sr); S.sf1 = *(const f32x4*)(ROW(p, k0, sr) + 4);                \
                            S.sf2 = *(const f32x4*)ROW(p, k0, 32 + sr); S.sf3 = *(const f32x4*)(ROW(p, k0, 32 + sr) + 4); } while (0)
#define SWRITE_KF(bf) do { *(bf16x8*)(K_lds + (bf) * SHM_K + kws) = pack8(S.sf0, S.sf1); *(bf16x8*)(K_lds + (bf) * SHM_K + kws + 32 * 256) = pack8(S.sf2, S.sf3); } while (0)
#define SWRITE_VF(bf) do { *(bf16x8*)(V_lds + (bf) * SHM_V + vst0) = pack8(S.sf0, S.sf1); *(bf16x8*)(V_lds + (bf) * SHM_V + vst1) = pack8(S.sf2, S.sf3); } while (0)
template <class TIn, class TOut>
__device__ __forceinline__ void causal_swa_prime(const BlockRef<TIn, TOut>& cur, int W, char* lds, Seam<TIn>& S, const int tid) {
    constexpr bool F32 = same_t<TIn, float>::v;
    const int wid = __builtin_amdgcn_readfirstlane(tid >> 6), lane = tid & 63, r32 = lane & 31, hi = lane >> 5;
    const int sr = tid >> 4, sc = (tid & 15) * 8, kws = KSWZ(sr, sc * 2); char* K_lds = lds + 2 * SHM_V;
    const int kb0 = ((cur.P0 + QB - 1) / KVBLK) * KVBLK;
    for (int d0 = 0; d0 < 8; ++d0) S.qr[d0] = load8<TIn>(cur.Q + (size_t)(wid * QBLK + r32) * PITCH + d0 * 16 + hi * 8);
    if constexpr (F32) { SLOAD_F((const float*)cur.K, kb0); VMW(); SWRITE_KF(0); SBAR(); SLOAD_F((const float*)cur.V, kb0); }
    else { SLOAD_H(cur.K, cur.V, cur.Fb, 0, kb0); VMW(); SWRITE_HK(0); }
    __syncthreads();
}
template <class TIn, class TOut>
__device__ __forceinline__ void causal_swa_block(const BlockRef<TIn, TOut>& cur, const BlockRef<TIn, TOut>& nxt, int skv, int W, char* lds, Seam<TIn>& S, const int tid) {
    constexpr bool F32 = same_t<TIn, float>::v;
    const int wid = __builtin_amdgcn_readfirstlane(tid >> 6), lane = tid & 63, r32 = lane & 31, hi = lane >> 5;
    const int j_lo = cur.jlo;
    int j_hi = (cur.P0 + QB - 1) / KVBLK + 1; if (j_hi > skv / KVBLK) j_hi = skv / KVBLK;
    const int NT = j_hi - j_lo;
    const int kbn = ((nxt.P0 + QB - 1) / KVBLK) * KVBLK;
    const int qlo = cur.P0 + wid * QBLK, qm = qlo + r32 - 4 * hi;
    char* V_lds = lds; char* K_lds = lds + 2 * SHM_V;
    float* ws = (float*)(lds + 2 * SHM_V + 2 * SHM_K) + wid * 64; float* li_l = ws, * al_l = ws + 32;
    float m_reg = -1e30f, l_reg = 0; f32x16 o[4] = {};
    const int sr = tid >> 4, sc = (tid & 15) * 8, vst0 = v_st(sr, sc), vst1 = v_st(32 + sr, sc), kws = KSWZ(sr, sc * 2);
    const int vb0 = (int)(uintptr_t)V_lds + v_rd_base(lane);
    const TIn* Kh = cur.K; const TIn* Vh = cur.V;
#define RESC(a) do { if (__any((a) < 1.f)) { if (hi == 0) al_l[r32] = (a); asm volatile("s_waitcnt lgkmcnt(0)" ::: "memory");              \
                     for (int d_ = 0; d_ < 4; ++d_) for (int r = 0; r < 16; ++r) o[d_][r] *= al_l[crow(r, hi)]; } } while (0)
#define KBASE(t) ((j_hi - 1 - (t)) * KVBLK)
#define ACT(t) (KBASE(t) <= qlo + QBLK - 1 && KBASE(t) + KVBLK - 1 >= qlo - W + 1)
#define MASKT(P0_, P1_, t) do { const int kb_ = KBASE(t); if ((!SK || ACT(t)) && (kb_ + KVBLK - 1 > qlo || kb_ <= qlo + QBLK - 1 - W)) mask_tile(P0_, P1_, qm - kb_, (unsigned)W); } while (0)
    constexpr int NQL = F32 ? 16 : 8;
    constexpr bool SK = WSKIP && !F32;
#define SEAM_K0() do { VMWN(NQL); if constexpr (F32) { SWRITE_KF(0); SBAR(); SLOAD_F((const float*)nxt.V, kbn); } else { SWRITE_HK(0); } SBAR(); } while (0)
    f32x16 pA0, pA1, pB0, pB1; float mnA, mnB, alA, alB; bf16x8 pa0, pa1, pa2, pa3; bool deadA = false, deadB = false;
    if constexpr (F32) { VMW(); SWRITE_VF(0); SBAR(); } else { SWRITE_HV(0); SBAR(); }
    if (NT > 1) { if constexpr (F32) SLOAD_F((const float*)Kh, KBASE(1)); else SLOAD_H(Kh, Vh, cur.Fb, 1, KBASE(1)); }
    SBAR(); qkt<0, SK>(pA0, pA1, K_lds, r32, hi, S.qr, ACT(0));
    if constexpr (F32) { if (NT > 1) { VMW(); SWRITE_KF(1); SBAR(); SLOAD_F((const float*)Vh, KBASE(1)); } }
    MASKT(pA0, pA1, 0); partialSM(pA0, pA1, m_reg, mnA, alA, deadA);
    if (NT > 1) { VMW(); if constexpr (F32) { SWRITE_VF(1); SBAR(); if (NT > 2) SLOAD_F((const float*)Kh, KBASE(2)); } else SWRITE_H(1); }
    __syncthreads();
#define HALF_STEP(PX0, PX1, mnX, alX, deadX, PY0, PY1, alY, deadY, t, KB, VB, SB) do {                                                      \
        SBAR(); qkt<KB, SK>(PX0, PX1, K_lds, r32, hi, S.qr, ACT(t));                                             \
        if (!deadY) finishSM(PY0, PY1, alY, l_reg, pa0, pa1, pa2, pa3); SBAR();                                               \
        if ((t) + 1 < NT) { if constexpr (F32) { VMW(); SWRITE_KF(SB); SBAR(); SLOAD_F((const float*)Vh, KBASE((t) + 1)); }  \
                            else { SLOAD_H(Kh, Vh, cur.Fb, SB, KBASE((t) + 1)); } SBAR(); }                                               \
        pv_tile<VB, SK>(o, vb0, pa0, pa1, pa2, pa3, ACT((t) - 1) && !deadY); MASKT(PX0, PX1, (t)); partialSM(PX0, PX1, m_reg, mnX, alX, deadX);                                        \
        __syncthreads();                                                                                                      \
        if ((t) + 1 < NT) { VMW(); if constexpr (F32) { SWRITE_VF(SB); SBAR(); if ((t) + 2 < NT) SLOAD_F((const float*)Kh, KBASE((t) + 2)); } \
                            else { SWRITE_H(SB); } }                                                                          \
        RESC(alX); __syncthreads(); } while (0)
    for (int t = 1; t + 1 < NT; t += 2) {
        HALF_STEP(pB0, pB1, mnB, alB, deadB, pA0, pA1, alA, deadA, t, 1, 0, 0);
        HALF_STEP(pA0, pA1, mnA, alA, deadA, pB0, pB1, alB, deadB, t + 1, 0, 1, 1);
    }
    const bool even = (NT & 1) == 0;
    if (even) { SBAR(); qkt<1, SK>(pB0, pB1, K_lds, r32, hi, S.qr, ACT(NT - 1)); SBAR(); }
#define QROW(e) (nxt.Q + (size_t)(wid * QBLK + r32) * PITCH + ((e) >> 1) * 16 + hi * 8 + ((e) & 1) * 4)
    if constexpr (F32) { SLOAD_F((const float*)nxt.K, kbn); SBAR();
#pragma unroll
        for (int e = 0; e < 8; ++e) S.tq[e] = *(const f32x4*)QROW(e); }
    else { SLOAD_H(nxt.K, nxt.V, nxt.Fb, 0, kbn); SBAR();
#pragma unroll
        for (int d0 = 0; d0 < 8; ++d0) S.qr[d0] = load8<TIn>(nxt.Q + (size_t)(wid * QBLK + r32) * PITCH + d0 * 16 + hi * 8); }
    SBAR();
    if (!deadA) finishSM(pA0, pA1, alA, l_reg, pa0, pa1, pa2, pa3); SBAR();
    if constexpr (F32) {
#pragma unroll
        for (int e = 8; e < 16; ++e) S.tq[e] = *(const f32x4*)QROW(e); SBAR(); }
#undef QROW
    pv_tile<0, SK>(o, vb0, pa0, pa1, pa2, pa3, ACT(even ? NT - 2 : NT - 1) && !deadA);
    if (even) { MASKT(pB0, pB1, NT - 1); partialSM(pB0, pB1, m_reg, mnB, alB, deadB); __syncthreads(); RESC(alB);
        if (!deadB) finishSM(pB0, pB1, alB, l_reg, pa0, pa1, pa2, pa3); SBAR(); pv_tile<1, SK>(o, vb0, pa0, pa1, pa2, pa3, ACT(NT - 1) && !deadB); }
    SBAR(); SEAM_K0();
    if (hi == 0) li_l[r32] = l_reg; asm volatile("s_waitcnt lgkmcnt(0)" ::: "memory");
    float rli[16];
#pragma unroll
    for (int r = 0; r < 16; ++r) rli[r] = __builtin_amdgcn_rcpf(li_l[crow(r, hi)]);
    TOut* Ow = cur.O + (size_t)(wid * QBLK) * PITCH;
#pragma unroll
    for (int r = 0; r < 16; ++r) { const int orow = crow(r, hi);
#pragma unroll
        for (int d0 = 0; d0 < 4; ++d0) { const float v = o[d0][r] * rli[r];
            if constexpr (same_t<TOut, float>::v) { Ow[(size_t)orow * PITCH + d0 * 32 + r32] = v; }
            else if constexpr (O_FP8) { const float vs = fminf(fmaxf(v * O8_SCALE, -440.f), 440.f), t1 = __shfl_xor(vs, 1), t2 = __shfl_xor(vs, 2), t3 = __shfl_xor(t1, 2);
                   unsigned w8 = 0u; w8 = __builtin_amdgcn_cvt_pk_fp8_f32(vs, t1, w8, false); w8 = __builtin_amdgcn_cvt_pk_fp8_f32(t2, t3, w8, true);
                   if ((r32 & 3) == 0) *(unsigned*)(cur.O8 + (size_t)(wid * QBLK + orow) * PITCH + d0 * 32 + r32) = w8; }
            else { const float vn = __shfl_xor(v, 1);
                   if ((r32 & 1) == 0) *(unsigned*)(Ow + (size_t)orow * PITCH + d0 * 32 + r32) = cvtpk(v, vn); } } }
    if constexpr (F32) {
#pragma unroll
        for (int d0 = 0; d0 < 8; ++d0) S.qr[d0] = pack8(S.tq[2 * d0], S.tq[2 * d0 + 1]); }
    __syncthreads();
#undef RESC
#undef KBASE
#undef ACT
#undef MASKT
#undef SEAM_K0
#undef HALF_STEP
}
#undef ROW
#undef VMW
#undef VMWN
#undef SLOAD_H
#undef SWRITE_HK
#undef SWRITE_HV
#undef SWRITE_H
#undef SLOAD_F
#undef SWRITE_KF
#undef SWRITE_VF


enum { ORDER_NATURAL = 0, ORDER_REVERSED = 1, ORDER_PAIRED = 2, ORDER_XCD = 4 };
__host__ __device__ inline int swa_nramp(int nqb, int W, int qoff) { const int t = W - 1 - qoff; const int n = t < 0 ? 0 : t / QB + 1; return n > nqb ? nqb : n; }
__host__ __device__ inline int swa_nx(int nqb, int nramp, int order) { return (order & ORDER_PAIRED) ? (nramp + 1) / 2 + (nqb - nramp) : nqb; }
struct SwaItem { int bh, qb0, qb1; };
__device__ __forceinline__ SwaItem swa_decode(int L, int nb, int nh, int nhkv, int nqb, int nx, int nramp, int order) {
    const int G = nh / nhkv; SwaItem it; int x;
    if ((order & ORDER_XCD) && (nb * nhkv) % 8 == 0) { const int xcd = L & 7, k = L >> 3, per = G * nx, gi = k / per, r = k - gi * per;
        it.bh = (gi * 8 + xcd) * G + r / nx; x = r % nx; }
    else { it.bh = L / nx; x = L - it.bh * nx; }
    if (order & ORDER_PAIRED) { const int ns = nqb - nramp;
        if (x < ns) { it.qb0 = it.qb1 = nqb - 1 - x; } else { it.qb0 = x - ns; it.qb1 = nramp - 1 - it.qb0; } }
    else { it.qb0 = it.qb1 = ((order & 3) == ORDER_REVERSED) ? nqb - 1 - x : x; }
    return it;
}

}

namespace pg8 {
struct ListOrder {
    int pm0, n;
    __device__ bool next(int i, Unit& u) const { if (i >= n) return false; u.pm = pm0 + i; u.pn = 0; return true; }
    __device__ __forceinline__ void a_ready(const Unit&) const {}
    __device__ __forceinline__ void done(const Unit&) const {}
};
struct EpiScaleBf16 {
    static constexpr bool PERM = true, AFTER_DRAIN = false;
    unsigned char* O; int ldc; const float* colscale; float os;
    __device__ __forceinline__ void operator()(const f32x4 (&acc)[2][2][4][2], const Unit& u, int wr, int wc, int fr, int fq) const {
        const int row0 = u.pm * BM + wr * 64 + fr; int col0 = u.pn * BM + wc * 32 + 8 * fq; asm volatile("" : "+v"(col0));
        f32x4 sv[2][2];
#pragma unroll
        for (int bj = 0; bj < 2; ++bj)
#pragma unroll
            for (int n = 0; n < 2; ++n) sv[bj][n] = *(const f32x4*)(colscale + col0 + bj * HALF + 4 * n) * os;
#pragma unroll
        for (int ai = 0; ai < 2; ++ai)
#pragma unroll
            for (int m = 0; m < 4; ++m) { unsigned char* rowp = O + (size_t)(row0 + ai * HALF + m * 16) * ldc + col0;
#pragma unroll
                for (int bj = 0; bj < 2; ++bj) { const f32x4 v0 = acc[ai][bj][m][0] * sv[bj][0], v1 = acc[ai][bj][m][1] * sv[bj][1];
                    unsigned w0 = 0u, w1 = 0u;
                    w0 = __builtin_amdgcn_cvt_pk_fp8_f32(fminf(fmaxf(v0[0], -440.f), 440.f), fminf(fmaxf(v0[1], -440.f), 440.f), w0, false); w0 = __builtin_amdgcn_cvt_pk_fp8_f32(fminf(fmaxf(v0[2], -440.f), 440.f), fminf(fmaxf(v0[3], -440.f), 440.f), w0, true);
                    w1 = __builtin_amdgcn_cvt_pk_fp8_f32(fminf(fmaxf(v1[0], -440.f), 440.f), fminf(fmaxf(v1[1], -440.f), 440.f), w1, false); w1 = __builtin_amdgcn_cvt_pk_fp8_f32(fminf(fmaxf(v1[2], -440.f), 440.f), fminf(fmaxf(v1[3], -440.f), 440.f), w1, true);
                    typedef unsigned u32x2_ __attribute__((ext_vector_type(2))); *(u32x2_*)(rowp + bj * HALF) = (u32x2_){w0, w1}; } }
    }
};
struct EpiRowScaleBf16 {
    static constexpr bool PERM = true, AFTER_DRAIN = false;
    bf16_t* O; int ldc; const float* rs; float cs; int split_cols; size_t split_stride;
    __device__ __forceinline__ void operator()(const f32x4 (&acc)[2][2][4][2], const Unit& u, int wr, int wc, int fr, int fq) const {
        int ln_; asm volatile("v_mbcnt_lo_u32_b32 %0, -1, 0\n\tv_mbcnt_hi_u32_b32 %0, -1, %0" : "=v"(ln_));
        (void)fr; (void)fq; const int row0 = u.pm * BM + wr * 64 + (ln_ & 15); int colt = u.pn * BM; bf16_t* base = O;
        if (split_cols) { const int t = colt / split_cols; base += (size_t)t * split_stride; colt -= t * split_cols; }
        const int col0 = colt + wc * 32 + 8 * (ln_ >> 4);
#pragma unroll
        for (int ai = 0; ai < 2; ++ai)
#pragma unroll
            for (int m = 0; m < 4; ++m) { const int row = row0 + ai * HALF + m * 16; const float sc = rs ? rs[row] * cs : cs; bf16_t* rowp = base + (size_t)row * ldc + col0;
#pragma unroll
                for (int bj = 0; bj < 2; ++bj) { const f32x4 v0 = acc[ai][bj][m][0] * sc, v1 = acc[ai][bj][m][1] * sc;
                    u32x4 w; w.x = cvt_pk_bf16(v0[0], v0[1]); w.y = cvt_pk_bf16(v0[2], v0[3]); w.z = cvt_pk_bf16(v1[0], v1[1]); w.w = cvt_pk_bf16(v1[2], v1[3]);
                    *(u32x4*)(rowp + bj * HALF) = w; } }
    }
};
struct EpiI8RowScaleBf16 {
    static constexpr bool PERM = true, AFTER_DRAIN = false;
    bf16_t* O; int ldc; const float* rs; float cs; int split_cols; size_t split_stride;
    __device__ __forceinline__ void operator()(const f32x4 (&acc)[2][2][4][2], const Unit& u, int wr, int wc, int fr, int fq) const {
        int ln_; asm volatile("v_mbcnt_lo_u32_b32 %0, -1, 0\n\tv_mbcnt_hi_u32_b32 %0, -1, %0" : "=v"(ln_));
        (void)fr; (void)fq; const int row0 = u.pm * BM + wr * 64 + (ln_ & 15); int colt = u.pn * BM; bf16_t* base = O;
        if (split_cols) { const int t = colt / split_cols; base += (size_t)t * split_stride; colt -= t * split_cols; }
        const int col0 = colt + wc * 32 + 8 * (ln_ >> 4);
#pragma unroll
        for (int ai = 0; ai < 2; ++ai)
#pragma unroll
            for (int m = 0; m < 4; ++m) { const int row = row0 + ai * HALF + m * 16; const float sc = rs[row] * cs; bf16_t* rowp = base + (size_t)row * ldc + col0;
#pragma unroll
                for (int bj = 0; bj < 2; ++bj) { typedef int i32x4_ __attribute__((ext_vector_type(4))); const i32x4_ i0 = __builtin_bit_cast(i32x4_, acc[ai][bj][m][0]), i1 = __builtin_bit_cast(i32x4_, acc[ai][bj][m][1]);
                    u32x4 w; w.x = cvt_pk_bf16((float)i0[0] * sc, (float)i0[1] * sc); w.y = cvt_pk_bf16((float)i0[2] * sc, (float)i0[3] * sc); w.z = cvt_pk_bf16((float)i1[0] * sc, (float)i1[1] * sc); w.w = cvt_pk_bf16((float)i1[2] * sc, (float)i1[3] * sc);
                    *(u32x4*)(rowp + bj * HALF) = w; } }
    }
};
struct EpiGate {
    static constexpr bool PERM = false, AFTER_DRAIN = false;
    const bf16_t* XC; float* AF; float* DF; const float* b_a; const float* b_x; const float* ls8; int cbase;
    __device__ __forceinline__ void operator()(const f32x4 (&acc)[2][2][4][2], const Unit& u, int wr, int wc, int fr, int fq) const {
        const unsigned row0 = (unsigned)(u.pm * BM + wr * 64 + fr);
#pragma unroll
        for (int n = 0; n < 2; ++n) { unsigned c = (unsigned)(cbase + wc * 32 + 16 * n + 4 * fq); asm volatile("" : "+v"(c));
            const f32x4 ba = *(const f32x4*)(b_a + c), bx = *(const f32x4*)(b_x + c), l8 = *(const f32x4*)(ls8 + c) * 1.4426950408889634f;
#pragma unroll
            for (int ai = 0; ai < 2; ++ai)
#pragma unroll
                for (int m = 0; m < 4; ++m) { const unsigned off = (row0 + ai * HALF + m * 16) * 1024u + c;
                    const f32x4 pr = acc[ai][0][m][n] + ba, pi = acc[ai][1][m][n] + bx;
                    const uint2 xr = *(const uint2*)((const char*)XC + off * 2u);
                    const float xc[4] = {__uint_as_float(xr.x << 16), __uint_as_float(xr.x & 0xffff0000u), __uint_as_float(xr.y << 16), __uint_as_float(xr.y & 0xffff0000u)};
                    u32x4 pw;
#pragma unroll
                    for (int e = 0; e < 4; ++e) { const float r = __builtin_amdgcn_rcpf(1.f + __builtin_amdgcn_exp2f(-1.4426950408889634f * pr[e])), ig = __builtin_amdgcn_rcpf(1.f + __builtin_amdgcn_exp2f(-1.4426950408889634f * pi[e]));
                        const float la = r * l8[e]; const float a = __builtin_amdgcn_exp2f(la); const float mult = __builtin_amdgcn_sqrtf(fmaxf(1.f - a * a, 0.f)); pw[e] = cvt_pk_bf16(la, mult * ig * xc[e]); }
                    *(u32x4*)((char*)AF + off * 4u) = pw; asm volatile("" ::: "memory"); } }
    }
};
}

#define LAS __attribute__((address_space(3)))
typedef unsigned short bf16;
typedef unsigned v4u __attribute__((ext_vector_type(4)));
typedef unsigned v2u __attribute__((ext_vector_type(2)));
typedef float f32x4 __attribute__((ext_vector_type(4)));
typedef float f32x16 __attribute__((ext_vector_type(16)));
typedef short bf16x8 __attribute__((ext_vector_type(8)));

constexpr int NTHREADS = 512, NWAVES = 8;
constexpr int LDS_BYTES = 155648 + 256, LDS_CTL = 155648;
constexpr int BATCH = 2, SEQ = 8192, DM = 2048, M = BATCH * SEQ, NEXP = 16384;
constexpr int NZ = 3072, NQKV = 6144, NODIN = 6160;
constexpr int ROW6 = 1536;
constexpr bool V_FP4 = true;
constexpr int ROWV = V_FP4 ? 1024 : ROW6;
constexpr int ROW4 = 1024;
constexpr float ALPHA = 1.4142135623730951f, LN_EPS = 1e-5f;
constexpr float ATT_SCALE = 0.08838834764831845f;

constexpr size_t MiB = 1u << 20;
constexpr size_t WS_MOD = 1 * MiB;
constexpr size_t WS_LS8 = 1 * MiB + 512 * 1024;
constexpr size_t WS_WIN = 2 * MiB, WS_WOUT = 14 * MiB, WS_WQKV = 22 * MiB, WS_WO = 46 * MiB, WS_WQ0 = 54 * MiB, WS_WQ1 = 62 * MiB;
constexpr size_t WS_KEYS = 70 * MiB, WS_WPOOL = 71 * MiB, WS_WAX = 71 * MiB + 512 * 1024, WS_WF = 72 * MiB;
constexpr size_t WS_FE = 77 * MiB, WS_FP = 77 * MiB + 64 * 1024, WS_KN = 77 * MiB + 128 * 1024, WS_QN = 77 * MiB + 192 * 1024, WS_DN = 77 * MiB + 256 * 1024;
constexpr size_t WS_AG = 73 * MiB, WS_HG = 73 * MiB + 512 * 1024, WS_LF = 74 * MiB, WS_FB = 75 * MiB;
constexpr size_t WS_SU = 76 * MiB, WS_SV = 76 * MiB + 128 * 1024;
constexpr size_t WS_HB8 = 208 * MiB, WS_SA = 79 * MiB;
constexpr float YP_SCALE = 64.f;
constexpr float W8O_SCALE = 2048.f, Y8_SCALE = 16.f;
constexpr size_t WS_YC8 = 240 * MiB;
constexpr float W8_SCALE = 1024.f;
constexpr size_t WS_PART = 400 * MiB;
constexpr size_t WS_AR = 496 * MiB, WS_EQ = 500 * MiB;
constexpr size_t WS_Y = 592 * MiB;
constexpr size_t WS_H6 = 752 * MiB, WS_HS = 785 * MiB;
constexpr size_t WS_TU = 80 * MiB, WS_TV = 144 * MiB;
constexpr size_t WS_HB = 336 * MiB, WS_ZB = 400 * MiB, WS_YC = 592 * MiB, WS_YB = 656 * MiB, WS_X1 = 720 * MiB, WS_H2 = 848 * MiB, WS_QP = 912 * MiB;
constexpr size_t WS_EI = 976 * MiB, WS_GT = 984 * MiB, WS_END = 992 * MiB;
constexpr size_t WS_AF = WS_H2, WS_DF = WS_QP;
constexpr size_t WS_PO = WS_YB, WS_XC = WS_YB + 32 * MiB;

struct Args { const float* in[24]; float* out; unsigned char* ws; int ph_lo, ph_hi; };

__device__ __forceinline__ float bf_lo(unsigned u) { return __uint_as_float(u << 16); }
__device__ __forceinline__ float bf_hi(unsigned u) { return __uint_as_float(u & 0xffff0000u); }
__device__ __forceinline__ unsigned pk2(float lo, float hi) { return pg8::cvt_pk_bf16(lo, hi); }
__device__ __forceinline__ unsigned pk2c(float lo, float hi) { typedef float f2_ __attribute__((ext_vector_type(2))); typedef __bf16 b2_ __attribute__((ext_vector_type(2))); const f2_ f = {lo, hi}; return __builtin_bit_cast(unsigned, __builtin_convertvector(f, b2_)); }
#define SWZ_XOR_(v, m) __uint_as_float((unsigned)__builtin_amdgcn_ds_swizzle((int)__float_as_uint(v), ((m) << 10) | 0x1f))
__device__ __forceinline__ float wave_sum(float v) {
    v += SWZ_XOR_(v, 1); v += SWZ_XOR_(v, 2); v += SWZ_XOR_(v, 4); v += SWZ_XOR_(v, 8); v += SWZ_XOR_(v, 16);
    const auto rr = __builtin_amdgcn_permlane32_swap(__float_as_uint(v), __float_as_uint(v), false, false);
    return __uint_as_float(rr[0]) + __uint_as_float(rr[1]);
}
__device__ __forceinline__ float wave_max(float v) {
    v = fmaxf(v, SWZ_XOR_(v, 1)); v = fmaxf(v, SWZ_XOR_(v, 2)); v = fmaxf(v, SWZ_XOR_(v, 4)); v = fmaxf(v, SWZ_XOR_(v, 8)); v = fmaxf(v, SWZ_XOR_(v, 16));
    const auto rr = __builtin_amdgcn_permlane32_swap(__float_as_uint(v), __float_as_uint(v), false, false);
    return fmaxf(__uint_as_float(rr[0]), __uint_as_float(rr[1]));
}
__device__ __forceinline__ float gelu_tanh(float x) { const float y = 0.7978845608028654f * (x + 0.044715f * x * x * x); return x * __builtin_amdgcn_rcpf(1.f + __builtin_amdgcn_exp2f(-2.8853900817779268f * y)); }
#define LDS_WAIT() asm volatile("s_waitcnt lgkmcnt(0)" ::: "memory")
__device__ __forceinline__ int lane_id() { int l; asm volatile("v_mbcnt_lo_u32_b32 %0, -1, 0\n\tv_mbcnt_hi_u32_b32 %0, -1, %0" : "=v"(l)); return l; }


#define XB_TMO      128
#define XB_XCNT(j)  (256  + 64 * (j))
#define XB_XSUB(j)  (1280 + 64 * (j))
#define XB_XGEN(j)  (2304 + 64 * (j))
#define XB_TOP      3328
#define XB_TOPGEN   3392
#define XCD_BAR_WORDS 3456
#define XB_SPIN_CAP (1u << 22)
__device__ __forceinline__ unsigned xb_ld(unsigned* p)              { return __hip_atomic_load(p, __ATOMIC_RELAXED, __HIP_MEMORY_SCOPE_AGENT); }
__device__ __forceinline__ unsigned xb_add(unsigned* p, unsigned v) { return __hip_atomic_fetch_add(p, v, __ATOMIC_RELAXED, __HIP_MEMORY_SCOPE_AGENT); }
__device__ __forceinline__ unsigned xb_xcc_id() { return (unsigned)__builtin_amdgcn_s_getreg((3 << 11) | 20) & 0xFu; }
#define XB_SPIN(cond, bar) do { unsigned _sp = 0; while (cond) { __builtin_amdgcn_s_sleep(1); \
    if ((++_sp & 255u) == 0u) { if (xb_ld(&(bar)[XB_TMO])) break; if (_sp > XB_SPIN_CAP) { atomicAdd(&(bar)[XB_TMO], 1u); break; } } } } while (0)
struct XcdBarrier { unsigned* bar; unsigned x; volatile LAS unsigned* st; };
__device__ __forceinline__ XcdBarrier xcd_barrier_post(unsigned* bar, volatile LAS unsigned* st, bool t0) {
    XcdBarrier b; b.bar = bar; b.x = xb_xcc_id(); b.st = st;
    if (t0) { st[2] = xb_add(&bar[XB_XCNT(b.x)], 1u); st[3] = b.x; }
    return b;
}
__device__ __forceinline__ void xcd_barrier_complete(unsigned* bar, unsigned x, unsigned& nloc, unsigned& nx, unsigned& uni) {
    const unsigned G = gridDim.x * gridDim.y * gridDim.z;
    unsigned sum, cnt, mine, sp = 0u;
    for (;;) {
        sum = 0u; cnt = 0u; mine = 0u; uni = (G & 7u) == 0u ? 1u : 0u;
#pragma unroll
        for (unsigned j = 0; j < 16; ++j) { const unsigned c = xb_ld(&bar[XB_XCNT(j)]); sum += c; cnt += (c > 0u) ? 1u : 0u; mine = (j == x) ? c : mine; uni = (c == (j < 8u ? (G >> 3) : 0u)) ? uni : 0u; }
        if (sum == G) break;
        __builtin_amdgcn_s_sleep(1);
        if ((++sp & 255u) == 0u) { if (xb_ld(&bar[XB_TMO])) break; if (sp > XB_SPIN_CAP) { atomicAdd(&bar[XB_TMO], 1u); break; } }
    }
    nloc = mine > 0u ? mine : 1u; nx = cnt > 0u ? cnt : 1u;
}
__device__ __forceinline__ void xcd_barrier(const XcdBarrier& b, bool t0) {
    asm volatile("s_waitcnt vmcnt(0)" ::: "memory");
    __syncthreads();
    if (t0) {
        unsigned* bar = b.bar;
        __builtin_amdgcn_s_waitcnt(0);
        unsigned nloc = b.st[0], nx = b.st[1];
        if (nloc == 0u) { unsigned uni; xcd_barrier_complete(bar, b.x, nloc, nx, uni); b.st[0] = nloc; b.st[1] = nx; b.st[4] = uni; }
        const unsigned old = xb_add(&bar[XB_XSUB(b.x)], 1u);
        const unsigned gen = old / nloc;
        if (old + 1u == (gen + 1u) * nloc) {
            __builtin_amdgcn_fence(__ATOMIC_RELEASE, "agent");
            asm volatile("s_waitcnt vmcnt(0)" ::: "memory");
            const unsigned og = xb_add(&bar[XB_TOP], 1u);
            const unsigned tg = og / nx;
            if (og + 1u == (tg + 1u) * nx) xb_add(&bar[XB_TOPGEN], 1u);
            else XB_SPIN(xb_ld(&bar[XB_TOPGEN]) == tg, bar);
            __builtin_amdgcn_fence(__ATOMIC_ACQUIRE, "agent");
            xb_add(&bar[XB_XGEN(b.x)], 1u);
            asm volatile("s_waitcnt vmcnt(0)" ::: "memory");
        } else {
            XB_SPIN(xb_ld(&bar[XB_XGEN(b.x)]) == gen, bar);
            __builtin_amdgcn_fence(__ATOMIC_ACQUIRE, "agent");
            asm volatile("s_waitcnt vmcnt(0)" ::: "memory");
        }
    }
    __syncthreads();
}

__device__ __forceinline__ void transpose_item(const float* W, int ldw, int nblk, bf16* WT, int K, LAS float* scr, int item, int lane) {
    const int kb = item / nblk, nb = item % nblk, k0 = 64 * kb, n0 = 32 * nb;
#pragma unroll 8
    for (int i = 0; i < 32; ++i) { const int kk = 2 * i + (lane >> 5); scr[kk * 33 + (lane & 31)] = W[(size_t)(k0 + kk) * ldw + n0 + (lane & 31)]; }
    LDS_WAIT(); asm volatile("" ::: "memory");
    const int c = lane & 7;
#pragma unroll
    for (int j = 0; j < 4; ++j) { const int n = (lane >> 3) + 8 * j; const LAS float* s = scr + (8 * c) * 33 + n;
        v4u o; o.x = pk2(s[0 * 33], s[1 * 33]); o.y = pk2(s[2 * 33], s[3 * 33]); o.z = pk2(s[4 * 33], s[5 * 33]); o.w = pk2(s[6 * 33], s[7 * 33]);
        *(v4u*)(WT + (size_t)(n0 + n) * K + k0 + 8 * c) = o; }
    LDS_WAIT(); asm volatile("" ::: "memory");
}
__device__ __forceinline__ unsigned pk4_i8(float a, float b, float c, float d) {
    const int ia = (int)rintf(fminf(fmaxf(a, -127.f), 127.f)), ib = (int)rintf(fminf(fmaxf(b, -127.f), 127.f)), ic = (int)rintf(fminf(fmaxf(c, -127.f), 127.f)), id = (int)rintf(fminf(fmaxf(d, -127.f), 127.f));
    return ((unsigned)ia & 0xffu) | (((unsigned)ib & 0xffu) << 8) | (((unsigned)ic & 0xffu) << 16) | ((unsigned)id << 24);
}
__device__ __forceinline__ void transpose_item_i8(const float* W, int ldw, int nblk, unsigned char* WT, int K, LAS float* scr, int item, int lane, float wscale) {
    const int kb = item / nblk, nb = item % nblk, k0 = 64 * kb, n0 = 32 * nb;
#pragma unroll 8
    for (int i = 0; i < 32; ++i) { const int kk = 2 * i + (lane >> 5); scr[kk * 33 + (lane & 31)] = W[(size_t)(k0 + kk) * ldw + n0 + (lane & 31)] * wscale; }
    LDS_WAIT(); asm volatile("" ::: "memory");
    const int c = lane & 7;
#pragma unroll
    for (int j = 0; j < 4; ++j) { const int n = (lane >> 3) + 8 * j; const LAS float* sp = scr + (8 * c) * 33 + n;
        *(v2u*)(WT + (size_t)(n0 + n) * K + k0 + 8 * c) = (v2u){pk4_i8(sp[0 * 33], sp[1 * 33], sp[2 * 33], sp[3 * 33]), pk4_i8(sp[4 * 33], sp[5 * 33], sp[6 * 33], sp[7 * 33])}; }
    LDS_WAIT(); asm volatile("" ::: "memory");
}
__device__ __forceinline__ float cl8(float x) { return fminf(fmaxf(x, -440.f), 440.f); }
__device__ __forceinline__ unsigned pk4_fp8(float a, float b, float c, float d) { unsigned w = 0u; w = __builtin_amdgcn_cvt_pk_fp8_f32(cl8(a), cl8(b), w, false); w = __builtin_amdgcn_cvt_pk_fp8_f32(cl8(c), cl8(d), w, true); return w; }
__device__ __forceinline__ void transpose_item8(const float* W, int ldw, int nblk, unsigned char* WT, int K, LAS float* scr, int item, int lane, float wscale = W8_SCALE) {
    const int kb = item / nblk, nb = item % nblk, k0 = 64 * kb, n0 = 32 * nb;
#pragma unroll 8
    for (int i = 0; i < 32; ++i) { const int kk = 2 * i + (lane >> 5); scr[kk * 33 + (lane & 31)] = W[(size_t)(k0 + kk) * ldw + n0 + (lane & 31)] * wscale; }
    LDS_WAIT(); asm volatile("" ::: "memory");
    const int c = lane & 7;
#pragma unroll
    for (int j = 0; j < 4; ++j) { const int n = (lane >> 3) + 8 * j; const LAS float* sp = scr + (8 * c) * 33 + n; unsigned w0 = 0u, w1 = 0u;
        w0 = __builtin_amdgcn_cvt_pk_fp8_f32(cl8(sp[0 * 33]), cl8(sp[1 * 33]), w0, false); w0 = __builtin_amdgcn_cvt_pk_fp8_f32(cl8(sp[2 * 33]), cl8(sp[3 * 33]), w0, true);
        w1 = __builtin_amdgcn_cvt_pk_fp8_f32(cl8(sp[4 * 33]), cl8(sp[5 * 33]), w1, false); w1 = __builtin_amdgcn_cvt_pk_fp8_f32(cl8(sp[6 * 33]), cl8(sp[7 * 33]), w1, true);
        *(v2u*)(WT + (size_t)(n0 + n) * K + k0 + 8 * c) = (v2u){w0, w1}; }
    LDS_WAIT(); asm volatile("" ::: "memory");
}
__device__ __forceinline__ void convert_item(const float* src, bf16* dst, size_t item, int lane) {
    const size_t base = item * 4096 + (size_t)lane * 8;
#pragma unroll
    for (int j = 0; j < 8; ++j) { const f32x4 a = *(const f32x4*)(src + base + j * 512), b = *(const f32x4*)(src + base + j * 512 + 4);
        v4u o; o.x = pk2(a[0], a[1]); o.y = pk2(a[2], a[3]); o.z = pk2(b[0], b[1]); o.w = pk2(b[2], b[3]);
        *(v4u*)(dst + base + j * 512) = o; }
}
__device__ __forceinline__ void fp8_row_item(const float* src, unsigned char* dst, float* scale, int row, int lane) {
    const float* p = src + (size_t)row * DM + 4 * lane; f32x4 v[8]; float mx = 0.f;
#pragma unroll
    for (int j = 0; j < 8; ++j) { v[j] = *(const f32x4*)(p + 256 * j); mx = fmaxf(mx, fmaxf(fmaxf(fabsf(v[j][0]), fabsf(v[j][1])), fmaxf(fabsf(v[j][2]), fabsf(v[j][3])))); }
    mx = fmaxf(wave_max(mx), 1e-30f); const float inv = 240.f / mx;
    unsigned* q = (unsigned*)(dst + (size_t)row * DM) + lane;
#pragma unroll
    for (int j = 0; j < 8; ++j) { unsigned w = 0u; w = __builtin_amdgcn_cvt_pk_fp8_f32(v[j][0] * inv, v[j][1] * inv, w, false); w = __builtin_amdgcn_cvt_pk_fp8_f32(v[j][2] * inv, v[j][3] * inv, w, true); q[64 * j] = w; }
    if (lane == 0) scale[row] = mx * (1.f / 240.f);
}
typedef float f32x16_t __attribute__((ext_vector_type(16)));
typedef float f32x32_t __attribute__((ext_vector_type(32)));
typedef unsigned u32x6_t __attribute__((ext_vector_type(6)));
typedef unsigned u32x3_t __attribute__((ext_vector_type(3)));
__device__ __forceinline__ void fp6_pack_block(const float (&v)[32], u32x6_t& p, unsigned& ebyte) {
    float mx = 0.f;
#pragma unroll
    for (int i = 0; i < 32; ++i) mx = fmaxf(mx, fabsf(v[i]));
    int ex = (int)((__float_as_uint(mx * (1.f / 7.5f)) + 0x7fffffu) >> 23) - 127; ex = ex < -126 ? -126 : (ex > 127 ? 127 : ex);
    const float inv = __uint_as_float((unsigned)(127 - ex) << 23);
    f32x16_t a, b;
#pragma unroll
    for (int i = 0; i < 16; ++i) { a[i] = v[2 * i] * inv; b[i] = v[2 * i + 1] * inv; }
    p = __builtin_amdgcn_cvt_scalef32_2xpk16_fp6_f32(a, b, 1.0f); ebyte = (unsigned)(ex + 127);
}
__device__ __forceinline__ void fp6_row_item(const float* src, unsigned char* dst, float* sdst, int row, int lane) {
    const float* p = src + (size_t)row * DM + 4 * lane; float v[32]; float mx = 0.f;
#pragma unroll
    for (int j = 0; j < 8; ++j) { const f32x4 x = *(const f32x4*)(p + 256 * j); v[4 * j] = x[0]; v[4 * j + 1] = x[1]; v[4 * j + 2] = x[2]; v[4 * j + 3] = x[3]; }
#pragma unroll
    for (int i = 0; i < 32; ++i) mx = fmaxf(mx, fabsf(v[i]));
    mx = fmaxf(wave_max(mx), 1e-30f);
    const float inv = 7.5f / mx;
    f32x16_t a, b;
#pragma unroll
    for (int i = 0; i < 16; ++i) { a[i] = v[2 * i] * inv; b[i] = v[2 * i + 1] * inv; }
    const u32x6_t pk = __builtin_amdgcn_cvt_scalef32_2xpk16_fp6_f32(a, b, 1.0f);
    unsigned char* q = dst + (size_t)row * ROW6;
    *(v4u*)(q + 16 * lane) = (v4u){pk[0], pk[1], pk[2], pk[3]}; *(v2u*)(q + 1024 + 8 * lane) = (v2u){pk[4], pk[5]};
    if (lane == 0) sdst[row] = mx * (1.f / 7.5f);
}
template <bool VORD>
__device__ __forceinline__ void fp4_row_item(const float* src, unsigned char* dst, float* sdst, int row, int lane) {
    const float* p = src + (size_t)row * DM + (VORD ? 32 : 8) * lane; float v[32]; float ss = 0.f;
    if constexpr (VORD) {
#pragma unroll
        for (int j = 0; j < 8; ++j) { const f32x4 x = *(const f32x4*)(p + 4 * j); v[4 * j] = x[0]; v[4 * j + 1] = x[1]; v[4 * j + 2] = x[2]; v[4 * j + 3] = x[3]; } }
    else
#pragma unroll
    for (int j = 0; j < 4; ++j) { const f32x4 x = *(const f32x4*)(p + 512 * j), y = *(const f32x4*)(p + 512 * j + 4); v[8 * j] = x[0]; v[8 * j + 1] = x[1]; v[8 * j + 2] = x[2]; v[8 * j + 3] = x[3]; v[8 * j + 4] = y[0]; v[8 * j + 5] = y[1]; v[8 * j + 6] = y[2]; v[8 * j + 7] = y[3]; }
#pragma unroll
    for (int i = 0; i < 32; ++i) ss += v[i] * v[i];
    const float sc = fmaxf(0.5f * sqrtf(wave_sum(ss) * (1.f / DM)), 1e-30f), inv = 1.f / sc;
    unsigned w[4] = {0u, 0u, 0u, 0u};
#pragma unroll
    for (int d = 0; d < 4; ++d) {
        w[d] = __builtin_amdgcn_cvt_scalef32_pk_fp4_f32(w[d], v[8 * d] * inv, v[8 * d + 1] * inv, 1.0f, 0);
        w[d] = __builtin_amdgcn_cvt_scalef32_pk_fp4_f32(w[d], v[8 * d + 2] * inv, v[8 * d + 3] * inv, 1.0f, 1);
        w[d] = __builtin_amdgcn_cvt_scalef32_pk_fp4_f32(w[d], v[8 * d + 4] * inv, v[8 * d + 5] * inv, 1.0f, 2);
        w[d] = __builtin_amdgcn_cvt_scalef32_pk_fp4_f32(w[d], v[8 * d + 6] * inv, v[8 * d + 7] * inv, 1.0f, 3); }
    unsigned char* q = dst + (size_t)(row / NEXP) * NEXP * ROW4 + ((size_t)(lane >> 3) * NEXP + (size_t)(row % NEXP)) * 128 + 16 * (lane & 7);
    *(v4u*)q = (v4u){w[0], w[1], w[2], w[3]};
    if (lane == 0) sdst[row] = sc;
}
__device__ __forceinline__ void ph_prologue(const Args& a, LAS unsigned char* lds, int tid, int lane, int wave) {
    unsigned char* ws = a.ws;
    if (blockIdx.x < 192) {
        LAS float* cact = (LAS float*)lds;
        LAS float* red = (LAS float*)(lds + 16384);
        for (int i = tid; i < 2 * DM; i += NTHREADS) { const float cv = a.in[1][i]; cact[i] = cv / (1.f + __expf(-cv)); }
        __syncthreads();
        const int item = blockIdx.x, l = item / 96, col0 = (item % 96) * 128, rsub = lane >> 5, c4 = lane & 31;
        const float* W = a.in[2] + (size_t)l * DM * 12288 + col0 + 4 * c4;
        f32x4 acc0 = {0.f, 0.f, 0.f, 0.f}, acc1 = {0.f, 0.f, 0.f, 0.f};
#pragma unroll 8
        for (int i = 0; i < 128; ++i) { const int k = wave * 256 + 2 * i + rsub; const f32x4 w = *(const f32x4*)(W + (size_t)k * 12288);
            acc0 += w * cact[k]; acc1 += w * cact[DM + k]; }
#pragma unroll
        for (int e = 0; e < 4; ++e) { acc0[e] += __shfl_xor(acc0[e], 32); acc1[e] += __shfl_xor(acc1[e], 32); }
        if (rsub == 0) {
#pragma unroll
            for (int e = 0; e < 4; ++e) { red[(wave * 2 + 0) * 128 + 4 * c4 + e] = acc0[e]; red[(wave * 2 + 1) * 128 + 4 * c4 + e] = acc1[e]; } }
        __syncthreads();
        if (tid < 256) { const int b = tid >> 7, col = tid & 127; float s = 0.f;
#pragma unroll
            for (int w8 = 0; w8 < 8; ++w8) s += red[(w8 * 2 + b) * 128 + col];
            s += a.in[3][l * 12288 + col0 + col];
            ((float*)(ws + WS_MOD))[(size_t)(l * 2 + b) * 12288 + col0 + col] = s; }
        __syncthreads();
    }
    LAS float* scr = (LAS float*)(lds + wave * 16384);
    const int gw = blockIdx.x * NWAVES + wave, NGW = gridDim.x * NWAVES;
    constexpr int I_WIN = 32 * 96, I_SQ = 32 * 64, I_QKV = 32 * 192, I_POOL = 4 * 32, I_AX = 16 * 8, I_WF = 16, I_KEYS = 128, I_TAB = 2 * NEXP, I_LS = 1;
    constexpr int NITEMS = I_WIN + 4 * I_SQ + I_QKV + I_POOL + I_AX + I_WF + I_KEYS + 2 * I_TAB + I_LS;
    for (int it = gw; it < NITEMS; it += NGW) {
        int r = it;
        if (r < 2 * I_TAB) { if (r < I_TAB) fp4_row_item<false>(a.in[8], ws + WS_TU, (float*)(ws + WS_SU), r, lane); else if constexpr (V_FP4) fp4_row_item<true>(a.in[9], ws + WS_TV, (float*)(ws + WS_SV), r - I_TAB, lane); else fp6_row_item(a.in[9], ws + WS_TV, (float*)(ws + WS_SV), r - I_TAB, lane); continue; } r -= 2 * I_TAB;
        if (r < I_WIN) { transpose_item_i8(a.in[10], NZ, 96, ws + WS_WIN, DM, scr, r, lane, W8_SCALE); continue; } r -= I_WIN;
        if (r < I_SQ) { transpose_item8(a.in[20], DM, 64, ws + WS_WOUT, DM, scr, r, lane, W8O_SCALE); continue; } r -= I_SQ;
        if (r < I_QKV) { transpose_item8(a.in[21], NODIN, 192, ws + WS_WQKV, DM, scr, r, lane); continue; } r -= I_QKV;
        if (r < I_SQ) { transpose_item8(a.in[23], DM, 64, ws + WS_WO, DM, scr, r, lane, W8O_SCALE); continue; } r -= I_SQ;
        if (r < I_SQ) { transpose_item_i8(a.in[6], DM, 64, ws + WS_WQ0, DM, scr, r, lane, W8_SCALE); continue; } r -= I_SQ;
        if (r < I_SQ) { transpose_item_i8(a.in[6] + (size_t)DM * DM, DM, 64, ws + WS_WQ1, DM, scr, r, lane, W8_SCALE); continue; } r -= I_SQ;
        if (r < I_POOL) { const int g = r >> 5; transpose_item(a.in[11] + g * 65536, 256, 8, (bf16*)(ws + WS_WPOOL) + g * 65536, 256, scr, r & 31, lane); continue; } r -= I_POOL;
        if (r < I_AX) { const int h = r >> 4, which = (r >> 3) & 1;
            transpose_item(a.in[which ? 17 : 15] + h * 16384, 128, 4, (bf16*)(ws + WS_WAX) + h * 32768 + which * 16384, 128, scr, r & 7, lane); continue; } r -= I_AX;
        if (r < I_WF) { bf16* WF = (bf16*)(ws + WS_WF);
            for (int k = lane; k < DM; k += 64) { const float v = a.in[21][(size_t)k * NODIN + NQKV + r]; WF[r * DM + k] = (bf16)(pk2(v, v) & 0xffffu); } continue; } r -= I_WF;
        if (r < I_KEYS) { convert_item(a.in[7], (bf16*)(ws + WS_KEYS), (size_t)r, lane); continue; } r -= I_KEYS;
        { float* LS8 = (float*)(ws + WS_LS8);
            for (int cch = lane; cch < 1024; cch += 64) { const float x = a.in[19][cch]; LS8[cch] = 8.f * (fminf(x, 0.f) - log1pf(__expf(-fabsf(x)))); } }
    }
}

__device__ __forceinline__ void ph_modulate(const float* src, const float* mod_l  , int sh_off, int sc_off, bf16* dst, unsigned char* dst8, float* rs, int lane, int wave) {
    const int gw = blockIdx.x * NWAVES + wave, NGW = gridDim.x * NWAVES;
    int cur_b = -1; f32x4 scv[8], shv[8];
    for (int t = gw; t < M; t += NGW) {
        const int b = t >> 13;
        if (b != cur_b) { cur_b = b; const float* mb = mod_l + b * 12288;
#pragma unroll
            for (int j = 0; j < 8; ++j) { scv[j] = *(const f32x4*)(mb + sc_off + 4 * lane + 256 * j) + 1.f; shv[j] = *(const f32x4*)(mb + sh_off + 4 * lane + 256 * j); } }
        const float* xr = src + (size_t)t * DM + 4 * lane; bf16* dr = dst + (size_t)t * DM + 4 * lane; f32x4 v[8]; float mx = 0.f;
#pragma unroll
        for (int j = 0; j < 8; ++j) { v[j] = *(const f32x4*)(xr + 256 * j) * scv[j] + shv[j]; uint2 o; o.x = pk2(v[j][0], v[j][1]); o.y = pk2(v[j][2], v[j][3]); *(uint2*)(dr + 256 * j) = o;
            mx = fmaxf(mx, fmaxf(fmaxf(fabsf(v[j][0]), fabsf(v[j][1])), fmaxf(fabsf(v[j][2]), fabsf(v[j][3])))); }
        mx = fmaxf(wave_max(mx), 1e-30f); const float inv = 127.f / mx; unsigned* q8 = (unsigned*)(dst8 + (size_t)t * DM) + lane;
#pragma unroll
        for (int j = 0; j < 8; ++j) q8[64 * j] = pk4_i8(v[j][0] * inv, v[j][1] * inv, v[j][2] * inv, v[j][3] * inv);
        if (lane == 0) rs[t] = mx * (1.f / 127.f);
    }
}

__device__ __forceinline__ void ld8(const bf16* p, float (&v)[8]) { const v4u u = *(const v4u*)p; v[0] = bf_lo(u.x); v[1] = bf_hi(u.x); v[2] = bf_lo(u.y); v[3] = bf_hi(u.y); v[4] = bf_lo(u.z); v[5] = bf_hi(u.z); v[6] = bf_lo(u.w); v[7] = bf_hi(u.w); }
__device__ __forceinline__ void st8(bf16* p, const float (&v)[8]) { v4u o; o.x = pk2(v[0], v[1]); o.y = pk2(v[2], v[3]); o.z = pk2(v[4], v[5]); o.w = pk2(v[6], v[7]); *(v4u*)p = o; }
__device__ __forceinline__ void ph_poolconv(const Args& a, int lane, int wave) {
    const bf16* Z = (const bf16*)(a.ws + WS_ZB); bf16* PO = (bf16*)(a.ws + WS_PO); bf16* XC = (bf16*)(a.ws + WS_XC);
    const int gw = blockIdx.x * NWAVES + wave, NGW = gridDim.x * NWAVES;
    for (int item = gw; item < 2048; item += NGW) {
        const int which = item & 3, t0 = (item >> 2) * 32, pos0 = t0 & (SEQ - 1);
        if (which < 2) {
            const int c = which * 512 + lane * 8, w = 2 << (c >> 8);
            float sum[8] = {0.f, 0.f, 0.f, 0.f, 0.f, 0.f, 0.f, 0.f};
            for (int s = 1; s < 16; ++s) if (s < w && pos0 - s >= 0) { float v[8]; ld8(Z + (size_t)(t0 - s) * NZ + c, v);
#pragma unroll
                for (int e = 0; e < 8; ++e) sum[e] += v[e]; }
            for (int i = 0; i < 32; ++i) { const int t = t0 + i, pos = pos0 + i; float cur[8], o[8]; ld8(Z + (size_t)t * NZ + c, cur);
                const float inv = 1.f / (float)(pos + 1 < w ? pos + 1 : w);
#pragma unroll
                for (int e = 0; e < 8; ++e) { sum[e] += cur[e]; o[e] = sum[e] * inv - cur[e]; }
                st8(PO + (size_t)t * 1024 + c, o);
                if (pos - w + 1 >= 0) { float old[8]; ld8(Z + (size_t)(t - w + 1) * NZ + c, old);
#pragma unroll
                    for (int e = 0; e < 8; ++e) sum[e] -= old[e]; } }
        } else {
            const int c = (which - 2) * 512 + lane * 8; const bf16* zc = Z + 1024 + c;
            float w0[8], w1[8], w2[8], w3[8], bb[8], x3[8], x2[8], x1[8];
#pragma unroll
            for (int e = 0; e < 8; ++e) { w0[e] = a.in[13][0 * 1024 + c + e]; w1[e] = a.in[13][1 * 1024 + c + e]; w2[e] = a.in[13][2 * 1024 + c + e]; w3[e] = a.in[13][3 * 1024 + c + e]; bb[e] = a.in[14][c + e]; x3[e] = 0.f; x2[e] = 0.f; x1[e] = 0.f; }
            if (pos0 >= 3) ld8(zc + (size_t)(t0 - 3) * NZ, x3);
            if (pos0 >= 2) ld8(zc + (size_t)(t0 - 2) * NZ, x2);
            if (pos0 >= 1) ld8(zc + (size_t)(t0 - 1) * NZ, x1);
            for (int i = 0; i < 32; ++i) { const int t = t0 + i; float x0[8], o[8]; ld8(zc + (size_t)t * NZ, x0);
#pragma unroll
                for (int e = 0; e < 8; ++e) { o[e] = bb[e] + w0[e] * x3[e] + w1[e] * x2[e] + w2[e] * x1[e] + w3[e] * x0[e]; x3[e] = x2[e]; x2[e] = x1[e]; x1[e] = x0[e]; }
                st8(XC + (size_t)t * 1024 + c, o); }
        }
    }
}

__device__ __forceinline__ void ph_scan_agg(const Args& a, int tid) {
    const unsigned* AD = (const unsigned*)(a.ws + WS_AF);
    float* AG = (float*)(a.ws + WS_AG); float* HG = (float*)(a.ws + WS_HG);
    for (int w = blockIdx.x; w < 256; w += gridDim.x) {
        const int st = w >> 1, c = (w & 1) * 512 + tid; const size_t base = (size_t)st * 128 * 1024 + c;
        float LA = 0.f, H = 0.f;
#pragma unroll 32
        for (int i = 0; i < 128; ++i) { const unsigned pw = AD[base + (size_t)i * 1024]; const float la = bf_lo(pw), dv = bf_hi(pw); H = __builtin_amdgcn_exp2f(la) * H + dv; LA += la; }
        AG[st * 1024 + c] = __builtin_amdgcn_exp2f(LA); HG[st * 1024 + c] = H;
    }
}
__device__ __forceinline__ void ph_scan_fin(const Args& a, int tid) {
    const unsigned* AD = (const unsigned*)(a.ws + WS_AF);
    const float* AG = (const float*)(a.ws + WS_AG); const float* HG = (const float*)(a.ws + WS_HG);
    const bf16* Z = (const bf16*)(a.ws + WS_ZB); unsigned char* YC8 = a.ws + WS_YC8;
    for (int w = blockIdx.x; w < 256; w += gridDim.x) {
        const int st = w >> 1, c = (w & 1) * 512 + tid, sin = st & 63, sb = st - sin; const size_t base = (size_t)st * 128 * 1024 + c;
        float h = 0.f;
#pragma unroll 8
        for (int s = 0; s < sin; ++s) h = AG[(sb + s) * 1024 + c] * h + HG[(sb + s) * 1024 + c];
#pragma unroll 16
        for (int i = 0; i < 128; ++i) { const size_t t = (size_t)st * 128 + i; const unsigned pw = AD[base + (size_t)i * 1024];
            h = __builtin_amdgcn_exp2f(bf_lo(pw)) * h + bf_hi(pw); const float gt = __uint_as_float((unsigned)Z[t * NZ + 2048 + c] << 16);
            YC8[t * DM + 1024 + c] = (unsigned char)(pk4_fp8(h * gelu_tanh(gt) * Y8_SCALE, 0.f, 0.f, 0.f) & 0xffu); }
    }
}

template <bool RES_MOD>
__device__ __forceinline__ void ph_ln(const bf16* Y, const float* Xin, const bf16* HBres, const float* mod_res, const float* mod_l, const float* lng, const float* lnb, bf16* H2, unsigned char* H28, float* SH, unsigned char* H6, float* HS, int lane, int wave) {
    const int gw = blockIdx.x * NWAVES + wave, NGW = gridDim.x * NWAVES;
    v4u yc[4]; f32x4 xc[8]; v4u rc[4];
    { const size_t ro = (size_t)gw * DM + 8 * lane;
#pragma unroll
      for (int j = 0; j < 4; ++j) { yc[j] = *(const v4u*)(Y + ro + 512 * j);
          if constexpr (RES_MOD) rc[j] = *(const v4u*)(HBres + ro + 512 * j); else { xc[2 * j] = *(const f32x4*)(Xin + ro + 512 * j); xc[2 * j + 1] = *(const f32x4*)(Xin + ro + 512 * j + 4); } } }
#pragma unroll 1
    for (int t = gw; t < M; t += NGW) {
        const int b = t >> 13; const float* mb = mod_l + b * 12288; const size_t ro = (size_t)t * DM + 8 * lane;
        int ln = lane; asm volatile("" : "+v"(ln));
        const int tn = t + NGW < M ? t + NGW : t; const size_t rn = (size_t)tn * DM + 8 * lane;
        v4u yn[4]; f32x4 xn[8]; v4u rn4[4];
#pragma unroll
        for (int j = 0; j < 4; ++j) { yn[j] = *(const v4u*)(Y + rn + 512 * j);
            if constexpr (RES_MOD) rn4[j] = *(const v4u*)(HBres + rn + 512 * j); else { xn[2 * j] = *(const f32x4*)(Xin + rn + 512 * j); xn[2 * j + 1] = *(const f32x4*)(Xin + rn + 512 * j + 4); } }
        float v[32];
#pragma unroll
        for (int j = 0; j < 4; ++j) { const v4u u = yc[j]; const float y8[8] = {bf_lo(u.x), bf_hi(u.x), bf_lo(u.y), bf_hi(u.y), bf_lo(u.z), bf_hi(u.z), bf_lo(u.w), bf_hi(u.w)};
            f32x4 xa, xb;
            if constexpr (RES_MOD) { const v4u r = rc[j]; const float* mr = mod_res + b * 12288 + 8 * ln + 512 * j;
                const f32x4 sa = *(const f32x4*)(mr + 2048), sb = *(const f32x4*)(mr + 2048 + 4), ha = *(const f32x4*)(mr), hb = *(const f32x4*)(mr + 4);
                const float r8[8] = {bf_lo(r.x), bf_hi(r.x), bf_lo(r.y), bf_hi(r.y), bf_lo(r.z), bf_hi(r.z), bf_lo(r.w), bf_hi(r.w)};
#pragma unroll
                for (int e = 0; e < 4; ++e) { xa[e] = (r8[e] - ha[e]) * __builtin_amdgcn_rcpf(1.f + sa[e]); xb[e] = (r8[4 + e] - hb[e]) * __builtin_amdgcn_rcpf(1.f + sb[e]); } }
            else { xa = xc[2 * j]; xb = xc[2 * j + 1]; }
            const f32x4 ga = *(const f32x4*)(mb + 4096 + 8 * ln + 512 * j), gb = *(const f32x4*)(mb + 4096 + 8 * ln + 512 * j + 4);
#pragma unroll
            for (int e = 0; e < 4; ++e) { v[8 * j + e] = ALPHA * xa[e] + (1.f + ga[e]) * y8[e]; v[8 * j + 4 + e] = ALPHA * xb[e] + (1.f + gb[e]) * y8[4 + e]; } }
        float s = 0.f;
#pragma unroll
        for (int e = 0; e < 32; ++e) s += v[e];
        const float mean = wave_sum(s) * (1.f / DM); float q = 0.f;
#pragma unroll
        for (int e = 0; e < 32; ++e) { v[e] -= mean; q += v[e] * v[e]; }
        const float rstd = rsqrtf(wave_sum(q) * (1.f / DM) + LN_EPS); float hmx = 0.f;
#pragma unroll
        for (int j = 0; j < 4; ++j) { const int co = 8 * ln + 512 * j;
            const f32x4 la = *(const f32x4*)(lng + co), lb = *(const f32x4*)(lng + co + 4), ba = *(const f32x4*)(lnb + co), bb = *(const f32x4*)(lnb + co + 4);
            const f32x4 sa = *(const f32x4*)(mb + 8192 + co), sb = *(const f32x4*)(mb + 8192 + co + 4), ha = *(const f32x4*)(mb + 6144 + co), hb = *(const f32x4*)(mb + 6144 + co + 4);
            float h8[8];
#pragma unroll
            for (int e = 0; e < 4; ++e) { const float na = v[8 * j + e] * rstd * la[e] + ba[e], nb = v[8 * j + 4 + e] * rstd * lb[e] + bb[e];
                h8[e] = na * (1.f + sa[e]) + ha[e]; h8[4 + e] = nb * (1.f + sb[e]) + hb[e]; }
            st8(H2 + ro + 512 * j, h8);
#pragma unroll
            for (int e = 0; e < 8; ++e) { v[8 * j + e] = h8[e]; hmx = fmaxf(hmx, fabsf(h8[e])); } }
        hmx = fmaxf(wave_max(hmx), 1e-30f); const float inv = 127.f / hmx;
#pragma unroll
        for (int j = 0; j < 4; ++j) *(v2u*)(H28 + ro + 512 * j) = (v2u){pk4_i8(v[8 * j] * inv, v[8 * j + 1] * inv, v[8 * j + 2] * inv, v[8 * j + 3] * inv), pk4_i8(v[8 * j + 4] * inv, v[8 * j + 5] * inv, v[8 * j + 6] * inv, v[8 * j + 7] * inv)};
        if (lane == 0) SH[t] = hmx * (1.f / 127.f);
        { const float inv6 = 7.5f / hmx; f32x16_t pa, pb;
#pragma unroll
          for (int i = 0; i < 16; ++i) { pa[i] = v[2 * i] * inv6; pb[i] = v[2 * i + 1] * inv6; }
          const u32x6_t pk = __builtin_amdgcn_cvt_scalef32_2xpk16_fp6_f32(pa, pb, 1.0f); unsigned char* hq = H6 + (size_t)t * 1536;
          *(v4u*)(hq + 16 * lane) = (v4u){pk[0], pk[1], pk[2], pk[3]}; *(v2u*)(hq + 1024 + 8 * lane) = (v2u){pk[4], pk[5]};
          if (lane == 0) HS[t] = hmx * (1.f / 7.5f); }
#pragma unroll
        for (int j = 0; j < 4; ++j) { yc[j] = yn[j]; if constexpr (RES_MOD) rc[j] = rn4[j]; else { xc[2 * j] = xn[2 * j]; xc[2 * j + 1] = xn[2 * j + 1]; } }
    }
}

__device__ __forceinline__ unsigned mono(float f) { const unsigned u = __float_as_uint(f); return (u & 0x80000000u) ? ~u : (u | 0x80000000u); }
__device__ __forceinline__ float unmono(unsigned u) { return __uint_as_float((u & 0x80000000u) ? (u & 0x7fffffffu) : ~u); }
__device__ __forceinline__ unsigned umax_(unsigned a, unsigned b) { return a > b ? a : b; }
__device__ __forceinline__ unsigned umin_(unsigned a, unsigned b) { return a < b ? a : b; }
template <bool DESC> __device__ __forceinline__ void bsort16(unsigned (&k)[16]) {
#pragma unroll
    for (int size = 2; size <= 16; size <<= 1)
#pragma unroll
        for (int stride = size >> 1; stride > 0; stride >>= 1)
#pragma unroll
            for (int i = 0; i < 16; ++i) { const int j = i ^ stride;
                if (j > i) { const bool first_max = (((i & size) == 0) == DESC); const unsigned hi = umax_(k[i], k[j]), lo = umin_(k[i], k[j]); k[i] = first_max ? hi : lo; k[j] = first_max ? lo : hi; } }
}
template <bool DESC> __device__ __forceinline__ void bmerge16(unsigned (&k)[16]) {
#pragma unroll
    for (int stride = 8; stride > 0; stride >>= 1)
#pragma unroll
        for (int i = 0; i < 16; ++i) { const int j = i ^ stride;
            if (j > i) { const unsigned hi = umax_(k[i], k[j]), lo = umin_(k[i], k[j]); k[i] = DESC ? hi : lo; k[j] = DESC ? lo : hi; } }
}
__device__ __forceinline__ void top16_of_64(const unsigned (&k)[64], unsigned (&o)[16]) {
    unsigned g0[16], g1[16], g2[16], g3[16];
#pragma unroll
    for (int i = 0; i < 16; ++i) { g0[i] = k[i]; g1[i] = k[16 + i]; g2[i] = k[32 + i]; g3[i] = k[48 + i]; }
    bsort16<true>(g0); bsort16<false>(g1); bsort16<true>(g2); bsort16<false>(g3);
#pragma unroll
    for (int i = 0; i < 16; ++i) { g0[i] = umax_(g0[i], g1[i]); g2[i] = umax_(g2[i], g3[i]); }
    bmerge16<true>(g0); bmerge16<false>(g2);
#pragma unroll
    for (int i = 0; i < 16; ++i) o[i] = umax_(g0[i], g2[i]);
    bmerge16<true>(o);
}
__device__ __forceinline__ int swz16(int row, int cb) { return cb ^ ((row & 15) << 4); }
__device__ __forceinline__ void ph_topk(const Args& a, int layer, LAS unsigned char* lds, int tid, int lane, int wave) {
    const bf16* QP = (const bf16*)(a.ws + WS_QP); const bf16* KEYS = (const bf16*)(a.ws + WS_KEYS) + (size_t)layer * 8 * 2 * 128 * 128;
    int* EI = (int*)(a.ws + WS_EI); float* GT = (float*)(a.ws + WS_GT); const float* SVl = (const float*)(a.ws + WS_SV) + layer * NEXP;
    LAS unsigned char* kt = lds;
    LAS unsigned* lists = (LAS unsigned*)(lds + 65536 + wave * 4096);
    const int r32 = lane & 31, hi = lane >> 5, h = blockIdx.x & 7, wgr = blockIdx.x >> 3, nwgh = gridDim.x >> 3;
    { const bf16* kh = KEYS + (size_t)h * 2 * 128 * 128;
#pragma unroll
      for (int i = 0; i < 8; ++i) { const int ch = tid + i * NTHREADS, row = ch >> 4, cb = (ch & 15) * 16;
          *(LAS v4u*)(kt + row * 256 + swz16(row, cb)) = *(const v4u*)(kh + (size_t)row * 128 + (cb >> 1)); } }
    __syncthreads();
    if (wgr < nwgh) {
#pragma unroll 1
    for (int u = wgr * NWAVES + wave; u < M / 32; u += nwgh * NWAVES) {
        const int t0 = u * 32; const bf16* qrow = QP + (size_t)(t0 + r32) * DM + h * 256 + 8 * hi;
        unsigned LL[2][16];
#pragma unroll
        for (int p = 0; p < 2; ++p) {
            bf16x8 bq[8];
#pragma unroll
            for (int sI = 0; sI < 8; ++sI) bq[sI] = *(const bf16x8*)(qrow + p * 128 + 16 * sI);
            f32x16 acc[4];
#pragma unroll
            for (int blk = 0; blk < 4; ++blk)
#pragma unroll
                for (int e = 0; e < 16; ++e) acc[blk][e] = 0.f;
#pragma unroll
            for (int sI = 0; sI < 8; ++sI)
#pragma unroll
                for (int blk = 0; blk < 4; ++blk) { const int krow = p * 128 + blk * 32 + r32;
                    const bf16x8 ak = *(const LAS bf16x8*)(kt + krow * 256 + swz16(krow, (16 * sI + 8 * hi) * 2));
                    acc[blk] = __builtin_amdgcn_mfma_f32_32x32x16_bf16(ak, bq[sI], acc[blk], 0, 0, 0); }
            unsigned kk[64], o[16];
#pragma unroll
            for (int blk = 0; blk < 4; ++blk)
#pragma unroll
                for (int e = 0; e < 16; ++e) { const int n = 32 * blk + (e & 3) + 8 * (e >> 2) + 4 * hi; kk[blk * 16 + e] = (mono(acc[blk][e]) & ~127u) | (unsigned)(127 - n); }
            top16_of_64(kk, o);
#pragma unroll
            for (int i = 0; i < 16; ++i) LL[p][i] = umax_(o[i], (unsigned)__shfl_xor((int)o[15 - i], 32));
            bmerge16<true>(LL[p]);
            if (hi == 0) { LAS v4u* lp = (LAS v4u*)(lists + (p * 32 + r32) * 16);
#pragma unroll
                for (int i = 0; i < 4; ++i) lp[i] = (v4u){LL[p][4 * i], LL[p][4 * i + 1], LL[p][4 * i + 2], LL[p][4 * i + 3]}; }
        }
        unsigned tk[16];
        { float f1[16], f2[16];
#pragma unroll
          for (int i = 0; i < 16; ++i) { f1[i] = unmono(LL[0][i] & ~127u); f2[i] = unmono(LL[1][i] & ~127u); }
          unsigned cd[32];
          {
            cd[0] = hi ? ((mono(f1[2] + f2[1]) & ~255u) | 222u) : ((mono(f1[0] + f2[0]) & ~255u) | 255u);
            cd[1] = hi ? ((mono(f1[2] + f2[2]) & ~255u) | 221u) : ((mono(f1[0] + f2[1]) & ~255u) | 254u);
            cd[2] = hi ? ((mono(f1[2] + f2[3]) & ~255u) | 220u) : ((mono(f1[0] + f2[2]) & ~255u) | 253u);
            cd[3] = hi ? ((mono(f1[2] + f2[4]) & ~255u) | 219u) : ((mono(f1[0] + f2[3]) & ~255u) | 252u);
            cd[4] = hi ? ((mono(f1[3] + f2[0]) & ~255u) | 207u) : ((mono(f1[0] + f2[4]) & ~255u) | 251u);
            cd[5] = hi ? ((mono(f1[3] + f2[1]) & ~255u) | 206u) : ((mono(f1[0] + f2[5]) & ~255u) | 250u);
            cd[6] = hi ? ((mono(f1[3] + f2[2]) & ~255u) | 205u) : ((mono(f1[0] + f2[6]) & ~255u) | 249u);
            cd[7] = hi ? ((mono(f1[3] + f2[3]) & ~255u) | 204u) : ((mono(f1[0] + f2[7]) & ~255u) | 248u);
            cd[8] = hi ? ((mono(f1[4] + f2[0]) & ~255u) | 191u) : ((mono(f1[0] + f2[8]) & ~255u) | 247u);
            cd[9] = hi ? ((mono(f1[4] + f2[1]) & ~255u) | 190u) : ((mono(f1[0] + f2[9]) & ~255u) | 246u);
            cd[10] = hi ? ((mono(f1[4] + f2[2]) & ~255u) | 189u) : ((mono(f1[0] + f2[10]) & ~255u) | 245u);
            cd[11] = hi ? ((mono(f1[5] + f2[0]) & ~255u) | 175u) : ((mono(f1[0] + f2[11]) & ~255u) | 244u);
            cd[12] = hi ? ((mono(f1[5] + f2[1]) & ~255u) | 174u) : ((mono(f1[0] + f2[12]) & ~255u) | 243u);
            cd[13] = hi ? ((mono(f1[6] + f2[0]) & ~255u) | 159u) : ((mono(f1[0] + f2[13]) & ~255u) | 242u);
            cd[14] = hi ? ((mono(f1[6] + f2[1]) & ~255u) | 158u) : ((mono(f1[0] + f2[14]) & ~255u) | 241u);
            cd[15] = hi ? ((mono(f1[7] + f2[0]) & ~255u) | 143u) : ((mono(f1[0] + f2[15]) & ~255u) | 240u);
            cd[16] = hi ? ((mono(f1[7] + f2[1]) & ~255u) | 142u) : ((mono(f1[1] + f2[0]) & ~255u) | 239u);
            cd[17] = hi ? ((mono(f1[8] + f2[0]) & ~255u) | 127u) : ((mono(f1[1] + f2[1]) & ~255u) | 238u);
            cd[18] = hi ? ((mono(f1[9] + f2[0]) & ~255u) | 111u) : ((mono(f1[1] + f2[2]) & ~255u) | 237u);
            cd[19] = hi ? ((mono(f1[10] + f2[0]) & ~255u) | 95u) : ((mono(f1[1] + f2[3]) & ~255u) | 236u);
            cd[20] = hi ? ((mono(f1[11] + f2[0]) & ~255u) | 79u) : ((mono(f1[1] + f2[4]) & ~255u) | 235u);
            cd[21] = hi ? ((mono(f1[12] + f2[0]) & ~255u) | 63u) : ((mono(f1[1] + f2[5]) & ~255u) | 234u);
            cd[22] = hi ? ((mono(f1[13] + f2[0]) & ~255u) | 47u) : ((mono(f1[1] + f2[6]) & ~255u) | 233u);
            cd[23] = hi ? ((mono(f1[14] + f2[0]) & ~255u) | 31u) : ((mono(f1[1] + f2[7]) & ~255u) | 232u);
            cd[24] = hi ? ((mono(f1[15] + f2[0]) & ~255u) | 15u) : ((mono(f1[2] + f2[0]) & ~255u) | 223u);
            cd[25] = 0u;
            cd[26] = 0u;
            cd[27] = 0u;
            cd[28] = 0u;
            cd[29] = 0u;
            cd[30] = 0u;
            cd[31] = 0u;
          }
          unsigned g0[16], g1[16];
#pragma unroll
          for (int i = 0; i < 16; ++i) { g0[i] = cd[i]; g1[i] = cd[16 + i]; }
          bsort16<true>(g0); bsort16<false>(g1);
#pragma unroll
          for (int i = 0; i < 16; ++i) g0[i] = umax_(g0[i], g1[i]);
          bmerge16<true>(g0);
#pragma unroll
          for (int i = 0; i < 16; ++i) tk[i] = umax_(g0[i], (unsigned)__shfl_xor((int)g0[15 - i], 32));
          bmerge16<true>(tk); }
        float ev[16]; const float m0 = unmono(tk[0] & ~255u); float den = 0.f;
#pragma unroll
        for (int k = 0; k < 16; ++k) { ev[k] = __expf(unmono(tk[k] & ~255u) - m0); den += ev[k]; }
        const float rden = 1.f / den;
        const LAS unsigned* L1 = lists + r32 * 16; const LAS unsigned* L2 = lists + (32 + r32) * 16;
        int ei[16];
#pragma unroll
        for (int k = 0; k < 16; ++k) { const int id = 255 - (int)(tk[k] & 255u), i = id >> 4, j = id & 15;
            const int n1 = 127 - (int)(L1[i] & 127u), n2 = 127 - (int)(L2[j] & 127u); ei[k] = n1 * 128 + n2; }
        if (hi == 0) { int* ep = EI + (size_t)(t0 + r32) * 128 + h * 16;
#pragma unroll
            for (int k = 0; k < 4; ++k) *(int4*)(ep + 4 * k) = make_int4(ei[4 * k], ei[4 * k + 1], ei[4 * k + 2], ei[4 * k + 3]); }
        else { float* gp = GT + (size_t)(t0 + r32) * 128 + h * 16; float gg[16];
#pragma unroll
            for (int k = 0; k < 16; ++k) gg[k] = ev[k] * rden * SVl[ei[k]];
#pragma unroll
            for (int k = 0; k < 4; ++k) *(f32x4*)(gp + 4 * k) = (f32x4){gg[4 * k], gg[4 * k + 1], gg[4 * k + 2], gg[4 * k + 3]}; }
    } }
    __syncthreads();
}

typedef int i32x8_t __attribute__((ext_vector_type(8)));
__device__ __forceinline__ void peer_slice(const Args& a, volatile LAS unsigned* st, int& x, int& rank, int& nrank) {
    (void)a; nrank = (int)(gridDim.x >> 3); const bool uni = st[4] != 0u;
    if (uni) { x = (int)st[3]; rank = (int)st[2]; } else { x = (int)(blockIdx.x & 7u); rank = (int)(blockIdx.x >> 3); }
    x = __builtin_amdgcn_readfirstlane(x); rank = __builtin_amdgcn_readfirstlane(rank);
}
__device__ __forceinline__ void ph_peer_u(const Args& a, int layer, volatile LAS unsigned* st, LAS unsigned char* lds, int lane, int wave) {
    int x, rank, nrank; peer_slice(a, st, x, rank, nrank); const int m16 = lane & 15, kc = lane >> 4, r8 = lane >> 3, sg = lane & 7;
    const unsigned char* TUb = a.ws + WS_TU + (size_t)layer * NEXP * ROW4 + (size_t)x * NEXP * 128;
    const unsigned char* H6 = a.ws + WS_H6 + 16 * (8 * x + kc); const int* EI = (const int*)(a.ws + WS_EI) + lane; bf16* PART = (bf16*)(a.ws + WS_PART) + x * 128 + 32 * kc;
    if (rank >= nrank) return;
    const int t0 = rank * NWAVES + wave, ts = nrank * NWAVES, nt = (M - t0 + ts - 1) / ts;
    LAS unsigned char* ub = lds + wave * 2304; LAS unsigned char* ubw = ub + r8 * 144 + 16 * sg; const LAS unsigned char* ubr = ub + m16 * 144 + 16 * kc;
    v4u U[8][2]; v4u ha[2], han[2]; v2u hb[2], hbn[2]; int en0 = 0, en1 = 0;
#pragma unroll
    for (int g = 0; g < 8; ++g) { U[g][0] = (v4u){0u, 0u, 0u, 0u}; U[g][1] = U[g][0]; }
    ha[0] = ha[1] = (v4u){0u, 0u, 0u, 0u}; hb[0] = hb[1] = (v2u){0u, 0u};
#pragma unroll 1
    for (int k = -2; k < nt; ++k) {
        const int k2 = k + 2 < nt ? k + 2 : nt - 1, k1 = k + 1 < nt ? (k + 1 < 0 ? 0 : k + 1) : nt - 1;
        const size_t tn2 = (size_t)(t0 + ts * k2), tn1 = (size_t)(t0 + ts * k1);
        const int enn0 = EI[tn2 * 128], enn1 = EI[tn2 * 128 + 64];
        { const unsigned char* hp = H6 + tn1 * 1536;
#pragma unroll
          for (int i = 0; i < 2; ++i) { han[i] = *(const v4u*)(hp + 64 * i); hbn[i] = *(const v2u*)(hp + 1024 - 8 * (8 * x + kc) + 32 * i); } }
        bf16* pp = PART + (size_t)(t0 + ts * (k < 0 ? 0 : k)) * 1024; unsigned pv0 = 0u, pv1 = 0u;
#pragma unroll
        for (int g = 0; g < 8; ++g) {
            { f32x4 acc = {0.f, 0.f, 0.f, 0.f};
                if (k >= 0) {
                    *(LAS v4u*)ubw = U[g][0]; *(LAS v4u*)(ubw + 8 * 144) = U[g][1];
#pragma unroll
                    for (int i = 0; i < 2; ++i) { const v4u uu = *(const LAS v4u*)(ubr + 64 * i); const i32x8_t A8 = {(int)uu.x, (int)uu.y, (int)uu.z, (int)uu.w, 0, 0, 0, 0};
                        const i32x8_t B8 = {(int)ha[i].x, (int)ha[i].y, (int)ha[i].z, (int)ha[i].w, (int)hb[i].x, (int)hb[i].y, 0, 0};
                        acc = __builtin_amdgcn_mfma_scale_f32_16x16x128_f8f6f4(A8, B8, acc, 4, 2, 0, 127, 0, 127); } }
                if ((g & 1) == 0) { pv0 = pk2c(acc[0], acc[1]); pv1 = pk2c(acc[2], acc[3]); }
                else if (m16 == 0) *(v4u*)(pp + 4 * (g - 1)) = (v4u){pv0, pv1, pk2c(acc[0], acc[1]), pk2c(acc[2], acc[3])}; }
#pragma unroll
            for (int j = 0; j < 2; ++j) { const int em = __shfl(g < 4 ? en0 : en1, (g & 3) * 16 + 8 * j + r8); U[g][j] = *(const v4u*)(TUb + (unsigned)(em * 128 + 16 * sg)); }
            __builtin_amdgcn_sched_barrier(0);
        }
#pragma unroll
        for (int i = 0; i < 2; ++i) { ha[i] = han[i]; hb[i] = hbn[i]; }
        en0 = enn0; en1 = enn1;
    }
}
__device__ __forceinline__ void ph_peer_coef(const Args& a, int layer, LAS unsigned char* lds, int lane, int wave) {
    const int p0 = 16 * ((lane >> 1) & 7) + 4 * (lane >> 4) + 2 * (lane & 1);
    const int* EI = (const int*)(a.ws + WS_EI) + p0; const float* GT = (const float*)(a.ws + WS_GT) + p0; const unsigned* PART = (const unsigned*)(a.ws + WS_PART) + lane;
    const float* SU = (const float*)(a.ws + WS_SU) + layer * NEXP; const float* HS = (const float*)(a.ws + WS_HS);
    unsigned char* AR = a.ws + WS_AR; int* EQ = (int*)(a.ws + WS_EQ) + (p0 & 7) * 16 + (p0 >> 3);
    LAS float* CFL = (LAS float*)(lds + wave * 1024);
    const int gw = blockIdx.x * NWAVES + wave, NGW = gridDim.x * NWAVES;
#pragma unroll 1
    for (int t = gw; t < M; t += NGW) {
        const size_t tt = (size_t)t; const int2 ee = *(const int2*)(EI + tt * 128); const float2 gg = *(const float2*)(GT + tt * 128); const float hs = HS[t];
        unsigned P[8];
#pragma unroll
        for (int xx = 0; xx < 8; ++xx) P[xx] = PART[(tt * 8 + xx) * 64];
        const float s0 = SU[ee.x], s1 = SU[ee.y];
        const float d0 = ((bf_lo(P[0]) + bf_lo(P[1])) + (bf_lo(P[2]) + bf_lo(P[3]))) + ((bf_lo(P[4]) + bf_lo(P[5])) + (bf_lo(P[6]) + bf_lo(P[7])));
        const float d1 = ((bf_hi(P[0]) + bf_hi(P[1])) + (bf_hi(P[2]) + bf_hi(P[3]))) + ((bf_hi(P[4]) + bf_hi(P[5])) + (bf_hi(P[6]) + bf_hi(P[7])));
        const float c0 = gelu_tanh(d0 * hs * s0) * gg.x, c1 = gelu_tanh(d1 * hs * s1) * gg.y;
        EQ[tt * 128] = ee.x * 128; EQ[tt * 128 + 16] = ee.y * 128;
        const float cmx = fmaxf(wave_max(fmaxf(fabsf(c0), fabsf(c1))), 1e-30f), csc = 7.5f / cmx;
        CFL[p0] = c0 * csc; CFL[p0 + 1] = c1 * csc;
        f32x16_t pa, pb;
#pragma unroll
        for (int i = 0; i < 8; ++i) { const f32x4 c4 = *(const LAS f32x4*)(CFL + 32 * (lane & 3) + 4 * i); pa[2 * i] = c4[0]; pb[2 * i] = c4[1]; pa[2 * i + 1] = c4[2]; pb[2 * i + 1] = c4[3]; }
        const u32x6_t ph = __builtin_amdgcn_cvt_scalef32_2xpk16_fp6_f32(pa, pb, 1.0f);
        if (lane < 4) { unsigned char* rp = AR + tt * 128 + 32 * lane; *(v4u*)rp = (v4u){ph[0], ph[1], ph[2], ph[3]}; *(v4u*)(rp + 16) = (v4u){ph[4], ph[5], __float_as_uint(cmx * (1.f / 7.5f)), 0u}; }
    }
}
__device__ __forceinline__ void ph_peer_v(const Args& a, int layer, volatile LAS unsigned* st, LAS unsigned char* lds, int lane, int wave) {
    int x, rank, nrank; peer_slice(a, st, x, rank, nrank); const int q = lane >> 3, sg = lane & 7, n16 = lane & 15, kc = lane >> 4;
    const unsigned char* TVb = a.ws + WS_TV + (size_t)layer * NEXP * ROWV + (size_t)x * NEXP * 128;
    const int* EQ = (const int*)(a.ws + WS_EQ) + q * 16; const unsigned char* AR = a.ws + WS_AR + 32 * kc;
    if (rank >= nrank) return;
    const int t0 = rank * NWAVES + wave, ts = nrank * NWAVES, nt = (M - t0 + ts - 1) / ts;
    constexpr int VS = 144;
    LAS unsigned char* img = lds + wave * (128 * VS);
    LAS unsigned char* iw = img + q * VS + 16 * sg;
    const LAS unsigned char* ir = img + (32 * kc + n16) * VS;
    typedef int v2i_ __attribute__((ext_vector_type(2)));
    int inv16, ncol; bool tr_ok;
    { *(LAS v2u*)(ir) = (v2u){0x11111111u * (unsigned)n16, 0x11111111u * (unsigned)n16};
      const v2i_ ra = __builtin_amdgcn_ds_read_tr4_b64_v2i32((LAS v2i_*)ir);
      *(LAS v2u*)(ir) = (v2u){0x76543210u, 0xfedcba98u};
      const v2i_ rb = __builtin_amdgcn_ds_read_tr4_b64_v2i32((LAS v2i_*)ir);
      const unsigned r0 = (unsigned)__builtin_amdgcn_readfirstlane(ra.x), r1 = (unsigned)__builtin_amdgcn_readfirstlane(ra.y);
      ncol = rb.x & 15; inv16 = 0; unsigned seen = 0u;
#pragma unroll
      for (int e = 0; e < 16; ++e) { const int rr = (int)(((e < 8 ? r0 : r1) >> (4 * (e & 7))) & 15u); if (rr == n16) inv16 = e; seen |= 1u << rr; }
      bool ok = (unsigned)ra.x == r0 && (unsigned)ra.y == r1 && (unsigned)rb.x == 0x11111111u * (unsigned)ncol && (unsigned)rb.y == 0x11111111u * (unsigned)ncol && seen == 0xffffu;
      unsigned cols = 0u;
#pragma unroll
      for (int i = 0; i < 16; ++i) cols |= 1u << (__shfl(ncol, i) & 15);
      ok = ok && cols == 0xffffu;
      ok = ok && r0 == 0x76543210u && r1 == 0xfedcba98u && ncol == n16;
      tr_ok = __all(ok); }
    unsigned char* Y4 = a.ws + WS_Y + 256 * x + 4 * lane;
    (void)inv16;
    v4u W[16];
#pragma unroll
    for (int i = 0; i < 16; ++i) W[i] = (v4u){0u, 0u, 0u, 0u};
    v4u epn[4], ar0 = {0u, 0u, 0u, 0u}, ar1 = ar0;
#pragma unroll
    for (int j = 0; j < 4; ++j) epn[j] = (v4u){0u, 0u, 0u, 0u};
#pragma unroll 1
    for (int k = -2; k < nt; ++k) {
        const int k2 = k + 2 < nt ? k + 2 : nt - 1, k1 = k + 1 < nt ? (k + 1 < 0 ? 0 : k + 1) : nt - 1; const size_t tn2 = (size_t)(t0 + ts * k2), tn1 = (size_t)(t0 + ts * k1);
        v4u epnn[4];
#pragma unroll
        for (int j = 0; j < 4; ++j) epnn[j] = *(const v4u*)(EQ + tn2 * 128 + 4 * j);
        const v4u arn0 = *(const v4u*)(AR + tn1 * 128), arn1 = *(const v4u*)(AR + tn1 * 128 + 16);
        int ep[16];
#pragma unroll
        for (int j = 0; j < 4; ++j) { ep[4 * j] = (int)epn[j].x; ep[4 * j + 1] = (int)epn[j].y; ep[4 * j + 2] = (int)epn[j].z; ep[4 * j + 3] = (int)epn[j].w; }
        __builtin_amdgcn_sched_barrier(0);
#pragma unroll
        for (int i = 0; i < 16; ++i) {
            *(LAS v4u*)(iw + 8 * i * VS) = W[i];
            W[i] = *(const v4u*)(TVb + (unsigned)(ep[i] + 16 * sg));
            __builtin_amdgcn_sched_barrier(0);
        }
        float yv[16];
#pragma unroll
        for (int j = 0; j < 16; ++j) yv[j] = 0.f;
        if (k >= 0) {
            i32x8_t A8 = {(int)ar0.x, (int)ar0.y, (int)ar0.z, (int)ar0.w, (int)ar1.x, (int)ar1.y, 0, 0};
            if (n16 != 0) A8 = (i32x8_t){0, 0, 0, 0, 0, 0, 0, 0};
            const float ysc = __uint_as_float(ar1.z);
#pragma unroll
            for (int j = 0; j < 16; ++j) {
                const v2i_ b0 = __builtin_amdgcn_ds_read_tr4_b64_v2i32((LAS v2i_*)(ir + 8 * j)), b1 = __builtin_amdgcn_ds_read_tr4_b64_v2i32((LAS v2i_*)(ir + 16 * VS + 8 * j));
                const i32x8_t B8 = {b0.x, b0.y, b1.x, b1.y, 0, 0, 0, 0};
                const f32x4 acc = __builtin_amdgcn_mfma_scale_f32_16x16x128_f8f6f4(A8, B8, (f32x4){0.f, 0.f, 0.f, 0.f}, 2, 4, 0, 127, 0, 127);
                yv[j] = acc[0] * ysc; }
        }
        if (!tr_ok) { _Pragma("unroll") for (int j = 0; j < 16; ++j) yv[j] = __builtin_nanf(""); }
        { LAS float* yl = (LAS float*)img;
          if (kc == 0) {
#pragma unroll
              for (int j = 0; j < 16; ++j) yl[16 * j + ncol] = yv[j]; }
          const f32x4 y4 = *(const LAS f32x4*)(yl + 4 * lane);
          *(unsigned*)(Y4 + (size_t)(t0 + ts * (k < 0 ? 0 : k)) * DM) = pk4_fp8(y4[0] * YP_SCALE, y4[1] * YP_SCALE, y4[2] * YP_SCALE, y4[3] * YP_SCALE); }
        ar0 = arn0; ar1 = arn1;
#pragma unroll
        for (int j = 0; j < 4; ++j) epn[j] = epnn[j];
    }
}
template <bool FINAL>
__device__ __forceinline__ void ph_peer_ln(const Args& a, const float* mod_l, const float* mod_next, const float* lng, const float* lnb, int lane, int wave) {
    const bf16* H2 = (const bf16*)(a.ws + WS_H2); bf16* HB = (bf16*)(a.ws + WS_HB); const unsigned char* Y = a.ws + WS_Y;
    const int gw = blockIdx.x * NWAVES + wave, NGW = gridDim.x * NWAVES;
#pragma unroll 1
    for (int t = gw; t < M; t += NGW) {
        const int b = t >> 13;
        float out[32];
        { unsigned lo0 = (unsigned)lane * 4u; asm volatile("" : "+v"(lo0)); const unsigned char* yrow = Y + (size_t)t * DM;
#pragma unroll
          for (int j = 0; j < 8; ++j) { const unsigned yw = *(const unsigned*)(yrow + lo0 + 256 * j); const auto ya = __builtin_amdgcn_cvt_pk_f32_fp8((int)yw, false), yb = __builtin_amdgcn_cvt_pk_f32_fp8((int)yw, true);
              out[4 * j] = ya[0] * (1.f / YP_SCALE); out[4 * j + 1] = ya[1] * (1.f / YP_SCALE); out[4 * j + 2] = yb[0] * (1.f / YP_SCALE); out[4 * j + 3] = yb[1] * (1.f / YP_SCALE); } }
        unsigned lo = (unsigned)lane * 16u; asm volatile("" : "+v"(lo));
        const char* mb = (const char*)(mod_l + b * 12288); const char* h2row = (const char*)(H2 + (size_t)t * DM);
#define LD4_(base, j_) (*(const f32x4*)((const char*)(base) + lo + 1024 * (j_)))
#pragma unroll
        for (int j = 0; j < 8; ++j) { const v2u hw = *(const v2u*)(h2row + (lo >> 1) + 512 * j); const float h4[4] = {bf_lo(hw.x), bf_hi(hw.x), bf_lo(hw.y), bf_hi(hw.y)};
            const f32x4 ga = LD4_(mb + 10240 * 4, j), sf = LD4_(mb + 8192 * 4, j), hf = LD4_(mb + 6144 * 4, j);
#pragma unroll
            for (int e = 0; e < 4; ++e) { const float x1 = (h4[e] - hf[e]) * __builtin_amdgcn_rcpf(1.f + sf[e]); out[4 * j + e] = ALPHA * x1 + (1.f + ga[e]) * out[4 * j + e]; } }
        float s = 0.f;
#pragma unroll
        for (int e = 0; e < 32; ++e) s += out[e];
        const float mean = wave_sum(s) * (1.f / DM); float q2 = 0.f;
#pragma unroll
        for (int e = 0; e < 32; ++e) { out[e] -= mean; q2 += out[e] * out[e]; }
        const float rstd = rsqrtf(wave_sum(q2) * (1.f / DM) + LN_EPS);
        const char* mn = (const char*)(mod_next + b * 12288); char* orow = (char*)(a.out + (size_t)t * DM); char* hrow = (char*)(HB + (size_t)t * DM);
        float hmx = 0.f; (void)hmx;
#pragma unroll
        for (int j = 0; j < 8; ++j) { const f32x4 la = LD4_(lng, j), ba = LD4_(lnb, j); f32x4 na;
#pragma unroll
            for (int e = 0; e < 4; ++e) na[e] = out[4 * j + e] * rstd * la[e] + ba[e];
            if constexpr (FINAL) *(f32x4*)(orow + lo + 1024 * j) = na;
            else { const f32x4 sa = LD4_(mn + 2048 * 4, j), ha = LD4_(mn, j);
#pragma unroll
                for (int e = 0; e < 4; ++e) { const float hn = na[e] * (1.f + sa[e]) + ha[e]; out[4 * j + e] = hn; hmx = fmaxf(hmx, fabsf(hn)); }
                *(v2u*)(hrow + (lo >> 1) + 512 * j) = (v2u){pk2(out[4 * j], out[4 * j + 1]), pk2(out[4 * j + 2], out[4 * j + 3])}; } }
        if constexpr (!FINAL) {
            hmx = fmaxf(wave_max(hmx), 1e-30f); const float inv8 = 240.f / hmx; unsigned char* h8row = a.ws + WS_HB8 + (size_t)t * DM;
#pragma unroll
            for (int j = 0; j < 8; ++j) { unsigned w = 0u; w = __builtin_amdgcn_cvt_pk_fp8_f32(out[4 * j] * inv8, out[4 * j + 1] * inv8, w, false); w = __builtin_amdgcn_cvt_pk_fp8_f32(out[4 * j + 2] * inv8, out[4 * j + 3] * inv8, w, true);
                *(unsigned*)(h8row + (lo >> 2) + 256 * j) = w; }
            if (lane == 0) ((float*)(a.ws + WS_SA))[t] = hmx * (1.f / 240.f); }
#undef LD4_
    }
}

__device__ __forceinline__ void ph_forget(const Args& a, LAS unsigned char* lds, int lane, int wave) {
    const bf16* HB = (const bf16*)(a.ws + WS_HB); const bf16* WF = (const bf16*)(a.ws + WS_WF); float* LF = (float*)(a.ws + WS_LF);
    const int m16 = lane & 15, kc = lane >> 4, kh = wave & 1;
    LAS f32x4* xch = (LAS f32x4*)lds;
    for (int base = blockIdx.x * (NWAVES / 2); base < M / 16; base += gridDim.x * (NWAVES / 2)) {
        const int item = base + (wave >> 1); const bool live = item < M / 16;
        const int t0 = (live ? item : 0) * 16; f32x4 acc = {0.f, 0.f, 0.f, 0.f};
        const bf16* ap = HB + (size_t)(t0 + m16) * DM + 8 * kc + 1024 * kh; const bf16* bp = WF + (size_t)m16 * DM + 8 * kc + 1024 * kh;
#pragma unroll 16
        for (int s = 0; s < 32; ++s) { const bf16x8 av = *(const bf16x8*)(ap + 32 * s), bv = *(const bf16x8*)(bp + 32 * s); acc = __builtin_amdgcn_mfma_f32_16x16x32_bf16(av, bv, acc, 0, 0, 0); }
        xch[wave * 64 + lane] = acc;
        __syncthreads();
        if (kh == 0 && live) { const f32x4 oth = xch[(wave + 1) * 64 + lane]; const float bfv = a.in[22][m16]; f32x4 o;
#pragma unroll
            for (int r = 0; r < 4; ++r) { const float x = acc[r] + oth[r] + bfv; o[r] = fminf(x, 0.f) - log1pf(__expf(-fabsf(x))); }
            const int t = t0 + 4 * kc, b = t >> 13, pos = t & (SEQ - 1);
            *(f32x4*)(LF + (size_t)(b * 16 + m16) * SEQ + pos) = o; }
        __syncthreads();
    }
}
__device__ __forceinline__ void ph_cumsum(const Args& a, int lane, int wave) {
    const float* LF = (const float*)(a.ws + WS_LF); float* FB = (float*)(a.ws + WS_FB);
    float* FE = (float*)(a.ws + WS_FE); float* FP = (float*)(a.ws + WS_FP);
    const int gw = blockIdx.x * NWAVES + wave, NGW = gridDim.x * NWAVES;
    const int sidx = NGW >= 1056 ? gw - 1024 : gw;
    for (int seq = sidx; seq >= 0 && seq < 32; seq += NGW) {
        const float* src = LF + (size_t)seq * SEQ + lane * 128; float* dst = FB + (size_t)seq * SEQ + lane * 128;
        f32x4 vv[32];
#pragma unroll
        for (int i = 0; i < 32; ++i) vv[i] = *(const f32x4*)(src + 4 * i);
        float s = 0.f;
#pragma unroll
        for (int i = 0; i < 32; ++i) s += (vv[i][0] + vv[i][1]) + (vv[i][2] + vv[i][3]);
        float inc = s;
#pragma unroll
        for (int o = 1; o < 64; o <<= 1) { const float n = __shfl_up(inc, o); if (lane >= o) inc += n; }
        float run = inc - s;
#pragma unroll
        for (int i = 0; i < 32; ++i) { const f32x4 v = vv[i]; f32x4 o;
            run += v[0]; o[0] = run; run += v[1]; o[1] = run; run += v[2]; o[2] = run; run += v[3]; o[3] = run;
            if (i == 0 && (lane & 1) == 0) FP[seq * 32 + (lane >> 1)] = -o[0];
            if (i == 15) FE[seq * 128 + 2 * lane] = -o[3];
            if (i == 31) FE[seq * 128 + 2 * lane + 1] = -o[3];
            *(f32x4*)(dst + 4 * i) = o * (-1.f / ATT_SCALE); }
    }
    const bf16* QK = (const bf16*)(a.ws + WS_ZB);
    for (int item = gw; item < 1024; item += NGW) {
        const int seq = item >> 5, blk = item & 31, b = seq >> 4, h = seq & 15;
        const bf16* qb = QK + ((size_t)b * SEQ + (size_t)blk * 256) * DM + h * 128 + 8 * (lane & 15); const bf16* kb = qb + (size_t)M * DM;
        float mq = 0.f, mk = 0.f, md = 3.0e38f;
#pragma unroll 8
        for (int r = 0; r < 64; ++r) { const size_t ro = (size_t)(4 * r + (lane >> 4)) * DM; float vq[8], vk[8]; ld8(qb + ro, vq); ld8(kb + ro, vk);
            float sq = 0.f, sk = 0.f, sd = 0.f;
#pragma unroll
            for (int e = 0; e < 8; ++e) { sq += vq[e] * vq[e]; sk += vk[e] * vk[e]; sd += vq[e] * vk[e]; }
            sq += SWZ_XOR_(sq, 1); sk += SWZ_XOR_(sk, 1); sd += SWZ_XOR_(sd, 1); sq += SWZ_XOR_(sq, 2); sk += SWZ_XOR_(sk, 2); sd += SWZ_XOR_(sd, 2);
            sq += SWZ_XOR_(sq, 4); sk += SWZ_XOR_(sk, 4); sd += SWZ_XOR_(sd, 4); sq += SWZ_XOR_(sq, 8); sk += SWZ_XOR_(sk, 8); sd += SWZ_XOR_(sd, 8);
            mq = fmaxf(mq, sq); mk = fmaxf(mk, sk); md = fminf(md, sd); }
        mq = wave_max(mq); mk = wave_max(mk); md = -wave_max(-md);
        if (lane == 0) { ((float*)(a.ws + WS_QN))[seq * 32 + blk] = mq; ((float*)(a.ws + WS_KN))[seq * 32 + blk] = mk; ((float*)(a.ws + WS_DN))[seq * 32 + blk] = md; }
    }
}

constexpr float SKIP_T = 20.f;
__device__ __forceinline__ attn::BlockRef<__hip_bfloat16, __hip_bfloat16> attn_mkref(int L, const __hip_bfloat16* Q, const __hip_bfloat16* K, const __hip_bfloat16* V, __hip_bfloat16* O, const unsigned char* ws, int lane) {
    const int qb = 31 - (L >> 5), seq = L & 31, b = seq >> 4, h = seq & 15;
    attn::BlockRef<__hip_bfloat16, __hip_bfloat16> r; const size_t rowq = (size_t)b * SEQ + (size_t)qb * attn::QB, row0 = (size_t)b * SEQ;
    r.Q = Q + rowq * DM + h * 128; r.O = O + rowq * DM + h * 128; r.K = K + row0 * DM + h * 128; r.V = V + row0 * DM + h * 128; r.Fb = (const float*)(ws + WS_FB) + (size_t)seq * SEQ; r.P0 = qb * attn::QB; r.O8 = (unsigned char*)ws + WS_YC8 + rowq * DM + h * 128;
    const char* FE = (const char*)((const float*)(ws + WS_FE) + seq * 128); const char* KN = (const char*)((const float*)(ws + WS_KN) + seq * 32);
    unsigned l4 = (unsigned)lane * 4u; asm volatile("" : "+v"(l4));
    const float kn = wave_max((lane & 31) <= qb ? *(const float*)(KN + (l4 & 124u)) : 0.f), qn = ((const float*)(ws + WS_QN))[seq * 32 + qb], fp = ((const float*)(ws + WS_FP))[seq * 32 + qb];
    const float dn = ((const float*)(ws + WS_DN))[seq * 32 + qb];
    const float tgt = fp - (SKIP_T + (sqrtf(qn * kn) * 1.0001f - dn) * ATT_SCALE);
    const int cnt = __popcll(__ballot(*(const float*)(FE + l4) <= tgt)) + __popcll(__ballot(*(const float*)(FE + 256 + l4) <= tgt));
    r.jlo = cnt < 4 * qb ? cnt : 4 * qb;
    return r;
}
__device__ __forceinline__ void ph_attention(const Args& a, char* lds, const int tid) {
    using namespace attn;
    typedef __hip_bfloat16 T;
    const T* Q = (const T*)(a.ws + WS_ZB); const T* K = Q + (size_t)M * DM; const T* V = K + (size_t)M * DM; T* O = (T*)(a.ws + WS_YC);
    unsigned* ctr = (unsigned*)(a.ws + 32768);
    volatile int* nextw = (volatile int*)(lds + attn::LDS_BYTES);
    const int lane = tid & 63, total = 1024;
    int L = blockIdx.x; if (L >= total) return;
    BlockRef<T, T> cur = attn_mkref(L, Q, K, V, O, a.ws, lane);
    Seam<T> S;
    causal_swa_prime<T, T>(cur, SEQ, lds, S, tid);
    for (;;) {
        if (tid == 0) *nextw = (int)gridDim.x + (int)__hip_atomic_fetch_add(ctr, 1u, __ATOMIC_RELAXED, __HIP_MEMORY_SCOPE_AGENT);
        __syncthreads();
        const int Ln = __builtin_amdgcn_readfirstlane(*nextw); const bool last = Ln >= total;
        const BlockRef<T, T> nxt = last ? cur : attn_mkref(Ln, Q, K, V, O, a.ws, lane);
        causal_swa_block<T, T>(cur, nxt, SEQ, SEQ, lds, S, tid);
        if (last) break;
        cur = nxt; L = Ln;
    }
}

__global__ void __launch_bounds__(NTHREADS, 2) mk_fwd(Args a) {
    extern __shared__ __attribute__((aligned(16))) unsigned char lds_raw[];
    cg::grid_group grid = cg::this_grid();
    LAS unsigned char* lds = (LAS unsigned char*)lds_raw;
    const int wave = __builtin_amdgcn_readfirstlane((int)threadIdx.x >> 6);
    unsigned char* ws = a.ws;
    const float* MOD = (const float*)(ws + WS_MOD);
    const int lo = a.ph_lo, hi = a.ph_hi;
    XcdBarrier bar;
    { const int l0 = lane_id(); volatile LAS unsigned* st = (volatile LAS unsigned*)(lds + LDS_CTL);
      if (wave == 0 && l0 == 0) { st[0] = 0u; st[1] = 0u; }
      __syncthreads();
      bar.bar = (unsigned*)ws; bar.x = xb_xcc_id(); bar.st = st;
      if (lo == 0) { if (blockIdx.x == 0) { unsigned* z = (unsigned*)ws; const int t_ = wave * 64 + l0;
#pragma unroll 1
              for (int i = t_; i < 4096; i += NTHREADS) __hip_atomic_store(z + i, 0u, __ATOMIC_RELAXED, __HIP_MEMORY_SCOPE_AGENT);
              if (t_ == 0) __hip_atomic_store(z + 8192, 0u, __ATOMIC_RELAXED, __HIP_MEMORY_SCOPE_AGENT); } }
      else if (wave == 0 && l0 == 0) { st[2] = xb_add(&bar.bar[XB_XCNT(bar.x)], 1u); st[3] = bar.x; } }
    int ph = 0;
#define PHASE_BEGIN if (ph >= lo && ph < hi) { const int lane = lane_id(), tid = wave * 64 + lane; (void)tid; (void)lane;
#define TID tid
#define PHASE_END   if (ph + 1 < hi) { if (ph == 0) { grid.sync(); if (wave == 0 && lane_id() == 0) { bar.st[2] = xb_add(&bar.bar[XB_XCNT(bar.x)], 1u); bar.st[3] = bar.x; } } else xcd_barrier(bar, wave == 0 && lane_id() == 0);     } } ++ph;
    bf16* HB = (bf16*)(ws + WS_HB); bf16* ZB = (bf16*)(ws + WS_ZB); bf16* YC = (bf16*)(ws + WS_YC); bf16* YB = (bf16*)(ws + WS_YB);
    float* X1 = (float*)(ws + WS_X1); bf16* H2 = (bf16*)(ws + WS_H2); bf16* QP = (bf16*)(ws + WS_QP);

    PHASE_BEGIN ph_prologue(a, lds, tid, lane, wave); PHASE_END
    PHASE_BEGIN ph_modulate(a.in[0], MOD, 0, 2048, HB, ws + WS_HB8, (float*)(ws + WS_SA), lane, wave); PHASE_END
    PHASE_BEGIN { pg8::Gemm g{(const bf16*)(ws + WS_HB8), (const bf16*)(ws + WS_WIN), M, NZ, DM / 2, DM / 2, DM / 2}; pg8::StaticOrder S; S.init(M, NZ, gridDim.x, blockIdx.x);
        pg8::EpiI8RowScaleBf16 E{ZB, NZ, (const float*)(ws + WS_SA), 1.f / W8_SCALE, 0, 0}; pg8::gemm_phase<pg8::EpiI8RowScaleBf16, pg8::StaticOrder, true, true, false, true>(lds, g, S, E, TID); } PHASE_END
    PHASE_BEGIN ph_poolconv(a, lane, wave); PHASE_END
    PHASE_BEGIN {
        if (gridDim.x == 256) {
            { const int gq = blockIdx.x >> 6, pm = blockIdx.x & 63;
              pg8::Gemm g{(const bf16*)(ws + WS_PO) + gq * 256, (const bf16*)(ws + WS_WPOOL) + gq * 65536, M, 256, 256, 1024, 256}; pg8::ListOrder S{pm, 1};
              pg8::EpiScaleBf16 E{ws + WS_YC8 + gq * 256, DM, a.in[12] + gq * 256, Y8_SCALE}; pg8::gemm_phase<pg8::EpiScaleBf16, pg8::ListOrder, false, true>(lds, g, S, E, TID); }
            { const int hb = blockIdx.x >> 5, pm0 = (blockIdx.x & 31) * 2;
              int kg = 128; asm volatile("" : "+s"(kg));
              pg8::Gemm g{(const bf16*)(ws + WS_XC) + hb * 128, (const bf16*)(ws + WS_WAX) + hb * 32768, M, 256, kg, 1024, 128}; pg8::ListOrder S{pm0, 2};
              pg8::EpiGate E{(const bf16*)(ws + WS_XC), (float*)(ws + WS_AF), (float*)(ws + WS_DF), a.in[16], a.in[18], (const float*)(ws + WS_LS8), hb * 128};
              pg8::gemm_phase<pg8::EpiGate, pg8::ListOrder, false, false>(lds, g, S, E, wave * 64 + lane_id()); }
        } } PHASE_END
    PHASE_BEGIN ph_scan_agg(a, tid); PHASE_END
    PHASE_BEGIN ph_scan_fin(a, tid); PHASE_END
    PHASE_BEGIN { pg8::Gemm g{(const bf16*)(ws + WS_YC8), (const bf16*)(ws + WS_WOUT), M, DM, DM / 2, DM / 2, DM / 2}; pg8::StaticOrder S; S.init(M, DM, gridDim.x, blockIdx.x);
        pg8::EpiRowScaleBf16 E{YB, DM, nullptr, 1.f / (W8O_SCALE * Y8_SCALE), 0, 0}; pg8::gemm_phase<pg8::EpiRowScaleBf16, pg8::StaticOrder, true, true, true>(lds, g, S, E, TID); } PHASE_END
    PHASE_BEGIN ph_ln<true>(YB, nullptr, HB, MOD, MOD, a.in[4], a.in[5], H2, ws + WS_X1, (float*)(ws + WS_X1 + 64 * MiB), ws + WS_H6, (float*)(ws + WS_HS), lane, wave); PHASE_END
    PHASE_BEGIN { pg8::Gemm g{(const bf16*)(ws + WS_X1), (const bf16*)(ws + WS_WQ0), M, DM, DM / 2, DM / 2, DM / 2}; pg8::StaticOrder S; S.init(M, DM, gridDim.x, blockIdx.x);
        pg8::EpiI8RowScaleBf16 E{QP, DM, (const float*)(ws + WS_X1 + 64 * MiB), 1.f / W8_SCALE, 0, 0}; pg8::gemm_phase<pg8::EpiI8RowScaleBf16, pg8::StaticOrder, true, true, false, true>(lds, g, S, E, TID); } PHASE_END
    PHASE_BEGIN ph_topk(a, 0, lds, tid, lane, wave); PHASE_END
    PHASE_BEGIN ph_peer_u(a, 0, (volatile LAS unsigned*)(lds + LDS_CTL), lds, lane, wave); PHASE_END
    PHASE_BEGIN ph_peer_coef(a, 0, lds, lane, wave); PHASE_END
    PHASE_BEGIN ph_peer_v(a, 0, (volatile LAS unsigned*)(lds + LDS_CTL), lds, lane, wave); PHASE_END
    PHASE_BEGIN ph_peer_ln<false>(a, MOD, MOD + 2 * 12288, a.in[4] + DM, a.in[5] + DM, lane, wave); PHASE_END
    PHASE_BEGIN { pg8::Gemm g{(const bf16*)(ws + WS_HB8), (const bf16*)(ws + WS_WQKV), M, NQKV, DM / 2, DM / 2, DM / 2}; pg8::StaticOrder S; S.init(M, NQKV, gridDim.x, blockIdx.x);
        pg8::EpiRowScaleBf16 E{ZB, DM, (const float*)(ws + WS_SA), 1.f / W8_SCALE, DM, (size_t)M * DM}; pg8::gemm_phase<pg8::EpiRowScaleBf16, pg8::StaticOrder, true, true, true>(lds, g, S, E, TID);
        ph_forget(a, lds, lane, wave); } PHASE_END
    PHASE_BEGIN ph_cumsum(a, lane, wave); PHASE_END
    PHASE_BEGIN ph_attention(a, (char*)lds_raw, TID); PHASE_END
    PHASE_BEGIN { pg8::Gemm g{(const bf16*)(ws + WS_YC8), (const bf16*)(ws + WS_WO), M, DM, DM / 2, DM / 2, DM / 2}; pg8::StaticOrder S; S.init(M, DM, gridDim.x, blockIdx.x);
        pg8::EpiRowScaleBf16 E{YB, DM, nullptr, 1.f / (W8O_SCALE * attn::O8_SCALE), 0, 0}; pg8::gemm_phase<pg8::EpiRowScaleBf16, pg8::StaticOrder, true, true, true>(lds, g, S, E, TID); } PHASE_END
    PHASE_BEGIN ph_ln<true>(YB, nullptr, HB, MOD + 2 * 12288, MOD + 2 * 12288, a.in[4] + 2 * DM, a.in[5] + 2 * DM, H2, ws + WS_X1, (float*)(ws + WS_X1 + 64 * MiB), ws + WS_H6, (float*)(ws + WS_HS), lane, wave); PHASE_END
    PHASE_BEGIN { pg8::Gemm g{(const bf16*)(ws + WS_X1), (const bf16*)(ws + WS_WQ1), M, DM, DM / 2, DM / 2, DM / 2}; pg8::StaticOrder S; S.init(M, DM, gridDim.x, blockIdx.x);
        pg8::EpiI8RowScaleBf16 E{QP, DM, (const float*)(ws + WS_X1 + 64 * MiB), 1.f / W8_SCALE, 0, 0}; pg8::gemm_phase<pg8::EpiI8RowScaleBf16, pg8::StaticOrder, true, true, false, true>(lds, g, S, E, TID); } PHASE_END
    PHASE_BEGIN ph_topk(a, 1, lds, tid, lane, wave); PHASE_END
    PHASE_BEGIN ph_peer_u(a, 1, (volatile LAS unsigned*)(lds + LDS_CTL), lds, lane, wave); PHASE_END
    PHASE_BEGIN ph_peer_coef(a, 1, lds, lane, wave); PHASE_END
    PHASE_BEGIN ph_peer_v(a, 1, (volatile LAS unsigned*)(lds + LDS_CTL), lds, lane, wave); PHASE_END
    PHASE_BEGIN ph_peer_ln<true>(a, MOD + 2 * 12288, MOD, a.in[4] + 3 * DM, a.in[5] + 3 * DM, lane, wave); PHASE_END
#undef PHASE_BEGIN
#undef TID
#undef PHASE_END
}
constexpr int N_PHASES = 26;

extern "C" void kernel_launch(void* const* d_in, const int* in_sizes, int n_in, void* d_out, int out_size, void* d_ws, size_t ws_size, hipStream_t stream) {
    static int grid = 0;
    if (grid == 0) {
        int dev = 0, cus = 0, per_cu = 0;
        if (n_in != 24 || out_size != M * DM || ws_size < WS_END) { fprintf(stderr, "kernel_launch: unexpected shapes (n_in %d, out %d, ws %zu)\n", n_in, out_size, ws_size); grid = -1; return; }
        (void)hipGetDevice(&dev);
        (void)hipDeviceGetAttribute(&cus, hipDeviceAttributeMultiprocessorCount, dev);
        (void)hipFuncSetAttribute((const void*)mk_fwd, hipFuncAttributeMaxDynamicSharedMemorySize, LDS_BYTES);
        (void)hipOccupancyMaxActiveBlocksPerMultiprocessor(&per_cu, (const void*)mk_fwd, NTHREADS, LDS_BYTES);
        if (per_cu < 1) { fprintf(stderr, "kernel_launch: occupancy query reports %d blocks per CU\n", per_cu); grid = -1; return; }
        grid = cus;
        if (grid != 256) fprintf(stderr, "kernel_launch: %d CUs; phase 4 is written for 256 workgroups\n", grid);
    }
    if (grid < 0) return;
#ifdef MK_SPLIT
    if (hipMemsetAsync(d_ws, 0, 65536, stream) != hipSuccess) { fprintf(stderr, "kernel_launch: hipMemsetAsync failed\n"); return; }
#endif
    Args a{};
    for (int i = 0; i < 24; ++i) a.in[i] = (const float*)d_in[i];
    a.out = (float*)d_out; a.ws = (unsigned char*)d_ws;
#ifndef MK_SPLIT
    a.ph_lo = 0; a.ph_hi = N_PHASES;
    void* args[] = {&a};
    hipError_t e = hipLaunchCooperativeKernel((const void*)mk_fwd, dim3(grid), dim3(NTHREADS), args, LDS_BYTES, stream);
    if (e != hipSuccess) fprintf(stderr, "cooperative launch failed: %s (grid %d)\n", hipGetErrorString(e), grid);
#else
    for (int p = 0; p < N_PHASES; ++p) { a.ph_lo = p; a.ph_hi = p + 1; void* args[] = {&a};
        hipError_t e = hipLaunchCooperativeKernel((const void*)mk_fwd, dim3(grid), dim3(NTHREADS), args, LDS_BYTES, stream);
        if (e != hipSuccess) { fprintf(stderr, "launch %d failed: %s\n", p, hipGetErrorString(e)); break; } }
#endif
}
```

```cpp
#include <hip/hip_runtime.h>
#include <hip/hip_bf16.h>
#include <hip/hip_cooperative_groups.h>
#include <cstdio>
#include <cstdint>
#include <cmath>
namespace cg = cooperative_groups;
namespace pg8 {
#define PG8_LAS __attribute__((address_space(3)))
typedef unsigned short bf16_t;
typedef short bf16x8 __attribute__((ext_vector_type(8)));
typedef float f32x4 __attribute__((ext_vector_type(4)));
typedef unsigned u32x4 __attribute__((ext_vector_type(4)));
constexpr int BM = 256, BK = 64, HALF = 128, HTB = HALF * BK * 2  , STAGE_BYTES = 8 * HTB, NXCD = 8, WGM = 8;

__host__ __device__ __forceinline__ int lds_byte(int r, int c) { const int st = (r >> 4) * 2 + (c >> 5), rr = r & 15, cc = c & 31, ob = rr * 64 + cc * 2; return st * 1024 + (ob ^ (((ob >> 9) & 1) << 5)); }
__host__ __device__ __forceinline__ void stage_rc(int b, int& R, int& C) { const int st = b / 1024, sb = b % 1024, swz = sb ^ (((sb >> 9) & 1) << 5); R = (st >> 1) * 16 + swz / 64; C = (st & 1) * 32 + (swz % 64) / 2; }
__host__ __device__ __forceinline__ int perm32(int rho) { const int n = rho >> 4, i = rho & 15; return 8 * (i >> 2) + 4 * n + (i & 3); }

struct Unit { int pm, pn; };
struct Gemm { const bf16_t* A; const bf16_t* Bt; int M, N, K, lda, ldb; };

struct StaticOrder {
    int nM, nN, nwg, G, c;
    __host__ __device__ void init(int M, int N, int G_, int c_) { nM = M / BM; nN = N / BM; nwg = nM * nN; G = G_; c = c_; }
    __host__ __device__ bool next(int i, Unit& u) const {
        const long L = (long)i * G + c; if (L >= nwg) return false;
        int wgid = (int)L; { const int q = nwg / NXCD, r = nwg % NXCD, xcd = wgid % NXCD, off = wgid / NXCD; wgid = (xcd < r ? xcd * (q + 1) : r * (q + 1) + (xcd - r) * q) + off; }
        const int nig = WGM * nN, gid = wgid / nig, fm = gid * WGM, gsz = (nM - fm) < WGM ? (nM - fm) : WGM;
        u.pm = fm + ((wgid % nig) % gsz); u.pn = (wgid % nig) / gsz; return true;
    }
    __device__ __forceinline__ void a_ready(const Unit&) const {}
    __device__ __forceinline__ void done(const Unit&) const {}
};

__device__ __forceinline__ unsigned cvt_pk_bf16(float lo, float hi) { typedef float f2_ __attribute__((ext_vector_type(2))); typedef __bf16 b2_ __attribute__((ext_vector_type(2))); const f2_ f = {lo, hi}; return __builtin_bit_cast(unsigned, __builtin_convertvector(f, b2_)); }
typedef float f32x2 __attribute__((ext_vector_type(2)));
__device__ __forceinline__ f32x2 gelu_pk(f32x2 v) {
    const f32x2 av = __builtin_elementwise_abs(v), d = av * 0.2316418882f + 1.0f;
    f32x2 t; t.x = __builtin_amdgcn_rcpf(d.x); t.y = __builtin_amdgcn_rcpf(d.y);
    f32x2 q = t * 0.5307027145f + (-0.7265760135f); q = q * t + 0.7107068705f; q = q * t + (-0.142248368f); q = q * t + 0.127414796f; q = q * t;
    const f32x2 s = (v * v) * (-0.72134752044f);
    f32x2 e; e.x = __builtin_amdgcn_exp2f(s.x); e.y = __builtin_amdgcn_exp2f(s.y);
    const f32x2 m = v * (q * e), r = v - m;
    f32x2 o; o.x = v.x < 0.f ? m.x : r.x; o.y = v.y < 0.f ? m.y : r.y; return o;
}

template <int ACT  > struct EpiBf16 {
    static constexpr bool PERM = true, AFTER_DRAIN = false; static_assert(ACT == 0 || ACT == 1, "EpiBf16: ACT is 0 (none) or 1 (gelu_pk)");
    bf16_t* O; int ldc; const float* bias; int split_cols; size_t split_stride; float scale0;
    __device__ __forceinline__ void operator()(const f32x4 (&acc)[2][2][4][2], const Unit& u, int wr, int wc, int fr, int fq) const {
        const int row0 = u.pm * BM + wr * 64 + fr; int colt = u.pn * BM; bf16_t* base = O;
        float sc = 1.f; if (split_cols) { const int t = colt / split_cols; base += (size_t)t * split_stride; colt -= t * split_cols; if (t == 0) sc = scale0; }
        const int col0 = colt + wc * 32 + 8 * fq, bcol0 = u.pn * BM + wc * 32 + 8 * fq;
        f32x4 bv[2][2];
#pragma unroll
        for (int bj = 0; bj < 2; ++bj)
#pragma unroll
            for (int n = 0; n < 2; ++n) bv[bj][n] = bias ? *(const f32x4*)(bias + bcol0 + bj * HALF + 4 * n) : (f32x4){0.f, 0.f, 0.f, 0.f};
#pragma unroll
        for (int ai = 0; ai < 2; ++ai)
#pragma unroll
            for (int m = 0; m < 4; ++m) { bf16_t* rowp = base + (size_t)(row0 + ai * HALF + m * 16) * ldc + col0;
#pragma unroll
                for (int bj = 0; bj < 2; ++bj) { f32x4 v0 = acc[ai][bj][m][0] + bv[bj][0], v1 = acc[ai][bj][m][1] + bv[bj][1];
                    if (ACT == 1) { f32x2 a = gelu_pk((f32x2){v0[0], v0[1]}), b = gelu_pk((f32x2){v0[2], v0[3]}), c = gelu_pk((f32x2){v1[0], v1[1]}), d = gelu_pk((f32x2){v1[2], v1[3]});
                        v0 = (f32x4){a.x, a.y, b.x, b.y}; v1 = (f32x4){c.x, c.y, d.x, d.y}; }
                    v0 = v0 * sc; v1 = v1 * sc; u32x4 w; w.x = cvt_pk_bf16(v0[0], v0[1]); w.y = cvt_pk_bf16(v0[2], v0[3]); w.z = cvt_pk_bf16(v1[0], v1[1]); w.w = cvt_pk_bf16(v1[2], v1[3]);
                    *(u32x4*)(rowp + bj * HALF) = w; } }
    }
};

template <class Epi, class Sched, bool ALIGN_EPI = false, bool SP2 = false, bool FP8 = false, bool I8 = false>
__device__ __forceinline__ void gemm_phase(PG8_LAS unsigned char* lds, const Gemm g, const Sched& S, const Epi& E, const int tid) {
    const int wid = __builtin_amdgcn_readfirstlane(tid >> 6), lane = tid & 63, wr = wid >> 2, wc = wid & 3, fr = lane & 15, fq = lane >> 4;
    const int K = g.K, nt = K / BK;
    unsigned voffA[2], voffB[2];
#pragma unroll
    for (int i = 0; i < 2; ++i) { int R, C; stage_rc(tid * 16 + i * 8192, R, C); const int Rb = Epi::PERM ? ((R & ~31) + perm32(R & 31)) : R;
        voffA[i] = (unsigned)(R * g.lda + C) * 2u; voffB[i] = (unsigned)(Rb * g.ldb + C) * 2u; }
    const __amdgpu_buffer_rsrc_t rA = __builtin_amdgcn_make_buffer_rsrc((void*)g.A, 0, (int)((size_t)g.M * g.lda * 2), 0x00020000), rB = __builtin_amdgcn_make_buffer_rsrc((void*)g.Bt, 0, (int)((size_t)g.N * g.ldb * 2), 0x00020000);
    const size_t kstep = (size_t)(BK * 2);
    const size_t hstepA = (size_t)HALF * g.lda * 2, hstepB = (size_t)HALF * g.ldb * 2;
    const size_t tstepA = 2 * hstepA, tstepB = 2 * hstepB;
    const unsigned ldsw = (unsigned)wid * 1024u;
    const int aoffk[2] = {FP8 ? lds_byte(wr * 64 + fr, fq * 16) : lds_byte(wr * 64 + fr, fq * 8), FP8 ? lds_byte(wr * 64 + fr, fq * 16 + 8) : lds_byte(wr * 64 + fr, fq * 8) + 1024};
    const int boffk[2] = {FP8 ? lds_byte(wc * 32 + fr, fq * 16) : lds_byte(wc * 32 + fr, fq * 8), FP8 ? lds_byte(wc * 32 + fr, fq * 16 + 8) : lds_byte(wc * 32 + fr, fq * 8) + 1024};
#define PG8_SA(b, h) (((b) * 2 + (h)) * HTB)
#define PG8_SB(b, h) ((4 + (b) * 2 + (h)) * HTB)
#define PG8_STAGE(bufoff, gbase, voff, rs, gorig) do { _Pragma("unroll") for (int _i = 0; _i < 2; ++_i) \
        __builtin_amdgcn_raw_ptr_buffer_load_lds(rs, (PG8_LAS void*)(lds + (bufoff) + ldsw + _i * 8192), 16, (voff)[_i], (unsigned)((const char*)(gbase) - (const char*)(gorig)), 0, 0); } while (0)
#define PG8_LDA(dst, b, h) do { if constexpr (FP8) { _Pragma("unroll") for (int m = 0; m < 4; ++m) dst##8[m] = __builtin_shufflevector(*(const PG8_LAS bf16x8*)(lds + PG8_SA(b, h) + aoffk[0] + m * 2048), *(const PG8_LAS bf16x8*)(lds + PG8_SA(b, h) + aoffk[1] + m * 2048), 0, 1, 2, 3, 4, 5, 6, 7, 8, 9, 10, 11, 12, 13, 14, 15); } \
        else { _Pragma("unroll") for (int m = 0; m < 4; ++m) _Pragma("unroll") for (int k = 0; k < 2; ++k) dst[m][k] = *(const PG8_LAS bf16x8*)(lds + PG8_SA(b, h) + aoffk[k] + m * 2048); } } while (0)
#define PG8_LDB(dst, b, h) do { if constexpr (FP8) { _Pragma("unroll") for (int n = 0; n < 2; ++n) dst##8[n] = __builtin_shufflevector(*(const PG8_LAS bf16x8*)(lds + PG8_SB(b, h) + boffk[0] + n * 2048), *(const PG8_LAS bf16x8*)(lds + PG8_SB(b, h) + boffk[1] + n * 2048), 0, 1, 2, 3, 4, 5, 6, 7, 8, 9, 10, 11, 12, 13, 14, 15); } \
        else { _Pragma("unroll") for (int n = 0; n < 2; ++n) _Pragma("unroll") for (int k = 0; k < 2; ++k) dst[n][k] = *(const PG8_LAS bf16x8*)(lds + PG8_SB(b, h) + boffk[k] + n * 2048); } } while (0)
#define PG8_MMA(ai, bj, At, Bt) do { __builtin_amdgcn_s_setprio(1); _Pragma("unroll") for (int m = 0; m < 4; ++m) _Pragma("unroll") for (int n = 0; n < 2; ++n) { \
        if constexpr (FP8) { typedef int i32x8 __attribute__((ext_vector_type(8))); \
            acc[ai][bj][m][n] = __builtin_amdgcn_mfma_scale_f32_16x16x128_f8f6f4(__builtin_bit_cast(i32x8, Bt##8[n]), __builtin_bit_cast(i32x8, At##8[m]), acc[ai][bj][m][n], 0, 0, 0, 127, 0, 127); } \
        else if constexpr (I8) { typedef int i32x4_ __attribute__((ext_vector_type(4))); _Pragma("unroll") for (int k = 0; k < 2; ++k) \
            acc[ai][bj][m][n] = __builtin_bit_cast(f32x4, __builtin_amdgcn_mfma_i32_16x16x64_i8(__builtin_bit_cast(i32x4_, Bt[n][k]), __builtin_bit_cast(i32x4_, At[m][k]), __builtin_bit_cast(i32x4_, acc[ai][bj][m][n]), 0, 0, 0)); } \
        else { _Pragma("unroll") for (int k = 0; k < 2; ++k) acc[ai][bj][m][n] = __builtin_amdgcn_mfma_f32_16x16x32_bf16(Bt[n][k], At[m][k], acc[ai][bj][m][n], 0, 0, 0); } } \
        __builtin_amdgcn_s_setprio(0); } while (0)
#define PG8_WAIT_V(n) asm volatile("s_waitcnt vmcnt(" #n ")" ::: "memory")
#define PG8_WAIT_L(n) asm volatile("s_waitcnt lgkmcnt(" #n ")" ::: "memory")
#define PG8_BAR __builtin_amdgcn_s_barrier()
#define PG8_SCHED __builtin_amdgcn_sched_barrier(0)
    Unit cur, nxt; int ui = 0;
    if (!S.next(0, cur)) return;
    f32x4 acc[2][2][4][2];
#pragma unroll
    for (int a = 0; a < 2; ++a)
#pragma unroll
        for (int b = 0; b < 2; ++b)
#pragma unroll
            for (int m = 0; m < 4; ++m)
#pragma unroll
                for (int n = 0; n < 2; ++n) acc[a][b][m][n] = (f32x4){0.f, 0.f, 0.f, 0.f};
    bf16x8 At[4][2], B0[2][2], B1[2][2]; typedef short bf16x16 __attribute__((ext_vector_type(16))); bf16x16 At8[4], B08[2], B18[2];
    const char* cA = (const char*)g.A + (size_t)cur.pm * tstepA; const char* cB = (const char*)g.Bt + (size_t)cur.pn * tstepB;
    S.a_ready(cur);
    if constexpr (SP2) {
        PG8_STAGE(PG8_SB(0, 0), cB, voffB, rB, g.Bt); PG8_STAGE(PG8_SB(0, 1), cB + hstepB, voffB, rB, g.Bt); PG8_STAGE(PG8_SA(0, 0), cA, voffA, rA, g.A); PG8_STAGE(PG8_SA(0, 1), cA + hstepA, voffA, rA, g.A);
        if (wr == 1) PG8_BAR;
        PG8_WAIT_V(2); PG8_BAR;
        PG8_STAGE(PG8_SB(1, 0), cB + kstep, voffB, rB, g.Bt); PG8_STAGE(PG8_SA(1, 0), cA + kstep, voffA, rA, g.A); PG8_STAGE(PG8_SB(1, 1), cB + hstepB + kstep, voffB, rB, g.Bt);
        PG8_WAIT_V(6); PG8_BAR;
    } else {
        PG8_STAGE(PG8_SB(0, 0), cB, voffB, rB, g.Bt); PG8_STAGE(PG8_SA(0, 0), cA, voffA, rA, g.A); PG8_STAGE(PG8_SB(0, 1), cB + hstepB, voffB, rB, g.Bt); PG8_STAGE(PG8_SA(0, 1), cA + hstepA, voffA, rA, g.A);
        if (wr == 1) PG8_BAR;
        PG8_WAIT_V(4); PG8_BAR;
        PG8_STAGE(PG8_SB(1, 0), cB + kstep, voffB, rB, g.Bt); PG8_STAGE(PG8_SA(1, 0), cA + kstep, voffA, rA, g.A); PG8_STAGE(PG8_SB(1, 1), cB + hstepB + kstep, voffB, rB, g.Bt);
        PG8_WAIT_V(6); PG8_BAR;
    }
    for (;;) {
        const bool has_next = S.next(ui + 1, nxt);
        const char* nA = has_next ? (const char*)g.A + (size_t)nxt.pm * tstepA : cA; const char* nB = has_next ? (const char*)g.Bt + (size_t)nxt.pn * tstepB : cB;
        for (int t = 0; t < nt; t += 2) {
            const bool last = (t == nt - 2);
            const char* a1 = cA + (size_t)(t + 1) * kstep;
            const char* a2 = last ? nA : cA + (size_t)(t + 2) * kstep; const char* b2 = last ? nB : cB + (size_t)(t + 2) * kstep;
            const char* a3 = a2 + kstep; const char* b3 = b2 + kstep;
            if (last && has_next) S.a_ready(nxt);
            if constexpr (SP2) {
            PG8_LDB(B0, 0, 0); PG8_LDB(B1, 0, 1); PG8_SCHED; PG8_LDA(At, 0, 0); PG8_STAGE(PG8_SA(1, 1), a1 + hstepA, voffA, rA, g.A);
            PG8_WAIT_V(8); PG8_WAIT_L(0); PG8_BAR; PG8_MMA(0, 0, At, B0); PG8_MMA(0, 1, At, B1); PG8_BAR; PG8_SCHED;
            PG8_LDA(At, 0, 1); PG8_STAGE(PG8_SB(0, 0), b2, voffB, rB, g.Bt); PG8_STAGE(PG8_SB(0, 1), b2 + hstepB, voffB, rB, g.Bt); PG8_STAGE(PG8_SA(0, 0), a2, voffA, rA, g.A);
            PG8_WAIT_V(8); PG8_WAIT_L(0); PG8_BAR; PG8_MMA(1, 0, At, B0); PG8_MMA(1, 1, At, B1); PG8_BAR; PG8_SCHED;
            PG8_LDB(B0, 1, 0); PG8_LDB(B1, 1, 1); PG8_SCHED; PG8_LDA(At, 1, 0); PG8_STAGE(PG8_SA(0, 1), a2 + hstepA, voffA, rA, g.A);
            PG8_WAIT_V(8); PG8_WAIT_L(0); PG8_BAR; PG8_MMA(0, 0, At, B0); PG8_MMA(0, 1, At, B1); PG8_BAR; PG8_SCHED;
            PG8_LDA(At, 1, 1); PG8_STAGE(PG8_SB(1, 0), b3, voffB, rB, g.Bt); PG8_STAGE(PG8_SB(1, 1), b3 + hstepB, voffB, rB, g.Bt); PG8_STAGE(PG8_SA(1, 0), a3, voffA, rA, g.A);
            PG8_WAIT_V(8); PG8_WAIT_L(0); PG8_BAR; PG8_MMA(1, 0, At, B0); PG8_MMA(1, 1, At, B1); PG8_BAR; PG8_SCHED;
            } else {
            PG8_LDB(B0, 0, 0); PG8_SCHED; PG8_LDA(At, 0, 0); PG8_STAGE(PG8_SA(1, 1), a1 + hstepA, voffA, rA, g.A);
            PG8_WAIT_L(8); PG8_BAR; PG8_WAIT_L(0); PG8_MMA(0, 0, At, B0); PG8_BAR; PG8_SCHED;
            PG8_LDB(B1, 0, 1); PG8_STAGE(PG8_SB(0, 0), b2, voffB, rB, g.Bt);
            PG8_BAR; PG8_WAIT_L(0); PG8_MMA(0, 1, At, B1); PG8_BAR;
            PG8_LDA(At, 0, 1); PG8_STAGE(PG8_SA(0, 0), a2, voffA, rA, g.A);
            PG8_BAR; PG8_WAIT_L(0); PG8_MMA(1, 0, At, B0); PG8_BAR; PG8_SCHED;
            PG8_STAGE(PG8_SB(0, 1), b2 + hstepB, voffB, rB, g.Bt);
            PG8_WAIT_V(6); PG8_BAR; PG8_MMA(1, 1, At, B1); PG8_BAR;
            PG8_LDB(B0, 1, 0); PG8_SCHED; PG8_LDA(At, 1, 0); PG8_STAGE(PG8_SA(0, 1), a2 + hstepA, voffA, rA, g.A);
            PG8_WAIT_L(8); PG8_BAR; PG8_WAIT_L(0); PG8_MMA(0, 0, At, B0); PG8_BAR; PG8_SCHED;
            PG8_LDB(B1, 1, 1); PG8_STAGE(PG8_SB(1, 0), b3, voffB, rB, g.Bt);
            PG8_BAR; PG8_WAIT_L(0); PG8_MMA(0, 1, At, B1); PG8_BAR;
            PG8_LDA(At, 1, 1); PG8_STAGE(PG8_SA(1, 0), a3, voffA, rA, g.A);
            PG8_BAR; PG8_WAIT_L(0); PG8_MMA(1, 0, At, B0); PG8_BAR; PG8_SCHED;
            PG8_STAGE(PG8_SB(1, 1), b3 + hstepB, voffB, rB, g.Bt);
            PG8_WAIT_V(6); PG8_BAR; PG8_MMA(1, 1, At, B1); PG8_BAR;
            }
        }
        if constexpr (ALIGN_EPI) { if (wr == 0) PG8_BAR; }
        if constexpr (!Epi::AFTER_DRAIN) { E(acc, cur, wr, wc, fr, fq); S.done(cur); }
        if (!has_next) break;
#pragma unroll
        for (int a = 0; a < 2; ++a)
#pragma unroll
            for (int b = 0; b < 2; ++b)
#pragma unroll
                for (int m = 0; m < 4; ++m)
#pragma unroll
                    for (int n = 0; n < 2; ++n) acc[a][b][m][n] = (f32x4){0.f, 0.f, 0.f, 0.f};
        cur = nxt; cA = nA; cB = nB; ++ui;
        if constexpr (ALIGN_EPI) { if (wr == 1) PG8_BAR; }
    }
    PG8_WAIT_V(0);
    if constexpr (!ALIGN_EPI) { if (wr == 0) PG8_BAR; }
    PG8_BAR;
    if constexpr (Epi::AFTER_DRAIN) { E.fused(acc, cur, wr, wc, fr, fq, lds, wid, lane); S.done(cur); }
#undef PG8_SA
#undef PG8_SB
#undef PG8_STAGE
#undef PG8_LDA
#undef PG8_LDB
#undef PG8_MMA
#undef PG8_WAIT_V
#undef PG8_WAIT_L
#undef PG8_BAR
#undef PG8_SCHED
}
}

namespace attn {
constexpr float SCALE = 0.08838834764831845f;
constexpr int D = 128, PITCH = 2048;
constexpr float THR = 8.f; constexpr bool WSKIP = true; constexpr bool O_FP8 = true; constexpr float O8_SCALE = 16.f;
constexpr int NW = 8, QBLK = 32, KVBLK = 64, QB = NW * QBLK;
constexpr int SHM_V = KVBLK * D * 2, SHM_K = KVBLK * D * 2;
constexpr int LDS_BIAS = 2 * SHM_V + 2 * SHM_K + NW * 64 * 4;
constexpr int LDS_BYTES = LDS_BIAS + 2 * 256;
using bf16 = __hip_bfloat16;
typedef short bf16x8 __attribute__((ext_vector_type(8)));
typedef short s16x4 __attribute__((ext_vector_type(4)));
typedef float f32x16 __attribute__((ext_vector_type(16)));
typedef float f32x4 __attribute__((ext_vector_type(4)));
typedef unsigned u32x4 __attribute__((ext_vector_type(4)));
template <class A, class Bt> struct same_t { static constexpr bool v = false; };
template <class A> struct same_t<A, A> { static constexpr bool v = true; };

#define KSWZ(row, colB) ((row) * 256 + ((colB) ^ (((row) & 7) << 4)))
#define SBAR() __builtin_amdgcn_sched_barrier(0)
__device__ __forceinline__ int v_st(int k, int c) { const int kk = (k & ~0xC) | ((k & 4) << 1) | ((k & 8) >> 1); return ((kk >> 3) * 4 + (c >> 5)) * 512 + ((kk & 7) * 32 + (c & 31)) * 2; }
__device__ __forceinline__ int v_rd_base(int lane) { return ((lane & 3) << 3) | (((lane >> 2) & 3) << 6) | (((lane >> 4) & 1) << 5) | (((lane >> 5) & 1) << 8); }
constexpr int v_rd_off(int d0, int ks, int half) { return d0 * 512 + ks * 4096 + half * 2048; }
__device__ __forceinline__ int crow(int r, int hi) { return (r & 3) + 8 * (r >> 2) + 4 * hi; }
__device__ __forceinline__ unsigned cvtpk(float lo, float hi) {
    typedef float f2_ __attribute__((ext_vector_type(2))); typedef __bf16 b2_ __attribute__((ext_vector_type(2))); const f2_ f = {lo, hi}; return __builtin_bit_cast(unsigned, __builtin_convertvector(f, b2_));
}
__device__ __forceinline__ bf16x8 pack8(f32x4 a, f32x4 b) {
    u32x4 w = {cvtpk(a[0], a[1]), cvtpk(a[2], a[3]), cvtpk(b[0], b[1]), cvtpk(b[2], b[3])};
    return *reinterpret_cast<bf16x8*>(&w);
}
template <class T> __device__ __forceinline__ bf16x8 load8(const T* p) {
    if constexpr (same_t<T, float>::v) { return pack8(*(const f32x4*)p, *(const f32x4*)(p + 4)); }
    else { return *reinterpret_cast<const bf16x8*>(p); }
}
__device__ __forceinline__ void mask_tile(f32x16& p0, f32x16& p1, int dq, unsigned W) {
    const float NEG = -__builtin_inff();
#pragma unroll
    for (int r = 0; r < 16; ++r) {
        const int c = (r & 3) + 8 * (r >> 2);
        if ((unsigned)(dq - c) >= W) p0[r] = NEG;
        if ((unsigned)(dq - c - 32) >= W) p1[r] = NEG;
    }
}
constexpr float DEAD_T = 20.f;
__device__ __forceinline__ void partialSM(f32x16& p0, f32x16& p1, float& m_reg, float& mn, float& alpha, bool& dead) {
    float pmax = p0[0]; for (int r = 1; r < 16; ++r) pmax = fmaxf(pmax, p0[r]); for (int r = 0; r < 16; ++r) pmax = fmaxf(pmax, p1[r]);
    { auto rr = __builtin_amdgcn_permlane32_swap(__float_as_uint(pmax), __float_as_uint(pmax), false, false);
      pmax = fmaxf(__uint_as_float(rr[0]), __uint_as_float(rr[1])); }
    constexpr float C2 = 1.4426950408889634f * SCALE;
    dead = __all((pmax - m_reg) * SCALE < -DEAD_T);
    if (dead) { mn = m_reg; alpha = 1.f; return; }
    if (__builtin_expect(__all((pmax - m_reg) * SCALE <= THR), 1)) { mn = m_reg; alpha = 1.f; }
    else { mn = fmaxf(m_reg, pmax); alpha = __builtin_amdgcn_exp2f((m_reg - mn) * C2); m_reg = mn; }
    const float mnL = -mn * C2;
    for (int r = 0; r < 16; ++r) p0[r] = fmaf(p0[r], C2, mnL); for (int r = 0; r < 16; ++r) p1[r] = fmaf(p1[r], C2, mnL);
    for (int r = 0; r < 16; ++r) p0[r] = __builtin_amdgcn_exp2f(p0[r]);
}
__device__ __forceinline__ void finishSM(f32x16& p0, f32x16& p1, float alpha, float& l_reg, bf16x8& pa0, bf16x8& pa1, bf16x8& pa2, bf16x8& pa3) {
    for (int r = 0; r < 16; ++r) p1[r] = __builtin_amdgcn_exp2f(p1[r]);
    float ps = 0; for (int r = 0; r < 16; ++r) ps += p0[r]; for (int r = 0; r < 16; ++r) ps += p1[r];
    { auto rr = __builtin_amdgcn_permlane32_swap(__float_as_uint(ps), __float_as_uint(ps), false, false);
      ps = __uint_as_float(rr[0]) + __uint_as_float(rr[1]); }
    l_reg = l_reg * alpha + ps;
#define PK4(P, B_, OUT) do { unsigned a0 = cvtpk(P[B_+0], P[B_+1]), a1 = cvtpk(P[B_+2], P[B_+3]);                          \
        unsigned b0 = cvtpk(P[B_+4], P[B_+5]), b1 = cvtpk(P[B_+6], P[B_+7]);                                             \
        auto r0 = __builtin_amdgcn_permlane32_swap(a0, b0, false, false); auto r1 = __builtin_amdgcn_permlane32_swap(a1, b1, false, false); \
        u32x4 w = {r0[0], r1[0], r0[1], r1[1]}; OUT = *reinterpret_cast<bf16x8*>(&w); } while (0)
    PK4(p0, 0, pa0); PK4(p0, 8, pa1); PK4(p1, 0, pa2); PK4(p1, 8, pa3);
#undef PK4
}
template <int KB, bool SK>
__device__ __forceinline__ void qkt(f32x16& p0, f32x16& p1, const char* K_lds, int r32, int hi, const bf16x8* qr, bool act) {
    const float* bl = (const float*)(K_lds - 2 * SHM_V + LDS_BIAS + KB * 256) + 4 * hi;
    if (SK && !act) { const float NEG = -__builtin_inff();
#pragma unroll
        for (int r = 0; r < 16; ++r) { p0[r] = NEG; p1[r] = NEG; } return; }
#pragma unroll
    for (int g_ = 0; g_ < 4; ++g_) { const f32x4 b0_ = *(const f32x4*)(bl + 8 * g_), b1_ = *(const f32x4*)(bl + 32 + 8 * g_);
#pragma unroll
        for (int e_ = 0; e_ < 4; ++e_) { p0[4 * g_ + e_] = b0_[e_]; p1[4 * g_ + e_] = b1_[e_]; } }
    const char* kb[4];
#pragma unroll
    for (int dd = 0; dd < 4; ++dd) kb[dd] = K_lds + KB * SHM_K + KSWZ(r32, (dd * 16 + hi * 8) * 2);
#pragma unroll
    for (int d0 = 0; d0 < 8; ++d0) { const char* a = kb[d0 & 3] + (d0 >> 2) * 128;
        bf16x8 b0 = *reinterpret_cast<const bf16x8*>(a);
        bf16x8 b1 = *reinterpret_cast<const bf16x8*>(a + 32 * 256);
        p0 = __builtin_amdgcn_mfma_f32_32x32x16_bf16(b0, qr[d0], p0, 0, 0, 0);
        p1 = __builtin_amdgcn_mfma_f32_32x32x16_bf16(b1, qr[d0], p1, 0, 0, 0); }
}
template <int VB, bool SK>
__device__ __forceinline__ void pv_tile(f32x16* o, int vb0, bf16x8 pa0, bf16x8 pa1, bf16x8 pa2, bf16x8 pa3, bool act) {
    if (SK && !act) return;
#define TRRD(dst, off) asm volatile("ds_read_b64_tr_b16 %0, %1 offset:%2" : "=&v"(dst) : "v"(vb0), "i"(off) : "memory")
#define PV_D0(d0) do { s16x4 l0, l1, l2, l3, h0, h1, h2, h3; constexpr int b_ = VB * SHM_V + v_rd_off(d0, 0, 0);     \
        TRRD(l0, b_); TRRD(h0, b_ + 2048); TRRD(l1, b_ + 4096); TRRD(h1, b_ + 6144); TRRD(l2, b_ + 8192); TRRD(h2, b_ + 10240); TRRD(l3, b_ + 12288); TRRD(h3, b_ + 14336); \
        asm volatile("s_waitcnt lgkmcnt(0)" ::: "memory"); SBAR();                 \
        o[d0] = __builtin_amdgcn_mfma_f32_32x32x16_bf16(pa0, (bf16x8){l0[0], l0[1], l0[2], l0[3], h0[0], h0[1], h0[2], h0[3]}, o[d0], 0, 0, 0);   \
        o[d0] = __builtin_amdgcn_mfma_f32_32x32x16_bf16(pa1, (bf16x8){l1[0], l1[1], l1[2], l1[3], h1[0], h1[1], h1[2], h1[3]}, o[d0], 0, 0, 0);   \
        o[d0] = __builtin_amdgcn_mfma_f32_32x32x16_bf16(pa2, (bf16x8){l2[0], l2[1], l2[2], l2[3], h2[0], h2[1], h2[2], h2[3]}, o[d0], 0, 0, 0);   \
        o[d0] = __builtin_amdgcn_mfma_f32_32x32x16_bf16(pa3, (bf16x8){l3[0], l3[1], l3[2], l3[3], h3[0], h3[1], h3[2], h3[3]}, o[d0], 0, 0, 0); } while (0)
    PV_D0(0); PV_D0(1); PV_D0(2); PV_D0(3);
#undef PV_D0
#undef TRRD
}

template <class TIn, class TOut> struct BlockRef { const TIn* Q; const TIn* K; const TIn* V; TOut* O; const float* Fb; int P0; int jlo; unsigned char* O8; };
template <class TIn> struct Seam {
    bf16x8 qr[8];
    bf16x8 st_v0, st_v1, st_k0, st_k1; f32x4 sf0, sf1, sf2, sf3;
    f32x4 tq[16];
};
__device__ __forceinline__ int swa_jlo(int P0, int W) { const int lowk = P0 - W + 1; return lowk > 0 ? lowk / KVBLK : 0; }
#define ROW(p, k0, rr) ((const TIn*)((const char*)(p) + (unsigned)((((k0) + (rr)) * PITCH + sc) * (int)sizeof(TIn))))
#define VMW() asm volatile("s_waitcnt vmcnt(0)" ::: "memory")
#define VMWN(n) asm volatile("s_waitcnt vmcnt(%0)" :: "i"(n) : "memory")
#define SLOAD_H(Kp, Vp, Fp, bb, k0) do { S.st_v0 = load8<TIn>(ROW(Vp, k0, sr)); S.st_v1 = load8<TIn>(ROW(Vp, k0, 32 + sr));              \
                         S.st_k0 = load8<TIn>(ROW(Kp, k0, sr)); S.st_k1 = load8<TIn>(ROW(Kp, k0, 32 + sr));                          \
                         if (wid == 0) __builtin_amdgcn_global_load_lds((const unsigned*)((Fp) + (k0) + lane), (__attribute__((address_space(3))) unsigned*)(lds + LDS_BIAS + (bb) * 256), 4, 0, 0); } while (0)
#define SWRITE_HK(bf) do { int t_ = tid; asm volatile("" : "+v"(t_)); const int kws_ = KSWZ(t_ >> 4, (t_ & 15) * 16);     \
        *(bf16x8*)(K_lds + (bf) * SHM_K + kws_) = S.st_k0; *(bf16x8*)(K_lds + (bf) * SHM_K + kws_ + 32 * 256) = S.st_k1; } while (0)
#define SWRITE_HV(bf) do { int t_ = tid; asm volatile("" : "+v"(t_)); const int vst0_ = v_st(t_ >> 4, (t_ & 15) * 8), vst1_ = v_st(32 + (t_ >> 4), (t_ & 15) * 8); \
        *(bf16x8*)(V_lds + (bf) * SHM_V + vst0_) = S.st_v0; *(bf16x8*)(V_lds + (bf) * SHM_V + vst1_) = S.st_v1; } while (0)
#define SWRITE_H(bf) do { SWRITE_HV(bf); SWRITE_HK(bf); } while (0)
#define SLOAD_F(p, k0) do { S.sf0 = *(const f32x4*)ROW(p, k0, sr); S.sf1 = *(const f32x4*)(ROW(p, k0, sr) + 4);                \
                            S.sf2 = *(const f32x4*)ROW(p, k0, 32 + sr); S.sf3 = *(const f32x4*)(ROW(p, k0, 32 + sr) + 4); } while (0)
#define SWRITE_KF(bf) do { *(bf16x8*)(K_lds + (bf) * SHM_K + kws) = pack8(S.sf0, S.sf1); *(bf16x8*)(K_lds + (bf) * SHM_K + kws + 32 * 256) = pack8(S.sf2, S.sf3); } while (0)
#define SWRITE_VF(bf) do { *(bf16x8*)(V_lds + (bf) * SHM_V + vst0) = pack8(S.sf0, S.sf1); *(bf16x8*)(V_lds + (bf) * SHM_V + vst1) = pack8(S.sf2, S.sf3); } while (0)
template <class TIn, class TOut>
__device__ __forceinline__ void causal_swa_prime(const BlockRef<TIn, TOut>& cur, int W, char* lds, Seam<TIn>& S, const int tid) {
    constexpr bool F32 = same_t<TIn, float>::v;
    const int wid = __builtin_amdgcn_readfirstlane(tid >> 6), lane = tid & 63, r32 = lane & 31, hi = lane >> 5;
    const int sr = tid >> 4, sc = (tid & 15) * 8, kws = KSWZ(sr, sc * 2); char* K_lds = lds + 2 * SHM_V;
    const int kb0 = ((cur.P0 + QB - 1) / KVBLK) * KVBLK;
    for (int d0 = 0; d0 < 8; ++d0) S.qr[d0] = load8<TIn>(cur.Q + (size_t)(wid * QBLK + r32) * PITCH + d0 * 16 + hi * 8);
    if constexpr (F32) { SLOAD_F((const float*)cur.K, kb0); VMW(); SWRITE_KF(0); SBAR(); SLOAD_F((const float*)cur.V, kb0); }
    else { SLOAD_H(cur.K, cur.V, cur.Fb, 0, kb0); VMW(); SWRITE_HK(0); }
    __syncthreads();
}
template <class TIn, class TOut>
__device__ __forceinline__ void causal_swa_block(const BlockRef<TIn, TOut>& cur, const BlockRef<TIn, TOut>& nxt, int skv, int W, char* lds, Seam<TIn>& S, const int tid) {
    constexpr bool F32 = same_t<TIn, float>::v;
    const int wid = __builtin_amdgcn_readfirstlane(tid >> 6), lane = tid & 63, r32 = lane & 31, hi = lane >> 5;
    const int j_lo = cur.jlo;
    int j_hi = (cur.P0 + QB - 1) / KVBLK + 1; if (j_hi > skv / KVBLK) j_hi = skv / KVBLK;
    const int NT = j_hi - j_lo;
    const int kbn = ((nxt.P0 + QB - 1) / KVBLK) * KVBLK;
    const int qlo = cur.P0 + wid * QBLK, qm = qlo + r32 - 4 * hi;
    char* V_lds = lds; char* K_lds = lds + 2 * SHM_V;
    float* ws = (float*)(lds + 2 * SHM_V + 2 * SHM_K) + wid * 64; float* li_l = ws, * al_l = ws + 32;
    float m_reg = -1e30f, l_reg = 0; f32x16 o[4] = {};
    const int sr = tid >> 4, sc = (tid & 15) * 8, vst0 = v_st(sr, sc), vst1 = v_st(32 + sr, sc), kws = KSWZ(sr, sc * 2);
    const int vb0 = (int)(uintptr_t)V_lds + v_rd_base(lane);
    const TIn* Kh = cur.K; const TIn* Vh = cur.V;
#define RESC(a) do { if (__any((a) < 1.f)) { if (hi == 0) al_l[r32] = (a); asm volatile("s_waitcnt lgkmcnt(0)" ::: "memory");              \
                     for (int d_ = 0; d_ < 4; ++d_) for (int r = 0; r < 16; ++r) o[d_][r] *= al_l[crow(r, hi)]; } } while (0)
#define KBASE(t) ((j_hi - 1 - (t)) * KVBLK)
#define ACT(t) (KBASE(t) <= qlo + QBLK - 1 && KBASE(t) + KVBLK - 1 >= qlo - W + 1)
#define MASKT(P0_, P1_, t) do { const int kb_ = KBASE(t); if ((!SK || ACT(t)) && (kb_ + KVBLK - 1 > qlo || kb_ <= qlo + QBLK - 1 - W)) mask_tile(P0_, P1_, qm - kb_, (unsigned)W); } while (0)
    constexpr int NQL = F32 ? 16 : 8;
    constexpr bool SK = WSKIP && !F32;
#define SEAM_K0() do { VMWN(NQL); if constexpr (F32) { SWRITE_KF(0); SBAR(); SLOAD_F((const float*)nxt.V, kbn); } else { SWRITE_HK(0); } SBAR(); } while (0)
    f32x16 pA0, pA1, pB0, pB1; float mnA, mnB, alA, alB; bf16x8 pa0, pa1, pa2, pa3; bool deadA = false, deadB = false;
    if constexpr (F32) { VMW(); SWRITE_VF(0); SBAR(); } else { SWRITE_HV(0); SBAR(); }
    if (NT > 1) { if constexpr (F32) SLOAD_F((const float*)Kh, KBASE(1)); else SLOAD_H(Kh, Vh, cur.Fb, 1, KBASE(1)); }
    SBAR(); qkt<0, SK>(pA0, pA1, K_lds, r32, hi, S.qr, ACT(0));
    if constexpr (F32) { if (NT > 1) { VMW(); SWRITE_KF(1); SBAR(); SLOAD_F((const float*)Vh, KBASE(1)); } }
    MASKT(pA0, pA1, 0); partialSM(pA0, pA1, m_reg, mnA, alA, deadA);
    if (NT > 1) { VMW(); if constexpr (F32) { SWRITE_VF(1); SBAR(); if (NT > 2) SLOAD_F((const float*)Kh, KBASE(2)); } else SWRITE_H(1); }
    __syncthreads();
#define HALF_STEP(PX0, PX1, mnX, alX, deadX, PY0, PY1, alY, deadY, t, KB, VB, SB) do {                                                      \
        SBAR(); qkt<KB, SK>(PX0, PX1, K_lds, r32, hi, S.qr, ACT(t));                                             \
        if (!deadY) finishSM(PY0, PY1, alY, l_reg, pa0, pa1, pa2, pa3); SBAR();                                               \
        if ((t) + 1 < NT) { if constexpr (F32) { VMW(); SWRITE_KF(SB); SBAR(); SLOAD_F((const float*)Vh, KBASE((t) + 1)); }  \
                            else { SLOAD_H(Kh, Vh, cur.Fb, SB, KBASE((t) + 1)); } SBAR(); }                                               \
        pv_tile<VB, SK>(o, vb0, pa0, pa1, pa2, pa3, ACT((t) - 1) && !deadY); MASKT(PX0, PX1, (t)); partialSM(PX0, PX1, m_reg, mnX, alX, deadX);                                        \
        __syncthreads();                                                                                                      \
        if ((t) + 1 < NT) { VMW(); if constexpr (F32) { SWRITE_VF(SB); SBAR(); if ((t) + 2 < NT) SLOAD_F((const float*)Kh, KBASE((t) + 2)); } \
                            else { SWRITE_H(SB); } }                                                                          \
        RESC(alX); __syncthreads(); } while (0)
    for (int t = 1; t + 1 < NT; t += 2) {
        HALF_STEP(pB0, pB1, mnB, alB, deadB, pA0, pA1, alA, deadA, t, 1, 0, 0);
        HALF_STEP(pA0, pA1, mnA, alA, deadA, pB0, pB1, alB, deadB, t + 1, 0, 1, 1);
    }
    const bool even = (NT & 1) == 0;
    if (even) { SBAR(); qkt<1, SK>(pB0, pB1, K_lds, r32, hi, S.qr, ACT(NT - 1)); SBAR(); }
#define QROW(e) (nxt.Q + (size_t)(wid * QBLK + r32) * PITCH + ((e) >> 1) * 16 + hi * 8 + ((e) & 1) * 4)
    if constexpr (F32) { SLOAD_F((const float*)nxt.K, kbn); SBAR();
#pragma unroll
        for (int e = 0; e < 8; ++e) S.tq[e] = *(const f32x4*)QROW(e); }
    else { SLOAD_H(nxt.K, nxt.V, nxt.Fb, 0, kbn); SBAR();
#pragma unroll
        for (int d0 = 0; d0 < 8; ++d0) S.qr[d0] = load8<TIn>(nxt.Q + (size_t)(wid * QBLK + r32) * PITCH + d0 * 16 + hi * 8); }
    SBAR();
    if (!deadA) finishSM(pA0, pA1, alA, l_reg, pa0, pa1, pa2, pa3); SBAR();
    if constexpr (F32) {
#pragma unroll
        for (int e = 8; e < 16; ++e) S.tq[e] = *(const f32x4*)QROW(e); SBAR(); }
#undef QROW
    pv_tile<0, SK>(o, vb0, pa0, pa1, pa2, pa3, ACT(even ? NT - 2 : NT - 1) && !deadA);
    if (even) { MASKT(pB0, pB1, NT - 1); partialSM(pB0, pB1, m_reg, mnB, alB, deadB); __syncthreads(); RESC(alB);
        if (!deadB) finishSM(pB0, pB1, alB, l_reg, pa0, pa1, pa2, pa3); SBAR(); pv_tile<1, SK>(o, vb0, pa0, pa1, pa2, pa3, ACT(NT - 1) && !deadB); }
    SBAR(); SEAM_K0();
    if (hi == 0) li_l[r32] = l_reg; asm volatile("s_waitcnt lgkmcnt(0)" ::: "memory");
    float rli[16];
#pragma unroll
    for (int r = 0; r < 16; ++r) rli[r] = __builtin_amdgcn_rcpf(li_l[crow(r, hi)]);
    TOut* Ow = cur.O + (size_t)(wid * QBLK) * PITCH;
#pragma unroll
    for (int r = 0; r < 16; ++r) { const int orow = crow(r, hi);
#pragma unroll
        for (int d0 = 0; d0 < 4; ++d0) { const float v = o[d0][r] * rli[r];
            if constexpr (same_t<TOut, float>::v) { Ow[(size_t)orow * PITCH + d0 * 32 + r32] = v; }
            else if constexpr (O_FP8) { const float vs = fminf(fmaxf(v * O8_SCALE, -440.f), 440.f), t1 = __shfl_xor(vs, 1), t2 = __shfl_xor(vs, 2), t3 = __shfl_xor(t1, 2);
                   unsigned w8 = 0u; w8 = __builtin_amdgcn_cvt_pk_fp8_f32(vs, t1, w8, false); w8 = __builtin_amdgcn_cvt_pk_fp8_f32(t2, t3, w8, true);
                   if ((r32 & 3) == 0) *(unsigned*)(cur.O8 + (size_t)(wid * QBLK + orow) * PITCH + d0 * 32 + r32) = w8; }
            else { const float vn = __shfl_xor(v, 1);
                   if ((r32 & 1) == 0) *(unsigned*)(Ow + (size_t)orow * PITCH + d0 * 32 + r32) = cvtpk(v, vn); } } }
    if constexpr (F32) {
#pragma unroll
        for (int d0 = 0; d0 < 8; ++d0) S.qr[d0] = pack8(S.tq[2 * d0], S.tq[2 * d0 + 1]); }
    __syncthreads();
#undef RESC
#undef KBASE
#undef ACT
#undef MASKT
#undef SEAM_K0
#undef HALF_STEP
}
#undef ROW
#undef VMW
#undef VMWN
#undef SLOAD_H
#undef SWRITE_HK
#undef SWRITE_HV
#undef SWRITE_H
#undef SLOAD_F
#undef SWRITE_KF
#undef SWRITE_VF


enum { ORDER_NATURAL = 0, ORDER_REVERSED = 1, ORDER_PAIRED = 2, ORDER_XCD = 4 };
__host__ __device__ inline int swa_nramp(int nqb, int W, int qoff) { const int t = W - 1 - qoff; const int n = t < 0 ? 0 : t / QB + 1; return n > nqb ? nqb : n; }
__host__ __device__ inline int swa_nx(int nqb, int nramp, int order) { return (order & ORDER_PAIRED) ? (nramp + 1) / 2 + (nqb - nramp) : nqb; }
struct SwaItem { int bh, qb0, qb1; };
__device__ __forceinline__ SwaItem swa_decode(int L, int nb, int nh, int nhkv, int nqb, int nx, int nramp, int order) {
    const int G = nh / nhkv; SwaItem it; int x;
    if ((order & ORDER_XCD) && (nb * nhkv) % 8 == 0) { const int xcd = L & 7, k = L >> 3, per = G * nx, gi = k / per, r = k - gi * per;
        it.bh = (gi * 8 + xcd) * G + r / nx; x = r % nx; }
    else { it.bh = L / nx; x = L - it.bh * nx; }
    if (order & ORDER_PAIRED) { const int ns = nqb - nramp;
        if (x < ns) { it.qb0 = it.qb1 = nqb - 1 - x; } else { it.qb0 = x - ns; it.qb1 = nramp - 1 - it.qb0; } }
    else { it.qb0 = it.qb1 = ((order & 3) == ORDER_REVERSED) ? nqb - 1 - x : x; }
    return it;
}

}

namespace pg8 {
struct ListOrder {
    int pm0, n;
    __device__ bool next(int i, Unit& u) const { if (i >= n) return false; u.pm = pm0 + i; u.pn = 0; return true; }
    __device__ __forceinline__ void a_ready(const Unit&) const {}
    __device__ __forceinline__ void done(const Unit&) const {}
};
struct EpiScaleBf16 {
    static constexpr bool PERM = true, AFTER_DRAIN = false;
    unsigned char* O; int ldc; const float* colscale; float os;
    __device__ __forceinline__ void operator()(const f32x4 (&acc)[2][2][4][2], const Unit& u, int wr, int wc, int fr, int fq) const {
        const int row0 = u.pm * BM + wr * 64 + fr; int col0 = u.pn * BM + wc * 32 + 8 * fq; asm volatile("" : "+v"(col0));
        f32x4 sv[2][2];
#pragma unroll
        for (int bj = 0; bj < 2; ++bj)
#pragma unroll
            for (int n = 0; n < 2; ++n) sv[bj][n] = *(const f32x4*)(colscale + col0 + bj * HALF + 4 * n) * os;
#pragma unroll
        for (int ai = 0; ai < 2; ++ai)
#pragma unroll
            for (int m = 0; m < 4; ++m) { unsigned char* rowp = O + (size_t)(row0 + ai * HALF + m * 16) * ldc + col0;
#pragma unroll
                for (int bj = 0; bj < 2; ++bj) { const f32x4 v0 = acc[ai][bj][m][0] * sv[bj][0], v1 = acc[ai][bj][m][1] * sv[bj][1];
                    unsigned w0 = 0u, w1 = 0u;
                    w0 = __builtin_amdgcn_cvt_pk_fp8_f32(fminf(fmaxf(v0[0], -440.f), 440.f), fminf(fmaxf(v0[1], -440.f), 440.f), w0, false); w0 = __builtin_amdgcn_cvt_pk_fp8_f32(fminf(fmaxf(v0[2], -440.f), 440.f), fminf(fmaxf(v0[3], -440.f), 440.f), w0, true);
                    w1 = __builtin_amdgcn_cvt_pk_fp8_f32(fminf(fmaxf(v1[0], -440.f), 440.f), fminf(fmaxf(v1[1], -440.f), 440.f), w1, false); w1 = __builtin_amdgcn_cvt_pk_fp8_f32(fminf(fmaxf(v1[2], -440.f), 440.f), fminf(fmaxf(v1[3], -440.f), 440.f), w1, true);
                    typedef unsigned u32x2_ __attribute__((ext_vector_type(2))); *(u32x2_*)(rowp + bj * HALF) = (u32x2_){w0, w1}; } }
    }
};
struct EpiRowScaleBf16 {
    static constexpr bool PERM = true, AFTER_DRAIN = false;
    bf16_t* O; int ldc; const float* rs; float cs; int split_cols; size_t split_stride;
    __device__ __forceinline__ void operator()(const f32x4 (&acc)[2][2][4][2], const Unit& u, int wr, int wc, int fr, int fq) const {
        int ln_; asm volatile("v_mbcnt_lo_u32_b32 %0, -1, 0\n\tv_mbcnt_hi_u32_b32 %0, -1, %0" : "=v"(ln_));
        (void)fr; (void)fq; const int row0 = u.pm * BM + wr * 64 + (ln_ & 15); int colt = u.pn * BM; bf16_t* base = O;
        if (split_cols) { const int t = colt / split_cols; base += (size_t)t * split_stride; colt -= t * split_cols; }
        const int col0 = colt + wc * 32 + 8 * (ln_ >> 4);
#pragma unroll
        for (int ai = 0; ai < 2; ++ai)
#pragma unroll
            for (int m = 0; m < 4; ++m) { const int row = row0 + ai * HALF + m * 16; const float sc = rs ? rs[row] * cs : cs; bf16_t* rowp = base + (size_t)row * ldc + col0;
#pragma unroll
                for (int bj = 0; bj < 2; ++bj) { const f32x4 v0 = acc[ai][bj][m][0] * sc, v1 = acc[ai][bj][m][1] * sc;
                    u32x4 w; w.x = cvt_pk_bf16(v0[0], v0[1]); w.y = cvt_pk_bf16(v0[2], v0[3]); w.z = cvt_pk_bf16(v1[0], v1[1]); w.w = cvt_pk_bf16(v1[2], v1[3]);
                    *(u32x4*)(rowp + bj * HALF) = w; } }
    }
};
struct EpiI8RowScaleBf16 {
    static constexpr bool PERM = true, AFTER_DRAIN = false;
    bf16_t* O; int ldc; const float* rs; float cs; int split_cols; size_t split_stride;
    __device__ __forceinline__ void operator()(const f32x4 (&acc)[2][2][4][2], const Unit& u, int wr, int wc, int fr, int fq) const {
        int ln_; asm volatile("v_mbcnt_lo_u32_b32 %0, -1, 0\n\tv_mbcnt_hi_u32_b32 %0, -1, %0" : "=v"(ln_));
        (void)fr; (void)fq; const int row0 = u.pm * BM + wr * 64 + (ln_ & 15); int colt = u.pn * BM; bf16_t* base = O;
        if (split_cols) { const int t = colt / split_cols; base += (size_t)t * split_stride; colt -= t * split_cols; }
        const int col0 = colt + wc * 32 + 8 * (ln_ >> 4);
#pragma unroll
        for (int ai = 0; ai < 2; ++ai)
#pragma unroll
            for (int m = 0; m < 4; ++m) { const int row = row0 + ai * HALF + m * 16; const float sc = rs[row] * cs; bf16_t* rowp = base + (size_t)row * ldc + col0;
#pragma unroll
                for (int bj = 0; bj < 2; ++bj) { typedef int i32x4_ __attribute__((ext_vector_type(4))); const i32x4_ i0 = __builtin_bit_cast(i32x4_, acc[ai][bj][m][0]), i1 = __builtin_bit_cast(i32x4_, acc[ai][bj][m][1]);
                    u32x4 w; w.x = cvt_pk_bf16((float)i0[0] * sc, (float)i0[1] * sc); w.y = cvt_pk_bf16((float)i0[2] * sc, (float)i0[3] * sc); w.z = cvt_pk_bf16((float)i1[0] * sc, (float)i1[1] * sc); w.w = cvt_pk_bf16((float)i1[2] * sc, (float)i1[3] * sc);
                    *(u32x4*)(rowp + bj * HALF) = w; } }
    }
};
struct EpiGate {
    static constexpr bool PERM = false, AFTER_DRAIN = false;
    const bf16_t* XC; float* AF; float* DF; const float* b_a; const float* b_x; const float* ls8; int cbase;
    __device__ __forceinline__ void operator()(const f32x4 (&acc)[2][2][4][2], const Unit& u, int wr, int wc, int fr, int fq) const {
        const unsigned row0 = (unsigned)(u.pm * BM + wr * 64 + fr);
#pragma unroll
        for (int n = 0; n < 2; ++n) { unsigned c = (unsigned)(cbase + wc * 32 + 16 * n + 4 * fq); asm volatile("" : "+v"(c));
            const f32x4 ba = *(const f32x4*)(b_a + c), bx = *(const f32x4*)(b_x + c), l8 = *(const f32x4*)(ls8 + c) * 1.4426950408889634f;
#pragma unroll
            for (int ai = 0; ai < 2; ++ai)
#pragma unroll
                for (int m = 0; m < 4; ++m) { const unsigned off = (row0 + ai * HALF + m * 16) * 1024u + c;
                    const f32x4 pr = acc[ai][0][m][n] + ba, pi = acc[ai][1][m][n] + bx;
                    const uint2 xr = *(const uint2*)((const char*)XC + off * 2u);
                    const float xc[4] = {__uint_as_float(xr.x << 16), __uint_as_float(xr.x & 0xffff0000u), __uint_as_float(xr.y << 16), __uint_as_float(xr.y & 0xffff0000u)};
                    u32x4 pw;
#pragma unroll
                    for (int e = 0; e < 4; ++e) { const float r = __builtin_amdgcn_rcpf(1.f + __builtin_amdgcn_exp2f(-1.4426950408889634f * pr[e])), ig = __builtin_amdgcn_rcpf(1.f + __builtin_amdgcn_exp2f(-1.4426950408889634f * pi[e]));
                        const float la = r * l8[e]; const float a = __builtin_amdgcn_exp2f(la); const float mult = __builtin_amdgcn_sqrtf(fmaxf(1.f - a * a, 0.f)); pw[e] = cvt_pk_bf16(la, mult * ig * xc[e]); }
                    *(u32x4*)((char*)AF + off * 4u) = pw; asm volatile("" ::: "memory"); } }
    }
};
}

#define LAS __attribute__((address_space(3)))
typedef unsigned short bf16;
typedef unsigned v4u __attribute__((ext_vector_type(4)));
typedef unsigned v2u __attribute__((ext_vector_type(2)));
typedef float f32x4 __attribute__((ext_vector_type(4)));
typedef float f32x16 __attribute__((ext_vector_type(16)));
typedef short bf16x8 __attribute__((ext_vector_type(8)));

constexpr int NTHREADS = 512, NWAVES = 8;
constexpr int LDS_BYTES = 155648 + 256, LDS_CTL = 155648;
constexpr int BATCH = 2, SEQ = 8192, DM = 2048, M = BATCH * SEQ, NEXP = 16384;
constexpr int NZ = 3072, NQKV = 6144, NODIN = 6160;
constexpr int ROW6 = 1536;
constexpr bool V_FP4 = true;
constexpr int ROWV = V_FP4 ? 1024 : ROW6;
constexpr int ROW4 = 1024;
constexpr float ALPHA = 1.4142135623730951f, LN_EPS = 1e-5f;
constexpr float ATT_SCALE = 0.08838834764831845f;

constexpr size_t MiB = 1u << 20;
constexpr size_t WS_MOD = 1 * MiB;
constexpr size_t WS_LS8 = 1 * MiB + 512 * 1024;
constexpr size_t WS_WIN = 2 * MiB, WS_WOUT = 14 * MiB, WS_WQKV = 22 * MiB, WS_WO = 46 * MiB, WS_WQ0 = 54 * MiB, WS_WQ1 = 62 * MiB;
constexpr size_t WS_KEYS = 70 * MiB, WS_WPOOL = 71 * MiB, WS_WAX = 71 * MiB + 512 * 1024, WS_WF = 72 * MiB;
constexpr size_t WS_FE = 77 * MiB, WS_FP = 77 * MiB + 64 * 1024, WS_KN = 77 * MiB + 128 * 1024, WS_QN = 77 * MiB + 192 * 1024, WS_DN = 77 * MiB + 256 * 1024;
constexpr size_t WS_AG = 73 * MiB, WS_HG = 73 * MiB + 512 * 1024, WS_LF = 74 * MiB, WS_FB = 75 * MiB;
constexpr size_t WS_SU = 76 * MiB, WS_SV = 76 * MiB + 128 * 1024;
constexpr size_t WS_HB8 = 208 * MiB, WS_SA = 79 * MiB;
constexpr float YP_SCALE = 64.f;
constexpr float W8O_SCALE = 2048.f, Y8_SCALE = 16.f;
constexpr size_t WS_YC8 = 240 * MiB;
constexpr float W8_SCALE = 1024.f;
constexpr size_t WS_PART = 400 * MiB;
constexpr size_t WS_AR = 496 * MiB, WS_EQ = 500 * MiB;
constexpr size_t WS_Y = 592 * MiB;
constexpr size_t WS_H6 = 752 * MiB, WS_HS = 785 * MiB;
constexpr size_t WS_TU = 80 * MiB, WS_TV = 144 * MiB;
constexpr size_t WS_HB = 336 * MiB, WS_ZB = 400 * MiB, WS_YC = 592 * MiB, WS_YB = 656 * MiB, WS_X1 = 720 * MiB, WS_H2 = 848 * MiB, WS_QP = 912 * MiB;
constexpr size_t WS_EI = 976 * MiB, WS_GT = 984 * MiB, WS_END = 992 * MiB;
constexpr size_t WS_AF = WS_H2, WS_DF = WS_QP;
constexpr size_t WS_PO = WS_YB, WS_XC = WS_YB + 32 * MiB;

struct Args { const float* in[24]; float* out; unsigned char* ws; int ph_lo, ph_hi; };

__device__ __forceinline__ float bf_lo(unsigned u) { return __uint_as_float(u << 16); }
__device__ __forceinline__ float bf_hi(unsigned u) { return __uint_as_float(u & 0xffff0000u); }
__device__ __forceinline__ unsigned pk2(float lo, float hi) { return pg8::cvt_pk_bf16(lo, hi); }
__device__ __forceinline__ unsigned pk2c(float lo, float hi) { typedef float f2_ __attribute__((ext_vector_type(2))); typedef __bf16 b2_ __attribute__((ext_vector_type(2))); const f2_ f = {lo, hi}; return __builtin_bit_cast(unsigned, __builtin_convertvector(f, b2_)); }
#define SWZ_XOR_(v, m) __uint_as_float((unsigned)__builtin_amdgcn_ds_swizzle((int)__float_as_uint(v), ((m) << 10) | 0x1f))
__device__ __forceinline__ float wave_sum(float v) {
    v += SWZ_XOR_(v, 1); v += SWZ_XOR_(v, 2); v += SWZ_XOR_(v, 4); v += SWZ_XOR_(v, 8); v += SWZ_XOR_(v, 16);
    const auto rr = __builtin_amdgcn_permlane32_swap(__float_as_uint(v), __float_as_uint(v), false, false);
    return __uint_as_float(rr[0]) + __uint_as_float(rr[1]);
}
__device__ __forceinline__ float wave_max(float v) {
    v = fmaxf(v, SWZ_XOR_(v, 1)); v = fmaxf(v, SWZ_XOR_(v, 2)); v = fmaxf(v, SWZ_XOR_(v, 4)); v = fmaxf(v, SWZ_XOR_(v, 8)); v = fmaxf(v, SWZ_XOR_(v, 16));
    const auto rr = __builtin_amdgcn_permlane32_swap(__float_as_uint(v), __float_as_uint(v), false, false);
    return fmaxf(__uint_as_float(rr[0]), __uint_as_float(rr[1]));
}
__device__ __forceinline__ float gelu_tanh(float x) { const float y = 0.7978845608028654f * (x + 0.044715f * x * x * x); return x * __builtin_amdgcn_rcpf(1.f + __builtin_amdgcn_exp2f(-2.8853900817779268f * y)); }
#define LDS_WAIT() asm volatile("s_waitcnt lgkmcnt(0)" ::: "memory")
__device__ __forceinline__ int lane_id() { int l; asm volatile("v_mbcnt_lo_u32_b32 %0, -1, 0\n\tv_mbcnt_hi_u32_b32 %0, -1, %0" : "=v"(l)); return l; }


#define XB_TMO      128
#define XB_XCNT(j)  (256  + 64 * (j))
#define XB_XSUB(j)  (1280 + 64 * (j))
#define XB_XGEN(j)  (2304 + 64 * (j))
#define XB_TOP      3328
#define XB_TOPGEN   3392
#define XCD_BAR_WORDS 3456
#define XB_SPIN_CAP (1u << 22)
__device__ __forceinline__ unsigned xb_ld(unsigned* p)              { return __hip_atomic_load(p, __ATOMIC_RELAXED, __HIP_MEMORY_SCOPE_AGENT); }
__device__ __forceinline__ unsigned xb_add(unsigned* p, unsigned v) { return __hip_atomic_fetch_add(p, v, __ATOMIC_RELAXED, __HIP_MEMORY_SCOPE_AGENT); }
__device__ __forceinline__ unsigned xb_xcc_id() { return (unsigned)__builtin_amdgcn_s_getreg((3 << 11) | 20) & 0xFu; }
#define XB_SPIN(cond, bar) do { unsigned _sp = 0; while (cond) { __builtin_amdgcn_s_sleep(1); \
    if ((++_sp & 255u) == 0u) { if (xb_ld(&(bar)[XB_TMO])) break; if (_sp > XB_SPIN_CAP) { atomicAdd(&(bar)[XB_TMO], 1u); break; } } } } while (0)
struct XcdBarrier { unsigned* bar; unsigned x; volatile LAS unsigned* st; };
__device__ __forceinline__ XcdBarrier xcd_barrier_post(unsigned* bar, volatile LAS unsigned* st, bool t0) {
    XcdBarrier b; b.bar = bar; b.x = xb_xcc_id(); b.st = st;
    if (t0) { st[2] = xb_add(&bar[XB_XCNT(b.x)], 1u); st[3] = b.x; }
    return b;
}
__device__ __forceinline__ void xcd_barrier_complete(unsigned* bar, unsigned x, unsigned& nloc, unsigned& nx, unsigned& uni) {
    const unsigned G = gridDim.x * gridDim.y * gridDim.z;
    unsigned sum, cnt, mine, sp = 0u;
    for (;;) {
        sum = 0u; cnt = 0u; mine = 0u; uni = (G & 7u) == 0u ? 1u : 0u;
#pragma unroll
        for (unsigned j = 0; j < 16; ++j) { const unsigned c = xb_ld(&bar[XB_XCNT(j)]); sum += c; cnt += (c > 0u) ? 1u : 0u; mine = (j == x) ? c : mine; uni = (c == (j < 8u ? (G >> 3) : 0u)) ? uni : 0u; }
        if (sum == G) break;
        __builtin_amdgcn_s_sleep(1);
        if ((++sp & 255u) == 0u) { if (xb_ld(&bar[XB_TMO])) break; if (sp > XB_SPIN_CAP) { atomicAdd(&bar[XB_TMO], 1u); break; } }
    }
    nloc = mine > 0u ? mine : 1u; nx = cnt > 0u ? cnt : 1u;
}
__device__ __forceinline__ void xcd_barrier(const XcdBarrier& b, bool t0) {
    asm volatile("s_waitcnt vmcnt(0)" ::: "memory");
    __syncthreads();
    if (t0) {
        unsigned* bar = b.bar;
        __builtin_amdgcn_s_waitcnt(0);
        unsigned nloc = b.st[0], nx = b.st[1];
        if (nloc == 0u) { unsigned uni; xcd_barrier_complete(bar, b.x, nloc, nx, uni); b.st[0] = nloc; b.st[1] = nx; b.st[4] = uni; }
        const unsigned old = xb_add(&bar[XB_XSUB(b.x)], 1u);
        const unsigned gen = old / nloc;
        if (old + 1u == (gen + 1u) * nloc) {
            __builtin_amdgcn_fence(__ATOMIC_RELEASE, "agent");
            asm volatile("s_waitcnt vmcnt(0)" ::: "memory");
            const unsigned og = xb_add(&bar[XB_TOP], 1u);
            const unsigned tg = og / nx;
            if (og + 1u == (tg + 1u) * nx) xb_add(&bar[XB_TOPGEN], 1u);
            else XB_SPIN(xb_ld(&bar[XB_TOPGEN]) == tg, bar);
            __builtin_amdgcn_fence(__ATOMIC_ACQUIRE, "agent");
            xb_add(&bar[XB_XGEN(b.x)], 1u);
            asm volatile("s_waitcnt vmcnt(0)" ::: "memory");
        } else {
            XB_SPIN(xb_ld(&bar[XB_XGEN(b.x)]) == gen, bar);
            __builtin_amdgcn_fence(__ATOMIC_ACQUIRE, "agent");
            asm volatile("s_waitcnt vmcnt(0)" ::: "memory");
        }
    }
    __syncthreads();
}

__device__ __forceinline__ void transpose_item(const float* W, int ldw, int nblk, bf16* WT, int K, LAS float* scr, int item, int lane) {
    const int kb = item / nblk, nb = item % nblk, k0 = 64 * kb, n0 = 32 * nb;
#pragma unroll 8
    for (int i = 0; i < 32; ++i) { const int kk = 2 * i + (lane >> 5); scr[kk * 33 + (lane & 31)] = W[(size_t)(k0 + kk) * ldw + n0 + (lane & 31)]; }
    LDS_WAIT(); asm volatile("" ::: "memory");
    const int c = lane & 7;
#pragma unroll
    for (int j = 0; j < 4; ++j) { const int n = (lane >> 3) + 8 * j; const LAS float* s = scr + (8 * c) * 33 + n;
        v4u o; o.x = pk2(s[0 * 33], s[1 * 33]); o.y = pk2(s[2 * 33], s[3 * 33]); o.z = pk2(s[4 * 33], s[5 * 33]); o.w = pk2(s[6 * 33], s[7 * 33]);
        *(v4u*)(WT + (size_t)(n0 + n) * K + k0 + 8 * c) = o; }
    LDS_WAIT(); asm volatile("" ::: "memory");
}
__device__ __forceinline__ unsigned pk4_i8(float a, float b, float c, float d) {
    const int ia = (int)rintf(fminf(fmaxf(a, -127.f), 127.f)), ib = (int)rintf(fminf(fmaxf(b, -127.f), 127.f)), ic = (int)rintf(fminf(fmaxf(c, -127.f), 127.f)), id = (int)rintf(fminf(fmaxf(d, -127.f), 127.f));
    return ((unsigned)ia & 0xffu) | (((unsigned)ib & 0xffu) << 8) | (((unsigned)ic & 0xffu) << 16) | ((unsigned)id << 24);
}
__device__ __forceinline__ void transpose_item_i8(const float* W, int ldw, int nblk, unsigned char* WT, int K, LAS float* scr, int item, int lane, float wscale) {
    const int kb = item / nblk, nb = item % nblk, k0 = 64 * kb, n0 = 32 * nb;
#pragma unroll 8
    for (int i = 0; i < 32; ++i) { const int kk = 2 * i + (lane >> 5); scr[kk * 33 + (lane & 31)] = W[(size_t)(k0 + kk) * ldw + n0 + (lane & 31)] * wscale; }
    LDS_WAIT(); asm volatile("" ::: "memory");
    const int c = lane & 7;
#pragma unroll
    for (int j = 0; j < 4; ++j) { const int n = (lane >> 3) + 8 * j; const LAS float* sp = scr + (8 * c) * 33 + n;
        *(v2u*)(WT + (size_t)(n0 + n) * K + k0 + 8 * c) = (v2u){pk4_i8(sp[0 * 33], sp[1 * 33], sp[2 * 33], sp[3 * 33]), pk4_i8(sp[4 * 33], sp[5 * 33], sp[6 * 33], sp[7 * 33])}; }
    LDS_WAIT(); asm volatile("" ::: "memory");
}
__device__ __forceinline__ float cl8(float x) { return fminf(fmaxf(x, -440.f), 440.f); }
__device__ __forceinline__ unsigned pk4_fp8(float a, float b, float c, float d) { unsigned w = 0u; w = __builtin_amdgcn_cvt_pk_fp8_f32(cl8(a), cl8(b), w, false); w = __builtin_amdgcn_cvt_pk_fp8_f32(cl8(c), cl8(d), w, true); return w; }
__device__ __forceinline__ void transpose_item8(const float* W, int ldw, int nblk, unsigned char* WT, int K, LAS float* scr, int item, int lane, float wscale = W8_SCALE) {
    const int kb = item / nblk, nb = item % nblk, k0 = 64 * kb, n0 = 32 * nb;
#pragma unroll 8
    for (int i = 0; i < 32; ++i) { const int kk = 2 * i + (lane >> 5); scr[kk * 33 + (lane & 31)] = W[(size_t)(k0 + kk) * ldw + n0 + (lane & 31)] * wscale; }
    LDS_WAIT(); asm volatile("" ::: "memory");
    const int c = lane & 7;
#pragma unroll
    for (int j = 0; j < 4; ++j) { const int n = (lane >> 3) + 8 * j; const LAS float* sp = scr + (8 * c) * 33 + n; unsigned w0 = 0u, w1 = 0u;
        w0 = __builtin_amdgcn_cvt_pk_fp8_f32(cl8(sp[0 * 33]), cl8(sp[1 * 33]), w0, false); w0 = __builtin_amdgcn_cvt_pk_fp8_f32(cl8(sp[2 * 33]), cl8(sp[3 * 33]), w0, true);
        w1 = __builtin_amdgcn_cvt_pk_fp8_f32(cl8(sp[4 * 33]), cl8(sp[5 * 33]), w1, false); w1 = __builtin_amdgcn_cvt_pk_fp8_f32(cl8(sp[6 * 33]), cl8(sp[7 * 33]), w1, true);
        *(v2u*)(WT + (size_t)(n0 + n) * K + k0 + 8 * c) = (v2u){w0, w1}; }
    LDS_WAIT(); asm volatile("" ::: "memory");
}
__device__ __forceinline__ void convert_item(const float* src, bf16* dst, size_t item, int lane) {
    const size_t base = item * 4096 + (size_t)lane * 8;
#pragma unroll
    for (int j = 0; j < 8; ++j) { const f32x4 a = *(const f32x4*)(src + base + j * 512), b = *(const f32x4*)(src + base + j * 512 + 4);
        v4u o; o.x = pk2(a[0], a[1]); o.y = pk2(a[2], a[3]); o.z = pk2(b[0], b[1]); o.w = pk2(b[2], b[3]);
        *(v4u*)(dst + base + j * 512) = o; }
}
__device__ __forceinline__ void fp8_row_item(const float* src, unsigned char* dst, float* scale, int row, int lane) {
    const float* p = src + (size_t)row * DM + 4 * lane; f32x4 v[8]; float mx = 0.f;
#pragma unroll
    for (int j = 0; j < 8; ++j) { v[j] = *(const f32x4*)(p + 256 * j); mx = fmaxf(mx, fmaxf(fmaxf(fabsf(v[j][0]), fabsf(v[j][1])), fmaxf(fabsf(v[j][2]), fabsf(v[j][3])))); }
    mx = fmaxf(wave_max(mx), 1e-30f); const float inv = 240.f / mx;
    unsigned* q = (unsigned*)(dst + (size_t)row * DM) + lane;
#pragma unroll
    for (int j = 0; j < 8; ++j) { unsigned w = 0u; w = __builtin_amdgcn_cvt_pk_fp8_f32(v[j][0] * inv, v[j][1] * inv, w, false); w = __builtin_amdgcn_cvt_pk_fp8_f32(v[j][2] * inv, v[j][3] * inv, w, true); q[64 * j] = w; }
    if (lane == 0) scale[row] = mx * (1.f / 240.f);
}
typedef float f32x16_t __attribute__((ext_vector_type(16)));
typedef float f32x32_t __attribute__((ext_vector_type(32)));
typedef unsigned u32x6_t __attribute__((ext_vector_type(6)));
typedef unsigned u32x3_t __attribute__((ext_vector_type(3)));
__device__ __forceinline__ void fp6_pack_block(const float (&v)[32], u32x6_t& p, unsigned& ebyte) {
    float mx = 0.f;
#pragma unroll
    for (int i = 0; i < 32; ++i) mx = fmaxf(mx, fabsf(v[i]));
    int ex = (int)((__float_as_uint(mx * (1.f / 7.5f)) + 0x7fffffu) >> 23) - 127; ex = ex < -126 ? -126 : (ex > 127 ? 127 : ex);
    const float inv = __uint_as_float((unsigned)(127 - ex) << 23);
    f32x16_t a, b;
#pragma unroll
    for (int i = 0; i < 16; ++i) { a[i] = v[2 * i] * inv; b[i] = v[2 * i + 1] * inv; }
    p = __builtin_amdgcn_cvt_scalef32_2xpk16_fp6_f32(a, b, 1.0f); ebyte = (unsigned)(ex + 127);
}
__device__ __forceinline__ void fp6_row_item(const float* src, unsigned char* dst, float* sdst, int row, int lane) {
    const float* p = src + (size_t)row * DM + 4 * lane; float v[32]; float mx = 0.f;
#pragma unroll
    for (int j = 0; j < 8; ++j) { const f32x4 x = *(const f32x4*)(p + 256 * j); v[4 * j] = x[0]; v[4 * j + 1] = x[1]; v[4 * j + 2] = x[2]; v[4 * j + 3] = x[3]; }
#pragma unroll
    for (int i = 0; i < 32; ++i) mx = fmaxf(mx, fabsf(v[i]));
    mx = fmaxf(wave_max(mx), 1e-30f);
    const float inv = 7.5f / mx;
    f32x16_t a, b;
#pragma unroll
    for (int i = 0; i < 16; ++i) { a[i] = v[2 * i] * inv; b[i] = v[2 * i + 1] * inv; }
    const u32x6_t pk = __builtin_amdgcn_cvt_scalef32_2xpk16_fp6_f32(a, b, 1.0f);
    unsigned char* q = dst + (size_t)row * ROW6;
    *(v4u*)(q + 16 * lane) = (v4u){pk[0], pk[1], pk[2], pk[3]}; *(v2u*)(q + 1024 + 8 * lane) = (v2u){pk[4], pk[5]};
    if (lane == 0) sdst[row] = mx * (1.f / 7.5f);
}
template <bool VORD>
__device__ __forceinline__ void fp4_row_item(const float* src, unsigned char* dst, float* sdst, int row, int lane) {
    const float* p = src + (size_t)row * DM + (VORD ? 32 : 8) * lane; float v[32]; float ss = 0.f;
    if constexpr (VORD) {
#pragma unroll
        for (int j = 0; j < 8; ++j) { const f32x4 x = *(const f32x4*)(p + 4 * j); v[4 * j] = x[0]; v[4 * j + 1] = x[1]; v[4 * j + 2] = x[2]; v[4 * j + 3] = x[3]; } }
    else
#pragma unroll
    for (int j = 0; j < 4; ++j) { const f32x4 x = *(const f32x4*)(p + 512 * j), y = *(const f32x4*)(p + 512 * j + 4); v[8 * j] = x[0]; v[8 * j + 1] = x[1]; v[8 * j + 2] = x[2]; v[8 * j + 3] = x[3]; v[8 * j + 4] = y[0]; v[8 * j + 5] = y[1]; v[8 * j + 6] = y[2]; v[8 * j + 7] = y[3]; }
#pragma unroll
    for (int i = 0; i < 32; ++i) ss += v[i] * v[i];
    const float sc = fmaxf(0.5f * sqrtf(wave_sum(ss) * (1.f / DM)), 1e-30f), inv = 1.f / sc;
    unsigned w[4] = {0u, 0u, 0u, 0u};
#pragma unroll
    for (int d = 0; d < 4; ++d) {
        w[d] = __builtin_amdgcn_cvt_scalef32_pk_fp4_f32(w[d], v[8 * d] * inv, v[8 * d + 1] * inv, 1.0f, 0);
        w[d] = __builtin_amdgcn_cvt_scalef32_pk_fp4_f32(w[d], v[8 * d + 2] * inv, v[8 * d + 3] * inv, 1.0f, 1);
        w[d] = __builtin_amdgcn_cvt_scalef32_pk_fp4_f32(w[d], v[8 * d + 4] * inv, v[8 * d + 5] * inv, 1.0f, 2);
        w[d] = __builtin_amdgcn_cvt_scalef32_pk_fp4_f32(w[d], v[8 * d + 6] * inv, v[8 * d + 7] * inv, 1.0f, 3); }
    unsigned char* q = dst + (size_t)(row / NEXP) * NEXP * ROW4 + ((size_t)(lane >> 3) * NEXP + (size_t)(row % NEXP)) * 128 + 16 * (lane & 7);
    *(v4u*)q = (v4u){w[0], w[1], w[2], w[3]};
    if (lane == 0) sdst[row] = sc;
}
__device__ __forceinline__ void ph_prologue(const Args& a, LAS unsigned char* lds, int tid, int lane, int wave) {
    unsigned char* ws = a.ws;
    if (blockIdx.x < 192) {
        LAS float* cact = (LAS float*)lds;
        LAS float* red = (LAS float*)(lds + 16384);
        for (int i = tid; i < 2 * DM; i += NTHREADS) { const float cv = a.in[1][i]; cact[i] = cv / (1.f + __expf(-cv)); }
        __syncthreads();
        const int item = blockIdx.x, l = item / 96, col0 = (item % 96) * 128, rsub = lane >> 5, c4 = lane & 31;
        const float* W = a.in[2] + (size_t)l * DM * 12288 + col0 + 4 * c4;
        f32x4 acc0 = {0.f, 0.f, 0.f, 0.f}, acc1 = {0.f, 0.f, 0.f, 0.f};
#pragma unroll 8
        for (int i = 0; i < 128; ++i) { const int k = wave * 256 + 2 * i + rsub; const f32x4 w = *(const f32x4*)(W + (size_t)k * 12288);
            acc0 += w * cact[k]; acc1 += w * cact[DM + k]; }
#pragma unroll
        for (int e = 0; e < 4; ++e) { acc0[e] += __shfl_xor(acc0[e], 32); acc1[e] += __shfl_xor(acc1[e], 32); }
        if (rsub == 0) {
#pragma unroll
            for (int e = 0; e < 4; ++e) { red[(wave * 2 + 0) * 128 + 4 * c4 + e] = acc0[e]; red[(wave * 2 + 1) * 128 + 4 * c4 + e] = acc1[e]; } }
        __syncthreads();
        if (tid < 256) { const int b = tid >> 7, col = tid & 127; float s = 0.f;
#pragma unroll
            for (int w8 = 0; w8 < 8; ++w8) s += red[(w8 * 2 + b) * 128 + col];
            s += a.in[3][l * 12288 + col0 + col];
            ((float*)(ws + WS_MOD))[(size_t)(l * 2 + b) * 12288 + col0 + col] = s; }
        __syncthreads();
    }
    LAS float* scr = (LAS float*)(lds + wave * 16384);
    const int gw = blockIdx.x * NWAVES + wave, NGW = gridDim.x * NWAVES;
    constexpr int I_WIN = 32 * 96, I_SQ = 32 * 64, I_QKV = 32 * 192, I_POOL = 4 * 32, I_AX = 16 * 8, I_WF = 16, I_KEYS = 128, I_TAB = 2 * NEXP, I_LS = 1;
    constexpr int NITEMS = I_WIN + 4 * I_SQ + I_QKV + I_POOL + I_AX + I_WF + I_KEYS + 2 * I_TAB + I_LS;
    for (int it = gw; it < NITEMS; it += NGW) {
        int r = it;
        if (r < 2 * I_TAB) { if (r < I_TAB) fp4_row_item<false>(a.in[8], ws + WS_TU, (float*)(ws + WS_SU), r, lane); else if constexpr (V_FP4) fp4_row_item<true>(a.in[9], ws + WS_TV, (float*)(ws + WS_SV), r - I_TAB, lane); else fp6_row_item(a.in[9], ws + WS_TV, (float*)(ws + WS_SV), r - I_TAB, lane); continue; } r -= 2 * I_TAB;
        if (r < I_WIN) { transpose_item_i8(a.in[10], NZ, 96, ws + WS_WIN, DM, scr, r, lane, W8_SCALE); continue; } r -= I_WIN;
        if (r < I_SQ) { transpose_item8(a.in[20], DM, 64, ws + WS_WOUT, DM, scr, r, lane, W8O_SCALE); continue; } r -= I_SQ;
        if (r < I_QKV) { transpose_item8(a.in[21], NODIN, 192, ws + WS_WQKV, DM, scr, r, lane); continue; } r -= I_QKV;
        if (r < I_SQ) { transpose_item8(a.in[23], DM, 64, ws + WS_WO, DM, scr, r, lane, W8O_SCALE); continue; } r -= I_SQ;
        if (r < I_SQ) { transpose_item_i8(a.in[6], DM, 64, ws + WS_WQ0, DM, scr, r, lane, W8_SCALE); continue; } r -= I_SQ;
        if (r < I_SQ) { transpose_item_i8(a.in[6] + (size_t)DM * DM, DM, 64, ws + WS_WQ1, DM, scr, r, lane, W8_SCALE); continue; } r -= I_SQ;
        if (r < I_POOL) { const int g = r >> 5; transpose_item(a.in[11] + g * 65536, 256, 8, (bf16*)(ws + WS_WPOOL) + g * 65536, 256, scr, r & 31, lane); continue; } r -= I_POOL;
        if (r < I_AX) { const int h = r >> 4, which = (r >> 3) & 1;
            transpose_item(a.in[which ? 17 : 15] + h * 16384, 128, 4, (bf16*)(ws + WS_WAX) + h * 32768 + which * 16384, 128, scr, r & 7, lane); continue; } r -= I_AX;
        if (r < I_WF) { bf16* WF = (bf16*)(ws + WS_WF);
            for (int k = lane; k < DM; k += 64) { const float v = a.in[21][(size_t)k * NODIN + NQKV + r]; WF[r * DM + k] = (bf16)(pk2(v, v) & 0xffffu); } continue; } r -= I_WF;
        if (r < I_KEYS) { convert_item(a.in[7], (bf16*)(ws + WS_KEYS), (size_t)r, lane); continue; } r -= I_KEYS;
        { float* LS8 = (float*)(ws + WS_LS8);
            for (int cch = lane; cch < 1024; cch += 64) { const float x = a.in[19][cch]; LS8[cch] = 8.f * (fminf(x, 0.f) - log1pf(__expf(-fabsf(x)))); } }
    }
}

__device__ __forceinline__ void ph_modulate(const float* src, const float* mod_l  , int sh_off, int sc_off, bf16* dst, unsigned char* dst8, float* rs, int lane, int wave) {
    const int gw = blockIdx.x * NWAVES + wave, NGW = gridDim.x * NWAVES;
    int cur_b = -1; f32x4 scv[8], shv[8];
    for (int t = gw; t < M; t += NGW) {
        const int b = t >> 13;
        if (b != cur_b) { cur_b = b; const float* mb = mod_l + b * 12288;
#pragma unroll
            for (int j = 0; j < 8; ++j) { scv[j] = *(const f32x4*)(mb + sc_off + 4 * lane + 256 * j) + 1.f; shv[j] = *(const f32x4*)(mb + sh_off + 4 * lane + 256 * j); } }
        const float* xr = src + (size_t)t * DM + 4 * lane; bf16* dr = dst + (size_t)t * DM + 4 * lane; f32x4 v[8]; float mx = 0.f;
#pragma unroll
        for (int j = 0; j < 8; ++j) { v[j] = *(const f32x4*)(xr + 256 * j) * scv[j] + shv[j]; uint2 o; o.x = pk2(v[j][0], v[j][1]); o.y = pk2(v[j][2], v[j][3]); *(uint2*)(dr + 256 * j) = o;
            mx = fmaxf(mx, fmaxf(fmaxf(fabsf(v[j][0]), fabsf(v[j][1])), fmaxf(fabsf(v[j][2]), fabsf(v[j][3])))); }
        mx = fmaxf(wave_max(mx), 1e-30f); const float inv = 127.f / mx; unsigned* q8 = (unsigned*)(dst8 + (size_t)t * DM) + lane;
#pragma unroll
        for (int j = 0; j < 8; ++j) q8[64 * j] = pk4_i8(v[j][0] * inv, v[j][1] * inv, v[j][2] * inv, v[j][3] * inv);
        if (lane == 0) rs[t] = mx * (1.f / 127.f);
    }
}

__device__ __forceinline__ void ld8(const bf16* p, float (&v)[8]) { const v4u u = *(const v4u*)p; v[0] = bf_lo(u.x); v[1] = bf_hi(u.x); v[2] = bf_lo(u.y); v[3] = bf_hi(u.y); v[4] = bf_lo(u.z); v[5] = bf_hi(u.z); v[6] = bf_lo(u.w); v[7] = bf_hi(u.w); }
__device__ __forceinline__ void st8(bf16* p, const float (&v)[8]) { v4u o; o.x = pk2(v[0], v[1]); o.y = pk2(v[2], v[3]); o.z = pk2(v[4], v[5]); o.w = pk2(v[6], v[7]); *(v4u*)p = o; }
__device__ __forceinline__ void ph_poolconv(const Args& a, int lane, int wave) {
    const bf16* Z = (const bf16*)(a.ws + WS_ZB); bf16* PO = (bf16*)(a.ws + WS_PO); bf16* XC = (bf16*)(a.ws + WS_XC);
    const int gw = blockIdx.x * NWAVES + wave, NGW = gridDim.x * NWAVES;
    for (int item = gw; item < 2048; item += NGW) {
        const int which = item & 3, t0 = (item >> 2) * 32, pos0 = t0 & (SEQ - 1);
        if (which < 2) {
            const int c = which * 512 + lane * 8, w = 2 << (c >> 8);
            float sum[8] = {0.f, 0.f, 0.f, 0.f, 0.f, 0.f, 0.f, 0.f};
            for (int s = 1; s < 16; ++s) if (s < w && pos0 - s >= 0) { float v[8]; ld8(Z + (size_t)(t0 - s) * NZ + c, v);
#pragma unroll
                for (int e = 0; e < 8; ++e) sum[e] += v[e]; }
            for (int i = 0; i < 32; ++i) { const int t = t0 + i, pos = pos0 + i; float cur[8], o[8]; ld8(Z + (size_t)t * NZ + c, cur);
                const float inv = 1.f / (float)(pos + 1 < w ? pos + 1 : w);
#pragma unroll
                for (int e = 0; e < 8; ++e) { sum[e] += cur[e]; o[e] = sum[e] * inv - cur[e]; }
                st8(PO + (size_t)t * 1024 + c, o);
                if (pos - w + 1 >= 0) { float old[8]; ld8(Z + (size_t)(t - w + 1) * NZ + c, old);
#pragma unroll
                    for (int e = 0; e < 8; ++e) sum[e] -= old[e]; } }
        } else {
            const int c = (which - 2) * 512 + lane * 8; const bf16* zc = Z + 1024 + c;
            float w0[8], w1[8], w2[8], w3[8], bb[8], x3[8], x2[8], x1[8];
#pragma unroll
            for (int e = 0; e < 8; ++e) { w0[e] = a.in[13][0 * 1024 + c + e]; w1[e] = a.in[13][1 * 1024 + c + e]; w2[e] = a.in[13][2 * 1024 + c + e]; w3[e] = a.in[13][3 * 1024 + c + e]; bb[e] = a.in[14][c + e]; x3[e] = 0.f; x2[e] = 0.f; x1[e] = 0.f; }
            if (pos0 >= 3) ld8(zc + (size_t)(t0 - 3) * NZ, x3);
            if (pos0 >= 2) ld8(zc + (size_t)(t0 - 2) * NZ, x2);
            if (pos0 >= 1) ld8(zc + (size_t)(t0 - 1) * NZ, x1);
            for (int i = 0; i < 32; ++i) { const int t = t0 + i; float x0[8], o[8]; ld8(zc + (size_t)t * NZ, x0);
#pragma unroll
                for (int e = 0; e < 8; ++e) { o[e] = bb[e] + w0[e] * x3[e] + w1[e] * x2[e] + w2[e] * x1[e] + w3[e] * x0[e]; x3[e] = x2[e]; x2[e] = x1[e]; x1[e] = x0[e]; }
                st8(XC + (size_t)t * 1024 + c, o); }
        }
    }
}

__device__ __forceinline__ void ph_scan_agg(const Args& a, int tid) {
    const unsigned* AD = (const unsigned*)(a.ws + WS_AF);
    float* AG = (float*)(a.ws + WS_AG); float* HG = (float*)(a.ws + WS_HG);
    for (int w = blockIdx.x; w < 256; w += gridDim.x) {
        const int st = w >> 1, c = (w & 1) * 512 + tid; const size_t base = (size_t)st * 128 * 1024 + c;
        float LA = 0.f, H = 0.f;
#pragma unroll 32
        for (int i = 0; i < 128; ++i) { const unsigned pw = AD[base + (size_t)i * 1024]; const float la = bf_lo(pw), dv = bf_hi(pw); H = __builtin_amdgcn_exp2f(la) * H + dv; LA += la; }
        AG[st * 1024 + c] = __builtin_amdgcn_exp2f(LA); HG[st * 1024 + c] = H;
    }
}
__device__ __forceinline__ void ph_scan_fin(const Args& a, int tid) {
    const unsigned* AD = (const unsigned*)(a.ws + WS_AF);
    const float* AG = (const float*)(a.ws + WS_AG); const float* HG = (const float*)(a.ws + WS_HG);
    const bf16* Z = (const bf16*)(a.ws + WS_ZB); unsigned char* YC8 = a.ws + WS_YC8;
    for (int w = blockIdx.x; w < 256; w += gridDim.x) {
        const int st = w >> 1, c = (w & 1) * 512 + tid, sin = st & 63, sb = st - sin; const size_t base = (size_t)st * 128 * 1024 + c;
        float h = 0.f;
#pragma unroll 32
        for (int s = 0; s < sin; ++s) h = AG[(sb + s) * 1024 + c] * h + HG[(sb + s) * 1024 + c];
#pragma unroll 16
        for (int i = 0; i < 128; ++i) { const size_t t = (size_t)st * 128 + i; const unsigned pw = AD[base + (size_t)i * 1024];
            h = __builtin_amdgcn_exp2f(bf_lo(pw)) * h + bf_hi(pw); const float gt = __uint_as_float((unsigned)Z[t * NZ + 2048 + c] << 16);
            YC8[t * DM + 1024 + c] = (unsigned char)(pk4_fp8(h * gelu_tanh(gt) * Y8_SCALE, 0.f, 0.f, 0.f) & 0xffu); }
    }
}

template <bool RES_MOD>
__device__ __forceinline__ void ph_ln(const bf16* Y, const float* Xin, const bf16* HBres, const float* mod_res, const float* mod_l, const float* lng, const float* lnb, bf16* H2, unsigned char* H28, float* SH, unsigned char* H6, float* HS, int lane, int wave) {
    const int gw = blockIdx.x * NWAVES + wave, NGW = gridDim.x * NWAVES;
    v4u yc[4]; f32x4 xc[8]; v4u rc[4];
    { const size_t ro = (size_t)gw * DM + 8 * lane;
#pragma unroll
      for (int j = 0; j < 4; ++j) { yc[j] = *(const v4u*)(Y + ro + 512 * j);
          if constexpr (RES_MOD) rc[j] = *(const v4u*)(HBres + ro + 512 * j); else { xc[2 * j] = *(const f32x4*)(Xin + ro + 512 * j); xc[2 * j + 1] = *(const f32x4*)(Xin + ro + 512 * j + 4); } } }
#pragma unroll 1
    for (int t = gw; t < M; t += NGW) {
        const int b = t >> 13; const float* mb = mod_l + b * 12288; const size_t ro = (size_t)t * DM + 8 * lane;
        int ln = lane; asm volatile("" : "+v"(ln));
        const int tn = t + NGW < M ? t + NGW : t; const size_t rn = (size_t)tn * DM + 8 * lane;
        v4u yn[4]; f32x4 xn[8]; v4u rn4[4];
#pragma unroll
        for (int j = 0; j < 4; ++j) { yn[j] = *(const v4u*)(Y + rn + 512 * j);
            if constexpr (RES_MOD) rn4[j] = *(const v4u*)(HBres + rn + 512 * j); else { xn[2 * j] = *(const f32x4*)(Xin + rn + 512 * j); xn[2 * j + 1] = *(const f32x4*)(Xin + rn + 512 * j + 4); } }
        float v[32];
#pragma unroll
        for (int j = 0; j < 4; ++j) { const v4u u = yc[j]; const float y8[8] = {bf_lo(u.x), bf_hi(u.x), bf_lo(u.y), bf_hi(u.y), bf_lo(u.z), bf_hi(u.z), bf_lo(u.w), bf_hi(u.w)};
            f32x4 xa, xb;
            if constexpr (RES_MOD) { const v4u r = rc[j]; const float* mr = mod_res + b * 12288 + 8 * ln + 512 * j;
                const f32x4 sa = *(const f32x4*)(mr + 2048), sb = *(const f32x4*)(mr + 2048 + 4), ha = *(const f32x4*)(mr), hb = *(const f32x4*)(mr + 4);
                const float r8[8] = {bf_lo(r.x), bf_hi(r.x), bf_lo(r.y), bf_hi(r.y), bf_lo(r.z), bf_hi(r.z), bf_lo(r.w), bf_hi(r.w)};
#pragma unroll
                for (int e = 0; e < 4; ++e) { xa[e] = (r8[e] - ha[e]) * __builtin_amdgcn_rcpf(1.f + sa[e]); xb[e] = (r8[4 + e] - hb[e]) * __builtin_amdgcn_rcpf(1.f + sb[e]); } }
            else { xa = xc[2 * j]; xb = xc[2 * j + 1]; }
            const f32x4 ga = *(const f32x4*)(mb + 4096 + 8 * ln + 512 * j), gb = *(const f32x4*)(mb + 4096 + 8 * ln + 512 * j + 4);
#pragma unroll
            for (int e = 0; e < 4; ++e) { v[8 * j + e] = ALPHA * xa[e] + (1.f + ga[e]) * y8[e]; v[8 * j + 4 + e] = ALPHA * xb[e] + (1.f + gb[e]) * y8[4 + e]; } }
        float s = 0.f;
#pragma unroll
        for (int e = 0; e < 32; ++e) s += v[e];
        const float mean = wave_sum(s) * (1.f / DM); float q = 0.f;
#pragma unroll
        for (int e = 0; e < 32; ++e) { v[e] -= mean; q += v[e] * v[e]; }
        const float rstd = rsqrtf(wave_sum(q) * (1.f / DM) + LN_EPS); float hmx = 0.f;
#pragma unroll
        for (int j = 0; j < 4; ++j) { const int co = 8 * ln + 512 * j;
            const f32x4 la = *(const f32x4*)(lng + co), lb = *(const f32x4*)(lng + co + 4), ba = *(const f32x4*)(lnb + co), bb = *(const f32x4*)(lnb + co + 4);
            const f32x4 sa = *(const f32x4*)(mb + 8192 + co), sb = *(const f32x4*)(mb + 8192 + co + 4), ha = *(const f32x4*)(mb + 6144 + co), hb = *(const f32x4*)(mb + 6144 + co + 4);
            float h8[8];
#pragma unroll
            for (int e = 0; e < 4; ++e) { const float na = v[8 * j + e] * rstd * la[e] + ba[e], nb = v[8 * j + 4 + e] * rstd * lb[e] + bb[e];
                h8[e] = na * (1.f + sa[e]) + ha[e]; h8[4 + e] = nb * (1.f + sb[e]) + hb[e]; }
            st8(H2 + ro + 512 * j, h8);
#pragma unroll
            for (int e = 0; e < 8; ++e) { v[8 * j + e] = h8[e]; hmx = fmaxf(hmx, fabsf(h8[e])); } }
        hmx = fmaxf(wave_max(hmx), 1e-30f); const float inv = 127.f / hmx;
#pragma unroll
        for (int j = 0; j < 4; ++j) *(v2u*)(H28 + ro + 512 * j) = (v2u){pk4_i8(v[8 * j] * inv, v[8 * j + 1] * inv, v[8 * j + 2] * inv, v[8 * j + 3] * inv), pk4_i8(v[8 * j + 4] * inv, v[8 * j + 5] * inv, v[8 * j + 6] * inv, v[8 * j + 7] * inv)};
        if (lane == 0) SH[t] = hmx * (1.f / 127.f);
        { const float inv6 = 7.5f / hmx; f32x16_t pa, pb;
#pragma unroll
          for (int i = 0; i < 16; ++i) { pa[i] = v[2 * i] * inv6; pb[i] = v[2 * i + 1] * inv6; }
          const u32x6_t pk = __builtin_amdgcn_cvt_scalef32_2xpk16_fp6_f32(pa, pb, 1.0f); unsigned char* hq = H6 + (size_t)t * 1536;
          *(v4u*)(hq + 16 * lane) = (v4u){pk[0], pk[1], pk[2], pk[3]}; *(v2u*)(hq + 1024 + 8 * lane) = (v2u){pk[4], pk[5]};
          if (lane == 0) HS[t] = hmx * (1.f / 7.5f); }
#pragma unroll
        for (int j = 0; j < 4; ++j) { yc[j] = yn[j]; if constexpr (RES_MOD) rc[j] = rn4[j]; else { xc[2 * j] = xn[2 * j]; xc[2 * j + 1] = xn[2 * j + 1]; } }
    }
}

__device__ __forceinline__ unsigned mono(float f) { const unsigned u = __float_as_uint(f); return (u & 0x80000000u) ? ~u : (u | 0x80000000u); }
__device__ __forceinline__ float unmono(unsigned u) { return __uint_as_float((u & 0x80000000u) ? (u & 0x7fffffffu) : ~u); }
__device__ __forceinline__ unsigned umax_(unsigned a, unsigned b) { return a > b ? a : b; }
__device__ __forceinline__ unsigned umin_(unsigned a, unsigned b) { return a < b ? a : b; }
template <bool DESC> __device__ __forceinline__ void bsort16(unsigned (&k)[16]) {
#pragma unroll
    for (int size = 2; size <= 16; size <<= 1)
#pragma unroll
        for (int stride = size >> 1; stride > 0; stride >>= 1)
#pragma unroll
            for (int i = 0; i < 16; ++i) { const int j = i ^ stride;
                if (j > i) { const bool first_max = (((i & size) == 0) == DESC); const unsigned hi = umax_(k[i], k[j]), lo = umin_(k[i], k[j]); k[i] = first_max ? hi : lo; k[j] = first_max ? lo : hi; } }
}
template <bool DESC> __device__ __forceinline__ void bmerge16(unsigned (&k)[16]) {
#pragma unroll
    for (int stride = 8; stride > 0; stride >>= 1)
#pragma unroll
        for (int i = 0; i < 16; ++i) { const int j = i ^ stride;
            if (j > i) { const unsigned hi = umax_(k[i], k[j]), lo = umin_(k[i], k[j]); k[i] = DESC ? hi : lo; k[j] = DESC ? lo : hi; } }
}
__device__ __forceinline__ void top16_of_64(const unsigned (&k)[64], unsigned (&o)[16]) {
    unsigned g0[16], g1[16], g2[16], g3[16];
#pragma unroll
    for (int i = 0; i < 16; ++i) { g0[i] = k[i]; g1[i] = k[16 + i]; g2[i] = k[32 + i]; g3[i] = k[48 + i]; }
    bsort16<true>(g0); bsort16<false>(g1); bsort16<true>(g2); bsort16<false>(g3);
#pragma unroll
    for (int i = 0; i < 16; ++i) { g0[i] = umax_(g0[i], g1[i]); g2[i] = umax_(g2[i], g3[i]); }
    bmerge16<true>(g0); bmerge16<false>(g2);
#pragma unroll
    for (int i = 0; i < 16; ++i) o[i] = umax_(g0[i], g2[i]);
    bmerge16<true>(o);
}
__device__ __forceinline__ int swz16(int row, int cb) { return cb ^ ((row & 15) << 4); }
__device__ __forceinline__ void ph_topk(const Args& a, int layer, LAS unsigned char* lds, int tid, int lane, int wave) {
    const bf16* QP = (const bf16*)(a.ws + WS_QP); const bf16* KEYS = (const bf16*)(a.ws + WS_KEYS) + (size_t)layer * 8 * 2 * 128 * 128;
    int* EI = (int*)(a.ws + WS_EI); float* GT = (float*)(a.ws + WS_GT); const float* SVl = (const float*)(a.ws + WS_SV) + layer * NEXP;
    LAS unsigned char* kt = lds;
    LAS unsigned* lists = (LAS unsigned*)(lds + 65536 + wave * 4096);
    const int r32 = lane & 31, hi = lane >> 5, h = blockIdx.x & 7, wgr = blockIdx.x >> 3, nwgh = gridDim.x >> 3;
    { const bf16* kh = KEYS + (size_t)h * 2 * 128 * 128;
#pragma unroll
      for (int i = 0; i < 8; ++i) { const int ch = tid + i * NTHREADS, row = ch >> 4, cb = (ch & 15) * 16;
          *(LAS v4u*)(kt + row * 256 + swz16(row, cb)) = *(const v4u*)(kh + (size_t)row * 128 + (cb >> 1)); } }
    __syncthreads();
    if (wgr < nwgh) {
#pragma unroll 1
    for (int u = wgr * NWAVES + wave; u < M / 32; u += nwgh * NWAVES) {
        const int t0 = u * 32; const bf16* qrow = QP + (size_t)(t0 + r32) * DM + h * 256 + 8 * hi;
        unsigned LL[2][16];
#pragma unroll
        for (int p = 0; p < 2; ++p) {
            bf16x8 bq[8];
#pragma unroll
            for (int sI = 0; sI < 8; ++sI) bq[sI] = *(const bf16x8*)(qrow + p * 128 + 16 * sI);
            f32x16 acc[4];
#pragma unroll
            for (int blk = 0; blk < 4; ++blk)
#pragma unroll
                for (int e = 0; e < 16; ++e) acc[blk][e] = 0.f;
#pragma unroll
            for (int sI = 0; sI < 8; ++sI)
#pragma unroll
                for (int blk = 0; blk < 4; ++blk) { const int krow = p * 128 + blk * 32 + r32;
                    const bf16x8 ak = *(const LAS bf16x8*)(kt + krow * 256 + swz16(krow, (16 * sI + 8 * hi) * 2));
                    acc[blk] = __builtin_amdgcn_mfma_f32_32x32x16_bf16(ak, bq[sI], acc[blk], 0, 0, 0); }
            unsigned kk[64], o[16];
#pragma unroll
            for (int blk = 0; blk < 4; ++blk)
#pragma unroll
                for (int e = 0; e < 16; ++e) { const int n = 32 * blk + (e & 3) + 8 * (e >> 2) + 4 * hi; kk[blk * 16 + e] = (mono(acc[blk][e]) & ~127u) | (unsigned)(127 - n); }
            top16_of_64(kk, o);
#pragma unroll
            for (int i = 0; i < 16; ++i) LL[p][i] = umax_(o[i], (unsigned)__shfl_xor((int)o[15 - i], 32));
            bmerge16<true>(LL[p]);
            if (hi == 0) { LAS v4u* lp = (LAS v4u*)(lists + (p * 32 + r32) * 16);
#pragma unroll
                for (int i = 0; i < 4; ++i) lp[i] = (v4u){LL[p][4 * i], LL[p][4 * i + 1], LL[p][4 * i + 2], LL[p][4 * i + 3]}; }
        }
        unsigned tk[16];
        { float f1[16], f2[16];
#pragma unroll
          for (int i = 0; i < 16; ++i) { f1[i] = unmono(LL[0][i] & ~127u); f2[i] = unmono(LL[1][i] & ~127u); }
          unsigned cd[32];
          {
            cd[0] = hi ? ((mono(f1[2] + f2[1]) & ~255u) | 222u) : ((mono(f1[0] + f2[0]) & ~255u) | 255u);
            cd[1] = hi ? ((mono(f1[2] + f2[2]) & ~255u) | 221u) : ((mono(f1[0] + f2[1]) & ~255u) | 254u);
            cd[2] = hi ? ((mono(f1[2] + f2[3]) & ~255u) | 220u) : ((mono(f1[0] + f2[2]) & ~255u) | 253u);
            cd[3] = hi ? ((mono(f1[2] + f2[4]) & ~255u) | 219u) : ((mono(f1[0] + f2[3]) & ~255u) | 252u);
            cd[4] = hi ? ((mono(f1[3] + f2[0]) & ~255u) | 207u) : ((mono(f1[0] + f2[4]) & ~255u) | 251u);
            cd[5] = hi ? ((mono(f1[3] + f2[1]) & ~255u) | 206u) : ((mono(f1[0] + f2[5]) & ~255u) | 250u);
            cd[6] = hi ? ((mono(f1[3] + f2[2]) & ~255u) | 205u) : ((mono(f1[0] + f2[6]) & ~255u) | 249u);
            cd[7] = hi ? ((mono(f1[3] + f2[3]) & ~255u) | 204u) : ((mono(f1[0] + f2[7]) & ~255u) | 248u);
            cd[8] = hi ? ((mono(f1[4] + f2[0]) & ~255u) | 191u) : ((mono(f1[0] + f2[8]) & ~255u) | 247u);
            cd[9] = hi ? ((mono(f1[4] + f2[1]) & ~255u) | 190u) : ((mono(f1[0] + f2[9]) & ~255u) | 246u);
            cd[10] = hi ? ((mono(f1[4] + f2[2]) & ~255u) | 189u) : ((mono(f1[0] + f2[10]) & ~255u) | 245u);
            cd[11] = hi ? ((mono(f1[5] + f2[0]) & ~255u) | 175u) : ((mono(f1[0] + f2[11]) & ~255u) | 244u);
            cd[12] = hi ? ((mono(f1[5] + f2[1]) & ~255u) | 174u) : ((mono(f1[0] + f2[12]) & ~255u) | 243u);
            cd[13] = hi ? ((mono(f1[6] + f2[0]) & ~255u) | 159u) : ((mono(f1[0] + f2[13]) & ~255u) | 242u);
            cd[14] = hi ? ((mono(f1[6] + f2[1]) & ~255u) | 158u) : ((mono(f1[0] + f2[14]) & ~255u) | 241u);
            cd[15] = hi ? ((mono(f1[7] + f2[0]) & ~255u) | 143u) : ((mono(f1[0] + f2[15]) & ~255u) | 240u);
            cd[16] = hi ? ((mono(f1[7] + f2[1]) & ~255u) | 142u) : ((mono(f1[1] + f2[0]) & ~255u) | 239u);
            cd[17] = hi ? ((mono(f1[8] + f2[0]) & ~255u) | 127u) : ((mono(f1[1] + f2[1]) & ~255u) | 238u);
            cd[18] = hi ? ((mono(f1[9] + f2[0]) & ~255u) | 111u) : ((mono(f1[1] + f2[2]) & ~255u) | 237u);
            cd[19] = hi ? ((mono(f1[10] + f2[0]) & ~255u) | 95u) : ((mono(f1[1] + f2[3]) & ~255u) | 236u);
            cd[20] = hi ? ((mono(f1[11] + f2[0]) & ~255u) | 79u) : ((mono(f1[1] + f2[4]) & ~255u) | 235u);
            cd[21] = hi ? ((mono(f1[12] + f2[0]) & ~255u) | 63u) : ((mono(f1[1] + f2[5]) & ~255u) | 234u);
            cd[22] = hi ? ((mono(f1[13] + f2[0]) & ~255u) | 47u) : ((mono(f1[1] + f2[6]) & ~255u) | 233u);
            cd[23] = hi ? ((mono(f1[14] + f2[0]) & ~255u) | 31u) : ((mono(f1[1] + f2[7]) & ~255u) | 232u);
            cd[24] = hi ? ((mono(f1[15] + f2[0]) & ~255u) | 15u) : ((mono(f1[2] + f2[0]) & ~255u) | 223u);
            cd[25] = 0u;
            cd[26] = 0u;
            cd[27] = 0u;
            cd[28] = 0u;
            cd[29] = 0u;
            cd[30] = 0u;
            cd[31] = 0u;
          }
          unsigned g0[16], g1[16];
#pragma unroll
          for (int i = 0; i < 16; ++i) { g0[i] = cd[i]; g1[i] = cd[16 + i]; }
          bsort16<true>(g0); bsort16<false>(g1);
#pragma unroll
          for (int i = 0; i < 16; ++i) g0[i] = umax_(g0[i], g1[i]);
          bmerge16<true>(g0);
#pragma unroll
          for (int i = 0; i < 16; ++i) tk[i] = umax_(g0[i], (unsigned)__shfl_xor((int)g0[15 - i], 32));
          bmerge16<true>(tk); }
        float ev[16]; const float m0 = unmono(tk[0] & ~255u); float den = 0.f;
#pragma unroll
        for (int k = 0; k < 16; ++k) { ev[k] = __expf(unmono(tk[k] & ~255u) - m0); den += ev[k]; }
        const float rden = 1.f / den;
        const LAS unsigned* L1 = lists + r32 * 16; const LAS unsigned* L2 = lists + (32 + r32) * 16;
        int ei[16];
#pragma unroll
        for (int k = 0; k < 16; ++k) { const int id = 255 - (int)(tk[k] & 255u), i = id >> 4, j = id & 15;
            const int n1 = 127 - (int)(L1[i] & 127u), n2 = 127 - (int)(L2[j] & 127u); ei[k] = n1 * 128 + n2; }
        if (hi == 0) { int* ep = EI + (size_t)(t0 + r32) * 128 + h * 16;
#pragma unroll
            for (int k = 0; k < 4; ++k) *(int4*)(ep + 4 * k) = make_int4(ei[4 * k], ei[4 * k + 1], ei[4 * k + 2], ei[4 * k + 3]); }
        else { float* gp = GT + (size_t)(t0 + r32) * 128 + h * 16; float gg[16];
#pragma unroll
            for (int k = 0; k < 16; ++k) gg[k] = ev[k] * rden * SVl[ei[k]];
#pragma unroll
            for (int k = 0; k < 4; ++k) *(f32x4*)(gp + 4 * k) = (f32x4){gg[4 * k], gg[4 * k + 1], gg[4 * k + 2], gg[4 * k + 3]}; }
    } }
    __syncthreads();
}

typedef int i32x8_t __attribute__((ext_vector_type(8)));
__device__ __forceinline__ void peer_slice(const Args& a, volatile LAS unsigned* st, int& x, int& rank, int& nrank) {
    (void)a; nrank = (int)(gridDim.x >> 3); const bool uni = st[4] != 0u;
    if (uni) { x = (int)st[3]; rank = (int)st[2]; } else { x = (int)(blockIdx.x & 7u); rank = (int)(blockIdx.x >> 3); }
    x = __builtin_amdgcn_readfirstlane(x); rank = __builtin_amdgcn_readfirstlane(rank);
}
__device__ __forceinline__ void ph_peer_u(const Args& a, int layer, volatile LAS unsigned* st, LAS unsigned char* lds, int lane, int wave) {
    int x, rank, nrank; peer_slice(a, st, x, rank, nrank); const int m16 = lane & 15, kc = lane >> 4, r8 = lane >> 3, sg = lane & 7;
    const unsigned char* TUb = a.ws + WS_TU + (size_t)layer * NEXP * ROW4 + (size_t)x * NEXP * 128;
    const unsigned char* H6 = a.ws + WS_H6 + 16 * (8 * x + kc); const int* EI = (const int*)(a.ws + WS_EI) + lane; bf16* PART = (bf16*)(a.ws + WS_PART) + x * 128 + 32 * kc;
    if (rank >= nrank) return;
    const int t0 = rank * NWAVES + wave, ts = nrank * NWAVES, nt = (M - t0 + ts - 1) / ts;
    LAS unsigned char* ub = lds + wave * 2304; LAS unsigned char* ubw = ub + r8 * 144 + 16 * sg; const LAS unsigned char* ubr = ub + m16 * 144 + 16 * kc;
    v4u U[8][2]; v4u ha[2], han[2]; v2u hb[2], hbn[2]; int en0 = 0, en1 = 0;
#pragma unroll
    for (int g = 0; g < 8; ++g) { U[g][0] = (v4u){0u, 0u, 0u, 0u}; U[g][1] = U[g][0]; }
    ha[0] = ha[1] = (v4u){0u, 0u, 0u, 0u}; hb[0] = hb[1] = (v2u){0u, 0u};
    en0 = EI[(size_t)t0 * 128]; en1 = EI[(size_t)t0 * 128 + 64];
#pragma unroll 1
    for (int k = -1; k < nt; ++k) {
        const int k2 = k + 2 < nt ? k + 2 : nt - 1, k1 = k + 1 < nt ? (k + 1 < 0 ? 0 : k + 1) : nt - 1;
        const size_t tn2 = (size_t)(t0 + ts * k2), tn1 = (size_t)(t0 + ts * k1);
        const int enn0 = EI[tn2 * 128], enn1 = EI[tn2 * 128 + 64];
        { const unsigned char* hp = H6 + tn1 * 1536;
#pragma unroll
          for (int i = 0; i < 2; ++i) { han[i] = *(const v4u*)(hp + 64 * i); hbn[i] = *(const v2u*)(hp + 1024 - 8 * (8 * x + kc) + 32 * i); } }
        bf16* pp = PART + (size_t)(t0 + ts * (k < 0 ? 0 : k)) * 1024; unsigned pv0 = 0u, pv1 = 0u;
#pragma unroll
        for (int g = 0; g < 8; ++g) {
            { f32x4 acc = {0.f, 0.f, 0.f, 0.f};
                if (k >= 0) {
                    *(LAS v4u*)ubw = U[g][0]; *(LAS v4u*)(ubw + 8 * 144) = U[g][1];
#pragma unroll
                    for (int i = 0; i < 2; ++i) { const v4u uu = *(const LAS v4u*)(ubr + 64 * i); const i32x8_t A8 = {(int)uu.x, (int)uu.y, (int)uu.z, (int)uu.w, 0, 0, 0, 0};
                        const i32x8_t B8 = {(int)ha[i].x, (int)ha[i].y, (int)ha[i].z, (int)ha[i].w, (int)hb[i].x, (int)hb[i].y, 0, 0};
                        acc = __builtin_amdgcn_mfma_scale_f32_16x16x128_f8f6f4(A8, B8, acc, 4, 2, 0, 127, 0, 127); } }
                if ((g & 1) == 0) { pv0 = pk2c(acc[0], acc[1]); pv1 = pk2c(acc[2], acc[3]); }
                else if (m16 == 0) *(v4u*)(pp + 4 * (g - 1)) = (v4u){pv0, pv1, pk2c(acc[0], acc[1]), pk2c(acc[2], acc[3])}; }
#pragma unroll
            for (int j = 0; j < 2; ++j) { const int em = __shfl(g < 4 ? en0 : en1, (g & 3) * 16 + 8 * j + r8); U[g][j] = *(const v4u*)(TUb + (unsigned)(em * 128 + 16 * sg)); }
            __builtin_amdgcn_sched_barrier(0);
        }
#pragma unroll
        for (int i = 0; i < 2; ++i) { ha[i] = han[i]; hb[i] = hbn[i]; }
        en0 = enn0; en1 = enn1;
    }
}
__device__ __forceinline__ void ph_peer_coef(const Args& a, int layer, LAS unsigned char* lds, int lane, int wave) {
    const int p0 = 16 * ((lane >> 1) & 7) + 4 * (lane >> 4) + 2 * (lane & 1);
    const int* EI = (const int*)(a.ws + WS_EI) + p0; const float* GT = (const float*)(a.ws + WS_GT) + p0; const unsigned* PART = (const unsigned*)(a.ws + WS_PART) + lane;
    const float* SU = (const float*)(a.ws + WS_SU) + layer * NEXP; const float* HS = (const float*)(a.ws + WS_HS);
    unsigned char* AR = a.ws + WS_AR; int* EQ = (int*)(a.ws + WS_EQ) + (p0 & 7) * 16 + (p0 >> 3);
    LAS float* CFL = (LAS float*)(lds + wave * 1024);
    const int gw = blockIdx.x * NWAVES + wave, NGW = gridDim.x * NWAVES;
#pragma unroll 1
    for (int t = gw; t < M; t += NGW) {
        const size_t tt = (size_t)t; const int2 ee = *(const int2*)(EI + tt * 128); const float2 gg = *(const float2*)(GT + tt * 128); const float hs = HS[t];
        unsigned P[8];
#pragma unroll
        for (int xx = 0; xx < 8; ++xx) P[xx] = PART[(tt * 8 + xx) * 64];
        const float s0 = SU[ee.x], s1 = SU[ee.y];
        const float d0 = ((bf_lo(P[0]) + bf_lo(P[1])) + (bf_lo(P[2]) + bf_lo(P[3]))) + ((bf_lo(P[4]) + bf_lo(P[5])) + (bf_lo(P[6]) + bf_lo(P[7])));
        const float d1 = ((bf_hi(P[0]) + bf_hi(P[1])) + (bf_hi(P[2]) + bf_hi(P[3]))) + ((bf_hi(P[4]) + bf_hi(P[5])) + (bf_hi(P[6]) + bf_hi(P[7])));
        const float c0 = gelu_tanh(d0 * hs * s0) * gg.x, c1 = gelu_tanh(d1 * hs * s1) * gg.y;
        EQ[tt * 128] = ee.x * 128; EQ[tt * 128 + 16] = ee.y * 128;
        const float cmx = fmaxf(wave_max(fmaxf(fabsf(c0), fabsf(c1))), 1e-30f), csc = 7.5f / cmx;
        CFL[p0] = c0 * csc; CFL[p0 + 1] = c1 * csc;
        f32x16_t pa, pb;
#pragma unroll
        for (int i = 0; i < 8; ++i) { const f32x4 c4 = *(const LAS f32x4*)(CFL + 32 * (lane & 3) + 4 * i); pa[2 * i] = c4[0]; pb[2 * i] = c4[1]; pa[2 * i + 1] = c4[2]; pb[2 * i + 1] = c4[3]; }
        const u32x6_t ph = __builtin_amdgcn_cvt_scalef32_2xpk16_fp6_f32(pa, pb, 1.0f);
        if (lane < 4) { unsigned char* rp = AR + tt * 128 + 32 * lane; *(v4u*)rp = (v4u){ph[0], ph[1], ph[2], ph[3]}; *(v4u*)(rp + 16) = (v4u){ph[4], ph[5], __float_as_uint(cmx * (1.f / 7.5f)), 0u}; }
    }
}
__device__ __forceinline__ void ph_peer_v(const Args& a, int layer, volatile LAS unsigned* st, LAS unsigned char* lds, int lane, int wave) {
    int x, rank, nrank; peer_slice(a, st, x, rank, nrank); const int q = lane >> 3, sg = lane & 7, n16 = lane & 15, kc = lane >> 4;
    const unsigned char* TVb = a.ws + WS_TV + (size_t)layer * NEXP * ROWV + (size_t)x * NEXP * 128;
    const int* EQ = (const int*)(a.ws + WS_EQ) + q * 16; const unsigned char* AR = a.ws + WS_AR + 32 * kc;
    if (rank >= nrank) return;
    const int t0 = rank * NWAVES + wave, ts = nrank * NWAVES, nt = (M - t0 + ts - 1) / ts;
    constexpr int VS = 144;
    LAS unsigned char* img = lds + wave * (128 * VS);
    LAS unsigned char* iw = img + q * VS + 16 * sg;
    const LAS unsigned char* ir = img + (32 * kc + n16) * VS;
    typedef int v2i_ __attribute__((ext_vector_type(2)));
    int inv16, ncol; bool tr_ok;
    { *(LAS v2u*)(ir) = (v2u){0x11111111u * (unsigned)n16, 0x11111111u * (unsigned)n16};
      const v2i_ ra = __builtin_amdgcn_ds_read_tr4_b64_v2i32((LAS v2i_*)ir);
      *(LAS v2u*)(ir) = (v2u){0x76543210u, 0xfedcba98u};
      const v2i_ rb = __builtin_amdgcn_ds_read_tr4_b64_v2i32((LAS v2i_*)ir);
      const unsigned r0 = (unsigned)__builtin_amdgcn_readfirstlane(ra.x), r1 = (unsigned)__builtin_amdgcn_readfirstlane(ra.y);
      ncol = rb.x & 15; inv16 = 0; unsigned seen = 0u;
#pragma unroll
      for (int e = 0; e < 16; ++e) { const int rr = (int)(((e < 8 ? r0 : r1) >> (4 * (e & 7))) & 15u); if (rr == n16) inv16 = e; seen |= 1u << rr; }
      bool ok = (unsigned)ra.x == r0 && (unsigned)ra.y == r1 && (unsigned)rb.x == 0x11111111u * (unsigned)ncol && (unsigned)rb.y == 0x11111111u * (unsigned)ncol && seen == 0xffffu;
      unsigned cols = 0u;
#pragma unroll
      for (int i = 0; i < 16; ++i) cols |= 1u << (__shfl(ncol, i) & 15);
      ok = ok && cols == 0xffffu;
      ok = ok && r0 == 0x76543210u && r1 == 0xfedcba98u && ncol == n16;
      tr_ok = __all(ok); }
    unsigned char* Y4 = a.ws + WS_Y + 256 * x + 4 * lane;
    (void)inv16;
    v4u W[16];
#pragma unroll
    for (int i = 0; i < 16; ++i) W[i] = (v4u){0u, 0u, 0u, 0u};
    v4u epn[4], ar0 = {0u, 0u, 0u, 0u}, ar1 = ar0;
#pragma unroll
    for (int j = 0; j < 4; ++j) epn[j] = (v4u){0u, 0u, 0u, 0u};
#pragma unroll
    for (int j = 0; j < 4; ++j) epn[j] = *(const v4u*)(EQ + (size_t)t0 * 128 + 4 * j);
#pragma unroll 1
    for (int k = -1; k < nt; ++k) {
        const int k2 = k + 2 < nt ? k + 2 : nt - 1, k1 = k + 1 < nt ? (k + 1 < 0 ? 0 : k + 1) : nt - 1; const size_t tn2 = (size_t)(t0 + ts * k2), tn1 = (size_t)(t0 + ts * k1);
        v4u epnn[4];
#pragma unroll
        for (int j = 0; j < 4; ++j) epnn[j] = *(const v4u*)(EQ + tn2 * 128 + 4 * j);
        const v4u arn0 = *(const v4u*)(AR + tn1 * 128), arn1 = *(const v4u*)(AR + tn1 * 128 + 16);
        int ep[16];
#pragma unroll
        for (int j = 0; j < 4; ++j) { ep[4 * j] = (int)epn[j].x; ep[4 * j + 1] = (int)epn[j].y; ep[4 * j + 2] = (int)epn[j].z; ep[4 * j + 3] = (int)epn[j].w; }
        __builtin_amdgcn_sched_barrier(0);
#pragma unroll
        for (int i = 0; i < 16; ++i) {
            *(LAS v4u*)(iw + 8 * i * VS) = W[i];
            W[i] = *(const v4u*)(TVb + (unsigned)(ep[i] + 16 * sg));
            __builtin_amdgcn_sched_barrier(0);
        }
        float yv[16];
#pragma unroll
        for (int j = 0; j < 16; ++j) yv[j] = 0.f;
        if (k >= 0) {
            i32x8_t A8 = {(int)ar0.x, (int)ar0.y, (int)ar0.z, (int)ar0.w, (int)ar1.x, (int)ar1.y, 0, 0};
            if (n16 != 0) A8 = (i32x8_t){0, 0, 0, 0, 0, 0, 0, 0};
            const float ysc = __uint_as_float(ar1.z);
#pragma unroll
            for (int j = 0; j < 16; ++j) {
                const v2i_ b0 = __builtin_amdgcn_ds_read_tr4_b64_v2i32((LAS v2i_*)(ir + 8 * j)), b1 = __builtin_amdgcn_ds_read_tr4_b64_v2i32((LAS v2i_*)(ir + 16 * VS + 8 * j));
                const i32x8_t B8 = {b0.x, b0.y, b1.x, b1.y, 0, 0, 0, 0};
                const f32x4 acc = __builtin_amdgcn_mfma_scale_f32_16x16x128_f8f6f4(A8, B8, (f32x4){0.f, 0.f, 0.f, 0.f}, 2, 4, 0, 127, 0, 127);
                yv[j] = acc[0] * ysc; }
        }
        if (!tr_ok) { _Pragma("unroll") for (int j = 0; j < 16; ++j) yv[j] = __builtin_nanf(""); }
        { LAS float* yl = (LAS float*)img;
          if (kc == 0) {
#pragma unroll
              for (int j = 0; j < 16; ++j) yl[16 * j + ncol] = yv[j]; }
          const f32x4 y4 = *(const LAS f32x4*)(yl + 4 * lane);
          *(unsigned*)(Y4 + (size_t)(t0 + ts * (k < 0 ? 0 : k)) * DM) = pk4_fp8(y4[0] * YP_SCALE, y4[1] * YP_SCALE, y4[2] * YP_SCALE, y4[3] * YP_SCALE); }
        ar0 = arn0; ar1 = arn1;
#pragma unroll
        for (int j = 0; j < 4; ++j) epn[j] = epnn[j];
    }
}
template <bool FINAL>
__device__ __forceinline__ void ph_peer_ln(const Args& a, const float* mod_l, const float* mod_next, const float* lng, const float* lnb, int lane, int wave) {
    const bf16* H2 = (const bf16*)(a.ws + WS_H2); bf16* HB = (bf16*)(a.ws + WS_HB); const unsigned char* Y = a.ws + WS_Y;
    const int gw = blockIdx.x * NWAVES + wave, NGW = gridDim.x * NWAVES;
#pragma unroll 1
    for (int t = gw; t < M; t += NGW) {
        const int b = t >> 13;
        float out[32];
        { unsigned lo0 = (unsigned)lane * 4u; asm volatile("" : "+v"(lo0)); const unsigned char* yrow = Y + (size_t)t * DM;
#pragma unroll
          for (int j = 0; j < 8; ++j) { const unsigned yw = *(const unsigned*)(yrow + lo0 + 256 * j); const auto ya = __builtin_amdgcn_cvt_pk_f32_fp8((int)yw, false), yb = __builtin_amdgcn_cvt_pk_f32_fp8((int)yw, true);
              out[4 * j] = ya[0] * (1.f / YP_SCALE); out[4 * j + 1] = ya[1] * (1.f / YP_SCALE); out[4 * j + 2] = yb[0] * (1.f / YP_SCALE); out[4 * j + 3] = yb[1] * (1.f / YP_SCALE); } }
        unsigned lo = (unsigned)lane * 16u; asm volatile("" : "+v"(lo));
        const char* mb = (const char*)(mod_l + b * 12288); const char* h2row = (const char*)(H2 + (size_t)t * DM);
#define LD4_(base, j_) (*(const f32x4*)((const char*)(base) + lo + 1024 * (j_)))
#pragma unroll
        for (int j = 0; j < 8; ++j) { const v2u hw = *(const v2u*)(h2row + (lo >> 1) + 512 * j); const float h4[4] = {bf_lo(hw.x), bf_hi(hw.x), bf_lo(hw.y), bf_hi(hw.y)};
            const f32x4 ga = LD4_(mb + 10240 * 4, j), sf = LD4_(mb + 8192 * 4, j), hf = LD4_(mb + 6144 * 4, j);
#pragma unroll
            for (int e = 0; e < 4; ++e) { const float x1 = (h4[e] - hf[e]) * __builtin_amdgcn_rcpf(1.f + sf[e]); out[4 * j + e] = ALPHA * x1 + (1.f + ga[e]) * out[4 * j + e]; } }
        float s = 0.f;
#pragma unroll
        for (int e = 0; e < 32; ++e) s += out[e];
        const float mean = wave_sum(s) * (1.f / DM); float q2 = 0.f;
#pragma unroll
        for (int e = 0; e < 32; ++e) { out[e] -= mean; q2 += out[e] * out[e]; }
        const float rstd = rsqrtf(wave_sum(q2) * (1.f / DM) + LN_EPS);
        const char* mn = (const char*)(mod_next + b * 12288); char* orow = (char*)(a.out + (size_t)t * DM); char* hrow = (char*)(HB + (size_t)t * DM);
        float hmx = 0.f; (void)hmx;
#pragma unroll
        for (int j = 0; j < 8; ++j) { const f32x4 la = LD4_(lng, j), ba = LD4_(lnb, j); f32x4 na;
#pragma unroll
            for (int e = 0; e < 4; ++e) na[e] = out[4 * j + e] * rstd * la[e] + ba[e];
            if constexpr (FINAL) *(f32x4*)(orow + lo + 1024 * j) = na;
            else { const f32x4 sa = LD4_(mn + 2048 * 4, j), ha = LD4_(mn, j);
#pragma unroll
                for (int e = 0; e < 4; ++e) { const float hn = na[e] * (1.f + sa[e]) + ha[e]; out[4 * j + e] = hn; hmx = fmaxf(hmx, fabsf(hn)); }
                *(v2u*)(hrow + (lo >> 1) + 512 * j) = (v2u){pk2(out[4 * j], out[4 * j + 1]), pk2(out[4 * j + 2], out[4 * j + 3])}; } }
        if constexpr (!FINAL) {
            hmx = fmaxf(wave_max(hmx), 1e-30f); const float inv8 = 240.f / hmx; unsigned char* h8row = a.ws + WS_HB8 + (size_t)t * DM;
#pragma unroll
            for (int j = 0; j < 8; ++j) { unsigned w = 0u; w = __builtin_amdgcn_cvt_pk_fp8_f32(out[4 * j] * inv8, out[4 * j + 1] * inv8, w, false); w = __builtin_amdgcn_cvt_pk_fp8_f32(out[4 * j + 2] * inv8, out[4 * j + 3] * inv8, w, true);
                *(unsigned*)(h8row + (lo >> 2) + 256 * j) = w; }
            if (lane == 0) ((float*)(a.ws + WS_SA))[t] = hmx * (1.f / 240.f); }
#undef LD4_
    }
}

__device__ __forceinline__ void ph_forget(const Args& a, LAS unsigned char* lds, int lane, int wave) {
    const bf16* HB = (const bf16*)(a.ws + WS_HB); const bf16* WF = (const bf16*)(a.ws + WS_WF); float* LF = (float*)(a.ws + WS_LF);
    const int m16 = lane & 15, kc = lane >> 4, kh = wave & 1;
    LAS f32x4* xch = (LAS f32x4*)lds;
    for (int base = blockIdx.x * (NWAVES / 2); base < M / 16; base += gridDim.x * (NWAVES / 2)) {
        const int item = base + (wave >> 1); const bool live = item < M / 16;
        const int t0 = (live ? item : 0) * 16; f32x4 acc = {0.f, 0.f, 0.f, 0.f};
        const bf16* ap = HB + (size_t)(t0 + m16) * DM + 8 * kc + 1024 * kh; const bf16* bp = WF + (size_t)m16 * DM + 8 * kc + 1024 * kh;
#pragma unroll 16
        for (int s = 0; s < 32; ++s) { const bf16x8 av = *(const bf16x8*)(ap + 32 * s), bv = *(const bf16x8*)(bp + 32 * s); acc = __builtin_amdgcn_mfma_f32_16x16x32_bf16(av, bv, acc, 0, 0, 0); }
        xch[wave * 64 + lane] = acc;
        __syncthreads();
        if (kh == 0 && live) { const f32x4 oth = xch[(wave + 1) * 64 + lane]; const float bfv = a.in[22][m16]; f32x4 o;
#pragma unroll
            for (int r = 0; r < 4; ++r) { const float x = acc[r] + oth[r] + bfv; o[r] = fminf(x, 0.f) - log1pf(__expf(-fabsf(x))); }
            const int t = t0 + 4 * kc, b = t >> 13, pos = t & (SEQ - 1);
            *(f32x4*)(LF + (size_t)(b * 16 + m16) * SEQ + pos) = o; }
        __syncthreads();
    }
}
__device__ __forceinline__ void ph_cumsum(const Args& a, int lane, int wave) {
    const float* LF = (const float*)(a.ws + WS_LF); float* FB = (float*)(a.ws + WS_FB);
    float* FE = (float*)(a.ws + WS_FE); float* FP = (float*)(a.ws + WS_FP);
    const int gw = blockIdx.x * NWAVES + wave, NGW = gridDim.x * NWAVES;
    const int sidx = NGW >= 1056 ? gw - 1024 : gw;
    for (int seq = sidx; seq >= 0 && seq < 32; seq += NGW) {
        const float* src = LF + (size_t)seq * SEQ + lane * 128; float* dst = FB + (size_t)seq * SEQ + lane * 128;
        f32x4 vv[32];
#pragma unroll
        for (int i = 0; i < 32; ++i) vv[i] = *(const f32x4*)(src + 4 * i);
        float s = 0.f;
#pragma unroll
        for (int i = 0; i < 32; ++i) s += (vv[i][0] + vv[i][1]) + (vv[i][2] + vv[i][3]);
        float inc = s;
#pragma unroll
        for (int o = 1; o < 64; o <<= 1) { const float n = __shfl_up(inc, o); if (lane >= o) inc += n; }
        float run = inc - s;
#pragma unroll
        for (int i = 0; i < 32; ++i) { const f32x4 v = vv[i]; f32x4 o;
            run += v[0]; o[0] = run; run += v[1]; o[1] = run; run += v[2]; o[2] = run; run += v[3]; o[3] = run;
            if (i == 0 && (lane & 1) == 0) FP[seq * 32 + (lane >> 1)] = -o[0];
            if (i == 15) FE[seq * 128 + 2 * lane] = -o[3];
            if (i == 31) FE[seq * 128 + 2 * lane + 1] = -o[3];
            *(f32x4*)(dst + 4 * i) = o * (-1.f / ATT_SCALE); }
    }
    const bf16* QK = (const bf16*)(a.ws + WS_ZB);
    for (int item = gw; item < 1024; item += NGW) {
        const int seq = item >> 5, blk = item & 31, b = seq >> 4, h = seq & 15;
        const bf16* qb = QK + ((size_t)b * SEQ + (size_t)blk * 256) * DM + h * 128 + 8 * (lane & 15); const bf16* kb = qb + (size_t)M * DM;
        float mq = 0.f, mk = 0.f, md = 3.0e38f;
#pragma unroll 8
        for (int r = 0; r < 64; ++r) { const size_t ro = (size_t)(4 * r + (lane >> 4)) * DM; float vq[8], vk[8]; ld8(qb + ro, vq); ld8(kb + ro, vk);
            float sq = 0.f, sk = 0.f, sd = 0.f;
#pragma unroll
            for (int e = 0; e < 8; ++e) { sq += vq[e] * vq[e]; sk += vk[e] * vk[e]; sd += vq[e] * vk[e]; }
            sq += SWZ_XOR_(sq, 1); sk += SWZ_XOR_(sk, 1); sd += SWZ_XOR_(sd, 1); sq += SWZ_XOR_(sq, 2); sk += SWZ_XOR_(sk, 2); sd += SWZ_XOR_(sd, 2);
            sq += SWZ_XOR_(sq, 4); sk += SWZ_XOR_(sk, 4); sd += SWZ_XOR_(sd, 4); sq += SWZ_XOR_(sq, 8); sk += SWZ_XOR_(sk, 8); sd += SWZ_XOR_(sd, 8);
            mq = fmaxf(mq, sq); mk = fmaxf(mk, sk); md = fminf(md, sd); }
        mq = wave_max(mq); mk = wave_max(mk); md = -wave_max(-md);
        if (lane == 0) { ((float*)(a.ws + WS_QN))[seq * 32 + blk] = mq; ((float*)(a.ws + WS_KN))[seq * 32 + blk] = mk; ((float*)(a.ws + WS_DN))[seq * 32 + blk] = md; }
    }
}

constexpr float SKIP_T = 20.f;
__device__ __forceinline__ attn::BlockRef<__hip_bfloat16, __hip_bfloat16> attn_mkref(int L, const __hip_bfloat16* Q, const __hip_bfloat16* K, const __hip_bfloat16* V, __hip_bfloat16* O, const unsigned char* ws, int lane) {
    const int qb = 31 - (L >> 5), seq = L & 31, b = seq >> 4, h = seq & 15;
    attn::BlockRef<__hip_bfloat16, __hip_bfloat16> r; const size_t rowq = (size_t)b * SEQ + (size_t)qb * attn::QB, row0 = (size_t)b * SEQ;
    r.Q = Q + rowq * DM + h * 128; r.O = O + rowq * DM + h * 128; r.K = K + row0 * DM + h * 128; r.V = V + row0 * DM + h * 128; r.Fb = (const float*)(ws + WS_FB) + (size_t)seq * SEQ; r.P0 = qb * attn::QB; r.O8 = (unsigned char*)ws + WS_YC8 + rowq * DM + h * 128;
    const char* FE = (const char*)((const float*)(ws + WS_FE) + seq * 128); const char* KN = (const char*)((const float*)(ws + WS_KN) + seq * 32);
    unsigned l4 = (unsigned)lane * 4u; asm volatile("" : "+v"(l4));
    const float kn = wave_max((lane & 31) <= qb ? *(const float*)(KN + (l4 & 124u)) : 0.f), qn = ((const float*)(ws + WS_QN))[seq * 32 + qb], fp = ((const float*)(ws + WS_FP))[seq * 32 + qb];
    const float dn = ((const float*)(ws + WS_DN))[seq * 32 + qb];
    const float tgt = fp - (SKIP_T + (sqrtf(qn * kn) * 1.0001f - dn) * ATT_SCALE);
    const int cnt = __popcll(__ballot(*(const float*)(FE + l4) <= tgt)) + __popcll(__ballot(*(const float*)(FE + 256 + l4) <= tgt));
    r.jlo = cnt < 4 * qb ? cnt : 4 * qb;
    return r;
}
__device__ __forceinline__ void ph_attention(const Args& a, char* lds, const int tid) {
    using namespace attn;
    typedef __hip_bfloat16 T;
    const T* Q = (const T*)(a.ws + WS_ZB); const T* K = Q + (size_t)M * DM; const T* V = K + (size_t)M * DM; T* O = (T*)(a.ws + WS_YC);
    unsigned* ctr = (unsigned*)(a.ws + 32768);
    volatile int* nextw = (volatile int*)(lds + attn::LDS_BYTES);
    const int lane = tid & 63, total = 1024;
    int L = blockIdx.x; if (L >= total) return;
    BlockRef<T, T> cur = attn_mkref(L, Q, K, V, O, a.ws, lane);
    Seam<T> S;
    causal_swa_prime<T, T>(cur, SEQ, lds, S, tid);
    for (;;) {
        if (tid == 0) *nextw = (int)gridDim.x + (int)__hip_atomic_fetch_add(ctr, 1u, __ATOMIC_RELAXED, __HIP_MEMORY_SCOPE_AGENT);
        __syncthreads();
        const int Ln = __builtin_amdgcn_readfirstlane(*nextw); const bool last = Ln >= total;
        const BlockRef<T, T> nxt = last ? cur : attn_mkref(Ln, Q, K, V, O, a.ws, lane);
        causal_swa_block<T, T>(cur, nxt, SEQ, SEQ, lds, S, tid);
        if (last) break;
        cur = nxt; L = Ln;
    }
}

__global__ void __launch_bounds__(NTHREADS, 2) mk_fwd(Args a) {
    extern __shared__ __attribute__((aligned(16))) unsigned char lds_raw[];
    cg::grid_group grid = cg::this_grid();
    LAS unsigned char* lds = (LAS unsigned char*)lds_raw;
    const int wave = __builtin_amdgcn_readfirstlane((int)threadIdx.x >> 6);
    unsigned char* ws = a.ws;
    const float* MOD = (const float*)(ws + WS_MOD);
    const int lo = a.ph_lo, hi = a.ph_hi;
    XcdBarrier bar;
    { const int l0 = lane_id(); volatile LAS unsigned* st = (volatile LAS unsigned*)(lds + LDS_CTL);
      if (wave == 0 && l0 == 0) { st[0] = 0u; st[1] = 0u; }
      __syncthreads();
      bar.bar = (unsigned*)ws; bar.x = xb_xcc_id(); bar.st = st;
      if (lo == 0) { if (blockIdx.x == 0) { unsigned* z = (unsigned*)ws; const int t_ = wave * 64 + l0;
#pragma unroll 1
              for (int i = t_; i < 4096; i += NTHREADS) __hip_atomic_store(z + i, 0u, __ATOMIC_RELAXED, __HIP_MEMORY_SCOPE_AGENT);
              if (t_ == 0) __hip_atomic_store(z + 8192, 0u, __ATOMIC_RELAXED, __HIP_MEMORY_SCOPE_AGENT); } }
      else if (wave == 0 && l0 == 0) { st[2] = xb_add(&bar.bar[XB_XCNT(bar.x)], 1u); st[3] = bar.x; } }
    int ph = 0;
#define PHASE_BEGIN if (ph >= lo && ph < hi) { const int lane = lane_id(), tid = wave * 64 + lane; (void)tid; (void)lane;
#define TID tid
#define PHASE_END   if (ph + 1 < hi) { if (ph == 0) { grid.sync(); if (wave == 0 && lane_id() == 0) { bar.st[2] = xb_add(&bar.bar[XB_XCNT(bar.x)], 1u); bar.st[3] = bar.x; } } else xcd_barrier(bar, wave == 0 && lane_id() == 0);     } } ++ph;
    bf16* HB = (bf16*)(ws + WS_HB); bf16* ZB = (bf16*)(ws + WS_ZB); bf16* YC = (bf16*)(ws + WS_YC); bf16* YB = (bf16*)(ws + WS_YB);
    float* X1 = (float*)(ws + WS_X1); bf16* H2 = (bf16*)(ws + WS_H2); bf16* QP = (bf16*)(ws + WS_QP);

    PHASE_BEGIN ph_prologue(a, lds, tid, lane, wave); PHASE_END
    PHASE_BEGIN ph_modulate(a.in[0], MOD, 0, 2048, HB, ws + WS_HB8, (float*)(ws + WS_SA), lane, wave); PHASE_END
    PHASE_BEGIN { pg8::Gemm g{(const bf16*)(ws + WS_HB8), (const bf16*)(ws + WS_WIN), M, NZ, DM / 2, DM / 2, DM / 2}; pg8::StaticOrder S; S.init(M, NZ, gridDim.x, blockIdx.x);
        pg8::EpiI8RowScaleBf16 E{ZB, NZ, (const float*)(ws + WS_SA), 1.f / W8_SCALE, 0, 0}; pg8::gemm_phase<pg8::EpiI8RowScaleBf16, pg8::StaticOrder, true, true, false, true>(lds, g, S, E, TID); } PHASE_END
    PHASE_BEGIN ph_poolconv(a, lane, wave); PHASE_END
    PHASE_BEGIN {
        if (gridDim.x == 256) {
            { const int gq = blockIdx.x >> 6, pm = blockIdx.x & 63;
              pg8::Gemm g{(const bf16*)(ws + WS_PO) + gq * 256, (const bf16*)(ws + WS_WPOOL) + gq * 65536, M, 256, 256, 1024, 256}; pg8::ListOrder S{pm, 1};
              pg8::EpiScaleBf16 E{ws + WS_YC8 + gq * 256, DM, a.in[12] + gq * 256, Y8_SCALE}; pg8::gemm_phase<pg8::EpiScaleBf16, pg8::ListOrder, false, true>(lds, g, S, E, TID); }
            { const int hb = blockIdx.x >> 5, pm0 = (blockIdx.x & 31) * 2;
              int kg = 128; asm volatile("" : "+s"(kg));
              pg8::Gemm g{(const bf16*)(ws + WS_XC) + hb * 128, (const bf16*)(ws + WS_WAX) + hb * 32768, M, 256, kg, 1024, 128}; pg8::ListOrder S{pm0, 2};
              pg8::EpiGate E{(const bf16*)(ws + WS_XC), (float*)(ws + WS_AF), (float*)(ws + WS_DF), a.in[16], a.in[18], (const float*)(ws + WS_LS8), hb * 128};
              pg8::gemm_phase<pg8::EpiGate, pg8::ListOrder, false, false>(lds, g, S, E, wave * 64 + lane_id()); }
        } } PHASE_END
    PHASE_BEGIN ph_scan_agg(a, tid); PHASE_END
    PHASE_BEGIN ph_scan_fin(a, tid); PHASE_END
    PHASE_BEGIN { pg8::Gemm g{(const bf16*)(ws + WS_YC8), (const bf16*)(ws + WS_WOUT), M, DM, DM / 2, DM / 2, DM / 2}; pg8::StaticOrder S; S.init(M, DM, gridDim.x, blockIdx.x);
        pg8::EpiRowScaleBf16 E{YB, DM, nullptr, 1.f / (W8O_SCALE * Y8_SCALE), 0, 0}; pg8::gemm_phase<pg8::EpiRowScaleBf16, pg8::StaticOrder, true, true, true>(lds, g, S, E, TID); } PHASE_END
    PHASE_BEGIN ph_ln<true>(YB, nullptr, HB, MOD, MOD, a.in[4], a.in[5], H2, ws + WS_X1, (float*)(ws + WS_X1 + 64 * MiB), ws + WS_H6, (float*)(ws + WS_HS), lane, wave); PHASE_END
    PHASE_BEGIN { pg8::Gemm g{(const bf16*)(ws + WS_X1), (const bf16*)(ws + WS_WQ0), M, DM, DM / 2, DM / 2, DM / 2}; pg8::StaticOrder S; S.init(M, DM, gridDim.x, blockIdx.x);
        pg8::EpiI8RowScaleBf16 E{QP, DM, (const float*)(ws + WS_X1 + 64 * MiB), 1.f / W8_SCALE, 0, 0}; pg8::gemm_phase<pg8::EpiI8RowScaleBf16, pg8::StaticOrder, true, true, false, true>(lds, g, S, E, TID); } PHASE_END
    PHASE_BEGIN ph_topk(a, 0, lds, tid, lane, wave); PHASE_END
    PHASE_BEGIN ph_peer_u(a, 0, (volatile LAS unsigned*)(lds + LDS_CTL), lds, lane, wave); PHASE_END
    PHASE_BEGIN ph_peer_coef(a, 0, lds, lane, wave); PHASE_END
    PHASE_BEGIN ph_peer_v(a, 0, (volatile LAS unsigned*)(lds + LDS_CTL), lds, lane, wave); PHASE_END
    PHASE_BEGIN ph_peer_ln<false>(a, MOD, MOD + 2 * 12288, a.in[4] + DM, a.in[5] + DM, lane, wave); PHASE_END
    PHASE_BEGIN { pg8::Gemm g{(const bf16*)(ws + WS_HB8), (const bf16*)(ws + WS_WQKV), M, NQKV, DM / 2, DM / 2, DM / 2}; pg8::StaticOrder S; S.init(M, NQKV, gridDim.x, blockIdx.x);
        pg8::EpiRowScaleBf16 E{ZB, DM, (const float*)(ws + WS_SA), 1.f / W8_SCALE, DM, (size_t)M * DM}; pg8::gemm_phase<pg8::EpiRowScaleBf16, pg8::StaticOrder, true, true, true>(lds, g, S, E, TID);
        ph_forget(a, lds, lane, wave); } PHASE_END
    PHASE_BEGIN ph_cumsum(a, lane, wave); PHASE_END
    PHASE_BEGIN ph_attention(a, (char*)lds_raw, TID); PHASE_END
    PHASE_BEGIN { pg8::Gemm g{(const bf16*)(ws + WS_YC8), (const bf16*)(ws + WS_WO), M, DM, DM / 2, DM / 2, DM / 2}; pg8::StaticOrder S; S.init(M, DM, gridDim.x, blockIdx.x);
        pg8::EpiRowScaleBf16 E{YB, DM, nullptr, 1.f / (W8O_SCALE * attn::O8_SCALE), 0, 0}; pg8::gemm_phase<pg8::EpiRowScaleBf16, pg8::StaticOrder, true, true, true>(lds, g, S, E, TID); } PHASE_END
    PHASE_BEGIN ph_ln<true>(YB, nullptr, HB, MOD + 2 * 12288, MOD + 2 * 12288, a.in[4] + 2 * DM, a.in[5] + 2 * DM, H2, ws + WS_X1, (float*)(ws + WS_X1 + 64 * MiB), ws + WS_H6, (float*)(ws + WS_HS), lane, wave); PHASE_END
    PHASE_BEGIN { pg8::Gemm g{(const bf16*)(ws + WS_X1), (const bf16*)(ws + WS_WQ1), M, DM, DM / 2, DM / 2, DM / 2}; pg8::StaticOrder S; S.init(M, DM, gridDim.x, blockIdx.x);
        pg8::EpiI8RowScaleBf16 E{QP, DM, (const float*)(ws + WS_X1 + 64 * MiB), 1.f / W8_SCALE, 0, 0}; pg8::gemm_phase<pg8::EpiI8RowScaleBf16, pg8::StaticOrder, true, true, false, true>(lds, g, S, E, TID); } PHASE_END
    PHASE_BEGIN ph_topk(a, 1, lds, tid, lane, wave); PHASE_END
    PHASE_BEGIN ph_peer_u(a, 1, (volatile LAS unsigned*)(lds + LDS_CTL), lds, lane, wave); PHASE_END
    PHASE_BEGIN ph_peer_coef(a, 1, lds, lane, wave); PHASE_END
    PHASE_BEGIN ph_peer_v(a, 1, (volatile LAS unsigned*)(lds + LDS_CTL), lds, lane, wave); PHASE_END
    PHASE_BEGIN ph_peer_ln<true>(a, MOD + 2 * 12288, MOD, a.in[4] + 3 * DM, a.in[5] + 3 * DM, lane, wave); PHASE_END
#undef PHASE_BEGIN
#undef TID
#undef PHASE_END
}
constexpr int N_PHASES = 26;

extern "C" void kernel_launch(void* const* d_in, const int* in_sizes, int n_in, void* d_out, int out_size, void* d_ws, size_t ws_size, hipStream_t stream) {
    static int grid = 0;
    if (grid == 0) {
        int dev = 0, cus = 0, per_cu = 0;
        if (n_in != 24 || out_size != M * DM || ws_size < WS_END) { fprintf(stderr, "kernel_launch: unexpected shapes (n_in %d, out %d, ws %zu)\n", n_in, out_size, ws_size); grid = -1; return; }
        (void)hipGetDevice(&dev);
        (void)hipDeviceGetAttribute(&cus, hipDeviceAttributeMultiprocessorCount, dev);
        (void)hipFuncSetAttribute((const void*)mk_fwd, hipFuncAttributeMaxDynamicSharedMemorySize, LDS_BYTES);
        (void)hipOccupancyMaxActiveBlocksPerMultiprocessor(&per_cu, (const void*)mk_fwd, NTHREADS, LDS_BYTES);
        if (per_cu < 1) { fprintf(stderr, "kernel_launch: occupancy query reports %d blocks per CU\n", per_cu); grid = -1; return; }
        grid = cus;
        if (grid != 256) fprintf(stderr, "kernel_launch: %d CUs; phase 4 is written for 256 workgroups\n", grid);
    }
    if (grid < 0) return;
#ifdef MK_SPLIT
    if (hipMemsetAsync(d_ws, 0, 65536, stream) != hipSuccess) { fprintf(stderr, "kernel_launch: hipMemsetAsync failed\n"); return; }
#endif
    Args a{};
    for (int i = 0; i < 24; ++i) a.in[i] = (const float*)d_in[i];
    a.out = (float*)d_out; a.ws = (unsigned char*)d_ws;
#ifndef MK_SPLIT
    a.ph_lo = 0; a.ph_hi = N_PHASES;
    void* args[] = {&a};
    hipError_t e = hipLaunchCooperativeKernel((const void*)mk_fwd, dim3(grid), dim3(NTHREADS), args, LDS_BYTES, stream);
    if (e != hipSuccess) fprintf(stderr, "cooperative launch failed: %s (grid %d)\n", hipGetErrorString(e), grid);
#else
    for (int p = 0; p < N_PHASES; ++p) { a.ph_lo = p; a.ph_hi = p + 1; void* args[] = {&a};
        hipError_t e = hipLaunchCooperativeKernel((const void*)mk_fwd, dim3(grid), dim3(NTHREADS), args, LDS_BYTES, stream);
        if (e != hipSuccess) { fprintf(stderr, "launch %d failed: %s\n", p, hipGetErrorString(e)); break; } }
#endif
}
```

```cpp
#include <hip/hip_runtime.h>
#include <hip/hip_bf16.h>
#include <hip/hip_cooperative_groups.h>
#include <cstdio>
#include <cstdint>
#include <cmath>
namespace cg = cooperative_groups;
namespace pg8 {
#define PG8_LAS __attribute__((address_space(3)))
typedef unsigned short bf16_t;
typedef short bf16x8 __attribute__((ext_vector_type(8)));
typedef float f32x4 __attribute__((ext_vector_type(4)));
typedef unsigned u32x4 __attribute__((ext_vector_type(4)));
constexpr int BM = 256, BK = 64, HALF = 128, HTB = HALF * BK * 2  , STAGE_BYTES = 8 * HTB, NXCD = 8, WGM = 8;

__host__ __device__ __forceinline__ int lds_byte(int r, int c) { const int st = (r >> 4) * 2 + (c >> 5), rr = r & 15, cc = c & 31, ob = rr * 64 + cc * 2; return st * 1024 + (ob ^ (((ob >> 9) & 1) << 5)); }
__host__ __device__ __forceinline__ void stage_rc(int b, int& R, int& C) { const int st = b / 1024, sb = b % 1024, swz = sb ^ (((sb >> 9) & 1) << 5); R = (st >> 1) * 16 + swz / 64; C = (st & 1) * 32 + (swz % 64) / 2; }
__host__ __device__ __forceinline__ int perm32(int rho) { const int n = rho >> 4, i = rho & 15; return 8 * (i >> 2) + 4 * n + (i & 3); }

struct Unit { int pm, pn; };
struct Gemm { const bf16_t* A; const bf16_t* Bt; int M, N, K, lda, ldb; };

struct StaticOrder {
    int nM, nN, nwg, G, c;
    __host__ __device__ void init(int M, int N, int G_, int c_) { nM = M / BM; nN = N / BM; nwg = nM * nN; G = G_; c = c_; }
    __host__ __device__ bool next(int i, Unit& u) const {
        const long L = (long)i * G + c; if (L >= nwg) return false;
        int wgid = (int)L; { const int q = nwg / NXCD, r = nwg % NXCD, xcd = wgid % NXCD, off = wgid / NXCD; wgid = (xcd < r ? xcd * (q + 1) : r * (q + 1) + (xcd - r) * q) + off; }
        const int nig = WGM * nN, gid = wgid / nig, fm = gid * WGM, gsz = (nM - fm) < WGM ? (nM - fm) : WGM;
        u.pm = fm + ((wgid % nig) % gsz); u.pn = (wgid % nig) / gsz; return true;
    }
    __device__ __forceinline__ void a_ready(const Unit&) const {}
    __device__ __forceinline__ void done(const Unit&) const {}
};

__device__ __forceinline__ unsigned cvt_pk_bf16(float lo, float hi) { typedef float f2_ __attribute__((ext_vector_type(2))); typedef __bf16 b2_ __attribute__((ext_vector_type(2))); const f2_ f = {lo, hi}; return __builtin_bit_cast(unsigned, __builtin_convertvector(f, b2_)); }
typedef float f32x2 __attribute__((ext_vector_type(2)));
__device__ __forceinline__ f32x2 gelu_pk(f32x2 v) {
    const f32x2 av = __builtin_elementwise_abs(v), d = av * 0.2316418882f + 1.0f;
    f32x2 t; t.x = __builtin_amdgcn_rcpf(d.x); t.y = __builtin_amdgcn_rcpf(d.y);
    f32x2 q = t * 0.5307027145f + (-0.7265760135f); q = q * t + 0.7107068705f; q = q * t + (-0.142248368f); q = q * t + 0.127414796f; q = q * t;
    const f32x2 s = (v * v) * (-0.72134752044f);
    f32x2 e; e.x = __builtin_amdgcn_exp2f(s.x); e.y = __builtin_amdgcn_exp2f(s.y);
    const f32x2 m = v * (q * e), r = v - m;
    f32x2 o; o.x = v.x < 0.f ? m.x : r.x; o.y = v.y < 0.f ? m.y : r.y; return o;
}

template <int ACT  > struct EpiBf16 {
    static constexpr bool PERM = true, AFTER_DRAIN = false; static_assert(ACT == 0 || ACT == 1, "EpiBf16: ACT is 0 (none) or 1 (gelu_pk)");
    bf16_t* O; int ldc; const float* bias; int split_cols; size_t split_stride; float scale0;
    __device__ __forceinline__ void operator()(const f32x4 (&acc)[2][2][4][2], const Unit& u, int wr, int wc, int fr, int fq) const {
        const int row0 = u.pm * BM + wr * 64 + fr; int colt = u.pn * BM; bf16_t* base = O;
        float sc = 1.f; if (split_cols) { const int t = colt / split_cols; base += (size_t)t * split_stride; colt -= t * split_cols; if (t == 0) sc = scale0; }
        const int col0 = colt + wc * 32 + 8 * fq, bcol0 = u.pn * BM + wc * 32 + 8 * fq;
        f32x4 bv[2][2];
#pragma unroll
        for (int bj = 0; bj < 2; ++bj)
#pragma unroll
            for (int n = 0; n < 2; ++n) bv[bj][n] = bias ? *(const f32x4*)(bias + bcol0 + bj * HALF + 4 * n) : (f32x4){0.f, 0.f, 0.f, 0.f};
#pragma unroll
        for (int ai = 0; ai < 2; ++ai)
#pragma unroll
            for (int m = 0; m < 4; ++m) { bf16_t* rowp = base + (size_t)(row0 + ai * HALF + m * 16) * ldc + col0;
#pragma unroll
                for (int bj = 0; bj < 2; ++bj) { f32x4 v0 = acc[ai][bj][m][0] + bv[bj][0], v1 = acc[ai][bj][m][1] + bv[bj][1];
                    if (ACT == 1) { f32x2 a = gelu_pk((f32x2){v0[0], v0[1]}), b = gelu_pk((f32x2){v0[2], v0[3]}), c = gelu_pk((f32x2){v1[0], v1[1]}), d = gelu_pk((f32x2){v1[2], v1[3]});
                        v0 = (f32x4){a.x, a.y, b.x, b.y}; v1 = (f32x4){c.x, c.y, d.x, d.y}; }
                    v0 = v0 * sc; v1 = v1 * sc; u32x4 w; w.x = cvt_pk_bf16(v0[0], v0[1]); w.y = cvt_pk_bf16(v0[2], v0[3]); w.z = cvt_pk_bf16(v1[0], v1[1]); w.w = cvt_pk_bf16(v1[2], v1[3]);
                    *(u32x4*)(rowp + bj * HALF) = w; } }
    }
};

template <class Epi, class Sched, bool ALIGN_EPI = false, bool SP2 = false, bool FP8 = false, bool I8 = false>
__device__ __forceinline__ void gemm_phase(PG8_LAS unsigned char* lds, const Gemm g, const Sched& S, const Epi& E, const int tid) {
    const int wid = __builtin_amdgcn_readfirstlane(tid >> 6), lane = tid & 63, wr = wid >> 2, wc = wid & 3, fr = lane & 15, fq = lane >> 4;
    const int K = g.K, nt = K / BK;
    unsigned voffA[2], voffB[2];
#pragma unroll
    for (int i = 0; i < 2; ++i) { int R, C; stage_rc(tid * 16 + i * 8192, R, C); const int Rb = Epi::PERM ? ((R & ~31) + perm32(R & 31)) : R;
        voffA[i] = (unsigned)(R * g.lda + C) * 2u; voffB[i] = (unsigned)(Rb * g.ldb + C) * 2u; }
    const __amdgpu_buffer_rsrc_t rA = __builtin_amdgcn_make_buffer_rsrc((void*)g.A, 0, (int)((size_t)g.M * g.lda * 2), 0x00020000), rB = __builtin_amdgcn_make_buffer_rsrc((void*)g.Bt, 0, (int)((size_t)g.N * g.ldb * 2), 0x00020000);
    const size_t kstep = (size_t)(BK * 2);
    const size_t hstepA = (size_t)HALF * g.lda * 2, hstepB = (size_t)HALF * g.ldb * 2;
    const size_t tstepA = 2 * hstepA, tstepB = 2 * hstepB;
    const unsigned ldsw = (unsigned)wid * 1024u;
    const int aoffk[2] = {FP8 ? lds_byte(wr * 64 + fr, fq * 16) : lds_byte(wr * 64 + fr, fq * 8), FP8 ? lds_byte(wr * 64 + fr, fq * 16 + 8) : lds_byte(wr * 64 + fr, fq * 8) + 1024};
    const int boffk[2] = {FP8 ? lds_byte(wc * 32 + fr, fq * 16) : lds_byte(wc * 32 + fr, fq * 8), FP8 ? lds_byte(wc * 32 + fr, fq * 16 + 8) : lds_byte(wc * 32 + fr, fq * 8) + 1024};
#define PG8_SA(b, h) (((b) * 2 + (h)) * HTB)
#define PG8_SB(b, h) ((4 + (b) * 2 + (h)) * HTB)
#define PG8_STAGE(bufoff, gbase, voff, rs, gorig) do { _Pragma("unroll") for (int _i = 0; _i < 2; ++_i) \
        __builtin_amdgcn_raw_ptr_buffer_load_lds(rs, (PG8_LAS void*)(lds + (bufoff) + ldsw + _i * 8192), 16, (voff)[_i], (unsigned)((const char*)(gbase) - (const char*)(gorig)), 0, 0); } while (0)
#define PG8_LDA(dst, b, h) do { if constexpr (FP8) { _Pragma("unroll") for (int m = 0; m < 4; ++m) dst##8[m] = __builtin_shufflevector(*(const PG8_LAS bf16x8*)(lds + PG8_SA(b, h) + aoffk[0] + m * 2048), *(const PG8_LAS bf16x8*)(lds + PG8_SA(b, h) + aoffk[1] + m * 2048), 0, 1, 2, 3, 4, 5, 6, 7, 8, 9, 10, 11, 12, 13, 14, 15); } \
        else { _Pragma("unroll") for (int m = 0; m < 4; ++m) _Pragma("unroll") for (int k = 0; k < 2; ++k) dst[m][k] = *(const PG8_LAS bf16x8*)(lds + PG8_SA(b, h) + aoffk[k] + m * 2048); } } while (0)
#define PG8_LDB(dst, b, h) do { if constexpr (FP8) { _Pragma("unroll") for (int n = 0; n < 2; ++n) dst##8[n] = __builtin_shufflevector(*(const PG8_LAS bf16x8*)(lds + PG8_SB(b, h) + boffk[0] + n * 2048), *(const PG8_LAS bf16x8*)(lds + PG8_SB(b, h) + boffk[1] + n * 2048), 0, 1, 2, 3, 4, 5, 6, 7, 8, 9, 10, 11, 12, 13, 14, 15); } \
        else { _Pragma("unroll") for (int n = 0; n < 2; ++n) _Pragma("unroll") for (int k = 0; k < 2; ++k) dst[n][k] = *(const PG8_LAS bf16x8*)(lds + PG8_SB(b, h) + boffk[k] + n * 2048); } } while (0)
#define PG8_MMA(ai, bj, At, Bt) do { __builtin_amdgcn_s_setprio(1); _Pragma("unroll") for (int m = 0; m < 4; ++m) _Pragma("unroll") for (int n = 0; n < 2; ++n) { \
        if constexpr (FP8) { typedef int i32x8 __attribute__((ext_vector_type(8))); \
            acc[ai][bj][m][n] = __builtin_amdgcn_mfma_scale_f32_16x16x128_f8f6f4(__builtin_bit_cast(i32x8, Bt##8[n]), __builtin_bit_cast(i32x8, At##8[m]), acc[ai][bj][m][n], 0, 0, 0, 127, 0, 127); } \
        else if constexpr (I8) { typedef int i32x4_ __attribute__((ext_vector_type(4))); _Pragma("unroll") for (int k = 0; k < 2; ++k) \
            acc[ai][bj][m][n] = __builtin_bit_cast(f32x4, __builtin_amdgcn_mfma_i32_16x16x64_i8(__builtin_bit_cast(i32x4_, Bt[n][k]), __builtin_bit_cast(i32x4_, At[m][k]), __builtin_bit_cast(i32x4_, acc[ai][bj][m][n]), 0, 0, 0)); } \
        else { _Pragma("unroll") for (int k = 0; k < 2; ++k) acc[ai][bj][m][n] = __builtin_amdgcn_mfma_f32_16x16x32_bf16(Bt[n][k], At[m][k], acc[ai][bj][m][n], 0, 0, 0); } } \
        __builtin_amdgcn_s_setprio(0); } while (0)
#define PG8_WAIT_V(n) asm volatile("s_waitcnt vmcnt(" #n ")" ::: "memory")
#define PG8_WAIT_L(n) asm volatile("s_waitcnt lgkmcnt(" #n ")" ::: "memory")
#define PG8_BAR __builtin_amdgcn_s_barrier()
#define PG8_SCHED __builtin_amdgcn_sched_barrier(0)
    Unit cur, nxt; int ui = 0;
    if (!S.next(0, cur)) return;
    f32x4 acc[2][2][4][2];
#pragma unroll
    for (int a = 0; a < 2; ++a)
#pragma unroll
        for (int b = 0; b < 2; ++b)
#pragma unroll
            for (int m = 0; m < 4; ++m)
#pragma unroll
                for (int n = 0; n < 2; ++n) acc[a][b][m][n] = (f32x4){0.f, 0.f, 0.f, 0.f};
    bf16x8 At[4][2], B0[2][2], B1[2][2]; typedef short bf16x16 __attribute__((ext_vector_type(16))); bf16x16 At8[4], B08[2], B18[2];
    const char* cA = (const char*)g.A + (size_t)cur.pm * tstepA; const char* cB = (const char*)g.Bt + (size_t)cur.pn * tstepB;
    S.a_ready(cur);
    if constexpr (SP2) {
        PG8_STAGE(PG8_SB(0, 0), cB, voffB, rB, g.Bt); PG8_STAGE(PG8_SB(0, 1), cB + hstepB, voffB, rB, g.Bt); PG8_STAGE(PG8_SA(0, 0), cA, voffA, rA, g.A); PG8_STAGE(PG8_SA(0, 1), cA + hstepA, voffA, rA, g.A);
        if (wr == 1) PG8_BAR;
        PG8_WAIT_V(2); PG8_BAR;
        PG8_STAGE(PG8_SB(1, 0), cB + kstep, voffB, rB, g.Bt); PG8_STAGE(PG8_SA(1, 0), cA + kstep, voffA, rA, g.A); PG8_STAGE(PG8_SB(1, 1), cB + hstepB + kstep, voffB, rB, g.Bt);
        PG8_WAIT_V(6); PG8_BAR;
    } else {
        PG8_STAGE(PG8_SB(0, 0), cB, voffB, rB, g.Bt); PG8_STAGE(PG8_SA(0, 0), cA, voffA, rA, g.A); PG8_STAGE(PG8_SB(0, 1), cB + hstepB, voffB, rB, g.Bt); PG8_STAGE(PG8_SA(0, 1), cA + hstepA, voffA, rA, g.A);
        if (wr == 1) PG8_BAR;
        PG8_WAIT_V(4); PG8_BAR;
        PG8_STAGE(PG8_SB(1, 0), cB + kstep, voffB, rB, g.Bt); PG8_STAGE(PG8_SA(1, 0), cA + kstep, voffA, rA, g.A); PG8_STAGE(PG8_SB(1, 1), cB + hstepB + kstep, voffB, rB, g.Bt);
        PG8_WAIT_V(6); PG8_BAR;
    }
    for (;;) {
        const bool has_next = S.next(ui + 1, nxt);
        const char* nA = has_next ? (const char*)g.A + (size_t)nxt.pm * tstepA : cA; const char* nB = has_next ? (const char*)g.Bt + (size_t)nxt.pn * tstepB : cB;
        for (int t = 0; t < nt; t += 2) {
            const bool last = (t == nt - 2);
            const char* a1 = cA + (size_t)(t + 1) * kstep;
            const char* a2 = last ? nA : cA + (size_t)(t + 2) * kstep; const char* b2 = last ? nB : cB + (size_t)(t + 2) * kstep;
            const char* a3 = a2 + kstep; const char* b3 = b2 + kstep;
            if (last && has_next) S.a_ready(nxt);
            if constexpr (SP2) {
            PG8_LDB(B0, 0, 0); PG8_LDB(B1, 0, 1); PG8_SCHED; PG8_LDA(At, 0, 0); PG8_STAGE(PG8_SA(1, 1), a1 + hstepA, voffA, rA, g.A);
            PG8_WAIT_V(8); PG8_WAIT_L(0); PG8_BAR; PG8_MMA(0, 0, At, B0); PG8_MMA(0, 1, At, B1); PG8_BAR; PG8_SCHED;
            PG8_LDA(At, 0, 1); PG8_STAGE(PG8_SB(0, 0), b2, voffB, rB, g.Bt); PG8_STAGE(PG8_SB(0, 1), b2 + hstepB, voffB, rB, g.Bt); PG8_STAGE(PG8_SA(0, 0), a2, voffA, rA, g.A);
            PG8_WAIT_V(8); PG8_WAIT_L(0); PG8_BAR; PG8_MMA(1, 0, At, B0); PG8_MMA(1, 1, At, B1); PG8_BAR; PG8_SCHED;
            PG8_LDB(B0, 1, 0); PG8_LDB(B1, 1, 1); PG8_SCHED; PG8_LDA(At, 1, 0); PG8_STAGE(PG8_SA(0, 1), a2 + hstepA, voffA, rA, g.A);
            PG8_WAIT_V(8); PG8_WAIT_L(0); PG8_BAR; PG8_MMA(0, 0, At, B0); PG8_MMA(0, 1, At, B1); PG8_BAR; PG8_SCHED;
            PG8_LDA(At, 1, 1); PG8_STAGE(PG8_SB(1, 0), b3, voffB, rB, g.Bt); PG8_STAGE(PG8_SB(1, 1), b3 + hstepB, voffB, rB, g.Bt); PG8_STAGE(PG8_SA(1, 0), a3, voffA, rA, g.A);
            PG8_WAIT_V(8); PG8_WAIT_L(0); PG8_BAR; PG8_MMA(1, 0, At, B0); PG8_MMA(1, 1, At, B1); PG8_BAR; PG8_SCHED;
            } else {
            PG8_LDB(B0, 0, 0); PG8_SCHED; PG8_LDA(At, 0, 0); PG8_STAGE(PG8_SA(1, 1), a1 + hstepA, voffA, rA, g.A);
            PG8_WAIT_L(8); PG8_BAR; PG8_WAIT_L(0); PG8_MMA(0, 0, At, B0); PG8_BAR; PG8_SCHED;
            PG8_LDB(B1, 0, 1); PG8_STAGE(PG8_SB(0, 0), b2, voffB, rB, g.Bt);
            PG8_BAR; PG8_WAIT_L(0); PG8_MMA(0, 1, At, B1); PG8_BAR;
            PG8_LDA(At, 0, 1); PG8_STAGE(PG8_SA(0, 0), a2, voffA, rA, g.A);
            PG8_BAR; PG8_WAIT_L(0); PG8_MMA(1, 0, At, B0); PG8_BAR; PG8_SCHED;
            PG8_STAGE(PG8_SB(0, 1), b2 + hstepB, voffB, rB, g.Bt);
            PG8_WAIT_V(6); PG8_BAR; PG8_MMA(1, 1, At, B1); PG8_BAR;
            PG8_LDB(B0, 1, 0); PG8_SCHED; PG8_LDA(At, 1, 0); PG8_STAGE(PG8_SA(0, 1), a2 + hstepA, voffA, rA, g.A);
            PG8_WAIT_L(8); PG8_BAR; PG8_WAIT_L(0); PG8_MMA(0, 0, At, B0); PG8_BAR; PG8_SCHED;
            PG8_LDB(B1, 1, 1); PG8_STAGE(PG8_SB(1, 0), b3, voffB, rB, g.Bt);
            PG8_BAR; PG8_WAIT_L(0); PG8_MMA(0, 1, At, B1); PG8_BAR;
            PG8_LDA(At, 1, 1); PG8_STAGE(PG8_SA(1, 0), a3, voffA, rA, g.A);
            PG8_BAR; PG8_WAIT_L(0); PG8_MMA(1, 0, At, B0); PG8_BAR; PG8_SCHED;
            PG8_STAGE(PG8_SB(1, 1), b3 + hstepB, voffB, rB, g.Bt);
            PG8_WAIT_V(6); PG8_BAR; PG8_MMA(1, 1, At, B1); PG8_BAR;
            }
        }
        if constexpr (ALIGN_EPI) { if (wr == 0) PG8_BAR; }
        if constexpr (!Epi::AFTER_DRAIN) { E(acc, cur, wr, wc, fr, fq); S.done(cur); }
        if (!has_next) break;
#pragma unroll
        for (int a = 0; a < 2; ++a)
#pragma unroll
            for (int b = 0; b < 2; ++b)
#pragma unroll
                for (int m = 0; m < 4; ++m)
#pragma unroll
                    for (int n = 0; n < 2; ++n) acc[a][b][m][n] = (f32x4){0.f, 0.f, 0.f, 0.f};
        cur = nxt; cA = nA; cB = nB; ++ui;
        if constexpr (ALIGN_EPI) { if (wr == 1) PG8_BAR; }
    }
    PG8_WAIT_V(0);
    if constexpr (!ALIGN_EPI) { if (wr == 0) PG8_BAR; }
    PG8_BAR;
    if constexpr (Epi::AFTER_DRAIN) { E.fused(acc, cur, wr, wc, fr, fq, lds, wid, lane); S.done(cur); }
#undef PG8_SA
#undef PG8_SB
#undef PG8_STAGE
#undef PG8_LDA
#undef PG8_LDB
#undef PG8_MMA
#undef PG8_WAIT_V
#undef PG8_WAIT_L
#undef PG8_BAR
#undef PG8_SCHED
}
}

namespace attn {
constexpr float SCALE = 0.08838834764831845f;
constexpr int D = 128, PITCH = 2048;
constexpr float THR = 8.f; constexpr bool WSKIP = true; constexpr bool O_FP8 = true; constexpr float O8_SCALE = 16.f;
constexpr int NW = 8, QBLK = 32, KVBLK = 64, QB = NW * QBLK;
constexpr int SHM_V = KVBLK * D * 2, SHM_K = KVBLK * D * 2;
constexpr int LDS_BIAS = 2 * SHM_V + 2 * SHM_K + NW * 64 * 4;
constexpr int LDS_BYTES = LDS_BIAS + 2 * 256;
using bf16 = __hip_bfloat16;
typedef short bf16x8 __attribute__((ext_vector_type(8)));
typedef short s16x4 __attribute__((ext_vector_type(4)));
typedef float f32x16 __attribute__((ext_vector_type(16)));
typedef float f32x4 __attribute__((ext_vector_type(4)));
typedef unsigned u32x4 __attribute__((ext_vector_type(4)));
template <class A, class Bt> struct same_t { static constexpr bool v = false; };
template <class A> struct same_t<A, A> { static constexpr bool v = true; };

#define KSWZ(row, colB) ((row) * 256 + ((colB) ^ (((row) & 7) << 4)))
#define SBAR() __builtin_amdgcn_sched_barrier(0)
__device__ __forceinline__ int v_st(int k, int c) { const int kk = (k & ~0xC) | ((k & 4) << 1) | ((k & 8) >> 1); return ((kk >> 3) * 4 + (c >> 5)) * 512 + ((kk & 7) * 32 + (c & 31)) * 2; }
__device__ __forceinline__ int v_rd_base(int lane) { return ((lane & 3) << 3) | (((lane >> 2) & 3) << 6) | (((lane >> 4) & 1) << 5) | (((lane >> 5) & 1) << 8); }
constexpr int v_rd_off(int d0, int ks, int half) { return d0 * 512 + ks * 4096 + half * 2048; }
__device__ __forceinline__ int crow(int r, int hi) { return (r & 3) + 8 * (r >> 2) + 4 * hi; }
__device__ __forceinline__ unsigned cvtpk(float lo, float hi) {
    typedef float f2_ __attribute__((ext_vector_type(2))); typedef __bf16 b2_ __attribute__((ext_vector_type(2))); const f2_ f = {lo, hi}; return __builtin_bit_cast(unsigned, __builtin_convertvector(f, b2_));
}
__device__ __forceinline__ bf16x8 pack8(f32x4 a, f32x4 b) {
    u32x4 w = {cvtpk(a[0], a[1]), cvtpk(a[2], a[3]), cvtpk(b[0], b[1]), cvtpk(b[2], b[3])};
    return *reinterpret_cast<bf16x8*>(&w);
}
template <class T> __device__ __forceinline__ bf16x8 load8(const T* p) {
    if constexpr (same_t<T, float>::v) { return pack8(*(const f32x4*)p, *(const f32x4*)(p + 4)); }
    else { return *reinterpret_cast<const bf16x8*>(p); }
}
__device__ __forceinline__ void mask_tile(f32x16& p0, f32x16& p1, int dq, unsigned W) {
    const float NEG = -__builtin_inff();
#pragma unroll
    for (int r = 0; r < 16; ++r) {
        const int c = (r & 3) + 8 * (r >> 2);
        if ((unsigned)(dq - c) >= W) p0[r] = NEG;
        if ((unsigned)(dq - c - 32) >= W) p1[r] = NEG;
    }
}
constexpr float DEAD_T = 20.f;
__device__ __forceinline__ void partialSM(f32x16& p0, f32x16& p1, float& m_reg, float& mn, float& alpha, bool& dead) {
    float pmax = p0[0]; for (int r = 1; r < 16; ++r) pmax = fmaxf(pmax, p0[r]); for (int r = 0; r < 16; ++r) pmax = fmaxf(pmax, p1[r]);
    { auto rr = __builtin_amdgcn_permlane32_swap(__float_as_uint(pmax), __float_as_uint(pmax), false, false);
      pmax = fmaxf(__uint_as_float(rr[0]), __uint_as_float(rr[1])); }
    constexpr float C2 = 1.4426950408889634f * SCALE;
    dead = __all((pmax - m_reg) * SCALE < -DEAD_T);
    if (dead) { mn = m_reg; alpha = 1.f; return; }
    if (__builtin_expect(__all((pmax - m_reg) * SCALE <= THR), 1)) { mn = m_reg; alpha = 1.f; }
    else { mn = fmaxf(m_reg, pmax); alpha = __builtin_amdgcn_exp2f((m_reg - mn) * C2); m_reg = mn; }
    const float mnL = -mn * C2;
    for (int r = 0; r < 16; ++r) p0[r] = fmaf(p0[r], C2, mnL); for (int r = 0; r < 16; ++r) p1[r] = fmaf(p1[r], C2, mnL);
    for (int r = 0; r < 16; ++r) p0[r] = __builtin_amdgcn_exp2f(p0[r]);
}
__device__ __forceinline__ void finishSM(f32x16& p0, f32x16& p1, float alpha, float& l_reg, bf16x8& pa0, bf16x8& pa1, bf16x8& pa2, bf16x8& pa3) {
    for (int r = 0; r < 16; ++r) p1[r] = __builtin_amdgcn_exp2f(p1[r]);
    float ps = 0; for (int r = 0; r < 16; ++r) ps += p0[r]; for (int r = 0; r < 16; ++r) ps += p1[r];
    { auto rr = __builtin_amdgcn_permlane32_swap(__float_as_uint(ps), __float_as_uint(ps), false, false);
      ps = __uint_as_float(rr[0]) + __uint_as_float(rr[1]); }
    l_reg = l_reg * alpha + ps;
#define PK4(P, B_, OUT) do { unsigned a0 = cvtpk(P[B_+0], P[B_+1]), a1 = cvtpk(P[B_+2], P[B_+3]);                          \
        unsigned b0 = cvtpk(P[B_+4], P[B_+5]), b1 = cvtpk(P[B_+6], P[B_+7]);                                             \
        auto r0 = __builtin_amdgcn_permlane32_swap(a0, b0, false, false); auto r1 = __builtin_amdgcn_permlane32_swap(a1, b1, false, false); \
        u32x4 w = {r0[0], r1[0], r0[1], r1[1]}; OUT = *reinterpret_cast<bf16x8*>(&w); } while (0)
    PK4(p0, 0, pa0); PK4(p0, 8, pa1); PK4(p1, 0, pa2); PK4(p1, 8, pa3);
#undef PK4
}
template <int KB, bool SK>
__device__ __forceinline__ void qkt(f32x16& p0, f32x16& p1, const char* K_lds, int r32, int hi, const bf16x8* qr, bool act) {
    const float* bl = (const float*)(K_lds - 2 * SHM_V + LDS_BIAS + KB * 256) + 4 * hi;
    if (SK && !act) { const float NEG = -__builtin_inff();
#pragma unroll
        for (int r = 0; r < 16; ++r) { p0[r] = NEG; p1[r] = NEG; } return; }
#pragma unroll
    for (int g_ = 0; g_ < 4; ++g_) { const f32x4 b0_ = *(const f32x4*)(bl + 8 * g_), b1_ = *(const f32x4*)(bl + 32 + 8 * g_);
#pragma unroll
        for (int e_ = 0; e_ < 4; ++e_) { p0[4 * g_ + e_] = b0_[e_]; p1[4 * g_ + e_] = b1_[e_]; } }
    const char* kb[4];
#pragma unroll
    for (int dd = 0; dd < 4; ++dd) kb[dd] = K_lds + KB * SHM_K + KSWZ(r32, (dd * 16 + hi * 8) * 2);
#pragma unroll
    for (int d0 = 0; d0 < 8; ++d0) { const char* a = kb[d0 & 3] + (d0 >> 2) * 128;
        bf16x8 b0 = *reinterpret_cast<const bf16x8*>(a);
        bf16x8 b1 = *reinterpret_cast<const bf16x8*>(a + 32 * 256);
        p0 = __builtin_amdgcn_mfma_f32_32x32x16_bf16(b0, qr[d0], p0, 0, 0, 0);
        p1 = __builtin_amdgcn_mfma_f32_32x32x16_bf16(b1, qr[d0], p1, 0, 0, 0); }
}
template <int VB, bool SK>
__device__ __forceinline__ void pv_tile(f32x16* o, int vb0, bf16x8 pa0, bf16x8 pa1, bf16x8 pa2, bf16x8 pa3, bool act) {
    if (SK && !act) return;
#define TRRD(dst, off) asm volatile("ds_read_b64_tr_b16 %0, %1 offset:%2" : "=&v"(dst) : "v"(vb0), "i"(off) : "memory")
#define PV_D0(d0) do { s16x4 l0, l1, l2, l3, h0, h1, h2, h3; constexpr int b_ = VB * SHM_V + v_rd_off(d0, 0, 0);     \
        TRRD(l0, b_); TRRD(h0, b_ + 2048); TRRD(l1, b_ + 4096); TRRD(h1, b_ + 6144); TRRD(l2, b_ + 8192); TRRD(h2, b_ + 10240); TRRD(l3, b_ + 12288); TRRD(h3, b_ + 14336); \
        asm volatile("s_waitcnt lgkmcnt(0)" ::: "memory"); SBAR();                 \
        o[d0] = __builtin_amdgcn_mfma_f32_32x32x16_bf16(pa0, (bf16x8){l0[0], l0[1], l0[2], l0[3], h0[0], h0[1], h0[2], h0[3]}, o[d0], 0, 0, 0);   \
        o[d0] = __builtin_amdgcn_mfma_f32_32x32x16_bf16(pa1, (bf16x8){l1[0], l1[1], l1[2], l1[3], h1[0], h1[1], h1[2], h1[3]}, o[d0], 0, 0, 0);   \
        o[d0] = __builtin_amdgcn_mfma_f32_32x32x16_bf16(pa2, (bf16x8){l2[0], l2[1], l2[2], l2[3], h2[0], h2[1], h2[2], h2[3]}, o[d0], 0, 0, 0);   \
        o[d0] = __builtin_amdgcn_mfma_f32_32x32x16_bf16(pa3, (bf16x8){l3[0], l3[1], l3[2], l3[3], h3[0], h3[1], h3[2], h3[3]}, o[d0], 0, 0, 0); } while (0)
    PV_D0(0); PV_D0(1); PV_D0(2); PV_D0(3);
#undef PV_D0
#undef TRRD
}

template <class TIn, class TOut> struct BlockRef { const TIn* Q; const TIn* K; const TIn* V; TOut* O; const float* Fb; int P0; int jlo; unsigned char* O8; };
template <class TIn> struct Seam {
    bf16x8 qr[8];
    bf16x8 st_v0, st_v1, st_k0, st_k1; f32x4 sf0, sf1, sf2, sf3;
    f32x4 tq[16];
};
__device__ __forceinline__ int swa_jlo(int P0, int W) { const int lowk = P0 - W + 1; return lowk > 0 ? lowk / KVBLK : 0; }
#define ROW(p, k0, rr) ((const TIn*)((const char*)(p) + (unsigned)((((k0) + (rr)) * PITCH + sc) * (int)sizeof(TIn))))
#define VMW() asm volatile("s_waitcnt vmcnt(0)" ::: "memory")
#define VMWN(n) asm volatile("s_waitcnt vmcnt(%0)" :: "i"(n) : "memory")
#define SLOAD_H(Kp, Vp, Fp, bb, k0) do { S.st_v0 = load8<TIn>(ROW(Vp, k0, sr)); S.st_v1 = load8<TIn>(ROW(Vp, k0, 32 + sr));              \
                         S.st_k0 = load8<TIn>(ROW(Kp, k0, sr)); S.st_k1 = load8<TIn>(ROW(Kp, k0, 32 + sr));                          \
                         if (wid == 0) __builtin_amdgcn_global_load_lds((const unsigned*)((Fp) + (k0) + lane), (__attribute__((address_space(3))) unsigned*)(lds + LDS_BIAS + (bb) * 256), 4, 0, 0); } while (0)
#define SWRITE_HK(bf) do { int t_ = tid; asm volatile("" : "+v"(t_)); const int kws_ = KSWZ(t_ >> 4, (t_ & 15) * 16);     \
        *(bf16x8*)(K_lds + (bf) * SHM_K + kws_) = S.st_k0; *(bf16x8*)(K_lds + (bf) * SHM_K + kws_ + 32 * 256) = S.st_k1; } while (0)
#define SWRITE_HV(bf) do { int t_ = tid; asm volatile("" : "+v"(t_)); const int vst0_ = v_st(t_ >> 4, (t_ & 15) * 8), vst1_ = v_st(32 + (t_ >> 4), (t_ & 15) * 8); \
        *(bf16x8*)(V_lds + (bf) * SHM_V + vst0_) = S.st_v0; *(bf16x8*)(V_lds + (bf) * SHM_V + vst1_) = S.st_v1; } while (0)
#define SWRITE_H(bf) do { SWRITE_HV(bf); SWRITE_HK(bf); } while (0)
#define SLOAD_F(p, k0) do { S.sf0 = *(const f32x4*)ROW(p, k0, sr); S.sf1 = *(const f32x4*)(ROW(p, k0, sr) + 4);                \
                            S.sf2 = *(const f32x4*)ROW(p, k0, 32 + sr); S.sf3 = *(const f32x4*)(ROW(p, k0, 32 + sr) + 4); } while (0)
#define SWRITE_KF(bf) do { *(bf16x8*)(K_lds + (bf) * SHM_K + kws) = pack8(S.sf0, S.sf1); *(bf16x8*)(K_lds + (bf) * SHM_K + kws + 32 * 256) = pack8(S.sf2, S.sf3); } while (0)
#define SWRITE_VF(bf) do { *(bf16x8*)(V_lds + (bf) * SHM_V + vst0) = pack8(S.sf0, S.sf1); *(bf16x8*)(V_lds + (bf) * SHM_V + vst1) = pack8(S.sf2, S.sf3); } while (0)
template <class TIn, class TOut>
__device__ __forceinline__ void causal_swa_prime(const BlockRef<TIn, TOut>& cur, int W, char* lds, Seam<TIn>& S, const int tid) {
    constexpr bool F32 = same_t<TIn, float>::v;
    const int wid = __builtin_amdgcn_readfirstlane(tid >> 6), lane = tid & 63, r32 = lane & 31, hi = lane >> 5;
    const int sr = tid >> 4, sc = (tid & 15) * 8, kws = KSWZ(sr, sc * 2); char* K_lds = lds + 2 * SHM_V;
    const int kb0 = ((cur.P0 + QB - 1) / KVBLK) * KVBLK;
    for (int d0 = 0; d0 < 8; ++d0) S.qr[d0] = load8<TIn>(cur.Q + (size_t)(wid * QBLK + r32) * PITCH + d0 * 16 + hi * 8);
    if constexpr (F32) { SLOAD_F((const float*)cur.K, kb0); VMW(); SWRITE_KF(0); SBAR(); SLOAD_F((const float*)cur.V, kb0); }
    else { SLOAD_H(cur.K, cur.V, cur.Fb, 0, kb0); VMW(); SWRITE_HK(0); }
    __syncthreads();
}
template <class TIn, class TOut>
__device__ __forceinline__ void causal_swa_block(const BlockRef<TIn, TOut>& cur, const BlockRef<TIn, TOut>& nxt, int skv, int W, char* lds, Seam<TIn>& S, const int tid) {
    constexpr bool F32 = same_t<TIn, float>::v;
    const int wid = __builtin_amdgcn_readfirstlane(tid >> 6), lane = tid & 63, r32 = lane & 31, hi = lane >> 5;
    const int j_lo = cur.jlo;
    int j_hi = (cur.P0 + QB - 1) / KVBLK + 1; if (j_hi > skv / KVBLK) j_hi = skv / KVBLK;
    const int NT = j_hi - j_lo;
    const int kbn = ((nxt.P0 + QB - 1) / KVBLK) * KVBLK;
    const int qlo = cur.P0 + wid * QBLK, qm = qlo + r32 - 4 * hi;
    char* V_lds = lds; char* K_lds = lds + 2 * SHM_V;
    float* ws = (float*)(lds + 2 * SHM_V + 2 * SHM_K) + wid * 64; float* li_l = ws, * al_l = ws + 32;
    float m_reg = -1e30f, l_reg = 0; f32x16 o[4] = {};
    const int sr = tid >> 4, sc = (tid & 15) * 8, vst0 = v_st(sr, sc), vst1 = v_st(32 + sr, sc), kws = KSWZ(sr, sc * 2);
    const int vb0 = (int)(uintptr_t)V_lds + v_rd_base(lane);
    const TIn* Kh = cur.K; const TIn* Vh = cur.V;
#define RESC(a) do { if (__any((a) < 1.f)) { if (hi == 0) al_l[r32] = (a); asm volatile("s_waitcnt lgkmcnt(0)" ::: "memory");              \
                     for (int d_ = 0; d_ < 4; ++d_) for (int r = 0; r < 16; ++r) o[d_][r] *= al_l[crow(r, hi)]; } } while (0)
#define KBASE(t) ((j_hi - 1 - (t)) * KVBLK)
#define ACT(t) (KBASE(t) <= qlo + QBLK - 1 && KBASE(t) + KVBLK - 1 >= qlo - W + 1)
#define MASKT(P0_, P1_, t) do { const int kb_ = KBASE(t); if ((!SK || ACT(t)) && (kb_ + KVBLK - 1 > qlo || kb_ <= qlo + QBLK - 1 - W)) mask_tile(P0_, P1_, qm - kb_, (unsigned)W); } while (0)
    constexpr int NQL = F32 ? 16 : 8;
    constexpr bool SK = WSKIP && !F32;
#define SEAM_K0() do { VMWN(NQL); if constexpr (F32) { SWRITE_KF(0); SBAR(); SLOAD_F((const float*)nxt.V, kbn); } else { SWRITE_HK(0); } SBAR(); } while (0)
    f32x16 pA0, pA1, pB0, pB1; float mnA, mnB, alA, alB; bf16x8 pa0, pa1, pa2, pa3; bool deadA = false, deadB = false;
    if constexpr (F32) { VMW(); SWRITE_VF(0); SBAR(); } else { SWRITE_HV(0); SBAR(); }
    if (NT > 1) { if constexpr (F32) SLOAD_F((const float*)Kh, KBASE(1)); else SLOAD_H(Kh, Vh, cur.Fb, 1, KBASE(1)); }
    SBAR(); qkt<0, SK>(pA0, pA1, K_lds, r32, hi, S.qr, ACT(0));
    if constexpr (F32) { if (NT > 1) { VMW(); SWRITE_KF(1); SBAR(); SLOAD_F((const float*)Vh, KBASE(1)); } }
    MASKT(pA0, pA1, 0); partialSM(pA0, pA1, m_reg, mnA, alA, deadA);
    if (NT > 1) { VMW(); if constexpr (F32) { SWRITE_VF(1); SBAR(); if (NT > 2) SLOAD_F((const float*)Kh, KBASE(2)); } else SWRITE_H(1); }
    __syncthreads();
#define HALF_STEP(PX0, PX1, mnX, alX, deadX, PY0, PY1, alY, deadY, t, KB, VB, SB) do {                                                      \
        SBAR(); qkt<KB, SK>(PX0, PX1, K_lds, r32, hi, S.qr, ACT(t));                                             \
        if (!deadY) finishSM(PY0, PY1, alY, l_reg, pa0, pa1, pa2, pa3); SBAR();                                               \
        if ((t) + 1 < NT) { if constexpr (F32) { VMW(); SWRITE_KF(SB); SBAR(); SLOAD_F((const float*)Vh, KBASE((t) + 1)); }  \
                            else { SLOAD_H(Kh, Vh, cur.Fb, SB, KBASE((t) + 1)); } SBAR(); }                                               \
        pv_tile<VB, SK>(o, vb0, pa0, pa1, pa2, pa3, ACT((t) - 1) && !deadY); MASKT(PX0, PX1, (t)); partialSM(PX0, PX1, m_reg, mnX, alX, deadX);                                        \
        __syncthreads();                                                                                                      \
        if ((t) + 1 < NT) { VMW(); if constexpr (F32) { SWRITE_VF(SB); SBAR(); if ((t) + 2 < NT) SLOAD_F((const float*)Kh, KBASE((t) + 2)); } \
                            else { SWRITE_H(SB); } }                                                                          \
        RESC(alX); __syncthreads(); } while (0)
    for (int t = 1; t + 1 < NT; t += 2) {
        HALF_STEP(pB0, pB1, mnB, alB, deadB, pA0, pA1, alA, deadA, t, 1, 0, 0);
        HALF_STEP(pA0, pA1, mnA, alA, deadA, pB0, pB1, alB, deadB, t + 1, 0, 1, 1);
    }
    const bool even = (NT & 1) == 0;
    if (even) { SBAR(); qkt<1, SK>(pB0, pB1, K_lds, r32, hi, S.qr, ACT(NT - 1)); SBAR(); }
#define QROW(e) (nxt.Q + (size_t)(wid * QBLK + r32) * PITCH + ((e) >> 1) * 16 + hi * 8 + ((e) & 1) * 4)
    if constexpr (F32) { SLOAD_F((const float*)nxt.K, kbn); SBAR();
#pragma unroll
        for (int e = 0; e < 8; ++e) S.tq[e] = *(const f32x4*)QROW(e); }
    else { SLOAD_H(nxt.K, nxt.V, nxt.Fb, 0, kbn); SBAR();
#pragma unroll
        for (int d0 = 0; d0 < 8; ++d0) S.qr[d0] = load8<TIn>(nxt.Q + (size_t)(wid * QBLK + r32) * PITCH + d0 * 16 + hi * 8); }
    SBAR();
    if (!deadA) finishSM(pA0, pA1, alA, l_reg, pa0, pa1, pa2, pa3); SBAR();
    if constexpr (F32) {
#pragma unroll
        for (int e = 8; e < 16; ++e) S.tq[e] = *(const f32x4*)QROW(e); SBAR(); }
#undef QROW
    pv_tile<0, SK>(o, vb0, pa0, pa1, pa2, pa3, ACT(even ? NT - 2 : NT - 1) && !deadA);
    if (even) { MASKT(pB0, pB1, NT - 1); partialSM(pB0, pB1, m_reg, mnB, alB, deadB); __syncthreads(); RESC(alB);
        if (!deadB) finishSM(pB0, pB1, alB, l_reg, pa0, pa1, pa2, pa3); SBAR(); pv_tile<1, SK>(o, vb0, pa0, pa1, pa2, pa3, ACT(NT - 1) && !deadB); }
    SBAR(); SEAM_K0();
    if (hi == 0) li_l[r32] = l_reg; asm volatile("s_waitcnt lgkmcnt(0)" ::: "memory");
    float rli[16];
#pragma unroll
    for (int r = 0; r < 16; ++r) rli[r] = __builtin_amdgcn_rcpf(li_l[crow(r, hi)]);
    TOut* Ow = cur.O + (size_t)(wid * QBLK) * PITCH;
#pragma unroll
    for (int r = 0; r < 16; ++r) { const int orow = crow(r, hi);
#pragma unroll
        for (int d0 = 0; d0 < 4; ++d0) { const float v = o[d0][r] * rli[r];
            if constexpr (same_t<TOut, float>::v) { Ow[(size_t)orow * PITCH + d0 * 32 + r32] = v; }
            else if constexpr (O_FP8) { const float vs = fminf(fmaxf(v * O8_SCALE, -440.f), 440.f), t1 = __shfl_xor(vs, 1), t2 = __shfl_xor(vs, 2), t3 = __shfl_xor(t1, 2);
                   unsigned w8 = 0u; w8 = __builtin_amdgcn_cvt_pk_fp8_f32(vs, t1, w8, false); w8 = __builtin_amdgcn_cvt_pk_fp8_f32(t2, t3, w8, true);
                   if ((r32 & 3) == 0) *(unsigned*)(cur.O8 + (size_t)(wid * QBLK + orow) * PITCH + d0 * 32 + r32) = w8; }
            else { const float vn = __shfl_xor(v, 1);
                   if ((r32 & 1) == 0) *(unsigned*)(Ow + (size_t)orow * PITCH + d0 * 32 + r32) = cvtpk(v, vn); } } }
    if constexpr (F32) {
#pragma unroll
        for (int d0 = 0; d0 < 8; ++d0) S.qr[d0] = pack8(S.tq[2 * d0], S.tq[2 * d0 + 1]); }
    __syncthreads();
#undef RESC
#undef KBASE
#undef ACT
#undef MASKT
#undef SEAM_K0
#undef HALF_STEP
}
#undef ROW
#undef VMW
#undef VMWN
#undef SLOAD_H
#undef SWRITE_HK
#undef SWRITE_HV
#undef SWRITE_H
#undef SLOAD_F
#undef SWRITE_KF
#undef SWRITE_VF


enum { ORDER_NATURAL = 0, ORDER_REVERSED = 1, ORDER_PAIRED = 2, ORDER_XCD = 4 };
__host__ __device__ inline int swa_nramp(int nqb, int W, int qoff) { const int t = W - 1 - qoff; const int n = t < 0 ? 0 : t / QB + 1; return n > nqb ? nqb : n; }
__host__ __device__ inline int swa_nx(int nqb, int nramp, int order) { return (order & ORDER_PAIRED) ? (nramp + 1) / 2 + (nqb - nramp) : nqb; }
struct SwaItem { int bh, qb0, qb1; };
__device__ __forceinline__ SwaItem swa_decode(int L, int nb, int nh, int nhkv, int nqb, int nx, int nramp, int order) {
    const int G = nh / nhkv; SwaItem it; int x;
    if ((order & ORDER_XCD) && (nb * nhkv) % 8 == 0) { const int xcd = L & 7, k = L >> 3, per = G * nx, gi = k / per, r = k - gi * per;
        it.bh = (gi * 8 + xcd) * G + r / nx; x = r % nx; }
    else { it.bh = L / nx; x = L - it.bh * nx; }
    if (order & ORDER_PAIRED) { const int ns = nqb - nramp;
        if (x < ns) { it.qb0 = it.qb1 = nqb - 1 - x; } else { it.qb0 = x - ns; it.qb1 = nramp - 1 - it.qb0; } }
    else { it.qb0 = it.qb1 = ((order & 3) == ORDER_REVERSED) ? nqb - 1 - x : x; }
    return it;
}

}

namespace pg8 {
struct ListOrder {
    int pm0, n;
    __device__ bool next(int i, Unit& u) const { if (i >= n) return false; u.pm = pm0 + i; u.pn = 0; return true; }
    __device__ __forceinline__ void a_ready(const Unit&) const {}
    __device__ __forceinline__ void done(const Unit&) const {}
};
struct EpiScaleBf16 {
    static constexpr bool PERM = true, AFTER_DRAIN = false;
    unsigned char* O; int ldc; const float* colscale; float os;
    __device__ __forceinline__ void operator()(const f32x4 (&acc)[2][2][4][2], const Unit& u, int wr, int wc, int fr, int fq) const {
        const int row0 = u.pm * BM + wr * 64 + fr; int col0 = u.pn * BM + wc * 32 + 8 * fq; asm volatile("" : "+v"(col0));
        f32x4 sv[2][2];
#pragma unroll
        for (int bj = 0; bj < 2; ++bj)
#pragma unroll
            for (int n = 0; n < 2; ++n) sv[bj][n] = *(const f32x4*)(colscale + col0 + bj * HALF + 4 * n) * os;
#pragma unroll
        for (int ai = 0; ai < 2; ++ai)
#pragma unroll
            for (int m = 0; m < 4; ++m) { unsigned char* rowp = O + (size_t)(row0 + ai * HALF + m * 16) * ldc + col0;
#pragma unroll
                for (int bj = 0; bj < 2; ++bj) { const f32x4 v0 = acc[ai][bj][m][0] * sv[bj][0], v1 = acc[ai][bj][m][1] * sv[bj][1];
                    unsigned w0 = 0u, w1 = 0u;
                    w0 = __builtin_amdgcn_cvt_pk_fp8_f32(fminf(fmaxf(v0[0], -440.f), 440.f), fminf(fmaxf(v0[1], -440.f), 440.f), w0, false); w0 = __builtin_amdgcn_cvt_pk_fp8_f32(fminf(fmaxf(v0[2], -440.f), 440.f), fminf(fmaxf(v0[3], -440.f), 440.f), w0, true);
                    w1 = __builtin_amdgcn_cvt_pk_fp8_f32(fminf(fmaxf(v1[0], -440.f), 440.f), fminf(fmaxf(v1[1], -440.f), 440.f), w1, false); w1 = __builtin_amdgcn_cvt_pk_fp8_f32(fminf(fmaxf(v1[2], -440.f), 440.f), fminf(fmaxf(v1[3], -440.f), 440.f), w1, true);
                    typedef unsigned u32x2_ __attribute__((ext_vector_type(2))); *(u32x2_*)(rowp + bj * HALF) = (u32x2_){w0, w1}; } }
    }
};
struct EpiRowScaleBf16 {
    static constexpr bool PERM = true, AFTER_DRAIN = false;
    bf16_t* O; int ldc; const float* rs; float cs; int split_cols; size_t split_stride;
    __device__ __forceinline__ void operator()(const f32x4 (&acc)[2][2][4][2], const Unit& u, int wr, int wc, int fr, int fq) const {
        int ln_; asm volatile("v_mbcnt_lo_u32_b32 %0, -1, 0\n\tv_mbcnt_hi_u32_b32 %0, -1, %0" : "=v"(ln_));
        (void)fr; (void)fq; const int row0 = u.pm * BM + wr * 64 + (ln_ & 15); int colt = u.pn * BM; bf16_t* base = O;
        if (split_cols) { const int t = colt / split_cols; base += (size_t)t * split_stride; colt -= t * split_cols; }
        const int col0 = colt + wc * 32 + 8 * (ln_ >> 4);
#pragma unroll
        for (int ai = 0; ai < 2; ++ai)
#pragma unroll
            for (int m = 0; m < 4; ++m) { const int row = row0 + ai * HALF + m * 16; const float sc = rs ? rs[row] * cs : cs; bf16_t* rowp = base + (size_t)row * ldc + col0;
#pragma unroll
                for (int bj = 0; bj < 2; ++bj) { const f32x4 v0 = acc[ai][bj][m][0] * sc, v1 = acc[ai][bj][m][1] * sc;
                    u32x4 w; w.x = cvt_pk_bf16(v0[0], v0[1]); w.y = cvt_pk_bf16(v0[2], v0[3]); w.z = cvt_pk_bf16(v1[0], v1[1]); w.w = cvt_pk_bf16(v1[2], v1[3]);
                    *(u32x4*)(rowp + bj * HALF) = w; } }
    }
};
struct EpiI8RowScaleBf16 {
    static constexpr bool PERM = true, AFTER_DRAIN = false;
    bf16_t* O; int ldc; const float* rs; float cs; int split_cols; size_t split_stride;
    __device__ __forceinline__ void operator()(const f32x4 (&acc)[2][2][4][2], const Unit& u, int wr, int wc, int fr, int fq) const {
        int ln_; asm volatile("v_mbcnt_lo_u32_b32 %0, -1, 0\n\tv_mbcnt_hi_u32_b32 %0, -1, %0" : "=v"(ln_));
        (void)fr; (void)fq; const int row0 = u.pm * BM + wr * 64 + (ln_ & 15); int colt = u.pn * BM; bf16_t* base = O;
        if (split_cols) { const int t = colt / split_cols; base += (size_t)t * split_stride; colt -= t * split_cols; }
        const int col0 = colt + wc * 32 + 8 * (ln_ >> 4);
#pragma unroll
        for (int ai = 0; ai < 2; ++ai)
#pragma unroll
            for (int m = 0; m < 4; ++m) { const int row = row0 + ai * HALF + m * 16; const float sc = rs[row] * cs; bf16_t* rowp = base + (size_t)row * ldc + col0;
#pragma unroll
                for (int bj = 0; bj < 2; ++bj) { typedef int i32x4_ __attribute__((ext_vector_type(4))); const i32x4_ i0 = __builtin_bit_cast(i32x4_, acc[ai][bj][m][0]), i1 = __builtin_bit_cast(i32x4_, acc[ai][bj][m][1]);
                    u32x4 w; w.x = cvt_pk_bf16((float)i0[0] * sc, (float)i0[1] * sc); w.y = cvt_pk_bf16((float)i0[2] * sc, (float)i0[3] * sc); w.z = cvt_pk_bf16((float)i1[0] * sc, (float)i1[1] * sc); w.w = cvt_pk_bf16((float)i1[2] * sc, (float)i1[3] * sc);
                    *(u32x4*)(rowp + bj * HALF) = w; } }
    }
};
struct EpiGate {
    static constexpr bool PERM = false, AFTER_DRAIN = false;
    const bf16_t* XC; float* AF; float* DF; const float* b_a; const float* b_x; const float* ls8; int cbase;
    __device__ __forceinline__ void operator()(const f32x4 (&acc)[2][2][4][2], const Unit& u, int wr, int wc, int fr, int fq) const {
        const unsigned row0 = (unsigned)(u.pm * BM + wr * 64 + fr);
#pragma unroll
        for (int n = 0; n < 2; ++n) { unsigned c = (unsigned)(cbase + wc * 32 + 16 * n + 4 * fq); asm volatile("" : "+v"(c));
            const f32x4 ba = *(const f32x4*)(b_a + c), bx = *(const f32x4*)(b_x + c), l8 = *(const f32x4*)(ls8 + c) * 1.4426950408889634f;
#pragma unroll
            for (int ai = 0; ai < 2; ++ai)
#pragma unroll
                for (int m = 0; m < 4; ++m) { const unsigned off = (row0 + ai * HALF + m * 16) * 1024u + c;
                    const f32x4 pr = acc[ai][0][m][n] + ba, pi = acc[ai][1][m][n] + bx;
                    const uint2 xr = *(const uint2*)((const char*)XC + off * 2u);
                    const float xc[4] = {__uint_as_float(xr.x << 16), __uint_as_float(xr.x & 0xffff0000u), __uint_as_float(xr.y << 16), __uint_as_float(xr.y & 0xffff0000u)};
                    u32x4 pw;
#pragma unroll
                    for (int e = 0; e < 4; ++e) { const float r = __builtin_amdgcn_rcpf(1.f + __builtin_amdgcn_exp2f(-1.4426950408889634f * pr[e])), ig = __builtin_amdgcn_rcpf(1.f + __builtin_amdgcn_exp2f(-1.4426950408889634f * pi[e]));
                        const float la = r * l8[e]; const float a = __builtin_amdgcn_exp2f(la); const float mult = __builtin_amdgcn_sqrtf(fmaxf(1.f - a * a, 0.f)); pw[e] = cvt_pk_bf16(la, mult * ig * xc[e]); }
                    *(u32x4*)((char*)AF + off * 4u) = pw; asm volatile("" ::: "memory"); } }
    }
};
}

#define LAS __attribute__((address_space(3)))
typedef unsigned short bf16;
typedef unsigned v4u __attribute__((ext_vector_type(4)));
typedef unsigned v2u __attribute__((ext_vector_type(2)));
typedef float f32x4 __attribute__((ext_vector_type(4)));
typedef float f32x16 __attribute__((ext_vector_type(16)));
typedef short bf16x8 __attribute__((ext_vector_type(8)));

constexpr int NTHREADS = 512, NWAVES = 8;
constexpr int LDS_BYTES = 155648 + 256, LDS_CTL = 155648;
constexpr int BATCH = 2, SEQ = 8192, DM = 2048, M = BATCH * SEQ, NEXP = 16384;
constexpr int NZ = 3072, NQKV = 6144, NODIN = 6160;
constexpr int ROW6 = 1536;
constexpr bool V_FP4 = true;
constexpr int ROWV = V_FP4 ? 1024 : ROW6;
constexpr int ROW4 = 1024;
constexpr float ALPHA = 1.4142135623730951f, LN_EPS = 1e-5f;
constexpr float ATT_SCALE = 0.08838834764831845f;

constexpr size_t MiB = 1u << 20;
constexpr size_t WS_MOD = 1 * MiB;
constexpr size_t WS_LS8 = 1 * MiB + 512 * 1024;
constexpr size_t WS_WIN = 2 * MiB, WS_WOUT = 14 * MiB, WS_WQKV = 22 * MiB, WS_WO = 46 * MiB, WS_WQ0 = 54 * MiB, WS_WQ1 = 62 * MiB;
constexpr size_t WS_KEYS = 70 * MiB, WS_WPOOL = 71 * MiB, WS_WAX = 71 * MiB + 512 * 1024, WS_WF = 72 * MiB;
constexpr size_t WS_FE = 77 * MiB, WS_FP = 77 * MiB + 64 * 1024, WS_KN = 77 * MiB + 128 * 1024, WS_QN = 77 * MiB + 192 * 1024, WS_DN = 77 * MiB + 256 * 1024;
constexpr size_t WS_AG = 73 * MiB, WS_HG = 73 * MiB + 512 * 1024, WS_LF = 74 * MiB, WS_FB = 75 * MiB;
constexpr size_t WS_SU = 76 * MiB, WS_SV = 76 * MiB + 128 * 1024;
constexpr size_t WS_HB8 = 208 * MiB, WS_SA = 79 * MiB;
constexpr float YP_SCALE = 64.f;
constexpr float W8O_SCALE = 2048.f, Y8_SCALE = 16.f;
constexpr size_t WS_YC8 = 240 * MiB;
constexpr float W8_SCALE = 1024.f;
constexpr size_t WS_PART = 400 * MiB;
constexpr size_t WS_AR = 496 * MiB, WS_EQ = 500 * MiB;
constexpr size_t WS_Y = 592 * MiB;
constexpr size_t WS_H6 = 752 * MiB, WS_HS = 785 * MiB;
constexpr size_t WS_TU = 80 * MiB, WS_TV = 144 * MiB;
constexpr size_t WS_HB = 336 * MiB, WS_ZB = 400 * MiB, WS_YC = 592 * MiB, WS_YB = 656 * MiB, WS_X1 = 720 * MiB, WS_H2 = 848 * MiB, WS_QP = 912 * MiB;
constexpr size_t WS_EI = 976 * MiB, WS_GT = 984 * MiB, WS_END = 992 * MiB;
constexpr size_t WS_AF = WS_H2, WS_DF = WS_QP;
constexpr size_t WS_PO = WS_YB, WS_XC = WS_YB + 32 * MiB;

struct Args { const float* in[24]; float* out; unsigned char* ws; int ph_lo, ph_hi; };

__device__ __forceinline__ float bf_lo(unsigned u) { return __uint_as_float(u << 16); }
__device__ __forceinline__ float bf_hi(unsigned u) { return __uint_as_float(u & 0xffff0000u); }
__device__ __forceinline__ unsigned pk2(float lo, float hi) { return pg8::cvt_pk_bf16(lo, hi); }
__device__ __forceinline__ unsigned pk2c(float lo, float hi) { typedef float f2_ __attribute__((ext_vector_type(2))); typedef __bf16 b2_ __attribute__((ext_vector_type(2))); const f2_ f = {lo, hi}; return __builtin_bit_cast(unsigned, __builtin_convertvector(f, b2_)); }
#define SWZ_XOR_(v, m) __uint_as_float((unsigned)__builtin_amdgcn_ds_swizzle((int)__float_as_uint(v), ((m) << 10) | 0x1f))
__device__ __forceinline__ float wave_sum(float v) {
    v += SWZ_XOR_(v, 1); v += SWZ_XOR_(v, 2); v += SWZ_XOR_(v, 4); v += SWZ_XOR_(v, 8); v += SWZ_XOR_(v, 16);
    const auto rr = __builtin_amdgcn_permlane32_swap(__float_as_uint(v), __float_as_uint(v), false, false);
    return __uint_as_float(rr[0]) + __uint_as_float(rr[1]);
}
__device__ __forceinline__ float wave_max(float v) {
    v = fmaxf(v, SWZ_XOR_(v, 1)); v = fmaxf(v, SWZ_XOR_(v, 2)); v = fmaxf(v, SWZ_XOR_(v, 4)); v = fmaxf(v, SWZ_XOR_(v, 8)); v = fmaxf(v, SWZ_XOR_(v, 16));
    const auto rr = __builtin_amdgcn_permlane32_swap(__float_as_uint(v), __float_as_uint(v), false, false);
    return fmaxf(__uint_as_float(rr[0]), __uint_as_float(rr[1]));
}
__device__ __forceinline__ float gelu_tanh(float x) { const float y = 0.7978845608028654f * (x + 0.044715f * x * x * x); return x * __builtin_amdgcn_rcpf(1.f + __builtin_amdgcn_exp2f(-2.8853900817779268f * y)); }
#define LDS_WAIT() asm volatile("s_waitcnt lgkmcnt(0)" ::: "memory")
__device__ __forceinline__ int lane_id() { int l; asm volatile("v_mbcnt_lo_u32_b32 %0, -1, 0\n\tv_mbcnt_hi_u32_b32 %0, -1, %0" : "=v"(l)); return l; }


#define XB_TMO      128
#define XB_XCNT(j)  (256  + 64 * (j))
#define XB_XSUB(j)  (1280 + 64 * (j))
#define XB_XGEN(j)  (2304 + 64 * (j))
#define XB_TOP      3328
#define XB_TOPGEN   3392
#define XCD_BAR_WORDS 3456
#define XB_SPIN_CAP (1u << 22)
__device__ __forceinline__ unsigned xb_ld(unsigned* p)              { return __hip_atomic_load(p, __ATOMIC_RELAXED, __HIP_MEMORY_SCOPE_AGENT); }
__device__ __forceinline__ unsigned xb_add(unsigned* p, unsigned v) { return __hip_atomic_fetch_add(p, v, __ATOMIC_RELAXED, __HIP_MEMORY_SCOPE_AGENT); }
__device__ __forceinline__ unsigned xb_xcc_id() { return (unsigned)__builtin_amdgcn_s_getreg((3 << 11) | 20) & 0xFu; }
#define XB_SPIN(cond, bar) do { unsigned _sp = 0; while (cond) { __builtin_amdgcn_s_sleep(1); \
    if ((++_sp & 255u) == 0u) { if (xb_ld(&(bar)[XB_TMO])) break; if (_sp > XB_SPIN_CAP) { atomicAdd(&(bar)[XB_TMO], 1u); break; } } } } while (0)
struct XcdBarrier { unsigned* bar; unsigned x; volatile LAS unsigned* st; };
__device__ __forceinline__ XcdBarrier xcd_barrier_post(unsigned* bar, volatile LAS unsigned* st, bool t0) {
    XcdBarrier b; b.bar = bar; b.x = xb_xcc_id(); b.st = st;
    if (t0) { st[2] = xb_add(&bar[XB_XCNT(b.x)], 1u); st[3] = b.x; }
    return b;
}
__device__ __forceinline__ void xcd_barrier_complete(unsigned* bar, unsigned x, unsigned& nloc, unsigned& nx, unsigned& uni) {
    const unsigned G = gridDim.x * gridDim.y * gridDim.z;
    unsigned sum, cnt, mine, sp = 0u;
    for (;;) {
        sum = 0u; cnt = 0u; mine = 0u; uni = (G & 7u) == 0u ? 1u : 0u;
#pragma unroll
        for (unsigned j = 0; j < 16; ++j) { const unsigned c = xb_ld(&bar[XB_XCNT(j)]); sum += c; cnt += (c > 0u) ? 1u : 0u; mine = (j == x) ? c : mine; uni = (c == (j < 8u ? (G >> 3) : 0u)) ? uni : 0u; }
        if (sum == G) break;
        __builtin_amdgcn_s_sleep(1);
        if ((++sp & 255u) == 0u) { if (xb_ld(&bar[XB_TMO])) break; if (sp > XB_SPIN_CAP) { atomicAdd(&bar[XB_TMO], 1u); break; } }
    }
    nloc = mine > 0u ? mine : 1u; nx = cnt > 0u ? cnt : 1u;
}
__device__ __forceinline__ void xcd_barrier(const XcdBarrier& b, bool t0) {
    asm volatile("s_waitcnt vmcnt(0)" ::: "memory");
    __syncthreads();
    if (t0) {
        unsigned* bar = b.bar;
        __builtin_amdgcn_s_waitcnt(0);
        unsigned nloc = b.st[0], nx = b.st[1];
        if (nloc == 0u) { unsigned uni; xcd_barrier_complete(bar, b.x, nloc, nx, uni); b.st[0] = nloc; b.st[1] = nx; b.st[4] = uni; }
        const unsigned old = xb_add(&bar[XB_XSUB(b.x)], 1u);
        const unsigned gen = old / nloc;
        if (old + 1u == (gen + 1u) * nloc) {
            __builtin_amdgcn_fence(__ATOMIC_RELEASE, "agent");
            asm volatile("s_waitcnt vmcnt(0)" ::: "memory");
            const unsigned og = xb_add(&bar[XB_TOP], 1u);
            const unsigned tg = og / nx;
            if (og + 1u == (tg + 1u) * nx) xb_add(&bar[XB_TOPGEN], 1u);
            else XB_SPIN(xb_ld(&bar[XB_TOPGEN]) == tg, bar);
            __builtin_amdgcn_fence(__ATOMIC_ACQUIRE, "agent");
            xb_add(&bar[XB_XGEN(b.x)], 1u);
            asm volatile("s_waitcnt vmcnt(0)" ::: "memory");
        } else {
            XB_SPIN(xb_ld(&bar[XB_XGEN(b.x)]) == gen, bar);
            __builtin_amdgcn_fence(__ATOMIC_ACQUIRE, "agent");
            asm volatile("s_waitcnt vmcnt(0)" ::: "memory");
        }
    }
    __syncthreads();
}

__device__ __forceinline__ void transpose_item(const float* W, int ldw, int nblk, bf16* WT, int K, LAS float* scr, int item, int lane) {
    const int kb = item / nblk, nb = item % nblk, k0 = 64 * kb, n0 = 32 * nb;
#pragma unroll 8
    for (int i = 0; i < 32; ++i) { const int kk = 2 * i + (lane >> 5); scr[kk * 33 + (lane & 31)] = W[(size_t)(k0 + kk) * ldw + n0 + (lane & 31)]; }
    LDS_WAIT(); asm volatile("" ::: "memory");
    const int c = lane & 7;
#pragma unroll
    for (int j = 0; j < 4; ++j) { const int n = (lane >> 3) + 8 * j; const LAS float* s = scr + (8 * c) * 33 + n;
        v4u o; o.x = pk2(s[0 * 33], s[1 * 33]); o.y = pk2(s[2 * 33], s[3 * 33]); o.z = pk2(s[4 * 33], s[5 * 33]); o.w = pk2(s[6 * 33], s[7 * 33]);
        *(v4u*)(WT + (size_t)(n0 + n) * K + k0 + 8 * c) = o; }
    LDS_WAIT(); asm volatile("" ::: "memory");
}
__device__ __forceinline__ unsigned pk4_i8(float a, float b, float c, float d) {
    const int ia = (int)rintf(fminf(fmaxf(a, -127.f), 127.f)), ib = (int)rintf(fminf(fmaxf(b, -127.f), 127.f)), ic = (int)rintf(fminf(fmaxf(c, -127.f), 127.f)), id = (int)rintf(fminf(fmaxf(d, -127.f), 127.f));
    return ((unsigned)ia & 0xffu) | (((unsigned)ib & 0xffu) << 8) | (((unsigned)ic & 0xffu) << 16) | ((unsigned)id << 24);
}
__device__ __forceinline__ void transpose_item_i8(const float* W, int ldw, int nblk, unsigned char* WT, int K, LAS float* scr, int item, int lane, float wscale) {
    const int kb = item / nblk, nb = item % nblk, k0 = 64 * kb, n0 = 32 * nb;
#pragma unroll 8
    for (int i = 0; i < 32; ++i) { const int kk = 2 * i + (lane >> 5); scr[kk * 33 + (lane & 31)] = W[(size_t)(k0 + kk) * ldw + n0 + (lane & 31)] * wscale; }
    LDS_WAIT(); asm volatile("" ::: "memory");
    const int c = lane & 7;
#pragma unroll
    for (int j = 0; j < 4; ++j) { const int n = (lane >> 3) + 8 * j; const LAS float* sp = scr + (8 * c) * 33 + n;
        *(v2u*)(WT + (size_t)(n0 + n) * K + k0 + 8 * c) = (v2u){pk4_i8(sp[0 * 33], sp[1 * 33], sp[2 * 33], sp[3 * 33]), pk4_i8(sp[4 * 33], sp[5 * 33], sp[6 * 33], sp[7 * 33])}; }
    LDS_WAIT(); asm volatile("" ::: "memory");
}
__device__ __forceinline__ float cl8(float x) { return fminf(fmaxf(x, -440.f), 440.f); }
__device__ __forceinline__ unsigned pk4_fp8(float a, float b, float c, float d) { unsigned w = 0u; w = __builtin_amdgcn_cvt_pk_fp8_f32(cl8(a), cl8(b), w, false); w = __builtin_amdgcn_cvt_pk_fp8_f32(cl8(c), cl8(d), w, true); return w; }
__device__ __forceinline__ void transpose_item8(const float* W, int ldw, int nblk, unsigned char* WT, int K, LAS float* scr, int item, int lane, float wscale = W8_SCALE) {
    const int kb = item / nblk, nb = item % nblk, k0 = 64 * kb, n0 = 32 * nb;
#pragma unroll 8
    for (int i = 0; i < 32; ++i) { const int kk = 2 * i + (lane >> 5); scr[kk * 33 + (lane & 31)] = W[(size_t)(k0 + kk) * ldw + n0 + (lane & 31)] * wscale; }
    LDS_WAIT(); asm volatile("" ::: "memory");
    const int c = lane & 7;
#pragma unroll
    for (int j = 0; j < 4; ++j) { const int n = (lane >> 3) + 8 * j; const LAS float* sp = scr + (8 * c) * 33 + n; unsigned w0 = 0u, w1 = 0u;
        w0 = __builtin_amdgcn_cvt_pk_fp8_f32(cl8(sp[0 * 33]), cl8(sp[1 * 33]), w0, false); w0 = __builtin_amdgcn_cvt_pk_fp8_f32(cl8(sp[2 * 33]), cl8(sp[3 * 33]), w0, true);
        w1 = __builtin_amdgcn_cvt_pk_fp8_f32(cl8(sp[4 * 33]), cl8(sp[5 * 33]), w1, false); w1 = __builtin_amdgcn_cvt_pk_fp8_f32(cl8(sp[6 * 33]), cl8(sp[7 * 33]), w1, true);
        *(v2u*)(WT + (size_t)(n0 + n) * K + k0 + 8 * c) = (v2u){w0, w1}; }
    LDS_WAIT(); asm volatile("" ::: "memory");
}
__device__ __forceinline__ void convert_item(const float* src, bf16* dst, size_t item, int lane) {
    const size_t base = item * 4096 + (size_t)lane * 8;
#pragma unroll
    for (int j = 0; j < 8; ++j) { const f32x4 a = *(const f32x4*)(src + base + j * 512), b = *(const f32x4*)(src + base + j * 512 + 4);
        v4u o; o.x = pk2(a[0], a[1]); o.y = pk2(a[2], a[3]); o.z = pk2(b[0], b[1]); o.w = pk2(b[2], b[3]);
        *(v4u*)(dst + base + j * 512) = o; }
}
__device__ __forceinline__ void fp8_row_item(const float* src, unsigned char* dst, float* scale, int row, int lane) {
    const float* p = src + (size_t)row * DM + 4 * lane; f32x4 v[8]; float mx = 0.f;
#pragma unroll
    for (int j = 0; j < 8; ++j) { v[j] = *(const f32x4*)(p + 256 * j); mx = fmaxf(mx, fmaxf(fmaxf(fabsf(v[j][0]), fabsf(v[j][1])), fmaxf(fabsf(v[j][2]), fabsf(v[j][3])))); }
    mx = fmaxf(wave_max(mx), 1e-30f); const float inv = 240.f / mx;
    unsigned* q = (unsigned*)(dst + (size_t)row * DM) + lane;
#pragma unroll
    for (int j = 0; j < 8; ++j) { unsigned w = 0u; w = __builtin_amdgcn_cvt_pk_fp8_f32(v[j][0] * inv, v[j][1] * inv, w, false); w = __builtin_amdgcn_cvt_pk_fp8_f32(v[j][2] * inv, v[j][3] * inv, w, true); q[64 * j] = w; }
    if (lane == 0) scale[row] = mx * (1.f / 240.f);
}
typedef float f32x16_t __attribute__((ext_vector_type(16)));
typedef float f32x32_t __attribute__((ext_vector_type(32)));
typedef unsigned u32x6_t __attribute__((ext_vector_type(6)));
typedef unsigned u32x3_t __attribute__((ext_vector_type(3)));
__device__ __forceinline__ void fp6_pack_block(const float (&v)[32], u32x6_t& p, unsigned& ebyte) {
    float mx = 0.f;
#pragma unroll
    for (int i = 0; i < 32; ++i) mx = fmaxf(mx, fabsf(v[i]));
    int ex = (int)((__float_as_uint(mx * (1.f / 7.5f)) + 0x7fffffu) >> 23) - 127; ex = ex < -126 ? -126 : (ex > 127 ? 127 : ex);
    const float inv = __uint_as_float((unsigned)(127 - ex) << 23);
    f32x16_t a, b;
#pragma unroll
    for (int i = 0; i < 16; ++i) { a[i] = v[2 * i] * inv; b[i] = v[2 * i + 1] * inv; }
    p = __builtin_amdgcn_cvt_scalef32_2xpk16_fp6_f32(a, b, 1.0f); ebyte = (unsigned)(ex + 127);
}
__device__ __forceinline__ void fp6_row_item(const float* src, unsigned char* dst, float* sdst, int row, int lane) {
    const float* p = src + (size_t)row * DM + 4 * lane; float v[32]; float mx = 0.f;
#pragma unroll
    for (int j = 0; j < 8; ++j) { const f32x4 x = *(const f32x4*)(p + 256 * j); v[4 * j] = x[0]; v[4 * j + 1] = x[1]; v[4 * j + 2] = x[2]; v[4 * j + 3] = x[3]; }
#pragma unroll
    for (int i = 0; i < 32; ++i) mx = fmaxf(mx, fabsf(v[i]));
    mx = fmaxf(wave_max(mx), 1e-30f);
    const float inv = 7.5f / mx;
    f32x16_t a, b;
#pragma unroll
    for (int i = 0; i < 16; ++i) { a[i] = v[2 * i] * inv; b[i] = v[2 * i + 1] * inv; }
    const u32x6_t pk = __builtin_amdgcn_cvt_scalef32_2xpk16_fp6_f32(a, b, 1.0f);
    unsigned char* q = dst + (size_t)row * ROW6;
    *(v4u*)(q + 16 * lane) = (v4u){pk[0], pk[1], pk[2], pk[3]}; *(v2u*)(q + 1024 + 8 * lane) = (v2u){pk[4], pk[5]};
    if (lane == 0) sdst[row] = mx * (1.f / 7.5f);
}
template <bool VORD>
__device__ __forceinline__ void fp4_row_item(const float* src, unsigned char* dst, float* sdst, int row, int lane) {
    const float* p = src + (size_t)row * DM + (VORD ? 32 : 8) * lane; float v[32]; float ss = 0.f;
    if constexpr (VORD) {
#pragma unroll
        for (int j = 0; j < 8; ++j) { const f32x4 x = *(const f32x4*)(p + 4 * j); v[4 * j] = x[0]; v[4 * j + 1] = x[1]; v[4 * j + 2] = x[2]; v[4 * j + 3] = x[3]; } }
    else
#pragma unroll
    for (int j = 0; j < 4; ++j) { const f32x4 x = *(const f32x4*)(p + 512 * j), y = *(const f32x4*)(p + 512 * j + 4); v[8 * j] = x[0]; v[8 * j + 1] = x[1]; v[8 * j + 2] = x[2]; v[8 * j + 3] = x[3]; v[8 * j + 4] = y[0]; v[8 * j + 5] = y[1]; v[8 * j + 6] = y[2]; v[8 * j + 7] = y[3]; }
#pragma unroll
    for (int i = 0; i < 32; ++i) ss += v[i] * v[i];
    const float sc = fmaxf(0.5f * sqrtf(wave_sum(ss) * (1.f / DM)), 1e-30f), inv = 1.f / sc;
    unsigned w[4] = {0u, 0u, 0u, 0u};
#pragma unroll
    for (int d = 0; d < 4; ++d) {
        w[d] = __builtin_amdgcn_cvt_scalef32_pk_fp4_f32(w[d], v[8 * d] * inv, v[8 * d + 1] * inv, 1.0f, 0);
        w[d] = __builtin_amdgcn_cvt_scalef32_pk_fp4_f32(w[d], v[8 * d + 2] * inv, v[8 * d + 3] * inv, 1.0f, 1);
        w[d] = __builtin_amdgcn_cvt_scalef32_pk_fp4_f32(w[d], v[8 * d + 4] * inv, v[8 * d + 5] * inv, 1.0f, 2);
        w[d] = __builtin_amdgcn_cvt_scalef32_pk_fp4_f32(w[d], v[8 * d + 6] * inv, v[8 * d + 7] * inv, 1.0f, 3); }
    unsigned char* q = dst + (size_t)(row / NEXP) * NEXP * ROW4 + ((size_t)(lane >> 3) * NEXP + (size_t)(row % NEXP)) * 128 + 16 * (lane & 7);
    *(v4u*)q = (v4u){w[0], w[1], w[2], w[3]};
    if (lane == 0) sdst[row] = sc;
}
__device__ __forceinline__ void ph_prologue(const Args& a, LAS unsigned char* lds, int tid, int lane, int wave) {
    unsigned char* ws = a.ws;
    if (blockIdx.x < 192) {
        LAS float* cact = (LAS float*)lds;
        LAS float* red = (LAS float*)(lds + 16384);
        for (int i = tid; i < 2 * DM; i += NTHREADS) { const float cv = a.in[1][i]; cact[i] = cv / (1.f + __expf(-cv)); }
        __syncthreads();
        const int item = blockIdx.x, l = item / 96, col0 = (item % 96) * 128, rsub = lane >> 5, c4 = lane & 31;
        const float* W = a.in[2] + (size_t)l * DM * 12288 + col0 + 4 * c4;
        f32x4 acc0 = {0.f, 0.f, 0.f, 0.f}, acc1 = {0.f, 0.f, 0.f, 0.f};
#pragma unroll 8
        for (int i = 0; i < 128; ++i) { const int k = wave * 256 + 2 * i + rsub; const f32x4 w = *(const f32x4*)(W + (size_t)k * 12288);
            acc0 += w * cact[k]; acc1 += w * cact[DM + k]; }
#pragma unroll
        for (int e = 0; e < 4; ++e) { acc0[e] += __shfl_xor(acc0[e], 32); acc1[e] += __shfl_xor(acc1[e], 32); }
        if (rsub == 0) {
#pragma unroll
            for (int e = 0; e < 4; ++e) { red[(wave * 2 + 0) * 128 + 4 * c4 + e] = acc0[e]; red[(wave * 2 + 1) * 128 + 4 * c4 + e] = acc1[e]; } }
        __syncthreads();
        if (tid < 256) { const int b = tid >> 7, col = tid & 127; float s = 0.f;
#pragma unroll
            for (int w8 = 0; w8 < 8; ++w8) s += red[(w8 * 2 + b) * 128 + col];
            s += a.in[3][l * 12288 + col0 + col];
            ((float*)(ws + WS_MOD))[(size_t)(l * 2 + b) * 12288 + col0 + col] = s; }
        __syncthreads();
    }
    LAS float* scr = (LAS float*)(lds + wave * 16384);
    const int gw = blockIdx.x * NWAVES + wave, NGW = gridDim.x * NWAVES;
    constexpr int I_WIN = 32 * 96, I_SQ = 32 * 64, I_QKV = 32 * 192, I_POOL = 4 * 32, I_AX = 16 * 8, I_WF = 16, I_KEYS = 128, I_TAB = 2 * NEXP, I_LS = 1;
    constexpr int NITEMS = I_WIN + 4 * I_SQ + I_QKV + I_POOL + I_AX + I_WF + I_KEYS + 2 * I_TAB + I_LS;
    for (int it = gw; it < NITEMS; it += NGW) {
        int r = it;
        if (r < 2 * I_TAB) { if (r < I_TAB) fp4_row_item<false>(a.in[8], ws + WS_TU, (float*)(ws + WS_SU), r, lane); else if constexpr (V_FP4) fp4_row_item<true>(a.in[9], ws + WS_TV, (float*)(ws + WS_SV), r - I_TAB, lane); else fp6_row_item(a.in[9], ws + WS_TV, (float*)(ws + WS_SV), r - I_TAB, lane); continue; } r -= 2 * I_TAB;
        if (r < I_WIN) { transpose_item_i8(a.in[10], NZ, 96, ws + WS_WIN, DM, scr, r, lane, W8_SCALE); continue; } r -= I_WIN;
        if (r < I_SQ) { transpose_item8(a.in[20], DM, 64, ws + WS_WOUT, DM, scr, r, lane, W8O_SCALE); continue; } r -= I_SQ;
        if (r < I_QKV) { transpose_item8(a.in[21], NODIN, 192, ws + WS_WQKV, DM, scr, r, lane); continue; } r -= I_QKV;
        if (r < I_SQ) { transpose_item8(a.in[23], DM, 64, ws + WS_WO, DM, scr, r, lane, W8O_SCALE); continue; } r -= I_SQ;
        if (r < I_SQ) { transpose_item_i8(a.in[6], DM, 64, ws + WS_WQ0, DM, scr, r, lane, W8_SCALE); continue; } r -= I_SQ;
        if (r < I_SQ) { transpose_item_i8(a.in[6] + (size_t)DM * DM, DM, 64, ws + WS_WQ1, DM, scr, r, lane, W8_SCALE); continue; } r -= I_SQ;
        if (r < I_POOL) { const int g = r >> 5; transpose_item(a.in[11] + g * 65536, 256, 8, (bf16*)(ws + WS_WPOOL) + g * 65536, 256, scr, r & 31, lane); continue; } r -= I_POOL;
        if (r < I_AX) { const int h = r >> 4, which = (r >> 3) & 1;
            transpose_item(a.in[which ? 17 : 15] + h * 16384, 128, 4, (bf16*)(ws + WS_WAX) + h * 32768 + which * 16384, 128, scr, r & 7, lane); continue; } r -= I_AX;
        if (r < I_WF) { bf16* WF = (bf16*)(ws + WS_WF);
            for (int k = lane; k < DM; k += 64) { const float v = a.in[21][(size_t)k * NODIN + NQKV + r]; WF[r * DM + k] = (bf16)(pk2(v, v) & 0xffffu); } continue; } r -= I_WF;
        if (r < I_KEYS) { convert_item(a.in[7], (bf16*)(ws + WS_KEYS), (size_t)r, lane); continue; } r -= I_KEYS;
        { float* LS8 = (float*)(ws + WS_LS8);
            for (int cch = lane; cch < 1024; cch += 64) { const float x = a.in[19][cch]; LS8[cch] = 8.f * (fminf(x, 0.f) - log1pf(__expf(-fabsf(x)))); } }
    }
}

__device__ __forceinline__ void ph_modulate(const float* src, const float* mod_l  , int sh_off, int sc_off, bf16* dst, unsigned char* dst8, float* rs, int lane, int wave) {
    const int gw = blockIdx.x * NWAVES + wave, NGW = gridDim.x * NWAVES;
    int cur_b = -1; f32x4 scv[8], shv[8];
    for (int t = gw; t < M; t += NGW) {
        const int b = t >> 13;
        if (b != cur_b) { cur_b = b; const float* mb = mod_l + b * 12288;
#pragma unroll
            for (int j = 0; j < 8; ++j) { scv[j] = *(const f32x4*)(mb + sc_off + 4 * lane + 256 * j) + 1.f; shv[j] = *(const f32x4*)(mb + sh_off + 4 * lane + 256 * j); } }
        const float* xr = src + (size_t)t * DM + 4 * lane; bf16* dr = dst + (size_t)t * DM + 4 * lane; f32x4 v[8]; float mx = 0.f;
#pragma unroll
        for (int j = 0; j < 8; ++j) { v[j] = *(const f32x4*)(xr + 256 * j) * scv[j] + shv[j]; uint2 o; o.x = pk2(v[j][0], v[j][1]); o.y = pk2(v[j][2], v[j][3]); *(uint2*)(dr + 256 * j) = o;
            mx = fmaxf(mx, fmaxf(fmaxf(fabsf(v[j][0]), fabsf(v[j][1])), fmaxf(fabsf(v[j][2]), fabsf(v[j][3])))); }
        mx = fmaxf(wave_max(mx), 1e-30f); const float inv = 127.f / mx; unsigned* q8 = (unsigned*)(dst8 + (size_t)t * DM) + lane;
#pragma unroll
        for (int j = 0; j < 8; ++j) q8[64 * j] = pk4_i8(v[j][0] * inv, v[j][1] * inv, v[j][2] * inv, v[j][3] * inv);
        if (lane == 0) rs[t] = mx * (1.f / 127.f);
    }
}

__device__ __forceinline__ void ld8(const bf16* p, float (&v)[8]) { const v4u u = *(const v4u*)p; v[0] = bf_lo(u.x); v[1] = bf_hi(u.x); v[2] = bf_lo(u.y); v[3] = bf_hi(u.y); v[4] = bf_lo(u.z); v[5] = bf_hi(u.z); v[6] = bf_lo(u.w); v[7] = bf_hi(u.w); }
__device__ __forceinline__ void st8(bf16* p, const float (&v)[8]) { v4u o; o.x = pk2(v[0], v[1]); o.y = pk2(v[2], v[3]); o.z = pk2(v[4], v[5]); o.w = pk2(v[6], v[7]); *(v4u*)p = o; }
__device__ __forceinline__ void ph_poolconv(const Args& a, int lane, int wave) {
    const bf16* Z = (const bf16*)(a.ws + WS_ZB); bf16* PO = (bf16*)(a.ws + WS_PO); bf16* XC = (bf16*)(a.ws + WS_XC);
    const int gw = blockIdx.x * NWAVES + wave, NGW = gridDim.x * NWAVES;
    for (int item = gw; item < 2048; item += NGW) {
        const int which = item & 3, t0 = (item >> 2) * 32, pos0 = t0 & (SEQ - 1);
        if (which < 2) {
            const int c = which * 512 + lane * 8, w = 2 << (c >> 8);
            float sum[8] = {0.f, 0.f, 0.f, 0.f, 0.f, 0.f, 0.f, 0.f};
            for (int s = 1; s < 16; ++s) if (s < w && pos0 - s >= 0) { float v[8]; ld8(Z + (size_t)(t0 - s) * NZ + c, v);
#pragma unroll
                for (int e = 0; e < 8; ++e) sum[e] += v[e]; }
            for (int i = 0; i < 32; ++i) { const int t = t0 + i, pos = pos0 + i; float cur[8], o[8]; ld8(Z + (size_t)t * NZ + c, cur);
                const float inv = 1.f / (float)(pos + 1 < w ? pos + 1 : w);
#pragma unroll
                for (int e = 0; e < 8; ++e) { sum[e] += cur[e]; o[e] = sum[e] * inv - cur[e]; }
                st8(PO + (size_t)t * 1024 + c, o);
                if (pos - w + 1 >= 0) { float old[8]; ld8(Z + (size_t)(t - w + 1) * NZ + c, old);
#pragma unroll
                    for (int e = 0; e < 8; ++e) sum[e] -= old[e]; } }
        } else {
            const int c = (which - 2) * 512 + lane * 8; const bf16* zc = Z + 1024 + c;
            float w0[8], w1[8], w2[8], w3[8], bb[8], x3[8], x2[8], x1[8];
#pragma unroll
            for (int e = 0; e < 8; ++e) { w0[e] = a.in[13][0 * 1024 + c + e]; w1[e] = a.in[13][1 * 1024 + c + e]; w2[e] = a.in[13][2 * 1024 + c + e]; w3[e] = a.in[13][3 * 1024 + c + e]; bb[e] = a.in[14][c + e]; x3[e] = 0.f; x2[e] = 0.f; x1[e] = 0.f; }
            if (pos0 >= 3) ld8(zc + (size_t)(t0 - 3) * NZ, x3);
            if (pos0 >= 2) ld8(zc + (size_t)(t0 - 2) * NZ, x2);
            if (pos0 >= 1) ld8(zc + (size_t)(t0 - 1) * NZ, x1);
            for (int i = 0; i < 32; ++i) { const int t = t0 + i; float x0[8], o[8]; ld8(zc + (size_t)t * NZ, x0);
#pragma unroll
                for (int e = 0; e < 8; ++e) { o[e] = bb[e] + w0[e] * x3[e] + w1[e] * x2[e] + w2[e] * x1[e] + w3[e] * x0[e]; x3[e] = x2[e]; x2[e] = x1[e]; x1[e] = x0[e]; }
                st8(XC + (size_t)t * 1024 + c, o); }
        }
    }
}

__device__ __forceinline__ void ph_scan_agg(const Args& a, int tid) {
    const unsigned* AD = (const unsigned*)(a.ws + WS_AF);
    float* AG = (float*)(a.ws + WS_AG); float* HG = (float*)(a.ws + WS_HG);
    for (int w = blockIdx.x; w < 256; w += gridDim.x) {
        const int st = w >> 1, c = (w & 1) * 512 + tid; const size_t base = (size_t)st * 128 * 1024 + c;
        float LA = 0.f, H = 0.f;
#pragma unroll 32
        for (int i = 0; i < 128; ++i) { const unsigned pw = AD[base + (size_t)i * 1024]; const float la = bf_lo(pw), dv = bf_hi(pw); H = __builtin_amdgcn_exp2f(la) * H + dv; LA += la; }
        AG[st * 1024 + c] = __builtin_amdgcn_exp2f(LA); HG[st * 1024 + c] = H;
    }
}
__device__ __forceinline__ void ph_scan_fin(const Args& a, int tid) {
    const unsigned* AD = (const unsigned*)(a.ws + WS_AF);
    const float* AG = (const float*)(a.ws + WS_AG); const float* HG = (const float*)(a.ws + WS_HG);
    const bf16* Z = (const bf16*)(a.ws + WS_ZB); unsigned char* YC8 = a.ws + WS_YC8;
    for (int w = blockIdx.x; w < 256; w += gridDim.x) {
        const int st = w >> 1, c = (w & 1) * 512 + tid, sin = st & 63, sb = st - sin; const size_t base = (size_t)st * 128 * 1024 + c;
        float h = 0.f;
#pragma unroll 32
        for (int s = 0; s < sin; ++s) h = AG[(sb + s) * 1024 + c] * h + HG[(sb + s) * 1024 + c];
#pragma unroll 16
        for (int i = 0; i < 128; ++i) { const size_t t = (size_t)st * 128 + i; const unsigned pw = AD[base + (size_t)i * 1024];
            h = __builtin_amdgcn_exp2f(bf_lo(pw)) * h + bf_hi(pw); const float gt = __uint_as_float((unsigned)Z[t * NZ + 2048 + c] << 16);
            YC8[t * DM + 1024 + c] = (unsigned char)(pk4_fp8(h * gelu_tanh(gt) * Y8_SCALE, 0.f, 0.f, 0.f) & 0xffu); }
    }
}

template <bool RES_MOD>
__device__ __forceinline__ void ph_ln(const bf16* Y, const float* Xin, const bf16* HBres, const float* mod_res, const float* mod_l, const float* lng, const float* lnb, bf16* H2, unsigned char* H28, float* SH, unsigned char* H6, float* HS, int lane, int wave) {
    const int gw = blockIdx.x * NWAVES + wave, NGW = gridDim.x * NWAVES;
    v4u yc[4]; f32x4 xc[8]; v4u rc[4];
    { const size_t ro = (size_t)gw * DM + 8 * lane;
#pragma unroll
      for (int j = 0; j < 4; ++j) { yc[j] = *(const v4u*)(Y + ro + 512 * j);
          if constexpr (RES_MOD) rc[j] = *(const v4u*)(HBres + ro + 512 * j); else { xc[2 * j] = *(const f32x4*)(Xin + ro + 512 * j); xc[2 * j + 1] = *(const f32x4*)(Xin + ro + 512 * j + 4); } } }
#pragma unroll 1
    for (int t = gw; t < M; t += NGW) {
        const int b = t >> 13; const float* mb = mod_l + b * 12288; const size_t ro = (size_t)t * DM + 8 * lane;
        int ln = lane; asm volatile("" : "+v"(ln));
        const int tn = t + NGW < M ? t + NGW : t; const size_t rn = (size_t)tn * DM + 8 * lane;
        v4u yn[4]; f32x4 xn[8]; v4u rn4[4];
#pragma unroll
        for (int j = 0; j < 4; ++j) { yn[j] = *(const v4u*)(Y + rn + 512 * j);
            if constexpr (RES_MOD) rn4[j] = *(const v4u*)(HBres + rn + 512 * j); else { xn[2 * j] = *(const f32x4*)(Xin + rn + 512 * j); xn[2 * j + 1] = *(const f32x4*)(Xin + rn + 512 * j + 4); } }
        float v[32];
#pragma unroll
        for (int j = 0; j < 4; ++j) { const v4u u = yc[j]; const float y8[8] = {bf_lo(u.x), bf_hi(u.x), bf_lo(u.y), bf_hi(u.y), bf_lo(u.z), bf_hi(u.z), bf_lo(u.w), bf_hi(u.w)};
            f32x4 xa, xb;
            if constexpr (RES_MOD) { const v4u r = rc[j]; const float* mr = mod_res + b * 12288 + 8 * ln + 512 * j;
                const f32x4 sa = *(const f32x4*)(mr + 2048), sb = *(const f32x4*)(mr + 2048 + 4), ha = *(const f32x4*)(mr), hb = *(const f32x4*)(mr + 4);
                const float r8[8] = {bf_lo(r.x), bf_hi(r.x), bf_lo(r.y), bf_hi(r.y), bf_lo(r.z), bf_hi(r.z), bf_lo(r.w), bf_hi(r.w)};
#pragma unroll
                for (int e = 0; e < 4; ++e) { xa[e] = (r8[e] - ha[e]) * __builtin_amdgcn_rcpf(1.f + sa[e]); xb[e] = (r8[4 + e] - hb[e]) * __builtin_amdgcn_rcpf(1.f + sb[e]); } }
            else { xa = xc[2 * j]; xb = xc[2 * j + 1]; }
            const f32x4 ga = *(const f32x4*)(mb + 4096 + 8 * ln + 512 * j), gb = *(const f32x4*)(mb + 4096 + 8 * ln + 512 * j + 4);
#pragma unroll
            for (int e = 0; e < 4; ++e) { v[8 * j + e] = ALPHA * xa[e] + (1.f + ga[e]) * y8[e]; v[8 * j + 4 + e] = ALPHA * xb[e] + (1.f + gb[e]) * y8[4 + e]; } }
        float s = 0.f;
#pragma unroll
        for (int e = 0; e < 32; ++e) s += v[e];
        const float mean = wave_sum(s) * (1.f / DM); float q = 0.f;
#pragma unroll
        for (int e = 0; e < 32; ++e) { v[e] -= mean; q += v[e] * v[e]; }
        const float rstd = rsqrtf(wave_sum(q) * (1.f / DM) + LN_EPS); float hmx = 0.f;
#pragma unroll
        for (int j = 0; j < 4; ++j) { const int co = 8 * ln + 512 * j;
            const f32x4 la = *(const f32x4*)(lng + co), lb = *(const f32x4*)(lng + co + 4), ba = *(const f32x4*)(lnb + co), bb = *(const f32x4*)(lnb + co + 4);
            const f32x4 sa = *(const f32x4*)(mb + 8192 + co), sb = *(const f32x4*)(mb + 8192 + co + 4), ha = *(const f32x4*)(mb + 6144 + co), hb = *(const f32x4*)(mb + 6144 + co + 4);
            float h8[8];
#pragma unroll
            for (int e = 0; e < 4; ++e) { const float na = v[8 * j + e] * rstd * la[e] + ba[e], nb = v[8 * j + 4 + e] * rstd * lb[e] + bb[e];
                h8[e] = na * (1.f + sa[e]) + ha[e]; h8[4 + e] = nb * (1.f + sb[e]) + hb[e]; }
            st8(H2 + ro + 512 * j, h8);
#pragma unroll
            for (int e = 0; e < 8; ++e) { v[8 * j + e] = h8[e]; hmx = fmaxf(hmx, fabsf(h8[e])); } }
        hmx = fmaxf(wave_max(hmx), 1e-30f); const float inv = 127.f / hmx;
#pragma unroll
        for (int j = 0; j < 4; ++j) *(v2u*)(H28 + ro + 512 * j) = (v2u){pk4_i8(v[8 * j] * inv, v[8 * j + 1] * inv, v[8 * j + 2] * inv, v[8 * j + 3] * inv), pk4_i8(v[8 * j + 4] * inv, v[8 * j + 5] * inv, v[8 * j + 6] * inv, v[8 * j + 7] * inv)};
        if (lane == 0) SH[t] = hmx * (1.f / 127.f);
        { const float inv6 = 7.5f / hmx; f32x16_t pa, pb;
#pragma unroll
          for (int i = 0; i < 16; ++i) { pa[i] = v[2 * i] * inv6; pb[i] = v[2 * i + 1] * inv6; }
          const u32x6_t pk = __builtin_amdgcn_cvt_scalef32_2xpk16_fp6_f32(pa, pb, 1.0f); unsigned char* hq = H6 + (size_t)t * 1536;
          *(v4u*)(hq + 16 * lane) = (v4u){pk[0], pk[1], pk[2], pk[3]}; *(v2u*)(hq + 1024 + 8 * lane) = (v2u){pk[4], pk[5]};
          if (lane == 0) HS[t] = hmx * (1.f / 7.5f); }
#pragma unroll
        for (int j = 0; j < 4; ++j) { yc[j] = yn[j]; if constexpr (RES_MOD) rc[j] = rn4[j]; else { xc[2 * j] = xn[2 * j]; xc[2 * j + 1] = xn[2 * j + 1]; } }
    }
}

__device__ __forceinline__ unsigned mono(float f) { const unsigned u = __float_as_uint(f); return (u & 0x80000000u) ? ~u : (u | 0x80000000u); }
__device__ __forceinline__ float unmono(unsigned u) { return __uint_as_float((u & 0x80000000u) ? (u & 0x7fffffffu) : ~u); }
__device__ __forceinline__ unsigned umax_(unsigned a, unsigned b) { return a > b ? a : b; }
__device__ __forceinline__ unsigned umin_(unsigned a, unsigned b) { return a < b ? a : b; }
template <bool DESC> __device__ __forceinline__ void bsort16(unsigned (&k)[16]) {
#pragma unroll
    for (int size = 2; size <= 16; size <<= 1)
#pragma unroll
        for (int stride = size >> 1; stride > 0; stride >>= 1)
#pragma unroll
            for (int i = 0; i < 16; ++i) { const int j = i ^ stride;
                if (j > i) { const bool first_max = (((i & size) == 0) == DESC); const unsigned hi = umax_(k[i], k[j]), lo = umin_(k[i], k[j]); k[i] = first_max ? hi : lo; k[j] = first_max ? lo : hi; } }
}
template <bool DESC> __device__ __forceinline__ void bmerge16(unsigned (&k)[16]) {
#pragma unroll
    for (int stride = 8; stride > 0; stride >>= 1)
#pragma unroll
        for (int i = 0; i < 16; ++i) { const int j = i ^ stride;
            if (j > i) { const unsigned hi = umax_(k[i], k[j]), lo = umin_(k[i], k[j]); k[i] = DESC ? hi : lo; k[j] = DESC ? lo : hi; } }
}
__device__ __forceinline__ void top16_of_64(const unsigned (&k)[64], unsigned (&o)[16]) {
    unsigned g0[16], g1[16], g2[16], g3[16];
#pragma unroll
    for (int i = 0; i < 16; ++i) { g0[i] = k[i]; g1[i] = k[16 + i]; g2[i] = k[32 + i]; g3[i] = k[48 + i]; }
    bsort16<true>(g0); bsort16<false>(g1); bsort16<true>(g2); bsort16<false>(g3);
#pragma unroll
    for (int i = 0; i < 16; ++i) { g0[i] = umax_(g0[i], g1[i]); g2[i] = umax_(g2[i], g3[i]); }
    bmerge16<true>(g0); bmerge16<false>(g2);
#pragma unroll
    for (int i = 0; i < 16; ++i) o[i] = umax_(g0[i], g2[i]);
    bmerge16<true>(o);
}
__device__ __forceinline__ int swz16(int row, int cb) { return cb ^ ((row & 15) << 4); }
__device__ __forceinline__ void ph_topk(const Args& a, int layer, LAS unsigned char* lds, int tid, int lane, int wave) {
    const bf16* QP = (const bf16*)(a.ws + WS_QP); const bf16* KEYS = (const bf16*)(a.ws + WS_KEYS) + (size_t)layer * 8 * 2 * 128 * 128;
    int* EI = (int*)(a.ws + WS_EI); float* GT = (float*)(a.ws + WS_GT); const float* SVl = (const float*)(a.ws + WS_SV) + layer * NEXP;
    LAS unsigned char* kt = lds;
    LAS unsigned* lists = (LAS unsigned*)(lds + 65536 + wave * 4096);
    const int r32 = lane & 31, hi = lane >> 5, h = blockIdx.x & 7, wgr = blockIdx.x >> 3, nwgh = gridDim.x >> 3;
    { const bf16* kh = KEYS + (size_t)h * 2 * 128 * 128;
#pragma unroll
      for (int i = 0; i < 8; ++i) { const int ch = tid + i * NTHREADS, row = ch >> 4, cb = (ch & 15) * 16;
          *(LAS v4u*)(kt + row * 256 + swz16(row, cb)) = *(const v4u*)(kh + (size_t)row * 128 + (cb >> 1)); } }
    __syncthreads();
    if (wgr < nwgh) {
#pragma unroll 1
    for (int u = wgr * NWAVES + wave; u < M / 32; u += nwgh * NWAVES) {
        const int t0 = u * 32; const bf16* qrow = QP + (size_t)(t0 + r32) * DM + h * 256 + 8 * hi;
        unsigned LL[2][16];
#pragma unroll
        for (int p = 0; p < 2; ++p) {
            bf16x8 bq[8];
#pragma unroll
            for (int sI = 0; sI < 8; ++sI) bq[sI] = *(const bf16x8*)(qrow + p * 128 + 16 * sI);
            f32x16 acc[4];
#pragma unroll
            for (int blk = 0; blk < 4; ++blk)
#pragma unroll
                for (int e = 0; e < 16; ++e) acc[blk][e] = 0.f;
#pragma unroll
            for (int sI = 0; sI < 8; ++sI)
#pragma unroll
                for (int blk = 0; blk < 4; ++blk) { const int krow = p * 128 + blk * 32 + r32;
                    const bf16x8 ak = *(const LAS bf16x8*)(kt + krow * 256 + swz16(krow, (16 * sI + 8 * hi) * 2));
                    acc[blk] = __builtin_amdgcn_mfma_f32_32x32x16_bf16(ak, bq[sI], acc[blk], 0, 0, 0); }
            unsigned kk[64], o[16];
#pragma unroll
            for (int blk = 0; blk < 4; ++blk)
#pragma unroll
                for (int e = 0; e < 16; ++e) { const int n = 32 * blk + (e & 3) + 8 * (e >> 2) + 4 * hi; kk[blk * 16 + e] = (mono(acc[blk][e]) & ~127u) | (unsigned)(127 - n); }
            top16_of_64(kk, o);
#pragma unroll
            for (int i = 0; i < 16; ++i) LL[p][i] = umax_(o[i], (unsigned)__shfl_xor((int)o[15 - i], 32));
            bmerge16<true>(LL[p]);
            if (hi == 0) { LAS v4u* lp = (LAS v4u*)(lists + (p * 32 + r32) * 16);
#pragma unroll
                for (int i = 0; i < 4; ++i) lp[i] = (v4u){LL[p][4 * i], LL[p][4 * i + 1], LL[p][4 * i + 2], LL[p][4 * i + 3]}; }
        }
        unsigned tk[16];
        { float f1[16], f2[16];
#pragma unroll
          for (int i = 0; i < 16; ++i) { f1[i] = unmono(LL[0][i] & ~127u); f2[i] = unmono(LL[1][i] & ~127u); }
          unsigned cd[32];
          {
            cd[0] = hi ? ((mono(f1[2] + f2[1]) & ~255u) | 222u) : ((mono(f1[0] + f2[0]) & ~255u) | 255u);
            cd[1] = hi ? ((mono(f1[2] + f2[2]) & ~255u) | 221u) : ((mono(f1[0] + f2[1]) & ~255u) | 254u);
            cd[2] = hi ? ((mono(f1[2] + f2[3]) & ~255u) | 220u) : ((mono(f1[0] + f2[2]) & ~255u) | 253u);
            cd[3] = hi ? ((mono(f1[2] + f2[4]) & ~255u) | 219u) : ((mono(f1[0] + f2[3]) & ~255u) | 252u);
            cd[4] = hi ? ((mono(f1[3] + f2[0]) & ~255u) | 207u) : ((mono(f1[0] + f2[4]) & ~255u) | 251u);
            cd[5] = hi ? ((mono(f1[3] + f2[1]) & ~255u) | 206u) : ((mono(f1[0] + f2[5]) & ~255u) | 250u);
            cd[6] = hi ? ((mono(f1[3] + f2[2]) & ~255u) | 205u) : ((mono(f1[0] + f2[6]) & ~255u) | 249u);
            cd[7] = hi ? ((mono(f1[3] + f2[3]) & ~255u) | 204u) : ((mono(f1[0] + f2[7]) & ~255u) | 248u);
            cd[8] = hi ? ((mono(f1[4] + f2[0]) & ~255u) | 191u) : ((mono(f1[0] + f2[8]) & ~255u) | 247u);
            cd[9] = hi ? ((mono(f1[4] + f2[1]) & ~255u) | 190u) : ((mono(f1[0] + f2[9]) & ~255u) | 246u);
            cd[10] = hi ? ((mono(f1[4] + f2[2]) & ~255u) | 189u) : ((mono(f1[0] + f2[10]) & ~255u) | 245u);
            cd[11] = hi ? ((mono(f1[5] + f2[0]) & ~255u) | 175u) : ((mono(f1[0] + f2[11]) & ~255u) | 244u);
            cd[12] = hi ? ((mono(f1[5] + f2[1]) & ~255u) | 174u) : ((mono(f1[0] + f2[12]) & ~255u) | 243u);
            cd[13] = hi ? ((mono(f1[6] + f2[0]) & ~255u) | 159u) : ((mono(f1[0] + f2[13]) & ~255u) | 242u);
            cd[14] = hi ? ((mono(f1[6] + f2[1]) & ~255u) | 158u) : ((mono(f1[0] + f2[14]) & ~255u) | 241u);
            cd[15] = hi ? ((mono(f1[7] + f2[0]) & ~255u) | 143u) : ((mono(f1[0] + f2[15]) & ~255u) | 240u);
            cd[16] = hi ? ((mono(f1[7] + f2[1]) & ~255u) | 142u) : ((mono(f1[1] + f2[0]) & ~255u) | 239u);
            cd[17] = hi ? ((mono(f1[8] + f2[0]) & ~255u) | 127u) : ((mono(f1[1] + f2[1]) & ~255u) | 238u);
            cd[18] = hi ? ((mono(f1[9] + f2[0]) & ~255u) | 111u) : ((mono(f1[1] + f2[2]) & ~255u) | 237u);
            cd[19] = hi ? ((mono(f1[10] + f2[0]) & ~255u) | 95u) : ((mono(f1[1] + f2[3]) & ~255u) | 236u);
            cd[20] = hi ? ((mono(f1[11] + f2[0]) & ~255u) | 79u) : ((mono(f1[1] + f2[4]) & ~255u) | 235u);
            cd[21] = hi ? ((mono(f1[12] + f2[0]) & ~255u) | 63u) : ((mono(f1[1] + f2[5]) & ~255u) | 234u);
            cd[22] = hi ? ((mono(f1[13] + f2[0]) & ~255u) | 47u) : ((mono(f1[1] + f2[6]) & ~255u) | 233u);
            cd[23] = hi ? ((mono(f1[14] + f2[0]) & ~255u) | 31u) : ((mono(f1[1] + f2[7]) & ~255u) | 232u);
            cd[24] = hi ? ((mono(f1[15] + f2[0]) & ~255u) | 15u) : ((mono(f1[2] + f2[0]) & ~255u) | 223u);
            cd[25] = 0u;
            cd[26] = 0u;
            cd[27] = 0u;
            cd[28] = 0u;
            cd[29] = 0u;
            cd[30] = 0u;
            cd[31] = 0u;
          }
          unsigned g0[16], g1[16];
#pragma unroll
          for (int i = 0; i < 16; ++i) { g0[i] = cd[i]; g1[i] = cd[16 + i]; }
          bsort16<true>(g0); bsort16<false>(g1);
#pragma unroll
          for (int i = 0; i < 16; ++i) g0[i] = umax_(g0[i], g1[i]);
          bmerge16<true>(g0);
#pragma unroll
          for (int i = 0; i < 16; ++i) tk[i] = umax_(g0[i], (unsigned)__shfl_xor((int)g0[15 - i], 32));
          bmerge16<true>(tk); }
        float ev[16]; const float m0 = unmono(tk[0] & ~255u); float den = 0.f;
#pragma unroll
        for (int k = 0; k < 16; ++k) { ev[k] = __expf(unmono(tk[k] & ~255u) - m0); den += ev[k]; }
        const float rden = 1.f / den;
        const LAS unsigned* L1 = lists + r32 * 16; const LAS unsigned* L2 = lists + (32 + r32) * 16;
        int ei[16];
#pragma unroll
        for (int k = 0; k < 16; ++k) { const int id = 255 - (int)(tk[k] & 255u), i = id >> 4, j = id & 15;
            const int n1 = 127 - (int)(L1[i] & 127u), n2 = 127 - (int)(L2[j] & 127u); ei[k] = n1 * 128 + n2; }
        if (hi == 0) { int* ep = EI + (size_t)(t0 + r32) * 128 + h * 16;
#pragma unroll
            for (int k = 0; k < 4; ++k) *(int4*)(ep + 4 * k) = make_int4(ei[4 * k], ei[4 * k + 1], ei[4 * k + 2], ei[4 * k + 3]); }
        else { float* gp = GT + (size_t)(t0 + r32) * 128 + h * 16; float gg[16];
#pragma unroll
            for (int k = 0; k < 16; ++k) gg[k] = ev[k] * rden * SVl[ei[k]];
#pragma unroll
            for (int k = 0; k < 4; ++k) *(f32x4*)(gp + 4 * k) = (f32x4){gg[4 * k], gg[4 * k + 1], gg[4 * k + 2], gg[4 * k + 3]}; }
    } }
    __syncthreads();
}

typedef int i32x8_t __attribute__((ext_vector_type(8)));
__device__ __forceinline__ void peer_slice(const Args& a, volatile LAS unsigned* st, int& x, int& rank, int& nrank) {
    (void)a; nrank = (int)(gridDim.x >> 3); const bool uni = st[4] != 0u;
    if (uni) { x = (int)st[3]; rank = (int)st[2]; } else { x = (int)(blockIdx.x & 7u); rank = (int)(blockIdx.x >> 3); }
    x = __builtin_amdgcn_readfirstlane(x); rank = __builtin_amdgcn_readfirstlane(rank);
}
__device__ __forceinline__ void ph_peer_u(const Args& a, int layer, volatile LAS unsigned* st, LAS unsigned char* lds, int lane, int wave) {
    int x, rank, nrank; peer_slice(a, st, x, rank, nrank); const int m16 = lane & 15, kc = lane >> 4, r8 = lane >> 3, sg = lane & 7;
    const unsigned char* TUb = a.ws + WS_TU + (size_t)layer * NEXP * ROW4 + (size_t)x * NEXP * 128;
    const unsigned char* H6 = a.ws + WS_H6 + 16 * (8 * x + kc); const int* EI = (const int*)(a.ws + WS_EI) + lane; bf16* PART = (bf16*)(a.ws + WS_PART) + x * 128 + 32 * kc;
    if (rank >= nrank) return;
    const int t0 = rank * NWAVES + wave, ts = nrank * NWAVES, nt = (M - t0 + ts - 1) / ts;
    LAS unsigned char* ub = lds + wave * 2304; LAS unsigned char* ubw = ub + r8 * 144 + 16 * sg; const LAS unsigned char* ubr = ub + m16 * 144 + 16 * kc;
    v4u U[8][2]; v4u ha[2], han[2]; v2u hb[2], hbn[2]; int en0 = 0, en1 = 0;
#pragma unroll
    for (int g = 0; g < 8; ++g) { U[g][0] = (v4u){0u, 0u, 0u, 0u}; U[g][1] = U[g][0]; }
    ha[0] = ha[1] = (v4u){0u, 0u, 0u, 0u}; hb[0] = hb[1] = (v2u){0u, 0u};
    en0 = EI[(size_t)t0 * 128]; en1 = EI[(size_t)t0 * 128 + 64];
#pragma unroll 1
    for (int k = -1; k < nt; ++k) {
        const int k2 = k + 2 < nt ? k + 2 : nt - 1, k1 = k + 1 < nt ? (k + 1 < 0 ? 0 : k + 1) : nt - 1;
        const size_t tn2 = (size_t)(t0 + ts * k2), tn1 = (size_t)(t0 + ts * k1);
        const int enn0 = EI[tn2 * 128], enn1 = EI[tn2 * 128 + 64];
        { const unsigned char* hp = H6 + tn1 * 1536;
#pragma unroll
          for (int i = 0; i < 2; ++i) { han[i] = *(const v4u*)(hp + 64 * i); hbn[i] = *(const v2u*)(hp + 1024 - 8 * (8 * x + kc) + 32 * i); } }
        bf16* pp = PART + (size_t)(t0 + ts * (k < 0 ? 0 : k)) * 1024; unsigned pv0 = 0u, pv1 = 0u;
#pragma unroll
        for (int g = 0; g < 8; ++g) {
            { f32x4 acc = {0.f, 0.f, 0.f, 0.f};
                if (k >= 0) {
                    *(LAS v4u*)ubw = U[g][0]; *(LAS v4u*)(ubw + 8 * 144) = U[g][1];
#pragma unroll
                    for (int i = 0; i < 2; ++i) { const v4u uu = *(const LAS v4u*)(ubr + 64 * i); const i32x8_t A8 = {(int)uu.x, (int)uu.y, (int)uu.z, (int)uu.w, 0, 0, 0, 0};
                        const i32x8_t B8 = {(int)ha[i].x, (int)ha[i].y, (int)ha[i].z, (int)ha[i].w, (int)hb[i].x, (int)hb[i].y, 0, 0};
                        acc = __builtin_amdgcn_mfma_scale_f32_16x16x128_f8f6f4(A8, B8, acc, 4, 2, 0, 127, 0, 127); } }
                if ((g & 1) == 0) { pv0 = pk2c(acc[0], acc[1]); pv1 = pk2c(acc[2], acc[3]); }
                else if (m16 == 0) *(v4u*)(pp + 4 * (g - 1)) = (v4u){pv0, pv1, pk2c(acc[0], acc[1]), pk2c(acc[2], acc[3])}; }
#pragma unroll
            for (int j = 0; j < 2; ++j) { const int em = __shfl(g < 4 ? en0 : en1, (g & 3) * 16 + 8 * j + r8); U[g][j] = *(const v4u*)(TUb + (unsigned)(em * 128 + 16 * sg)); }
            __builtin_amdgcn_sched_barrier(0);
        }
#pragma unroll
        for (int i = 0; i < 2; ++i) { ha[i] = han[i]; hb[i] = hbn[i]; }
        en0 = enn0; en1 = enn1;
    }
}
__device__ __forceinline__ void ph_peer_coef(const Args& a, int layer, LAS unsigned char* lds, int lane, int wave) {
    const int p0 = 16 * ((lane >> 1) & 7) + 4 * (lane >> 4) + 2 * (lane & 1);
    const int* EI = (const int*)(a.ws + WS_EI) + p0; const float* GT = (const float*)(a.ws + WS_GT) + p0; const unsigned* PART = (const unsigned*)(a.ws + WS_PART) + lane;
    const float* SU = (const float*)(a.ws + WS_SU) + layer * NEXP; const float* HS = (const float*)(a.ws + WS_HS);
    unsigned char* AR = a.ws + WS_AR; int* EQ = (int*)(a.ws + WS_EQ) + (p0 & 7) * 16 + (p0 >> 3);
    LAS float* CFL = (LAS float*)(lds + wave * 1024);
    const int gw = blockIdx.x * NWAVES + wave, NGW = gridDim.x * NWAVES;
#pragma unroll 1
    for (int t = gw; t < M; t += NGW) {
        const size_t tt = (size_t)t; const int2 ee = *(const int2*)(EI + tt * 128); const float2 gg = *(const float2*)(GT + tt * 128); const float hs = HS[t];
        unsigned P[8];
#pragma unroll
        for (int xx = 0; xx < 8; ++xx) P[xx] = PART[(tt * 8 + xx) * 64];
        const float s0 = SU[ee.x], s1 = SU[ee.y];
        const float d0 = ((bf_lo(P[0]) + bf_lo(P[1])) + (bf_lo(P[2]) + bf_lo(P[3]))) + ((bf_lo(P[4]) + bf_lo(P[5])) + (bf_lo(P[6]) + bf_lo(P[7])));
        const float d1 = ((bf_hi(P[0]) + bf_hi(P[1])) + (bf_hi(P[2]) + bf_hi(P[3]))) + ((bf_hi(P[4]) + bf_hi(P[5])) + (bf_hi(P[6]) + bf_hi(P[7])));
        const float c0 = gelu_tanh(d0 * hs * s0) * gg.x, c1 = gelu_tanh(d1 * hs * s1) * gg.y;
        EQ[tt * 128] = ee.x * 128; EQ[tt * 128 + 16] = ee.y * 128;
        const float cmx = fmaxf(wave_max(fmaxf(fabsf(c0), fabsf(c1))), 1e-30f), csc = 7.5f / cmx;
        CFL[p0] = c0 * csc; CFL[p0 + 1] = c1 * csc;
        f32x16_t pa, pb;
#pragma unroll
        for (int i = 0; i < 8; ++i) { const f32x4 c4 = *(const LAS f32x4*)(CFL + 32 * (lane & 3) + 4 * i); pa[2 * i] = c4[0]; pb[2 * i] = c4[1]; pa[2 * i + 1] = c4[2]; pb[2 * i + 1] = c4[3]; }
        const u32x6_t ph = __builtin_amdgcn_cvt_scalef32_2xpk16_fp6_f32(pa, pb, 1.0f);
        if (lane < 4) { unsigned char* rp = AR + tt * 128 + 32 * lane; *(v4u*)rp = (v4u){ph[0], ph[1], ph[2], ph[3]}; *(v4u*)(rp + 16) = (v4u){ph[4], ph[5], __float_as_uint(cmx * (1.f / 7.5f)), 0u}; }
    }
}
__device__ __forceinline__ void ph_peer_v(const Args& a, int layer, volatile LAS unsigned* st, LAS unsigned char* lds, int lane, int wave) {
    int x, rank, nrank; peer_slice(a, st, x, rank, nrank); const int q = lane >> 3, sg = lane & 7, n16 = lane & 15, kc = lane >> 4;
    const unsigned char* TVb = a.ws + WS_TV + (size_t)layer * NEXP * ROWV + (size_t)x * NEXP * 128;
    const int* EQ = (const int*)(a.ws + WS_EQ) + q * 16; const unsigned char* AR = a.ws + WS_AR + 32 * kc;
    if (rank >= nrank) return;
    const int t0 = rank * NWAVES + wave, ts = nrank * NWAVES, nt = (M - t0 + ts - 1) / ts;
    constexpr int VS = 144;
    LAS unsigned char* img = lds + wave * (128 * VS);
    LAS unsigned char* iw = img + q * VS + 16 * sg;
    const LAS unsigned char* ir = img + (32 * kc + n16) * VS;
    typedef int v2i_ __attribute__((ext_vector_type(2)));
    int inv16, ncol; bool tr_ok;
    { *(LAS v2u*)(ir) = (v2u){0x11111111u * (unsigned)n16, 0x11111111u * (unsigned)n16};
      const v2i_ ra = __builtin_amdgcn_ds_read_tr4_b64_v2i32((LAS v2i_*)ir);
      *(LAS v2u*)(ir) = (v2u){0x76543210u, 0xfedcba98u};
      const v2i_ rb = __builtin_amdgcn_ds_read_tr4_b64_v2i32((LAS v2i_*)ir);
      const unsigned r0 = (unsigned)__builtin_amdgcn_readfirstlane(ra.x), r1 = (unsigned)__builtin_amdgcn_readfirstlane(ra.y);
      ncol = rb.x & 15; inv16 = 0; unsigned seen = 0u;
#pragma unroll
      for (int e = 0; e < 16; ++e) { const int rr = (int)(((e < 8 ? r0 : r1) >> (4 * (e & 7))) & 15u); if (rr == n16) inv16 = e; seen |= 1u << rr; }
      bool ok = (unsigned)ra.x == r0 && (unsigned)ra.y == r1 && (unsigned)rb.x == 0x11111111u * (unsigned)ncol && (unsigned)rb.y == 0x11111111u * (unsigned)ncol && seen == 0xffffu;
      unsigned cols = 0u;
#pragma unroll
      for (int i = 0; i < 16; ++i) cols |= 1u << (__shfl(ncol, i) & 15);
      ok = ok && cols == 0xffffu;
      ok = ok && r0 == 0x76543210u && r1 == 0xfedcba98u && ncol == n16;
      tr_ok = __all(ok); }
    unsigned char* Y4 = a.ws + WS_Y + 256 * x + 4 * lane;
    (void)inv16;
    v4u W[16];
#pragma unroll
    for (int i = 0; i < 16; ++i) W[i] = (v4u){0u, 0u, 0u, 0u};
    v4u epn[4], ar0 = {0u, 0u, 0u, 0u}, ar1 = ar0;
#pragma unroll
    for (int j = 0; j < 4; ++j) epn[j] = (v4u){0u, 0u, 0u, 0u};
#pragma unroll
    for (int j = 0; j < 4; ++j) epn[j] = *(const v4u*)(EQ + (size_t)t0 * 128 + 4 * j);
#pragma unroll 1
    for (int k = -1; k < nt; ++k) {
        const int k2 = k + 2 < nt ? k + 2 : nt - 1, k1 = k + 1 < nt ? (k + 1 < 0 ? 0 : k + 1) : nt - 1; const size_t tn2 = (size_t)(t0 + ts * k2), tn1 = (size_t)(t0 + ts * k1);
        v4u epnn[4];
#pragma unroll
        for (int j = 0; j < 4; ++j) epnn[j] = *(const v4u*)(EQ + tn2 * 128 + 4 * j);
        const v4u arn0 = *(const v4u*)(AR + tn1 * 128), arn1 = *(const v4u*)(AR + tn1 * 128 + 16);
        int ep[16];
#pragma unroll
        for (int j = 0; j < 4; ++j) { ep[4 * j] = (int)epn[j].x; ep[4 * j + 1] = (int)epn[j].y; ep[4 * j + 2] = (int)epn[j].z; ep[4 * j + 3] = (int)epn[j].w; }
        __builtin_amdgcn_sched_barrier(0);
#pragma unroll
        for (int i = 0; i < 16; ++i) {
            *(LAS v4u*)(iw + 8 * i * VS) = W[i];
            W[i] = *(const v4u*)(TVb + (unsigned)(ep[i] + 16 * sg));
            __builtin_amdgcn_sched_barrier(0);
        }
        float yv[16];
#pragma unroll
        for (int j = 0; j < 16; ++j) yv[j] = 0.f;
        if (k >= 0) {
            i32x8_t A8 = {(int)ar0.x, (int)ar0.y, (int)ar0.z, (int)ar0.w, (int)ar1.x, (int)ar1.y, 0, 0};
            if (n16 != 0) A8 = (i32x8_t){0, 0, 0, 0, 0, 0, 0, 0};
            const float ysc = __uint_as_float(ar1.z);
#pragma unroll
            for (int j = 0; j < 16; ++j) {
                const v2i_ b0 = __builtin_amdgcn_ds_read_tr4_b64_v2i32((LAS v2i_*)(ir + 8 * j)), b1 = __builtin_amdgcn_ds_read_tr4_b64_v2i32((LAS v2i_*)(ir + 16 * VS + 8 * j));
                const i32x8_t B8 = {b0.x, b0.y, b1.x, b1.y, 0, 0, 0, 0};
                const f32x4 acc = __builtin_amdgcn_mfma_scale_f32_16x16x128_f8f6f4(A8, B8, (f32x4){0.f, 0.f, 0.f, 0.f}, 2, 4, 0, 127, 0, 127);
                yv[j] = acc[0] * ysc; }
        }
        if (!tr_ok) { _Pragma("unroll") for (int j = 0; j < 16; ++j) yv[j] = __builtin_nanf(""); }
        { LAS float* yl = (LAS float*)img;
          if (kc == 0) {
#pragma unroll
              for (int j = 0; j < 16; ++j) yl[16 * j + ncol] = yv[j]; }
          const f32x4 y4 = *(const LAS f32x4*)(yl + 4 * lane);
          *(unsigned*)(Y4 + (size_t)(t0 + ts * (k < 0 ? 0 : k)) * DM) = pk4_fp8(y4[0] * YP_SCALE, y4[1] * YP_SCALE, y4[2] * YP_SCALE, y4[3] * YP_SCALE); }
        ar0 = arn0; ar1 = arn1;
#pragma unroll
        for (int j = 0; j < 4; ++j) epn[j] = epnn[j];
    }
}
template <bool FINAL>
__device__ __forceinline__ void ph_peer_ln(const Args& a, const float* mod_l, const float* mod_next, const float* lng, const float* lnb, LAS unsigned char* lds, int lane, int wave) {
    const bf16* H2 = (const bf16*)(a.ws + WS_H2); bf16* HB = (bf16*)(a.ws + WS_HB); const unsigned char* Y = a.ws + WS_Y;
    const int gw = blockIdx.x * NWAVES + wave, NGW = gridDim.x * NWAVES;
    { LAS float* lp = (LAS float*)lds; const int t_ = wave * 64 + lane;
#pragma unroll 1
      for (int i = t_; i < 12 * 512; i += NTHREADS) { const int v = i >> 9, c4 = (i & 511) * 4; const float* src;
          if (v < 6) src = mod_l + (v & 1) * 12288 + (v < 2 ? 10240 : (v < 4 ? 8192 : 6144));
          else if (v < 10) src = mod_next + (v & 1) * 12288 + (v < 8 ? 2048 : 0);
          else src = v == 10 ? lng : lnb;
          *(LAS f32x4*)(lp + v * 2048 + c4) = *(const f32x4*)(src + c4); }
      __syncthreads(); }
#pragma unroll 1
    for (int t = gw; t < M; t += NGW) {
        const int b = t >> 13;
        float out[32];
        { unsigned lo0 = (unsigned)lane * 4u; asm volatile("" : "+v"(lo0)); const unsigned char* yrow = Y + (size_t)t * DM;
#pragma unroll
          for (int j = 0; j < 8; ++j) { const unsigned yw = *(const unsigned*)(yrow + lo0 + 256 * j); const auto ya = __builtin_amdgcn_cvt_pk_f32_fp8((int)yw, false), yb = __builtin_amdgcn_cvt_pk_f32_fp8((int)yw, true);
              out[4 * j] = ya[0] * (1.f / YP_SCALE); out[4 * j + 1] = ya[1] * (1.f / YP_SCALE); out[4 * j + 2] = yb[0] * (1.f / YP_SCALE); out[4 * j + 3] = yb[1] * (1.f / YP_SCALE); } }
        unsigned lo = (unsigned)lane * 16u; asm volatile("" : "+v"(lo));
        const LAS char* lpb = (const LAS char*)lds + b * 8192; const char* h2row = (const char*)(H2 + (size_t)t * DM);
#define LD4_(vec, j_) (*(const LAS f32x4*)(lpb + (vec) * 16384 + lo + 1024 * (j_)))
#pragma unroll
        for (int j = 0; j < 8; ++j) { const v2u hw = *(const v2u*)(h2row + (lo >> 1) + 512 * j); const float h4[4] = {bf_lo(hw.x), bf_hi(hw.x), bf_lo(hw.y), bf_hi(hw.y)};
            const f32x4 ga = LD4_(0, j), sf = LD4_(1, j), hf = LD4_(2, j);
#pragma unroll
            for (int e = 0; e < 4; ++e) { const float x1 = (h4[e] - hf[e]) * __builtin_amdgcn_rcpf(1.f + sf[e]); out[4 * j + e] = ALPHA * x1 + (1.f + ga[e]) * out[4 * j + e]; } }
        float s = 0.f;
#pragma unroll
        for (int e = 0; e < 32; ++e) s += out[e];
        const float mean = wave_sum(s) * (1.f / DM); float q2 = 0.f;
#pragma unroll
        for (int e = 0; e < 32; ++e) { out[e] -= mean; q2 += out[e] * out[e]; }
        const float rstd = rsqrtf(wave_sum(q2) * (1.f / DM) + LN_EPS);
        char* orow = (char*)(a.out + (size_t)t * DM); char* hrow = (char*)(HB + (size_t)t * DM);
        float hmx = 0.f; (void)hmx;
#pragma unroll
        for (int j = 0; j < 8; ++j) { const f32x4 la = *(const LAS f32x4*)((const LAS char*)lds + 10 * 8192 + lo + 1024 * j), ba = *(const LAS f32x4*)((const LAS char*)lds + 11 * 8192 + lo + 1024 * j); f32x4 na;
#pragma unroll
            for (int e = 0; e < 4; ++e) na[e] = out[4 * j + e] * rstd * la[e] + ba[e];
            if constexpr (FINAL) *(f32x4*)(orow + lo + 1024 * j) = na;
            else { const f32x4 sa = LD4_(3, j), ha = LD4_(4, j);
#pragma unroll
                for (int e = 0; e < 4; ++e) { const float hn = na[e] * (1.f + sa[e]) + ha[e]; out[4 * j + e] = hn; hmx = fmaxf(hmx, fabsf(hn)); }
                *(v2u*)(hrow + (lo >> 1) + 512 * j) = (v2u){pk2(out[4 * j], out[4 * j + 1]), pk2(out[4 * j + 2], out[4 * j + 3])}; } }
        if constexpr (!FINAL) {
            hmx = fmaxf(wave_max(hmx), 1e-30f); const float inv8 = 240.f / hmx; unsigned char* h8row = a.ws + WS_HB8 + (size_t)t * DM;
#pragma unroll
            for (int j = 0; j < 8; ++j) { unsigned w = 0u; w = __builtin_amdgcn_cvt_pk_fp8_f32(out[4 * j] * inv8, out[4 * j + 1] * inv8, w, false); w = __builtin_amdgcn_cvt_pk_fp8_f32(out[4 * j + 2] * inv8, out[4 * j + 3] * inv8, w, true);
                *(unsigned*)(h8row + (lo >> 2) + 256 * j) = w; }
            if (lane == 0) ((float*)(a.ws + WS_SA))[t] = hmx * (1.f / 240.f); }
#undef LD4_
    }
}

__device__ __forceinline__ void ph_forget(const Args& a, LAS unsigned char* lds, int lane, int wave) {
    const bf16* HB = (const bf16*)(a.ws + WS_HB); const bf16* WF = (const bf16*)(a.ws + WS_WF); float* LF = (float*)(a.ws + WS_LF);
    const int m16 = lane & 15, kc = lane >> 4, kh = wave & 1;
    LAS f32x4* xch = (LAS f32x4*)lds;
    for (int base = blockIdx.x * (NWAVES / 2); base < M / 16; base += gridDim.x * (NWAVES / 2)) {
        const int item = base + (wave >> 1); const bool live = item < M / 16;
        const int t0 = (live ? item : 0) * 16; f32x4 acc = {0.f, 0.f, 0.f, 0.f};
        const bf16* ap = HB + (size_t)(t0 + m16) * DM + 8 * kc + 1024 * kh; const bf16* bp = WF + (size_t)m16 * DM + 8 * kc + 1024 * kh;
#pragma unroll 16
        for (int s = 0; s < 32; ++s) { const bf16x8 av = *(const bf16x8*)(ap + 32 * s), bv = *(const bf16x8*)(bp + 32 * s); acc = __builtin_amdgcn_mfma_f32_16x16x32_bf16(av, bv, acc, 0, 0, 0); }
        xch[wave * 64 + lane] = acc;
        __syncthreads();
        if (kh == 0 && live) { const f32x4 oth = xch[(wave + 1) * 64 + lane]; const float bfv = a.in[22][m16]; f32x4 o;
#pragma unroll
            for (int r = 0; r < 4; ++r) { const float x = acc[r] + oth[r] + bfv; o[r] = fminf(x, 0.f) - log1pf(__expf(-fabsf(x))); }
            const int t = t0 + 4 * kc, b = t >> 13, pos = t & (SEQ - 1);
            *(f32x4*)(LF + (size_t)(b * 16 + m16) * SEQ + pos) = o; }
        __syncthreads();
    }
}
__device__ __forceinline__ void ph_cumsum(const Args& a, int lane, int wave) {
    const float* LF = (const float*)(a.ws + WS_LF); float* FB = (float*)(a.ws + WS_FB);
    float* FE = (float*)(a.ws + WS_FE); float* FP = (float*)(a.ws + WS_FP);
    const int gw = blockIdx.x * NWAVES + wave, NGW = gridDim.x * NWAVES;
    const int sidx = NGW >= 1056 ? gw - 1024 : gw;
    for (int seq = sidx; seq >= 0 && seq < 32; seq += NGW) {
        const float* src = LF + (size_t)seq * SEQ + lane * 128; float* dst = FB + (size_t)seq * SEQ + lane * 128;
        f32x4 vv[32];
#pragma unroll
        for (int i = 0; i < 32; ++i) vv[i] = *(const f32x4*)(src + 4 * i);
        float s = 0.f;
#pragma unroll
        for (int i = 0; i < 32; ++i) s += (vv[i][0] + vv[i][1]) + (vv[i][2] + vv[i][3]);
        float inc = s;
#pragma unroll
        for (int o = 1; o < 64; o <<= 1) { const float n = __shfl_up(inc, o); if (lane >= o) inc += n; }
        float run = inc - s;
#pragma unroll
        for (int i = 0; i < 32; ++i) { const f32x4 v = vv[i]; f32x4 o;
            run += v[0]; o[0] = run; run += v[1]; o[1] = run; run += v[2]; o[2] = run; run += v[3]; o[3] = run;
            if (i == 0 && (lane & 1) == 0) FP[seq * 32 + (lane >> 1)] = -o[0];
            if (i == 15) FE[seq * 128 + 2 * lane] = -o[3];
            if (i == 31) FE[seq * 128 + 2 * lane + 1] = -o[3];
            *(f32x4*)(dst + 4 * i) = o * (-1.f / ATT_SCALE); }
    }
    const bf16* QK = (const bf16*)(a.ws + WS_ZB);
    for (int item = gw; item < 1024; item += NGW) {
        const int seq = item >> 5, blk = item & 31, b = seq >> 4, h = seq & 15;
        const bf16* qb = QK + ((size_t)b * SEQ + (size_t)blk * 256) * DM + h * 128 + 8 * (lane & 15); const bf16* kb = qb + (size_t)M * DM;
        float mq = 0.f, mk = 0.f, md = 3.0e38f;
#pragma unroll 8
        for (int r = 0; r < 64; ++r) { const size_t ro = (size_t)(4 * r + (lane >> 4)) * DM; float vq[8], vk[8]; ld8(qb + ro, vq); ld8(kb + ro, vk);
            float sq = 0.f, sk = 0.f, sd = 0.f;
#pragma unroll
            for (int e = 0; e < 8; ++e) { sq += vq[e] * vq[e]; sk += vk[e] * vk[e]; sd += vq[e] * vk[e]; }
            sq += SWZ_XOR_(sq, 1); sk += SWZ_XOR_(sk, 1); sd += SWZ_XOR_(sd, 1); sq += SWZ_XOR_(sq, 2); sk += SWZ_XOR_(sk, 2); sd += SWZ_XOR_(sd, 2);
            sq += SWZ_XOR_(sq, 4); sk += SWZ_XOR_(sk, 4); sd += SWZ_XOR_(sd, 4); sq += SWZ_XOR_(sq, 8); sk += SWZ_XOR_(sk, 8); sd += SWZ_XOR_(sd, 8);
            mq = fmaxf(mq, sq); mk = fmaxf(mk, sk); md = fminf(md, sd); }
        mq = wave_max(mq); mk = wave_max(mk); md = -wave_max(-md);
        if (lane == 0) { ((float*)(a.ws + WS_QN))[seq * 32 + blk] = mq; ((float*)(a.ws + WS_KN))[seq * 32 + blk] = mk; ((float*)(a.ws + WS_DN))[seq * 32 + blk] = md; }
    }
}

constexpr float SKIP_T = 20.f;
__device__ __forceinline__ attn::BlockRef<__hip_bfloat16, __hip_bfloat16> attn_mkref(int L, const __hip_bfloat16* Q, const __hip_bfloat16* K, const __hip_bfloat16* V, __hip_bfloat16* O, const unsigned char* ws, int lane) {
    const int qb = 31 - (L >> 5), seq = L & 31, b = seq >> 4, h = seq & 15;
    attn::BlockRef<__hip_bfloat16, __hip_bfloat16> r; const size_t rowq = (size_t)b * SEQ + (size_t)qb * attn::QB, row0 = (size_t)b * SEQ;
    r.Q = Q + rowq * DM + h * 128; r.O = O + rowq * DM + h * 128; r.K = K + row0 * DM + h * 128; r.V = V + row0 * DM + h * 128; r.Fb = (const float*)(ws + WS_FB) + (size_t)seq * SEQ; r.P0 = qb * attn::QB; r.O8 = (unsigned char*)ws + WS_YC8 + rowq * DM + h * 128;
    const char* FE = (const char*)((const float*)(ws + WS_FE) + seq * 128); const char* KN = (const char*)((const float*)(ws + WS_KN) + seq * 32);
    unsigned l4 = (unsigned)lane * 4u; asm volatile("" : "+v"(l4));
    const float kn = wave_max((lane & 31) <= qb ? *(const float*)(KN + (l4 & 124u)) : 0.f), qn = ((const float*)(ws + WS_QN))[seq * 32 + qb], fp = ((const float*)(ws + WS_FP))[seq * 32 + qb];
    const float dn = ((const float*)(ws + WS_DN))[seq * 32 + qb];
    const float tgt = fp - (SKIP_T + (sqrtf(qn * kn) * 1.0001f - dn) * ATT_SCALE);
    const int cnt = __popcll(__ballot(*(const float*)(FE + l4) <= tgt)) + __popcll(__ballot(*(const float*)(FE + 256 + l4) <= tgt));
    r.jlo = cnt < 4 * qb ? cnt : 4 * qb;
    return r;
}
__device__ __forceinline__ void ph_attention(const Args& a, char* lds, const int tid) {
    using namespace attn;
    typedef __hip_bfloat16 T;
    const T* Q = (const T*)(a.ws + WS_ZB); const T* K = Q + (size_t)M * DM; const T* V = K + (size_t)M * DM; T* O = (T*)(a.ws + WS_YC);
    unsigned* ctr = (unsigned*)(a.ws + 32768);
    volatile int* nextw = (volatile int*)(lds + attn::LDS_BYTES);
    const int lane = tid & 63, total = 1024;
    int L = blockIdx.x; if (L >= total) return;
    BlockRef<T, T> cur = attn_mkref(L, Q, K, V, O, a.ws, lane);
    Seam<T> S;
    causal_swa_prime<T, T>(cur, SEQ, lds, S, tid);
    for (;;) {
        if (tid == 0) *nextw = (int)gridDim.x + (int)__hip_atomic_fetch_add(ctr, 1u, __ATOMIC_RELAXED, __HIP_MEMORY_SCOPE_AGENT);
        __syncthreads();
        const int Ln = __builtin_amdgcn_readfirstlane(*nextw); const bool last = Ln >= total;
        const BlockRef<T, T> nxt = last ? cur : attn_mkref(Ln, Q, K, V, O, a.ws, lane);
        causal_swa_block<T, T>(cur, nxt, SEQ, SEQ, lds, S, tid);
        if (last) break;
        cur = nxt; L = Ln;
    }
}

__global__ void __launch_bounds__(NTHREADS, 2) mk_fwd(Args a) {
    extern __shared__ __attribute__((aligned(16))) unsigned char lds_raw[];
    cg::grid_group grid = cg::this_grid();
    LAS unsigned char* lds = (LAS unsigned char*)lds_raw;
    const int wave = __builtin_amdgcn_readfirstlane((int)threadIdx.x >> 6);
    unsigned char* ws = a.ws;
    const float* MOD = (const float*)(ws + WS_MOD);
    const int lo = a.ph_lo, hi = a.ph_hi;
    XcdBarrier bar;
    { const int l0 = lane_id(); volatile LAS unsigned* st = (volatile LAS unsigned*)(lds + LDS_CTL);
      if (wave == 0 && l0 == 0) { st[0] = 0u; st[1] = 0u; }
      __syncthreads();
      bar.bar = (unsigned*)ws; bar.x = xb_xcc_id(); bar.st = st;
      if (lo == 0) { if (blockIdx.x == 0) { unsigned* z = (unsigned*)ws; const int t_ = wave * 64 + l0;
#pragma unroll 1
              for (int i = t_; i < 4096; i += NTHREADS) __hip_atomic_store(z + i, 0u, __ATOMIC_RELAXED, __HIP_MEMORY_SCOPE_AGENT);
              if (t_ == 0) __hip_atomic_store(z + 8192, 0u, __ATOMIC_RELAXED, __HIP_MEMORY_SCOPE_AGENT); } }
      else if (wave == 0 && l0 == 0) { st[2] = xb_add(&bar.bar[XB_XCNT(bar.x)], 1u); st[3] = bar.x; } }
    int ph = 0;
#define PHASE_BEGIN if (ph >= lo && ph < hi) { const int lane = lane_id(), tid = wave * 64 + lane; (void)tid; (void)lane;
#define TID tid
#define PHASE_END   if (ph + 1 < hi) { if (ph == 0) { grid.sync(); if (wave == 0 && lane_id() == 0) { bar.st[2] = xb_add(&bar.bar[XB_XCNT(bar.x)], 1u); bar.st[3] = bar.x; } } else xcd_barrier(bar, wave == 0 && lane_id() == 0);     } } ++ph;
    bf16* HB = (bf16*)(ws + WS_HB); bf16* ZB = (bf16*)(ws + WS_ZB); bf16* YC = (bf16*)(ws + WS_YC); bf16* YB = (bf16*)(ws + WS_YB);
    float* X1 = (float*)(ws + WS_X1); bf16* H2 = (bf16*)(ws + WS_H2); bf16* QP = (bf16*)(ws + WS_QP);

    PHASE_BEGIN ph_prologue(a, lds, tid, lane, wave); PHASE_END
    PHASE_BEGIN ph_modulate(a.in[0], MOD, 0, 2048, HB, ws + WS_HB8, (float*)(ws + WS_SA), lane, wave); PHASE_END
    PHASE_BEGIN { pg8::Gemm g{(const bf16*)(ws + WS_HB8), (const bf16*)(ws + WS_WIN), M, NZ, DM / 2, DM / 2, DM / 2}; pg8::StaticOrder S; S.init(M, NZ, gridDim.x, blockIdx.x);
        pg8::EpiI8RowScaleBf16 E{ZB, NZ, (const float*)(ws + WS_SA), 1.f / W8_SCALE, 0, 0}; pg8::gemm_phase<pg8::EpiI8RowScaleBf16, pg8::StaticOrder, true, true, false, true>(lds, g, S, E, TID); } PHASE_END
    PHASE_BEGIN ph_poolconv(a, lane, wave); PHASE_END
    PHASE_BEGIN {
        if (gridDim.x == 256) {
            { const int gq = blockIdx.x >> 6, pm = blockIdx.x & 63;
              pg8::Gemm g{(const bf16*)(ws + WS_PO) + gq * 256, (const bf16*)(ws + WS_WPOOL) + gq * 65536, M, 256, 256, 1024, 256}; pg8::ListOrder S{pm, 1};
              pg8::EpiScaleBf16 E{ws + WS_YC8 + gq * 256, DM, a.in[12] + gq * 256, Y8_SCALE}; pg8::gemm_phase<pg8::EpiScaleBf16, pg8::ListOrder, false, true>(lds, g, S, E, TID); }
            { const int hb = blockIdx.x >> 5, pm0 = (blockIdx.x & 31) * 2;
              int kg = 128; asm volatile("" : "+s"(kg));
              pg8::Gemm g{(const bf16*)(ws + WS_XC) + hb * 128, (const bf16*)(ws + WS_WAX) + hb * 32768, M, 256, kg, 1024, 128}; pg8::ListOrder S{pm0, 2};
              pg8::EpiGate E{(const bf16*)(ws + WS_XC), (float*)(ws + WS_AF), (float*)(ws + WS_DF), a.in[16], a.in[18], (const float*)(ws + WS_LS8), hb * 128};
              pg8::gemm_phase<pg8::EpiGate, pg8::ListOrder, false, false>(lds, g, S, E, wave * 64 + lane_id()); }
        } } PHASE_END
    PHASE_BEGIN ph_scan_agg(a, tid); PHASE_END
    PHASE_BEGIN ph_scan_fin(a, tid); PHASE_END
    PHASE_BEGIN { pg8::Gemm g{(const bf16*)(ws + WS_YC8), (const bf16*)(ws + WS_WOUT), M, DM, DM / 2, DM / 2, DM / 2}; pg8::StaticOrder S; S.init(M, DM, gridDim.x, blockIdx.x);
        pg8::EpiRowScaleBf16 E{YB, DM, nullptr, 1.f / (W8O_SCALE * Y8_SCALE), 0, 0}; pg8::gemm_phase<pg8::EpiRowScaleBf16, pg8::StaticOrder, true, true, true>(lds, g, S, E, TID); } PHASE_END
    PHASE_BEGIN ph_ln<true>(YB, nullptr, HB, MOD, MOD, a.in[4], a.in[5], H2, ws + WS_X1, (float*)(ws + WS_X1 + 64 * MiB), ws + WS_H6, (float*)(ws + WS_HS), lane, wave); PHASE_END
    PHASE_BEGIN { pg8::Gemm g{(const bf16*)(ws + WS_X1), (const bf16*)(ws + WS_WQ0), M, DM, DM / 2, DM / 2, DM / 2}; pg8::StaticOrder S; S.init(M, DM, gridDim.x, blockIdx.x);
        pg8::EpiI8RowScaleBf16 E{QP, DM, (const float*)(ws + WS_X1 + 64 * MiB), 1.f / W8_SCALE, 0, 0}; pg8::gemm_phase<pg8::EpiI8RowScaleBf16, pg8::StaticOrder, true, true, false, true>(lds, g, S, E, TID); } PHASE_END
    PHASE_BEGIN ph_topk(a, 0, lds, tid, lane, wave); PHASE_END
    PHASE_BEGIN ph_peer_u(a, 0, (volatile LAS unsigned*)(lds + LDS_CTL), lds, lane, wave); PHASE_END
    PHASE_BEGIN ph_peer_coef(a, 0, lds, lane, wave); PHASE_END
    PHASE_BEGIN ph_peer_v(a, 0, (volatile LAS unsigned*)(lds + LDS_CTL), lds, lane, wave); PHASE_END
    PHASE_BEGIN ph_peer_ln<false>(a, MOD, MOD + 2 * 12288, a.in[4] + DM, a.in[5] + DM, lds, lane, wave); PHASE_END
    PHASE_BEGIN { pg8::Gemm g{(const bf16*)(ws + WS_HB8), (const bf16*)(ws + WS_WQKV), M, NQKV, DM / 2, DM / 2, DM / 2}; pg8::StaticOrder S; S.init(M, NQKV, gridDim.x, blockIdx.x);
        pg8::EpiRowScaleBf16 E{ZB, DM, (const float*)(ws + WS_SA), 1.f / W8_SCALE, DM, (size_t)M * DM}; pg8::gemm_phase<pg8::EpiRowScaleBf16, pg8::StaticOrder, true, true, true>(lds, g, S, E, TID);
        ph_forget(a, lds, lane, wave); } PHASE_END
    PHASE_BEGIN ph_cumsum(a, lane, wave); PHASE_END
    PHASE_BEGIN ph_attention(a, (char*)lds_raw, TID); PHASE_END
    PHASE_BEGIN { pg8::Gemm g{(const bf16*)(ws + WS_YC8), (const bf16*)(ws + WS_WO), M, DM, DM / 2, DM / 2, DM / 2}; pg8::StaticOrder S; S.init(M, DM, gridDim.x, blockIdx.x);
        pg8::EpiRowScaleBf16 E{YB, DM, nullptr, 1.f / (W8O_SCALE * attn::O8_SCALE), 0, 0}; pg8::gemm_phase<pg8::EpiRowScaleBf16, pg8::StaticOrder, true, true, true>(lds, g, S, E, TID); } PHASE_END
    PHASE_BEGIN ph_ln<true>(YB, nullptr, HB, MOD + 2 * 12288, MOD + 2 * 12288, a.in[4] + 2 * DM, a.in[5] + 2 * DM, H2, ws + WS_X1, (float*)(ws + WS_X1 + 64 * MiB), ws + WS_H6, (float*)(ws + WS_HS), lane, wave); PHASE_END
    PHASE_BEGIN { pg8::Gemm g{(const bf16*)(ws + WS_X1), (const bf16*)(ws + WS_WQ1), M, DM, DM / 2, DM / 2, DM / 2}; pg8::StaticOrder S; S.init(M, DM, gridDim.x, blockIdx.x);
        pg8::EpiI8RowScaleBf16 E{QP, DM, (const float*)(ws + WS_X1 + 64 * MiB), 1.f / W8_SCALE, 0, 0}; pg8::gemm_phase<pg8::EpiI8RowScaleBf16, pg8::StaticOrder, true, true, false, true>(lds, g, S, E, TID); } PHASE_END
    PHASE_BEGIN ph_topk(a, 1, lds, tid, lane, wave); PHASE_END
    PHASE_BEGIN ph_peer_u(a, 1, (volatile LAS unsigned*)(lds + LDS_CTL), lds, lane, wave); PHASE_END
    PHASE_BEGIN ph_peer_coef(a, 1, lds, lane, wave); PHASE_END
    PHASE_BEGIN ph_peer_v(a, 1, (volatile LAS unsigned*)(lds + LDS_CTL), lds, lane, wave); PHASE_END
    PHASE_BEGIN ph_peer_ln<true>(a, MOD + 2 * 12288, MOD, a.in[4] + 3 * DM, a.in[5] + 3 * DM, lds, lane, wave); PHASE_END
#undef PHASE_BEGIN
#undef TID
#undef PHASE_END
}
constexpr int N_PHASES = 26;

extern "C" void kernel_launch(void* const* d_in, const int* in_sizes, int n_in, void* d_out, int out_size, void* d_ws, size_t ws_size, hipStream_t stream) {
    static int grid = 0;
    if (grid == 0) {
        int dev = 0, cus = 0, per_cu = 0;
        if (n_in != 24 || out_size != M * DM || ws_size < WS_END) { fprintf(stderr, "kernel_launch: unexpected shapes (n_in %d, out %d, ws %zu)\n", n_in, out_size, ws_size); grid = -1; return; }
        (void)hipGetDevice(&dev);
        (void)hipDeviceGetAttribute(&cus, hipDeviceAttributeMultiprocessorCount, dev);
        (void)hipFuncSetAttribute((const void*)mk_fwd, hipFuncAttributeMaxDynamicSharedMemorySize, LDS_BYTES);
        (void)hipOccupancyMaxActiveBlocksPerMultiprocessor(&per_cu, (const void*)mk_fwd, NTHREADS, LDS_BYTES);
        if (per_cu < 1) { fprintf(stderr, "kernel_launch: occupancy query reports %d blocks per CU\n", per_cu); grid = -1; return; }
        grid = cus;
        if (grid != 256) fprintf(stderr, "kernel_launch: %d CUs; phase 4 is written for 256 workgroups\n", grid);
    }
    if (grid < 0) return;
#ifdef MK_SPLIT
    if (hipMemsetAsync(d_ws, 0, 65536, stream) != hipSuccess) { fprintf(stderr, "kernel_launch: hipMemsetAsync failed\n"); return; }
#endif
    Args a{};
    for (int i = 0; i < 24; ++i) a.in[i] = (const float*)d_in[i];
    a.out = (float*)d_out; a.ws = (unsigned char*)d_ws;
#ifndef MK_SPLIT
    a.ph_lo = 0; a.ph_hi = N_PHASES;
    void* args[] = {&a};
    hipError_t e = hipLaunchCooperativeKernel((const void*)mk_fwd, dim3(grid), dim3(NTHREADS), args, LDS_BYTES, stream);
    if (e != hipSuccess) fprintf(stderr, "cooperative launch failed: %s (grid %d)\n", hipGetErrorString(e), grid);
#else
    for (int p = 0; p < N_PHASES; ++p) { a.ph_lo = p; a.ph_hi = p + 1; void* args[] = {&a};
        hipError_t e = hipLaunchCooperativeKernel((const void*)mk_fwd, dim3(grid), dim3(NTHREADS), args, LDS_BYTES, stream);
        if (e != hipSuccess) { fprintf(stderr, "launch %d failed: %s\n", p, hipGetErrorString(e)); break; } }
#endif
}
```

```cpp
#include <hip/hip_runtime.h>
#include <hip/hip_bf16.h>
#include <hip/hip_cooperative_groups.h>
#include <cstdio>
#include <cstdint>
#include <cmath>
namespace cg = cooperative_groups;
namespace pg8 {
#define PG8_LAS __attribute__((address_space(3)))
typedef unsigned short bf16_t;
typedef short bf16x8 __attribute__((ext_vector_type(8)));
typedef float f32x4 __attribute__((ext_vector_type(4)));
typedef unsigned u32x4 __attribute__((ext_vector_type(4)));
constexpr int BM = 256, BK = 64, HALF = 128, HTB = HALF * BK * 2  , STAGE_BYTES = 8 * HTB, NXCD = 8, WGM = 8;

__host__ __device__ __forceinline__ int lds_byte(int r, int c) { const int st = (r >> 4) * 2 + (c >> 5), rr = r & 15, cc = c & 31, ob = rr * 64 + cc * 2; return st * 1024 + (ob ^ (((ob >> 9) & 1) << 5)); }
__host__ __device__ __forceinline__ void stage_rc(int b, int& R, int& C) { const int st = b / 1024, sb = b % 1024, swz = sb ^ (((sb >> 9) & 1) << 5); R = (st >> 1) * 16 + swz / 64; C = (st & 1) * 32 + (swz % 64) / 2; }
__host__ __device__ __forceinline__ int perm32(int rho) { const int n = rho >> 4, i = rho & 15; return 8 * (i >> 2) + 4 * n + (i & 3); }

struct Unit { int pm, pn; };
struct Gemm { const bf16_t* A; const bf16_t* Bt; int M, N, K, lda, ldb; };

struct StaticOrder {
    int nM, nN, nwg, G, c;
    __host__ __device__ void init(int M, int N, int G_, int c_) { nM = M / BM; nN = N / BM; nwg = nM * nN; G = G_; c = c_; }
    __host__ __device__ bool next(int i, Unit& u) const {
        const long L = (long)i * G + c; if (L >= nwg) return false;
        int wgid = (int)L; { const int q = nwg / NXCD, r = nwg % NXCD, xcd = wgid % NXCD, off = wgid / NXCD; wgid = (xcd < r ? xcd * (q + 1) : r * (q + 1) + (xcd - r) * q) + off; }
        const int nig = WGM * nN, gid = wgid / nig, fm = gid * WGM, gsz = (nM - fm) < WGM ? (nM - fm) : WGM;
        u.pm = fm + ((wgid % nig) % gsz); u.pn = (wgid % nig) / gsz; return true;
    }
    __device__ __forceinline__ void a_ready(const Unit&) const {}
    __device__ __forceinline__ void done(const Unit&) const {}
};

__device__ __forceinline__ unsigned cvt_pk_bf16(float lo, float hi) { typedef float f2_ __attribute__((ext_vector_type(2))); typedef __bf16 b2_ __attribute__((ext_vector_type(2))); const f2_ f = {lo, hi}; return __builtin_bit_cast(unsigned, __builtin_convertvector(f, b2_)); }
typedef float f32x2 __attribute__((ext_vector_type(2)));
__device__ __forceinline__ f32x2 gelu_pk(f32x2 v) {
    const f32x2 av = __builtin_elementwise_abs(v), d = av * 0.2316418882f + 1.0f;
    f32x2 t; t.x = __builtin_amdgcn_rcpf(d.x); t.y = __builtin_amdgcn_rcpf(d.y);
    f32x2 q = t * 0.5307027145f + (-0.7265760135f); q = q * t + 0.7107068705f; q = q * t + (-0.142248368f); q = q * t + 0.127414796f; q = q * t;
    const f32x2 s = (v * v) * (-0.72134752044f);
    f32x2 e; e.x = __builtin_amdgcn_exp2f(s.x); e.y = __builtin_amdgcn_exp2f(s.y);
    const f32x2 m = v * (q * e), r = v - m;
    f32x2 o; o.x = v.x < 0.f ? m.x : r.x; o.y = v.y < 0.f ? m.y : r.y; return o;
}

template <int ACT  > struct EpiBf16 {
    static constexpr bool PERM = true, AFTER_DRAIN = false; static_assert(ACT == 0 || ACT == 1, "EpiBf16: ACT is 0 (none) or 1 (gelu_pk)");
    bf16_t* O; int ldc; const float* bias; int split_cols; size_t split_stride; float scale0;
    __device__ __forceinline__ void operator()(const f32x4 (&acc)[2][2][4][2], const Unit& u, int wr, int wc, int fr, int fq) const {
        const int row0 = u.pm * BM + wr * 64 + fr; int colt = u.pn * BM; bf16_t* base = O;
        float sc = 1.f; if (split_cols) { const int t = colt / split_cols; base += (size_t)t * split_stride; colt -= t * split_cols; if (t == 0) sc = scale0; }
        const int col0 = colt + wc * 32 + 8 * fq, bcol0 = u.pn * BM + wc * 32 + 8 * fq;
        f32x4 bv[2][2];
#pragma unroll
        for (int bj = 0; bj < 2; ++bj)
#pragma unroll
            for (int n = 0; n < 2; ++n) bv[bj][n] = bias ? *(const f32x4*)(bias + bcol0 + bj * HALF + 4 * n) : (f32x4){0.f, 0.f, 0.f, 0.f};
#pragma unroll
        for (int ai = 0; ai < 2; ++ai)
#pragma unroll
            for (int m = 0; m < 4; ++m) { bf16_t* rowp = base + (size_t)(row0 + ai * HALF + m * 16) * ldc + col0;
#pragma unroll
                for (int bj = 0; bj < 2; ++bj) { f32x4 v0 = acc[ai][bj][m][0] + bv[bj][0], v1 = acc[ai][bj][m][1] + bv[bj][1];
                    if (ACT == 1) { f32x2 a = gelu_pk((f32x2){v0[0], v0[1]}), b = gelu_pk((f32x2){v0[2], v0[3]}), c = gelu_pk((f32x2){v1[0], v1[1]}), d = gelu_pk((f32x2){v1[2], v1[3]});
                        v0 = (f32x4){a.x, a.y, b.x, b.y}; v1 = (f32x4){c.x, c.y, d.x, d.y}; }
                    v0 = v0 * sc; v1 = v1 * sc; u32x4 w; w.x = cvt_pk_bf16(v0[0], v0[1]); w.y = cvt_pk_bf16(v0[2], v0[3]); w.z = cvt_pk_bf16(v1[0], v1[1]); w.w = cvt_pk_bf16(v1[2], v1[3]);
                    *(u32x4*)(rowp + bj * HALF) = w; } }
    }
};

template <class Epi, class Sched, bool ALIGN_EPI = false, bool SP2 = false, bool FP8 = false, bool I8 = false>
__device__ __forceinline__ void gemm_phase(PG8_LAS unsigned char* lds, const Gemm g, const Sched& S, const Epi& E, const int tid) {
    const int wid = __builtin_amdgcn_readfirstlane(tid >> 6), lane = tid & 63, wr = wid >> 2, wc = wid & 3, fr = lane & 15, fq = lane >> 4;
    const int K = g.K, nt = K / BK;
    unsigned voffA[2], voffB[2];
#pragma unroll
    for (int i = 0; i < 2; ++i) { int R, C; stage_rc(tid * 16 + i * 8192, R, C); const int Rb = Epi::PERM ? ((R & ~31) + perm32(R & 31)) : R;
        voffA[i] = (unsigned)(R * g.lda + C) * 2u; voffB[i] = (unsigned)(Rb * g.ldb + C) * 2u; }
    const __amdgpu_buffer_rsrc_t rA = __builtin_amdgcn_make_buffer_rsrc((void*)g.A, 0, (int)((size_t)g.M * g.lda * 2), 0x00020000), rB = __builtin_amdgcn_make_buffer_rsrc((void*)g.Bt, 0, (int)((size_t)g.N * g.ldb * 2), 0x00020000);
    const size_t kstep = (size_t)(BK * 2);
    const size_t hstepA = (size_t)HALF * g.lda * 2, hstepB = (size_t)HALF * g.ldb * 2;
    const size_t tstepA = 2 * hstepA, tstepB = 2 * hstepB;
    const unsigned ldsw = (unsigned)wid * 1024u;
    const int aoffk[2] = {FP8 ? lds_byte(wr * 64 + fr, fq * 16) : lds_byte(wr * 64 + fr, fq * 8), FP8 ? lds_byte(wr * 64 + fr, fq * 16 + 8) : lds_byte(wr * 64 + fr, fq * 8) + 1024};
    const int boffk[2] = {FP8 ? lds_byte(wc * 32 + fr, fq * 16) : lds_byte(wc * 32 + fr, fq * 8), FP8 ? lds_byte(wc * 32 + fr, fq * 16 + 8) : lds_byte(wc * 32 + fr, fq * 8) + 1024};
#define PG8_SA(b, h) (((b) * 2 + (h)) * HTB)
#define PG8_SB(b, h) ((4 + (b) * 2 + (h)) * HTB)
#define PG8_STAGE(bufoff, gbase, voff, rs, gorig) do { _Pragma("unroll") for (int _i = 0; _i < 2; ++_i) \
        __builtin_amdgcn_raw_ptr_buffer_load_lds(rs, (PG8_LAS void*)(lds + (bufoff) + ldsw + _i * 8192), 16, (voff)[_i], (unsigned)((const char*)(gbase) - (const char*)(gorig)), 0, 0); } while (0)
#define PG8_LDA(dst, b, h) do { if constexpr (FP8) { _Pragma("unroll") for (int m = 0; m < 4; ++m) dst##8[m] = __builtin_shufflevector(*(const PG8_LAS bf16x8*)(lds + PG8_SA(b, h) + aoffk[0] + m * 2048), *(const PG8_LAS bf16x8*)(lds + PG8_SA(b, h) + aoffk[1] + m * 2048), 0, 1, 2, 3, 4, 5, 6, 7, 8, 9, 10, 11, 12, 13, 14, 15); } \
        else { _Pragma("unroll") for (int m = 0; m < 4; ++m) _Pragma("unroll") for (int k = 0; k < 2; ++k) dst[m][k] = *(const PG8_LAS bf16x8*)(lds + PG8_SA(b, h) + aoffk[k] + m * 2048); } } while (0)
#define PG8_LDB(dst, b, h) do { if constexpr (FP8) { _Pragma("unroll") for (int n = 0; n < 2; ++n) dst##8[n] = __builtin_shufflevector(*(const PG8_LAS bf16x8*)(lds + PG8_SB(b, h) + boffk[0] + n * 2048), *(const PG8_LAS bf16x8*)(lds + PG8_SB(b, h) + boffk[1] + n * 2048), 0, 1, 2, 3, 4, 5, 6, 7, 8, 9, 10, 11, 12, 13, 14, 15); } \
        else { _Pragma("unroll") for (int n = 0; n < 2; ++n) _Pragma("unroll") for (int k = 0; k < 2; ++k) dst[n][k] = *(const PG8_LAS bf16x8*)(lds + PG8_SB(b, h) + boffk[k] + n * 2048); } } while (0)
#define PG8_MMA(ai, bj, At, Bt) do { __builtin_amdgcn_s_setprio(1); _Pragma("unroll") for (int m = 0; m < 4; ++m) _Pragma("unroll") for (int n = 0; n < 2; ++n) { \
        if constexpr (FP8) { typedef int i32x8 __attribute__((ext_vector_type(8))); \
            acc[ai][bj][m][n] = __builtin_amdgcn_mfma_scale_f32_16x16x128_f8f6f4(__builtin_bit_cast(i32x8, Bt##8[n]), __builtin_bit_cast(i32x8, At##8[m]), acc[ai][bj][m][n], 0, 0, 0, 127, 0, 127); } \
        else if constexpr (I8) { typedef int i32x4_ __attribute__((ext_vector_type(4))); _Pragma("unroll") for (int k = 0; k < 2; ++k) \
            acc[ai][bj][m][n] = __builtin_bit_cast(f32x4, __builtin_amdgcn_mfma_i32_16x16x64_i8(__builtin_bit_cast(i32x4_, Bt[n][k]), __builtin_bit_cast(i32x4_, At[m][k]), __builtin_bit_cast(i32x4_, acc[ai][bj][m][n]), 0, 0, 0)); } \
        else { _Pragma("unroll") for (int k = 0; k < 2; ++k) acc[ai][bj][m][n] = __builtin_amdgcn_mfma_f32_16x16x32_bf16(Bt[n][k], At[m][k], acc[ai][bj][m][n], 0, 0, 0); } } \
        __builtin_amdgcn_s_setprio(0); } while (0)
#define PG8_WAIT_V(n) asm volatile("s_waitcnt vmcnt(" #n ")" ::: "memory")
#define PG8_WAIT_L(n) asm volatile("s_waitcnt lgkmcnt(" #n ")" ::: "memory")
#define PG8_BAR __builtin_amdgcn_s_barrier()
#define PG8_SCHED __builtin_amdgcn_sched_barrier(0)
    Unit cur, nxt; int ui = 0;
    if (!S.next(0, cur)) return;
    f32x4 acc[2][2][4][2];
#pragma unroll
    for (int a = 0; a < 2; ++a)
#pragma unroll
        for (int b = 0; b < 2; ++b)
#pragma unroll
            for (int m = 0; m < 4; ++m)
#pragma unroll
                for (int n = 0; n < 2; ++n) acc[a][b][m][n] = (f32x4){0.f, 0.f, 0.f, 0.f};
    bf16x8 At[4][2], B0[2][2], B1[2][2]; typedef short bf16x16 __attribute__((ext_vector_type(16))); bf16x16 At8[4], B08[2], B18[2];
    const char* cA = (const char*)g.A + (size_t)cur.pm * tstepA; const char* cB = (const char*)g.Bt + (size_t)cur.pn * tstepB;
    S.a_ready(cur);
    if constexpr (SP2) {
        PG8_STAGE(PG8_SB(0, 0), cB, voffB, rB, g.Bt); PG8_STAGE(PG8_SB(0, 1), cB + hstepB, voffB, rB, g.Bt); PG8_STAGE(PG8_SA(0, 0), cA, voffA, rA, g.A); PG8_STAGE(PG8_SA(0, 1), cA + hstepA, voffA, rA, g.A);
        if (wr == 1) PG8_BAR;
        PG8_WAIT_V(2); PG8_BAR;
        PG8_STAGE(PG8_SB(1, 0), cB + kstep, voffB, rB, g.Bt); PG8_STAGE(PG8_SA(1, 0), cA + kstep, voffA, rA, g.A); PG8_STAGE(PG8_SB(1, 1), cB + hstepB + kstep, voffB, rB, g.Bt);
        PG8_WAIT_V(6); PG8_BAR;
    } else {
        PG8_STAGE(PG8_SB(0, 0), cB, voffB, rB, g.Bt); PG8_STAGE(PG8_SA(0, 0), cA, voffA, rA, g.A); PG8_STAGE(PG8_SB(0, 1), cB + hstepB, voffB, rB, g.Bt); PG8_STAGE(PG8_SA(0, 1), cA + hstepA, voffA, rA, g.A);
        if (wr == 1) PG8_BAR;
        PG8_WAIT_V(4); PG8_BAR;
        PG8_STAGE(PG8_SB(1, 0), cB + kstep, voffB, rB, g.Bt); PG8_STAGE(PG8_SA(1, 0), cA + kstep, voffA, rA, g.A); PG8_STAGE(PG8_SB(1, 1), cB + hstepB + kstep, voffB, rB, g.Bt);
        PG8_WAIT_V(6); PG8_BAR;
    }
    for (;;) {
        const bool has_next = S.next(ui + 1, nxt);
        const char* nA = has_next ? (const char*)g.A + (size_t)nxt.pm * tstepA : cA; const char* nB = has_next ? (const char*)g.Bt + (size_t)nxt.pn * tstepB : cB;
        for (int t = 0; t < nt; t += 2) {
            const bool last = (t == nt - 2);
            const char* a1 = cA + (size_t)(t + 1) * kstep;
            const char* a2 = last ? nA : cA + (size_t)(t + 2) * kstep; const char* b2 = last ? nB : cB + (size_t)(t + 2) * kstep;
            const char* a3 = a2 + kstep; const char* b3 = b2 + kstep;
            if (last && has_next) S.a_ready(nxt);
            if constexpr (SP2) {
            PG8_LDB(B0, 0, 0); PG8_LDB(B1, 0, 1); PG8_SCHED; PG8_LDA(At, 0, 0); PG8_STAGE(PG8_SA(1, 1), a1 + hstepA, voffA, rA, g.A);
            PG8_WAIT_V(8); PG8_WAIT_L(0); PG8_BAR; PG8_MMA(0, 0, At, B0); PG8_MMA(0, 1, At, B1); PG8_BAR; PG8_SCHED;
            PG8_LDA(At, 0, 1); PG8_STAGE(PG8_SB(0, 0), b2, voffB, rB, g.Bt); PG8_STAGE(PG8_SB(0, 1), b2 + hstepB, voffB, rB, g.Bt); PG8_STAGE(PG8_SA(0, 0), a2, voffA, rA, g.A);
            PG8_WAIT_V(8); PG8_WAIT_L(0); PG8_BAR; PG8_MMA(1, 0, At, B0); PG8_MMA(1, 1, At, B1); PG8_BAR; PG8_SCHED;
            PG8_LDB(B0, 1, 0); PG8_LDB(B1, 1, 1); PG8_SCHED; PG8_LDA(At, 1, 0); PG8_STAGE(PG8_SA(0, 1), a2 + hstepA, voffA, rA, g.A);
            PG8_WAIT_V(8); PG8_WAIT_L(0); PG8_BAR; PG8_MMA(0, 0, At, B0); PG8_MMA(0, 1, At, B1); PG8_BAR; PG8_SCHED;
            PG8_LDA(At, 1, 1); PG8_STAGE(PG8_SB(1, 0), b3, voffB, rB, g.Bt); PG8_STAGE(PG8_SB(1, 1), b3 + hstepB, voffB, rB, g.Bt); PG8_STAGE(PG8_SA(1, 0), a3, voffA, rA, g.A);
            PG8_WAIT_V(8); PG8_WAIT_L(0); PG8_BAR; PG8_MMA(1, 0, At, B0); PG8_MMA(1, 1, At, B1); PG8_BAR; PG8_SCHED;
            } else {
            PG8_LDB(B0, 0, 0); PG8_SCHED; PG8_LDA(At, 0, 0); PG8_STAGE(PG8_SA(1, 1), a1 + hstepA, voffA, rA, g.A);
            PG8_WAIT_L(8); PG8_BAR; PG8_WAIT_L(0); PG8_MMA(0, 0, At, B0); PG8_BAR; PG8_SCHED;
            PG8_LDB(B1, 0, 1); PG8_STAGE(PG8_SB(0, 0), b2, voffB, rB, g.Bt);
            PG8_BAR; PG8_WAIT_L(0); PG8_MMA(0, 1, At, B1); PG8_BAR;
            PG8_LDA(At, 0, 1); PG8_STAGE(PG8_SA(0, 0), a2, voffA, rA, g.A);
            PG8_BAR; PG8_WAIT_L(0); PG8_MMA(1, 0, At, B0); PG8_BAR; PG8_SCHED;
            PG8_STAGE(PG8_SB(0, 1), b2 + hstepB, voffB, rB, g.Bt);
            PG8_WAIT_V(6); PG8_BAR; PG8_MMA(1, 1, At, B1); PG8_BAR;
            PG8_LDB(B0, 1, 0); PG8_SCHED; PG8_LDA(At, 1, 0); PG8_STAGE(PG8_SA(0, 1), a2 + hstepA, voffA, rA, g.A);
            PG8_WAIT_L(8); PG8_BAR; PG8_WAIT_L(0); PG8_MMA(0, 0, At, B0); PG8_BAR; PG8_SCHED;
            PG8_LDB(B1, 1, 1); PG8_STAGE(PG8_SB(1, 0), b3, voffB, rB, g.Bt);
            PG8_BAR; PG8_WAIT_L(0); PG8_MMA(0, 1, At, B1); PG8_BAR;
            PG8_LDA(At, 1, 1); PG8_STAGE(PG8_SA(1, 0), a3, voffA, rA, g.A);
            PG8_BAR; PG8_WAIT_L(0); PG8_MMA(1, 0, At, B0); PG8_BAR; PG8_SCHED;
            PG8_STAGE(PG8_SB(1, 1), b3 + hstepB, voffB, rB, g.Bt);
            PG8_WAIT_V(6); PG8_BAR; PG8_MMA(1, 1, At, B1); PG8_BAR;
            }
        }
        if constexpr (ALIGN_EPI) { if (wr == 0) PG8_BAR; }
        if constexpr (!Epi::AFTER_DRAIN) { E(acc, cur, wr, wc, fr, fq); S.done(cur); }
        if (!has_next) break;
#pragma unroll
        for (int a = 0; a < 2; ++a)
#pragma unroll
            for (int b = 0; b < 2; ++b)
#pragma unroll
                for (int m = 0; m < 4; ++m)
#pragma unroll
                    for (int n = 0; n < 2; ++n) acc[a][b][m][n] = (f32x4){0.f, 0.f, 0.f, 0.f};
        cur = nxt; cA = nA; cB = nB; ++ui;
        if constexpr (ALIGN_EPI) { if (wr == 1) PG8_BAR; }
    }
    PG8_WAIT_V(0);
    if constexpr (!ALIGN_EPI) { if (wr == 0) PG8_BAR; }
    PG8_BAR;
    if constexpr (Epi::AFTER_DRAIN) { E.fused(acc, cur, wr, wc, fr, fq, lds, wid, lane); S.done(cur); }
#undef PG8_SA
#undef PG8_SB
#undef PG8_STAGE
#undef PG8_LDA
#undef PG8_LDB
#undef PG8_MMA
#undef PG8_WAIT_V
#undef PG8_WAIT_L
#undef PG8_BAR
#undef PG8_SCHED
}
}

namespace attn {
constexpr float SCALE = 0.08838834764831845f;
constexpr int D = 128, PITCH = 2048;
constexpr float THR = 8.f; constexpr bool WSKIP = true; constexpr bool O_FP8 = true; constexpr float O8_SCALE = 16.f;
constexpr int NW = 8, QBLK = 32, KVBLK = 64, QB = NW * QBLK;
constexpr int SHM_V = KVBLK * D * 2, SHM_K = KVBLK * D * 2;
constexpr int LDS_BIAS = 2 * SHM_V + 2 * SHM_K + NW * 64 * 4;
constexpr int LDS_BYTES = LDS_BIAS + 2 * 256;
using bf16 = __hip_bfloat16;
typedef short bf16x8 __attribute__((ext_vector_type(8)));
typedef short s16x4 __attribute__((ext_vector_type(4)));
typedef float f32x16 __attribute__((ext_vector_type(16)));
typedef float f32x4 __attribute__((ext_vector_type(4)));
typedef unsigned u32x4 __attribute__((ext_vector_type(4)));
template <class A, class Bt> struct same_t { static constexpr bool v = false; };
template <class A> struct same_t<A, A> { static constexpr bool v = true; };

#define KSWZ(row, colB) ((row) * 256 + ((colB) ^ (((row) & 7) << 4)))
#define SBAR() __builtin_amdgcn_sched_barrier(0)
__device__ __forceinline__ int v_st(int k, int c) { const int kk = (k & ~0xC) | ((k & 4) << 1) | ((k & 8) >> 1); return ((kk >> 3) * 4 + (c >> 5)) * 512 + ((kk & 7) * 32 + (c & 31)) * 2; }
__device__ __forceinline__ int v_rd_base(int lane) { return ((lane & 3) << 3) | (((lane >> 2) & 3) << 6) | (((lane >> 4) & 1) << 5) | (((lane >> 5) & 1) << 8); }
constexpr int v_rd_off(int d0, int ks, int half) { return d0 * 512 + ks * 4096 + half * 2048; }
__device__ __forceinline__ int crow(int r, int hi) { return (r & 3) + 8 * (r >> 2) + 4 * hi; }
__device__ __forceinline__ unsigned cvtpk(float lo, float hi) {
    typedef float f2_ __attribute__((ext_vector_type(2))); typedef __bf16 b2_ __attribute__((ext_vector_type(2))); const f2_ f = {lo, hi}; return __builtin_bit_cast(unsigned, __builtin_convertvector(f, b2_));
}
__device__ __forceinline__ bf16x8 pack8(f32x4 a, f32x4 b) {
    u32x4 w = {cvtpk(a[0], a[1]), cvtpk(a[2], a[3]), cvtpk(b[0], b[1]), cvtpk(b[2], b[3])};
    return *reinterpret_cast<bf16x8*>(&w);
}
template <class T> __device__ __forceinline__ bf16x8 load8(const T* p) {
    if constexpr (same_t<T, float>::v) { return pack8(*(const f32x4*)p, *(const f32x4*)(p + 4)); }
    else { return *reinterpret_cast<const bf16x8*>(p); }
}
__device__ __forceinline__ void mask_tile(f32x16& p0, f32x16& p1, int dq, unsigned W) {
    const float NEG = -__builtin_inff();
#pragma unroll
    for (int r = 0; r < 16; ++r) {
        const int c = (r & 3) + 8 * (r >> 2);
        if ((unsigned)(dq - c) >= W) p0[r] = NEG;
        if ((unsigned)(dq - c - 32) >= W) p1[r] = NEG;
    }
}
constexpr float DEAD_T = 20.f;
__device__ __forceinline__ void partialSM(f32x16& p0, f32x16& p1, float& m_reg, float& mn, float& alpha, bool& dead) {
    float pmax = p0[0]; for (int r = 1; r < 16; ++r) pmax = fmaxf(pmax, p0[r]); for (int r = 0; r < 16; ++r) pmax = fmaxf(pmax, p1[r]);
    { auto rr = __builtin_amdgcn_permlane32_swap(__float_as_uint(pmax), __float_as_uint(pmax), false, false);
      pmax = fmaxf(__uint_as_float(rr[0]), __uint_as_float(rr[1])); }
    constexpr float C2 = 1.4426950408889634f * SCALE;
    dead = __all((pmax - m_reg) * SCALE < -DEAD_T);
    if (dead) { mn = m_reg; alpha = 1.f; return; }
    if (__builtin_expect(__all((pmax - m_reg) * SCALE <= THR), 1)) { mn = m_reg; alpha = 1.f; }
    else { mn = fmaxf(m_reg, pmax); alpha = __builtin_amdgcn_exp2f((m_reg - mn) * C2); m_reg = mn; }
    const float mnL = -mn * C2;
    for (int r = 0; r < 16; ++r) p0[r] = fmaf(p0[r], C2, mnL); for (int r = 0; r < 16; ++r) p1[r] = fmaf(p1[r], C2, mnL);
    for (int r = 0; r < 16; ++r) p0[r] = __builtin_amdgcn_exp2f(p0[r]);
}
__device__ __forceinline__ void finishSM(f32x16& p0, f32x16& p1, float alpha, float& l_reg, bf16x8& pa0, bf16x8& pa1, bf16x8& pa2, bf16x8& pa3) {
    for (int r = 0; r < 16; ++r) p1[r] = __builtin_amdgcn_exp2f(p1[r]);
    float ps = 0; for (int r = 0; r < 16; ++r) ps += p0[r]; for (int r = 0; r < 16; ++r) ps += p1[r];
    { auto rr = __builtin_amdgcn_permlane32_swap(__float_as_uint(ps), __float_as_uint(ps), false, false);
      ps = __uint_as_float(rr[0]) + __uint_as_float(rr[1]); }
    l_reg = l_reg * alpha + ps;
#define PK4(P, B_, OUT) do { unsigned a0 = cvtpk(P[B_+0], P[B_+1]), a1 = cvtpk(P[B_+2], P[B_+3]);                          \
        unsigned b0 = cvtpk(P[B_+4], P[B_+5]), b1 = cvtpk(P[B_+6], P[B_+7]);                                             \
        auto r0 = __builtin_amdgcn_permlane32_swap(a0, b0, false, false); auto r1 = __builtin_amdgcn_permlane32_swap(a1, b1, false, false); \
        u32x4 w = {r0[0], r1[0], r0[1], r1[1]}; OUT = *reinterpret_cast<bf16x8*>(&w); } while (0)
    PK4(p0, 0, pa0); PK4(p0, 8, pa1); PK4(p1, 0, pa2); PK4(p1, 8, pa3);
#undef PK4
}
template <int KB, bool SK>
__device__ __forceinline__ void qkt(f32x16& p0, f32x16& p1, const char* K_lds, int r32, int hi, const bf16x8* qr, bool act) {
    const float* bl = (const float*)(K_lds - 2 * SHM_V + LDS_BIAS + KB * 256) + 4 * hi;
    if (SK && !act) { const float NEG = -__builtin_inff();
#pragma unroll
        for (int r = 0; r < 16; ++r) { p0[r] = NEG; p1[r] = NEG; } return; }
#pragma unroll
    for (int g_ = 0; g_ < 4; ++g_) { const f32x4 b0_ = *(const f32x4*)(bl + 8 * g_), b1_ = *(const f32x4*)(bl + 32 + 8 * g_);
#pragma unroll
        for (int e_ = 0; e_ < 4; ++e_) { p0[4 * g_ + e_] = b0_[e_]; p1[4 * g_ + e_] = b1_[e_]; } }
    const char* kb[4];
#pragma unroll
    for (int dd = 0; dd < 4; ++dd) kb[dd] = K_lds + KB * SHM_K + KSWZ(r32, (dd * 16 + hi * 8) * 2);
#pragma unroll
    for (int d0 = 0; d0 < 8; ++d0) { const char* a = kb[d0 & 3] + (d0 >> 2) * 128;
        bf16x8 b0 = *reinterpret_cast<const bf16x8*>(a);
        bf16x8 b1 = *reinterpret_cast<const bf16x8*>(a + 32 * 256);
        p0 = __builtin_amdgcn_mfma_f32_32x32x16_bf16(b0, qr[d0], p0, 0, 0, 0);
        p1 = __builtin_amdgcn_mfma_f32_32x32x16_bf16(b1, qr[d0], p1, 0, 0, 0); }
}
template <int VB, bool SK>
__device__ __forceinline__ void pv_tile(f32x16* o, int vb0, bf16x8 pa0, bf16x8 pa1, bf16x8 pa2, bf16x8 pa3, bool act) {
    if (SK && !act) return;
#define TRRD(dst, off) asm volatile("ds_read_b64_tr_b16 %0, %1 offset:%2" : "=&v"(dst) : "v"(vb0), "i"(off) : "memory")
#define PV_D0(d0) do { s16x4 l0, l1, l2, l3, h0, h1, h2, h3; constexpr int b_ = VB * SHM_V + v_rd_off(d0, 0, 0);     \
        TRRD(l0, b_); TRRD(h0, b_ + 2048); TRRD(l1, b_ + 4096); TRRD(h1, b_ + 6144); TRRD(l2, b_ + 8192); TRRD(h2, b_ + 10240); TRRD(l3, b_ + 12288); TRRD(h3, b_ + 14336); \
        asm volatile("s_waitcnt lgkmcnt(0)" ::: "memory"); SBAR();                 \
        o[d0] = __builtin_amdgcn_mfma_f32_32x32x16_bf16(pa0, (bf16x8){l0[0], l0[1], l0[2], l0[3], h0[0], h0[1], h0[2], h0[3]}, o[d0], 0, 0, 0);   \
        o[d0] = __builtin_amdgcn_mfma_f32_32x32x16_bf16(pa1, (bf16x8){l1[0], l1[1], l1[2], l1[3], h1[0], h1[1], h1[2], h1[3]}, o[d0], 0, 0, 0);   \
        o[d0] = __builtin_amdgcn_mfma_f32_32x32x16_bf16(pa2, (bf16x8){l2[0], l2[1], l2[2], l2[3], h2[0], h2[1], h2[2], h2[3]}, o[d0], 0, 0, 0);   \
        o[d0] = __builtin_amdgcn_mfma_f32_32x32x16_bf16(pa3, (bf16x8){l3[0], l3[1], l3[2], l3[3], h3[0], h3[1], h3[2], h3[3]}, o[d0], 0, 0, 0); } while (0)
    PV_D0(0); PV_D0(1); PV_D0(2); PV_D0(3);
#undef PV_D0
#undef TRRD
}

template <class TIn, class TOut> struct BlockRef { const TIn* Q; const TIn* K; const TIn* V; TOut* O; const float* Fb; int P0; int jlo; unsigned char* O8; };
template <class TIn> struct Seam {
    bf16x8 qr[8];
    bf16x8 st_v0, st_v1, st_k0, st_k1; f32x4 sf0, sf1, sf2, sf3;
    f32x4 tq[16];
};
__device__ __forceinline__ int swa_jlo(int P0, int W) { const int lowk = P0 - W + 1; return lowk > 0 ? lowk / KVBLK : 0; }
#define ROW(p, k0, rr) ((const TIn*)((const char*)(p) + (unsigned)((((k0) + (rr)) * PITCH + sc) * (int)sizeof(TIn))))
#define VMW() asm volatile("s_waitcnt vmcnt(0)" ::: "memory")
#define VMWN(n) asm volatile("s_waitcnt vmcnt(%0)" :: "i"(n) : "memory")
#define SLOAD_H(Kp, Vp, Fp, bb, k0) do { S.st_v0 = load8<TIn>(ROW(Vp, k0, sr)); S.st_v1 = load8<TIn>(ROW(Vp, k0, 32 + sr));              \
                         S.st_k0 = load8<TIn>(ROW(Kp, k0, sr)); S.st_k1 = load8<TIn>(ROW(Kp, k0, 32 + sr));                          \
                         if (wid == 0) __builtin_amdgcn_global_load_lds((const unsigned*)((Fp) + (k0) + lane), (__attribute__((address_space(3))) unsigned*)(lds + LDS_BIAS + (bb) * 256), 4, 0, 0); } while (0)
#define SWRITE_HK(bf) do { int t_ = tid; asm volatile("" : "+v"(t_)); const int kws_ = KSWZ(t_ >> 4, (t_ & 15) * 16);     \
        *(bf16x8*)(K_lds + (bf) * SHM_K + kws_) = S.st_k0; *(bf16x8*)(K_lds + (bf) * SHM_K + kws_ + 32 * 256) = S.st_k1; } while (0)
#define SWRITE_HV(bf) do { int t_ = tid; asm volatile("" : "+v"(t_)); const int vst0_ = v_st(t_ >> 4, (t_ & 15) * 8), vst1_ = v_st(32 + (t_ >> 4), (t_ & 15) * 8); \
        *(bf16x8*)(V_lds + (bf) * SHM_V + vst0_) = S.st_v0; *(bf16x8*)(V_lds + (bf) * SHM_V + vst1_) = S.st_v1; } while (0)
#define SWRITE_H(bf) do { SWRITE_HV(bf); SWRITE_HK(bf); } while (0)
#define SLOAD_F(p, k0) do { S.sf0 = *(const f32x4*)ROW(p, k0, sr); S.sf1 = *(const f32x4*)(ROW(p, k0, sr) + 4);                \
                            S.sf2 = *(const f32x4*)ROW(p, k0, 32 + sr); S.sf3 = *(const f32x4*)(ROW(p, k0, 32 + sr) + 4); } while (0)
#define SWRITE_KF(bf) do { *(bf16x8*)(K_lds + (bf) * SHM_K + kws) = pack8(S.sf0, S.sf1); *(bf16x8*)(K_lds + (bf) * SHM_K + kws + 32 * 256) = pack8(S.sf2, S.sf3); } while (0)
#define SWRITE_VF(bf) do { *(bf16x8*)(V_lds + (bf) * SHM_V + vst0) = pack8(S.sf0, S.sf1); *(bf16x8*)(V_lds + (bf) * SHM_V + vst1) = pack8(S.sf2, S.sf3); } while (0)
template <class TIn, class TOut>
__device__ __forceinline__ void causal_swa_prime(const BlockRef<TIn, TOut>& cur, int W, char* lds, Seam<TIn>& S, const int tid) {
    constexpr bool F32 = same_t<TIn, float>::v;
    const int wid = __builtin_amdgcn_readfirstlane(tid >> 6), lane = tid & 63, r32 = lane & 31, hi = lane >> 5;
    const int sr = tid >> 4, sc = (tid & 15) * 8, kws = KSWZ(sr, sc * 2); char* K_lds = lds + 2 * SHM_V;
    const int kb0 = ((cur.P0 + QB - 1) / KVBLK) * KVBLK;
    for (int d0 = 0; d0 < 8; ++d0) S.qr[d0] = load8<TIn>(cur.Q + (size_t)(wid * QBLK + r32) * PITCH + d0 * 16 + hi * 8);
    if constexpr (F32) { SLOAD_F((const float*)cur.K, kb0); VMW(); SWRITE_KF(0); SBAR(); SLOAD_F((const float*)cur.V, kb0); }
    else { SLOAD_H(cur.K, cur.V, cur.Fb, 0, kb0); VMW(); SWRITE_HK(0); }
    __syncthreads();
}
template <class TIn, class TOut>
__device__ __forceinline__ void causal_swa_block(const BlockRef<TIn, TOut>& cur, const BlockRef<TIn, TOut>& nxt, int skv, int W, char* lds, Seam<TIn>& S, const int tid) {
    constexpr bool F32 = same_t<TIn, float>::v;
    const int wid = __builtin_amdgcn_readfirstlane(tid >> 6), lane = tid & 63, r32 = lane & 31, hi = lane >> 5;
    const int j_lo = cur.jlo;
    int j_hi = (cur.P0 + QB - 1) / KVBLK + 1; if (j_hi > skv / KVBLK) j_hi = skv / KVBLK;
    const int NT = j_hi - j_lo;
    const int kbn = ((nxt.P0 + QB - 1) / KVBLK) * KVBLK;
    const int qlo = cur.P0 + wid * QBLK, qm = qlo + r32 - 4 * hi;
    char* V_lds = lds; char* K_lds = lds + 2 * SHM_V;
    float* ws = (float*)(lds + 2 * SHM_V + 2 * SHM_K) + wid * 64; float* li_l = ws, * al_l = ws + 32;
    float m_reg = -1e30f, l_reg = 0; f32x16 o[4] = {};
    const int sr = tid >> 4, sc = (tid & 15) * 8, vst0 = v_st(sr, sc), vst1 = v_st(32 + sr, sc), kws = KSWZ(sr, sc * 2);
    const int vb0 = (int)(uintptr_t)V_lds + v_rd_base(lane);
    const TIn* Kh = cur.K; const TIn* Vh = cur.V;
#define RESC(a) do { if (__any((a) < 1.f)) { if (hi == 0) al_l[r32] = (a); asm volatile("s_waitcnt lgkmcnt(0)" ::: "memory");              \
                     for (int d_ = 0; d_ < 4; ++d_) for (int r = 0; r < 16; ++r) o[d_][r] *= al_l[crow(r, hi)]; } } while (0)
#define KBASE(t) ((j_hi - 1 - (t)) * KVBLK)
#define ACT(t) (KBASE(t) <= qlo + QBLK - 1 && KBASE(t) + KVBLK - 1 >= qlo - W + 1)
#define MASKT(P0_, P1_, t) do { const int kb_ = KBASE(t); if ((!SK || ACT(t)) && (kb_ + KVBLK - 1 > qlo || kb_ <= qlo + QBLK - 1 - W)) mask_tile(P0_, P1_, qm - kb_, (unsigned)W); } while (0)
    constexpr int NQL = F32 ? 16 : 8;
    constexpr bool SK = WSKIP && !F32;
#define SEAM_K0() do { VMWN(NQL); if constexpr (F32) { SWRITE_KF(0); SBAR(); SLOAD_F((const float*)nxt.V, kbn); } else { SWRITE_HK(0); } SBAR(); } while (0)
    f32x16 pA0, pA1, pB0, pB1; float mnA, mnB, alA, alB; bf16x8 pa0, pa1, pa2, pa3; bool deadA = false, deadB = false;
    if constexpr (F32) { VMW(); SWRITE_VF(0); SBAR(); } else { SWRITE_HV(0); SBAR(); }
    if (NT > 1) { if constexpr (F32) SLOAD_F((const float*)Kh, KBASE(1)); else SLOAD_H(Kh, Vh, cur.Fb, 1, KBASE(1)); }
    SBAR(); qkt<0, SK>(pA0, pA1, K_lds, r32, hi, S.qr, ACT(0));
    if constexpr (F32) { if (NT > 1) { VMW(); SWRITE_KF(1); SBAR(); SLOAD_F((const float*)Vh, KBASE(1)); } }
    MASKT(pA0, pA1, 0); partialSM(pA0, pA1, m_reg, mnA, alA, deadA);
    if (NT > 1) { VMW(); if constexpr (F32) { SWRITE_VF(1); SBAR(); if (NT > 2) SLOAD_F((const float*)Kh, KBASE(2)); } else SWRITE_H(1); }
    __syncthreads();
#define HALF_STEP(PX0, PX1, mnX, alX, deadX, PY0, PY1, alY, deadY, t, KB, VB, SB) do {                                                      \
        SBAR(); qkt<KB, SK>(PX0, PX1, K_lds, r32, hi, S.qr, ACT(t));                                             \
        if (!deadY) finishSM(PY0, PY1, alY, l_reg, pa0, pa1, pa2, pa3); SBAR();                                               \
        if ((t) + 1 < NT) { if constexpr (F32) { VMW(); SWRITE_KF(SB); SBAR(); SLOAD_F((const float*)Vh, KBASE((t) + 1)); }  \
                            else { SLOAD_H(Kh, Vh, cur.Fb, SB, KBASE((t) + 1)); } SBAR(); }                                               \
        pv_tile<VB, SK>(o, vb0, pa0, pa1, pa2, pa3, ACT((t) - 1) && !deadY); MASKT(PX0, PX1, (t)); partialSM(PX0, PX1, m_reg, mnX, alX, deadX);                                        \
        __syncthreads();                                                                                                      \
        if ((t) + 1 < NT) { VMW(); if constexpr (F32) { SWRITE_VF(SB); SBAR(); if ((t) + 2 < NT) SLOAD_F((const float*)Kh, KBASE((t) + 2)); } \
                            else { SWRITE_H(SB); } }                                                                          \
        RESC(alX); __syncthreads(); } while (0)
    for (int t = 1; t + 1 < NT; t += 2) {
        HALF_STEP(pB0, pB1, mnB, alB, deadB, pA0, pA1, alA, deadA, t, 1, 0, 0);
        HALF_STEP(pA0, pA1, mnA, alA, deadA, pB0, pB1, alB, deadB, t + 1, 0, 1, 1);
    }
    const bool even = (NT & 1) == 0;
    if (even) { SBAR(); qkt<1, SK>(pB0, pB1, K_lds, r32, hi, S.qr, ACT(NT - 1)); SBAR(); }
#define QROW(e) (nxt.Q + (size_t)(wid * QBLK + r32) * PITCH + ((e) >> 1) * 16 + hi * 8 + ((e) & 1) * 4)
    if constexpr (F32) { SLOAD_F((const float*)nxt.K, kbn); SBAR();
#pragma unroll
        for (int e = 0; e < 8; ++e) S.tq[e] = *(const f32x4*)QROW(e); }
    else { SLOAD_H(nxt.K, nxt.V, nxt.Fb, 0, kbn); SBAR();
#pragma unroll
        for (int d0 = 0; d0 < 8; ++d0) S.qr[d0] = load8<TIn>(nxt.Q + (size_t)(wid * QBLK + r32) * PITCH + d0 * 16 + hi * 8); }
    SBAR();
    if (!deadA) finishSM(pA0, pA1, alA, l_reg, pa0, pa1, pa2, pa3); SBAR();
    if constexpr (F32) {
#pragma unroll
        for (int e = 8; e < 16; ++e) S.tq[e] = *(const f32x4*)QROW(e); SBAR(); }
#undef QROW
    pv_tile<0, SK>(o, vb0, pa0, pa1, pa2, pa3, ACT(even ? NT - 2 : NT - 1) && !deadA);
    if (even) { MASKT(pB0, pB1, NT - 1); partialSM(pB0, pB1, m_reg, mnB, alB, deadB); __syncthreads(); RESC(alB);
        if (!deadB) finishSM(pB0, pB1, alB, l_reg, pa0, pa1, pa2, pa3); SBAR(); pv_tile<1, SK>(o, vb0, pa0, pa1, pa2, pa3, ACT(NT - 1) && !deadB); }
    SBAR(); SEAM_K0();
    if (hi == 0) li_l[r32] = l_reg; asm volatile("s_waitcnt lgkmcnt(0)" ::: "memory");
    float rli[16];
#pragma unroll
    for (int r = 0; r < 16; ++r) rli[r] = __builtin_amdgcn_rcpf(li_l[crow(r, hi)]);
    TOut* Ow = cur.O + (size_t)(wid * QBLK) * PITCH;
#pragma unroll
    for (int r = 0; r < 16; ++r) { const int orow = crow(r, hi);
#pragma unroll
        for (int d0 = 0; d0 < 4; ++d0) { const float v = o[d0][r] * rli[r];
            if constexpr (same_t<TOut, float>::v) { Ow[(size_t)orow * PITCH + d0 * 32 + r32] = v; }
            else if constexpr (O_FP8) { const float vs = fminf(fmaxf(v * O8_SCALE, -440.f), 440.f), t1 = __shfl_xor(vs, 1), t2 = __shfl_xor(vs, 2), t3 = __shfl_xor(t1, 2);
                   unsigned w8 = 0u; w8 = __builtin_amdgcn_cvt_pk_fp8_f32(vs, t1, w8, false); w8 = __builtin_amdgcn_cvt_pk_fp8_f32(t2, t3, w8, true);
                   if ((r32 & 3) == 0) *(unsigned*)(cur.O8 + (size_t)(wid * QBLK + orow) * PITCH + d0 * 32 + r32) = w8; }
            else { const float vn = __shfl_xor(v, 1);
                   if ((r32 & 1) == 0) *(unsigned*)(Ow + (size_t)orow * PITCH + d0 * 32 + r32) = cvtpk(v, vn); } } }
    if constexpr (F32) {
#pragma unroll
        for (int d0 = 0; d0 < 8; ++d0) S.qr[d0] = pack8(S.tq[2 * d0], S.tq[2 * d0 + 1]); }
    __syncthreads();
#undef RESC
#undef KBASE
#undef ACT
#undef MASKT
#undef SEAM_K0
#undef HALF_STEP
}
#undef ROW
#undef VMW
#undef VMWN
#undef SLOAD_H
#undef SWRITE_HK
#undef SWRITE_HV
#undef SWRITE_H
#undef SLOAD_F
#undef SWRITE_KF
#undef SWRITE_VF


enum { ORDER_NATURAL = 0, ORDER_REVERSED = 1, ORDER_PAIRED = 2, ORDER_XCD = 4 };
__host__ __device__ inline int swa_nramp(int nqb, int W, int qoff) { const int t = W - 1 - qoff; const int n = t < 0 ? 0 : t / QB + 1; return n > nqb ? nqb : n; }
__host__ __device__ inline int swa_nx(int nqb, int nramp, int order) { return (order & ORDER_PAIRED) ? (nramp + 1) / 2 + (nqb - nramp) : nqb; }
struct SwaItem { int bh, qb0, qb1; };
__device__ __forceinline__ SwaItem swa_decode(int L, int nb, int nh, int nhkv, int nqb, int nx, int nramp, int order) {
    const int G = nh / nhkv; SwaItem it; int x;
    if ((order & ORDER_XCD) && (nb * nhkv) % 8 == 0) { const int xcd = L & 7, k = L >> 3, per = G * nx, gi = k / per, r = k - gi * per;
        it.bh = (gi * 8 + xcd) * G + r / nx; x = r % nx; }
    else { it.bh = L / nx; x = L - it.bh * nx; }
    if (order & ORDER_PAIRED) { const int ns = nqb - nramp;
        if (x < ns) { it.qb0 = it.qb1 = nqb - 1 - x; } else { it.qb0 = x - ns; it.qb1 = nramp - 1 - it.qb0; } }
    else { it.qb0 = it.qb1 = ((order & 3) == ORDER_REVERSED) ? nqb - 1 - x : x; }
    return it;
}

}

namespace pg8 {
struct ListOrder {
    int pm0, n;
    __device__ bool next(int i, Unit& u) const { if (i >= n) return false; u.pm = pm0 + i; u.pn = 0; return true; }
    __device__ __forceinline__ void a_ready(const Unit&) const {}
    __device__ __forceinline__ void done(const Unit&) const {}
};
struct EpiScaleBf16 {
    static constexpr bool PERM = true, AFTER_DRAIN = false;
    unsigned char* O; int ldc; const float* colscale; float os;
    __device__ __forceinline__ void operator()(const f32x4 (&acc)[2][2][4][2], const Unit& u, int wr, int wc, int fr, int fq) const {
        const int row0 = u.pm * BM + wr * 64 + fr; int col0 = u.pn * BM + wc * 32 + 8 * fq; asm volatile("" : "+v"(col0));
        f32x4 sv[2][2];
#pragma unroll
        for (int bj = 0; bj < 2; ++bj)
#pragma unroll
            for (int n = 0; n < 2; ++n) sv[bj][n] = *(const f32x4*)(colscale + col0 + bj * HALF + 4 * n) * os;
#pragma unroll
        for (int ai = 0; ai < 2; ++ai)
#pragma unroll
            for (int m = 0; m < 4; ++m) { unsigned char* rowp = O + (size_t)(row0 + ai * HALF + m * 16) * ldc + col0;
#pragma unroll
                for (int bj = 0; bj < 2; ++bj) { const f32x4 v0 = acc[ai][bj][m][0] * sv[bj][0], v1 = acc[ai][bj][m][1] * sv[bj][1];
                    unsigned w0 = 0u, w1 = 0u;
                    w0 = __builtin_amdgcn_cvt_pk_fp8_f32(fminf(fmaxf(v0[0], -440.f), 440.f), fminf(fmaxf(v0[1], -440.f), 440.f), w0, false); w0 = __builtin_amdgcn_cvt_pk_fp8_f32(fminf(fmaxf(v0[2], -440.f), 440.f), fminf(fmaxf(v0[3], -440.f), 440.f), w0, true);
                    w1 = __builtin_amdgcn_cvt_pk_fp8_f32(fminf(fmaxf(v1[0], -440.f), 440.f), fminf(fmaxf(v1[1], -440.f), 440.f), w1, false); w1 = __builtin_amdgcn_cvt_pk_fp8_f32(fminf(fmaxf(v1[2], -440.f), 440.f), fminf(fmaxf(v1[3], -440.f), 440.f), w1, true);
                    typedef unsigned u32x2_ __attribute__((ext_vector_type(2))); *(u32x2_*)(rowp + bj * HALF) = (u32x2_){w0, w1}; } }
    }
};
struct EpiRowScaleBf16 {
    static constexpr bool PERM = true, AFTER_DRAIN = false;
    bf16_t* O; int ldc; const float* rs; float cs; int split_cols; size_t split_stride;
    __device__ __forceinline__ void operator()(const f32x4 (&acc)[2][2][4][2], const Unit& u, int wr, int wc, int fr, int fq) const {
        int ln_; asm volatile("v_mbcnt_lo_u32_b32 %0, -1, 0\n\tv_mbcnt_hi_u32_b32 %0, -1, %0" : "=v"(ln_));
        (void)fr; (void)fq; const int row0 = u.pm * BM + wr * 64 + (ln_ & 15); int colt = u.pn * BM; bf16_t* base = O;
        if (split_cols) { const int t = colt / split_cols; base += (size_t)t * split_stride; colt -= t * split_cols; }
        const int col0 = colt + wc * 32 + 8 * (ln_ >> 4);
#pragma unroll
        for (int ai = 0; ai < 2; ++ai)
#pragma unroll
            for (int m = 0; m < 4; ++m) { const int row = row0 + ai * HALF + m * 16; const float sc = rs ? rs[row] * cs : cs; bf16_t* rowp = base + (size_t)row * ldc + col0;
#pragma unroll
                for (int bj = 0; bj < 2; ++bj) { const f32x4 v0 = acc[ai][bj][m][0] * sc, v1 = acc[ai][bj][m][1] * sc;
                    u32x4 w; w.x = cvt_pk_bf16(v0[0], v0[1]); w.y = cvt_pk_bf16(v0[2], v0[3]); w.z = cvt_pk_bf16(v1[0], v1[1]); w.w = cvt_pk_bf16(v1[2], v1[3]);
                    *(u32x4*)(rowp + bj * HALF) = w; } }
    }
};
struct EpiI8RowScaleBf16 {
    static constexpr bool PERM = true, AFTER_DRAIN = false;
    bf16_t* O; int ldc; const float* rs; float cs; int split_cols; size_t split_stride;
    __device__ __forceinline__ void operator()(const f32x4 (&acc)[2][2][4][2], const Unit& u, int wr, int wc, int fr, int fq) const {
        int ln_; asm volatile("v_mbcnt_lo_u32_b32 %0, -1, 0\n\tv_mbcnt_hi_u32_b32 %0, -1, %0" : "=v"(ln_));
        (void)fr; (void)fq; const int row0 = u.pm * BM + wr * 64 + (ln_ & 15); int colt = u.pn * BM; bf16_t* base = O;
        if (split_cols) { const int t = colt / split_cols; base += (size_t)t * split_stride; colt -= t * split_cols; }
        const int col0 = colt + wc * 32 + 8 * (ln_ >> 4);
#pragma unroll
        for (int ai = 0; ai < 2; ++ai)
#pragma unroll
            for (int m = 0; m < 4; ++m) { const int row = row0 + ai * HALF + m * 16; const float sc = rs[row] * cs; bf16_t* rowp = base + (size_t)row * ldc + col0;
#pragma unroll
                for (int bj = 0; bj < 2; ++bj) { typedef int i32x4_ __attribute__((ext_vector_type(4))); const i32x4_ i0 = __builtin_bit_cast(i32x4_, acc[ai][bj][m][0]), i1 = __builtin_bit_cast(i32x4_, acc[ai][bj][m][1]);
                    u32x4 w; w.x = cvt_pk_bf16((float)i0[0] * sc, (float)i0[1] * sc); w.y = cvt_pk_bf16((float)i0[2] * sc, (float)i0[3] * sc); w.z = cvt_pk_bf16((float)i1[0] * sc, (float)i1[1] * sc); w.w = cvt_pk_bf16((float)i1[2] * sc, (float)i1[3] * sc);
                    *(u32x4*)(rowp + bj * HALF) = w; } }
    }
};
struct EpiGate {
    static constexpr bool PERM = false, AFTER_DRAIN = false;
    const bf16_t* XC; float* AF; float* DF; const float* b_a; const float* b_x; const float* ls8; int cbase;
    __device__ __forceinline__ void operator()(const f32x4 (&acc)[2][2][4][2], const Unit& u, int wr, int wc, int fr, int fq) const {
        const unsigned row0 = (unsigned)(u.pm * BM + wr * 64 + fr);
#pragma unroll
        for (int n = 0; n < 2; ++n) { unsigned c = (unsigned)(cbase + wc * 32 + 16 * n + 4 * fq); asm volatile("" : "+v"(c));
            const f32x4 ba = *(const f32x4*)(b_a + c), bx = *(const f32x4*)(b_x + c), l8 = *(const f32x4*)(ls8 + c) * 1.4426950408889634f;
#pragma unroll
            for (int ai = 0; ai < 2; ++ai)
#pragma unroll
                for (int m = 0; m < 4; ++m) { const unsigned off = (row0 + ai * HALF + m * 16) * 1024u + c;
                    const f32x4 pr = acc[ai][0][m][n] + ba, pi = acc[ai][1][m][n] + bx;
                    const uint2 xr = *(const uint2*)((const char*)XC + off * 2u);
                    const float xc[4] = {__uint_as_float(xr.x << 16), __uint_as_float(xr.x & 0xffff0000u), __uint_as_float(xr.y << 16), __uint_as_float(xr.y & 0xffff0000u)};
                    u32x4 pw;
#pragma unroll
                    for (int e = 0; e < 4; ++e) { const float r = __builtin_amdgcn_rcpf(1.f + __builtin_amdgcn_exp2f(-1.4426950408889634f * pr[e])), ig = __builtin_amdgcn_rcpf(1.f + __builtin_amdgcn_exp2f(-1.4426950408889634f * pi[e]));
                        const float la = r * l8[e]; const float a = __builtin_amdgcn_exp2f(la); const float mult = __builtin_amdgcn_sqrtf(fmaxf(1.f - a * a, 0.f)); pw[e] = cvt_pk_bf16(la, mult * ig * xc[e]); }
                    *(u32x4*)((char*)AF + off * 4u) = pw; asm volatile("" ::: "memory"); } }
    }
};
}

#define LAS __attribute__((address_space(3)))
typedef unsigned short bf16;
typedef unsigned v4u __attribute__((ext_vector_type(4)));
typedef unsigned v2u __attribute__((ext_vector_type(2)));
typedef float f32x4 __attribute__((ext_vector_type(4)));
typedef float f32x16 __attribute__((ext_vector_type(16)));
typedef short bf16x8 __attribute__((ext_vector_type(8)));

constexpr int NTHREADS = 512, NWAVES = 8;
constexpr int LDS_BYTES = 155648 + 256, LDS_CTL = 155648;
constexpr int BATCH = 2, SEQ = 8192, DM = 2048, M = BATCH * SEQ, NEXP = 16384;
constexpr int NZ = 3072, NQKV = 6144, NODIN = 6160;
constexpr int ROW6 = 1536;
constexpr bool V_FP4 = true;
constexpr int ROWV = V_FP4 ? 1024 : ROW6;
constexpr int ROW4 = 1024;
constexpr float ALPHA = 1.4142135623730951f, LN_EPS = 1e-5f;
constexpr float ATT_SCALE = 0.08838834764831845f;

constexpr size_t MiB = 1u << 20;
constexpr size_t WS_MOD = 1 * MiB;
constexpr size_t WS_LS8 = 1 * MiB + 512 * 1024;
constexpr size_t WS_WIN = 2 * MiB, WS_WOUT = 14 * MiB, WS_WQKV = 22 * MiB, WS_WO = 46 * MiB, WS_WQ0 = 54 * MiB, WS_WQ1 = 62 * MiB;
constexpr size_t WS_KEYS = 70 * MiB, WS_WPOOL = 71 * MiB, WS_WAX = 71 * MiB + 512 * 1024, WS_WF = 72 * MiB;
constexpr size_t WS_FE = 77 * MiB, WS_FP = 77 * MiB + 64 * 1024, WS_KN = 77 * MiB + 128 * 1024, WS_QN = 77 * MiB + 192 * 1024, WS_DN = 77 * MiB + 256 * 1024;
constexpr size_t WS_AG = 73 * MiB, WS_HG = 73 * MiB + 512 * 1024, WS_LF = 74 * MiB, WS_FB = 75 * MiB;
constexpr size_t WS_SU = 76 * MiB, WS_SV = 76 * MiB + 128 * 1024;
constexpr size_t WS_HB8 = 208 * MiB, WS_SA = 79 * MiB;
constexpr float YP_SCALE = 64.f;
constexpr float W8O_SCALE = 2048.f, Y8_SCALE = 16.f;
constexpr size_t WS_YC8 = 240 * MiB;
constexpr float W8_SCALE = 1024.f;
constexpr size_t WS_PART = 400 * MiB;
constexpr size_t WS_AR = 496 * MiB, WS_EQ = 500 * MiB;
constexpr size_t WS_Y = 592 * MiB;
constexpr size_t WS_H6 = 752 * MiB, WS_HS = 785 * MiB;
constexpr size_t WS_TU = 80 * MiB, WS_TV = 144 * MiB;
constexpr size_t WS_HB = 336 * MiB, WS_ZB = 400 * MiB, WS_YC = 592 * MiB, WS_YB = 656 * MiB, WS_X1 = 720 * MiB, WS_H2 = 848 * MiB, WS_QP = 912 * MiB;
constexpr size_t WS_EI = 976 * MiB, WS_GT = 984 * MiB, WS_END = 992 * MiB;
constexpr size_t WS_AF = WS_H2, WS_DF = WS_QP;
constexpr size_t WS_PO = WS_YB, WS_XC = WS_YB + 32 * MiB;

struct Args { const float* in[24]; float* out; unsigned char* ws; int ph_lo, ph_hi; };

__device__ __forceinline__ float bf_lo(unsigned u) { return __uint_as_float(u << 16); }
__device__ __forceinline__ float bf_hi(unsigned u) { return __uint_as_float(u & 0xffff0000u); }
__device__ __forceinline__ unsigned pk2(float lo, float hi) { return pg8::cvt_pk_bf16(lo, hi); }
__device__ __forceinline__ unsigned pk2c(float lo, float hi) { typedef float f2_ __attribute__((ext_vector_type(2))); typedef __bf16 b2_ __attribute__((ext_vector_type(2))); const f2_ f = {lo, hi}; return __builtin_bit_cast(unsigned, __builtin_convertvector(f, b2_)); }
#define SWZ_XOR_(v, m) __uint_as_float((unsigned)__builtin_amdgcn_ds_swizzle((int)__float_as_uint(v), ((m) << 10) | 0x1f))
__device__ __forceinline__ float wave_sum(float v) {
    v += SWZ_XOR_(v, 1); v += SWZ_XOR_(v, 2); v += SWZ_XOR_(v, 4); v += SWZ_XOR_(v, 8); v += SWZ_XOR_(v, 16);
    const auto rr = __builtin_amdgcn_permlane32_swap(__float_as_uint(v), __float_as_uint(v), false, false);
    return __uint_as_float(rr[0]) + __uint_as_float(rr[1]);
}
__device__ __forceinline__ float wave_max(float v) {
    v = fmaxf(v, SWZ_XOR_(v, 1)); v = fmaxf(v, SWZ_XOR_(v, 2)); v = fmaxf(v, SWZ_XOR_(v, 4)); v = fmaxf(v, SWZ_XOR_(v, 8)); v = fmaxf(v, SWZ_XOR_(v, 16));
    const auto rr = __builtin_amdgcn_permlane32_swap(__float_as_uint(v), __float_as_uint(v), false, false);
    return fmaxf(__uint_as_float(rr[0]), __uint_as_float(rr[1]));
}
__device__ __forceinline__ float gelu_tanh(float x) { const float y = 0.7978845608028654f * (x + 0.044715f * x * x * x); return x * __builtin_amdgcn_rcpf(1.f + __builtin_amdgcn_exp2f(-2.8853900817779268f * y)); }
#define LDS_WAIT() asm volatile("s_waitcnt lgkmcnt(0)" ::: "memory")
__device__ __forceinline__ int lane_id() { int l; asm volatile("v_mbcnt_lo_u32_b32 %0, -1, 0\n\tv_mbcnt_hi_u32_b32 %0, -1, %0" : "=v"(l)); return l; }


#define XB_TMO      128
#define XB_XCNT(j)  (256  + 64 * (j))
#define XB_XSUB(j)  (1280 + 64 * (j))
#define XB_XGEN(j)  (2304 + 64 * (j))
#define XB_TOP      3328
#define XB_TOPGEN   3392
#define XCD_BAR_WORDS 3456
#define XB_SPIN_CAP (1u << 22)
__device__ __forceinline__ unsigned xb_ld(unsigned* p)              { return __hip_atomic_load(p, __ATOMIC_RELAXED, __HIP_MEMORY_SCOPE_AGENT); }
__device__ __forceinline__ unsigned xb_add(unsigned* p, unsigned v) { return __hip_atomic_fetch_add(p, v, __ATOMIC_RELAXED, __HIP_MEMORY_SCOPE_AGENT); }
__device__ __forceinline__ unsigned xb_xcc_id() { return (unsigned)__builtin_amdgcn_s_getreg((3 << 11) | 20) & 0xFu; }
#define XB_SPIN(cond, bar) do { unsigned _sp = 0; while (cond) { __builtin_amdgcn_s_sleep(1); \
    if ((++_sp & 255u) == 0u) { if (xb_ld(&(bar)[XB_TMO])) break; if (_sp > XB_SPIN_CAP) { atomicAdd(&(bar)[XB_TMO], 1u); break; } } } } while (0)
struct XcdBarrier { unsigned* bar; unsigned x; volatile LAS unsigned* st; };
__device__ __forceinline__ XcdBarrier xcd_barrier_post(unsigned* bar, volatile LAS unsigned* st, bool t0) {
    XcdBarrier b; b.bar = bar; b.x = xb_xcc_id(); b.st = st;
    if (t0) { st[2] = xb_add(&bar[XB_XCNT(b.x)], 1u); st[3] = b.x; }
    return b;
}
__device__ __forceinline__ void xcd_barrier_complete(unsigned* bar, unsigned x, unsigned& nloc, unsigned& nx, unsigned& uni) {
    const unsigned G = gridDim.x * gridDim.y * gridDim.z;
    unsigned sum, cnt, mine, sp = 0u;
    for (;;) {
        sum = 0u; cnt = 0u; mine = 0u; uni = (G & 7u) == 0u ? 1u : 0u;
#pragma unroll
        for (unsigned j = 0; j < 16; ++j) { const unsigned c = xb_ld(&bar[XB_XCNT(j)]); sum += c; cnt += (c > 0u) ? 1u : 0u; mine = (j == x) ? c : mine; uni = (c == (j < 8u ? (G >> 3) : 0u)) ? uni : 0u; }
        if (sum == G) break;
        __builtin_amdgcn_s_sleep(1);
        if ((++sp & 255u) == 0u) { if (xb_ld(&bar[XB_TMO])) break; if (sp > XB_SPIN_CAP) { atomicAdd(&bar[XB_TMO], 1u); break; } }
    }
    nloc = mine > 0u ? mine : 1u; nx = cnt > 0u ? cnt : 1u;
}
__device__ __forceinline__ void xcd_barrier(const XcdBarrier& b, bool t0) {
    asm volatile("s_waitcnt vmcnt(0)" ::: "memory");
    __syncthreads();
    if (t0) {
        unsigned* bar = b.bar;
        __builtin_amdgcn_s_waitcnt(0);
        unsigned nloc = b.st[0], nx = b.st[1];
        if (nloc == 0u) { unsigned uni; xcd_barrier_complete(bar, b.x, nloc, nx, uni); b.st[0] = nloc; b.st[1] = nx; b.st[4] = uni; }
        const unsigned old = xb_add(&bar[XB_XSUB(b.x)], 1u);
        const unsigned gen = old / nloc;
        if (old + 1u == (gen + 1u) * nloc) {
            __builtin_amdgcn_fence(__ATOMIC_RELEASE, "agent");
            asm volatile("s_waitcnt vmcnt(0)" ::: "memory");
            const unsigned og = xb_add(&bar[XB_TOP], 1u);
            const unsigned tg = og / nx;
            if (og + 1u == (tg + 1u) * nx) xb_add(&bar[XB_TOPGEN], 1u);
            else XB_SPIN(xb_ld(&bar[XB_TOPGEN]) == tg, bar);
            __builtin_amdgcn_fence(__ATOMIC_ACQUIRE, "agent");
            xb_add(&bar[XB_XGEN(b.x)], 1u);
            asm volatile("s_waitcnt vmcnt(0)" ::: "memory");
        } else {
            XB_SPIN(xb_ld(&bar[XB_XGEN(b.x)]) == gen, bar);
            __builtin_amdgcn_fence(__ATOMIC_ACQUIRE, "agent");
            asm volatile("s_waitcnt vmcnt(0)" ::: "memory");
        }
    }
    __syncthreads();
}

__device__ __forceinline__ void transpose_item(const float* W, int ldw, int nblk, bf16* WT, int K, LAS float* scr, int item, int lane) {
    const int kb = item / nblk, nb = item % nblk, k0 = 64 * kb, n0 = 32 * nb;
#pragma unroll 8
    for (int i = 0; i < 32; ++i) { const int kk = 2 * i + (lane >> 5); scr[kk * 33 + (lane & 31)] = W[(size_t)(k0 + kk) * ldw + n0 + (lane & 31)]; }
    LDS_WAIT(); asm volatile("" ::: "memory");
    const int c = lane & 7;
#pragma unroll
    for (int j = 0; j < 4; ++j) { const int n = (lane >> 3) + 8 * j; const LAS float* s = scr + (8 * c) * 33 + n;
        v4u o; o.x = pk2(s[0 * 33], s[1 * 33]); o.y = pk2(s[2 * 33], s[3 * 33]); o.z = pk2(s[4 * 33], s[5 * 33]); o.w = pk2(s[6 * 33], s[7 * 33]);
        *(v4u*)(WT + (size_t)(n0 + n) * K + k0 + 8 * c) = o; }
    LDS_WAIT(); asm volatile("" ::: "memory");
}
__device__ __forceinline__ unsigned pk4_i8(float a, float b, float c, float d) {
    const int ia = (int)rintf(fminf(fmaxf(a, -127.f), 127.f)), ib = (int)rintf(fminf(fmaxf(b, -127.f), 127.f)), ic = (int)rintf(fminf(fmaxf(c, -127.f), 127.f)), id = (int)rintf(fminf(fmaxf(d, -127.f), 127.f));
    return ((unsigned)ia & 0xffu) | (((unsigned)ib & 0xffu) << 8) | (((unsigned)ic & 0xffu) << 16) | ((unsigned)id << 24);
}
__device__ __forceinline__ void transpose_item_i8(const float* W, int ldw, int nblk, unsigned char* WT, int K, LAS float* scr, int item, int lane, float wscale) {
    const int kb = item / nblk, nb = item % nblk, k0 = 64 * kb, n0 = 32 * nb;
#pragma unroll 8
    for (int i = 0; i < 32; ++i) { const int kk = 2 * i + (lane >> 5); scr[kk * 33 + (lane & 31)] = W[(size_t)(k0 + kk) * ldw + n0 + (lane & 31)] * wscale; }
    LDS_WAIT(); asm volatile("" ::: "memory");
    const int c = lane & 7;
#pragma unroll
    for (int j = 0; j < 4; ++j) { const int n = (lane >> 3) + 8 * j; const LAS float* sp = scr + (8 * c) * 33 + n;
        *(v2u*)(WT + (size_t)(n0 + n) * K + k0 + 8 * c) = (v2u){pk4_i8(sp[0 * 33], sp[1 * 33], sp[2 * 33], sp[3 * 33]), pk4_i8(sp[4 * 33], sp[5 * 33], sp[6 * 33], sp[7 * 33])}; }
    LDS_WAIT(); asm volatile("" ::: "memory");
}
__device__ __forceinline__ float cl8(float x) { return fminf(fmaxf(x, -440.f), 440.f); }
__device__ __forceinline__ unsigned pk4_fp8(float a, float b, float c, float d) { unsigned w = 0u; w = __builtin_amdgcn_cvt_pk_fp8_f32(cl8(a), cl8(b), w, false); w = __builtin_amdgcn_cvt_pk_fp8_f32(cl8(c), cl8(d), w, true); return w; }
__device__ __forceinline__ void transpose_item8(const float* W, int ldw, int nblk, unsigned char* WT, int K, LAS float* scr, int item, int lane, float wscale = W8_SCALE) {
    const int kb = item / nblk, nb = item % nblk, k0 = 64 * kb, n0 = 32 * nb;
#pragma unroll 8
    for (int i = 0; i < 32; ++i) { const int kk = 2 * i + (lane >> 5); scr[kk * 33 + (lane & 31)] = W[(size_t)(k0 + kk) * ldw + n0 + (lane & 31)] * wscale; }
    LDS_WAIT(); asm volatile("" ::: "memory");
    const int c = lane & 7;
#pragma unroll
    for (int j = 0; j < 4; ++j) { const int n = (lane >> 3) + 8 * j; const LAS float* sp = scr + (8 * c) * 33 + n; unsigned w0 = 0u, w1 = 0u;
        w0 = __builtin_amdgcn_cvt_pk_fp8_f32(cl8(sp[0 * 33]), cl8(sp[1 * 33]), w0, false); w0 = __builtin_amdgcn_cvt_pk_fp8_f32(cl8(sp[2 * 33]), cl8(sp[3 * 33]), w0, true);
        w1 = __builtin_amdgcn_cvt_pk_fp8_f32(cl8(sp[4 * 33]), cl8(sp[5 * 33]), w1, false); w1 = __builtin_amdgcn_cvt_pk_fp8_f32(cl8(sp[6 * 33]), cl8(sp[7 * 33]), w1, true);
        *(v2u*)(WT + (size_t)(n0 + n) * K + k0 + 8 * c) = (v2u){w0, w1}; }
    LDS_WAIT(); asm volatile("" ::: "memory");
}
__device__ __forceinline__ void convert_item(const float* src, bf16* dst, size_t item, int lane) {
    const size_t base = item * 4096 + (size_t)lane * 8;
#pragma unroll
    for (int j = 0; j < 8; ++j) { const f32x4 a = *(const f32x4*)(src + base + j * 512), b = *(const f32x4*)(src + base + j * 512 + 4);
        v4u o; o.x = pk2(a[0], a[1]); o.y = pk2(a[2], a[3]); o.z = pk2(b[0], b[1]); o.w = pk2(b[2], b[3]);
        *(v4u*)(dst + base + j * 512) = o; }
}
__device__ __forceinline__ void fp8_row_item(const float* src, unsigned char* dst, float* scale, int row, int lane) {
    const float* p = src + (size_t)row * DM + 4 * lane; f32x4 v[8]; float mx = 0.f;
#pragma unroll
    for (int j = 0; j < 8; ++j) { v[j] = *(const f32x4*)(p + 256 * j); mx = fmaxf(mx, fmaxf(fmaxf(fabsf(v[j][0]), fabsf(v[j][1])), fmaxf(fabsf(v[j][2]), fabsf(v[j][3])))); }
    mx = fmaxf(wave_max(mx), 1e-30f); const float inv = 240.f / mx;
    unsigned* q = (unsigned*)(dst + (size_t)row * DM) + lane;
#pragma unroll
    for (int j = 0; j < 8; ++j) { unsigned w = 0u; w = __builtin_amdgcn_cvt_pk_fp8_f32(v[j][0] * inv, v[j][1] * inv, w, false); w = __builtin_amdgcn_cvt_pk_fp8_f32(v[j][2] * inv, v[j][3] * inv, w, true); q[64 * j] = w; }
    if (lane == 0) scale[row] = mx * (1.f / 240.f);
}
typedef float f32x16_t __attribute__((ext_vector_type(16)));
typedef float f32x32_t __attribute__((ext_vector_type(32)));
typedef unsigned u32x6_t __attribute__((ext_vector_type(6)));
typedef unsigned u32x3_t __attribute__((ext_vector_type(3)));
__device__ __forceinline__ void fp6_pack_block(const float (&v)[32], u32x6_t& p, unsigned& ebyte) {
    float mx = 0.f;
#pragma unroll
    for (int i = 0; i < 32; ++i) mx = fmaxf(mx, fabsf(v[i]));
    int ex = (int)((__float_as_uint(mx * (1.f / 7.5f)) + 0x7fffffu) >> 23) - 127; ex = ex < -126 ? -126 : (ex > 127 ? 127 : ex);
    const float inv = __uint_as_float((unsigned)(127 - ex) << 23);
    f32x16_t a, b;
#pragma unroll
    for (int i = 0; i < 16; ++i) { a[i] = v[2 * i] * inv; b[i] = v[2 * i + 1] * inv; }
    p = __builtin_amdgcn_cvt_scalef32_2xpk16_fp6_f32(a, b, 1.0f); ebyte = (unsigned)(ex + 127);
}
__device__ __forceinline__ void fp6_row_item(const float* src, unsigned char* dst, float* sdst, int row, int lane) {
    const float* p = src + (size_t)row * DM + 4 * lane; float v[32]; float mx = 0.f;
#pragma unroll
    for (int j = 0; j < 8; ++j) { const f32x4 x = *(const f32x4*)(p + 256 * j); v[4 * j] = x[0]; v[4 * j + 1] = x[1]; v[4 * j + 2] = x[2]; v[4 * j + 3] = x[3]; }
#pragma unroll
    for (int i = 0; i < 32; ++i) mx = fmaxf(mx, fabsf(v[i]));
    mx = fmaxf(wave_max(mx), 1e-30f);
    const float inv = 7.5f / mx;
    f32x16_t a, b;
#pragma unroll
    for (int i = 0; i < 16; ++i) { a[i] = v[2 * i] * inv; b[i] = v[2 * i + 1] * inv; }
    const u32x6_t pk = __builtin_amdgcn_cvt_scalef32_2xpk16_fp6_f32(a, b, 1.0f);
    unsigned char* q = dst + (size_t)row * ROW6;
    *(v4u*)(q + 16 * lane) = (v4u){pk[0], pk[1], pk[2], pk[3]}; *(v2u*)(q + 1024 + 8 * lane) = (v2u){pk[4], pk[5]};
    if (lane == 0) sdst[row] = mx * (1.f / 7.5f);
}
template <bool VORD>
__device__ __forceinline__ void fp4_row_item(const float* src, unsigned char* dst, float* sdst, int row, int lane) {
    const float* p = src + (size_t)row * DM + (VORD ? 32 : 8) * lane; float v[32]; float ss = 0.f;
    if constexpr (VORD) {
#pragma unroll
        for (int j = 0; j < 8; ++j) { const f32x4 x = *(const f32x4*)(p + 4 * j); v[4 * j] = x[0]; v[4 * j + 1] = x[1]; v[4 * j + 2] = x[2]; v[4 * j + 3] = x[3]; } }
    else
#pragma unroll
    for (int j = 0; j < 4; ++j) { const f32x4 x = *(const f32x4*)(p + 512 * j), y = *(const f32x4*)(p + 512 * j + 4); v[8 * j] = x[0]; v[8 * j + 1] = x[1]; v[8 * j + 2] = x[2]; v[8 * j + 3] = x[3]; v[8 * j + 4] = y[0]; v[8 * j + 5] = y[1]; v[8 * j + 6] = y[2]; v[8 * j + 7] = y[3]; }
#pragma unroll
    for (int i = 0; i < 32; ++i) ss += v[i] * v[i];
    const float sc = fmaxf(0.5f * sqrtf(wave_sum(ss) * (1.f / DM)), 1e-30f), inv = 1.f / sc;
    unsigned w[4] = {0u, 0u, 0u, 0u};
#pragma unroll
    for (int d = 0; d < 4; ++d) {
        w[d] = __builtin_amdgcn_cvt_scalef32_pk_fp4_f32(w[d], v[8 * d] * inv, v[8 * d + 1] * inv, 1.0f, 0);
        w[d] = __builtin_amdgcn_cvt_scalef32_pk_fp4_f32(w[d], v[8 * d + 2] * inv, v[8 * d + 3] * inv, 1.0f, 1);
        w[d] = __builtin_amdgcn_cvt_scalef32_pk_fp4_f32(w[d], v[8 * d + 4] * inv, v[8 * d + 5] * inv, 1.0f, 2);
        w[d] = __builtin_amdgcn_cvt_scalef32_pk_fp4_f32(w[d], v[8 * d + 6] * inv, v[8 * d + 7] * inv, 1.0f, 3); }
    unsigned char* q = dst + (size_t)(row / NEXP) * NEXP * ROW4 + ((size_t)(lane >> 3) * NEXP + (size_t)(row % NEXP)) * 128 + 16 * (lane & 7);
    *(v4u*)q = (v4u){w[0], w[1], w[2], w[3]};
    if (lane == 0) sdst[row] = sc;
}
__device__ __forceinline__ void ph_prologue(const Args& a, LAS unsigned char* lds, int tid, int lane, int wave) {
    unsigned char* ws = a.ws;
    if (blockIdx.x < 192) {
        LAS float* cact = (LAS float*)lds;
        LAS float* red = (LAS float*)(lds + 16384);
        for (int i = tid; i < 2 * DM; i += NTHREADS) { const float cv = a.in[1][i]; cact[i] = cv / (1.f + __expf(-cv)); }
        __syncthreads();
        const int item = blockIdx.x, l = item / 96, col0 = (item % 96) * 128, rsub = lane >> 5, c4 = lane & 31;
        const float* W = a.in[2] + (size_t)l * DM * 12288 + col0 + 4 * c4;
        f32x4 acc0 = {0.f, 0.f, 0.f, 0.f}, acc1 = {0.f, 0.f, 0.f, 0.f};
#pragma unroll 8
        for (int i = 0; i < 128; ++i) { const int k = wave * 256 + 2 * i + rsub; const f32x4 w = *(const f32x4*)(W + (size_t)k * 12288);
            acc0 += w * cact[k]; acc1 += w * cact[DM + k]; }
#pragma unroll
        for (int e = 0; e < 4; ++e) { acc0[e] += __shfl_xor(acc0[e], 32); acc1[e] += __shfl_xor(acc1[e], 32); }
        if (rsub == 0) {
#pragma unroll
            for (int e = 0; e < 4; ++e) { red[(wave * 2 + 0) * 128 + 4 * c4 + e] = acc0[e]; red[(wave * 2 + 1) * 128 + 4 * c4 + e] = acc1[e]; } }
        __syncthreads();
        if (tid < 256) { const int b = tid >> 7, col = tid & 127; float s = 0.f;
#pragma unroll
            for (int w8 = 0; w8 < 8; ++w8) s += red[(w8 * 2 + b) * 128 + col];
            s += a.in[3][l * 12288 + col0 + col];
            ((float*)(ws + WS_MOD))[(size_t)(l * 2 + b) * 12288 + col0 + col] = s; }
        __syncthreads();
    }
    LAS float* scr = (LAS float*)(lds + wave * 16384);
    const int gw = blockIdx.x * NWAVES + wave, NGW = gridDim.x * NWAVES;
    constexpr int I_WIN = 32 * 96, I_SQ = 32 * 64, I_QKV = 32 * 192, I_POOL = 4 * 32, I_AX = 16 * 8, I_WF = 16, I_KEYS = 128, I_TAB = 2 * NEXP, I_LS = 1;
    constexpr int NITEMS = I_WIN + 4 * I_SQ + I_QKV + I_POOL + I_AX + I_WF + I_KEYS + 2 * I_TAB + I_LS;
    for (int it = gw; it < NITEMS; it += NGW) {
        int r = it;
        if (r < 2 * I_TAB) { if (r < I_TAB) fp4_row_item<false>(a.in[8], ws + WS_TU, (float*)(ws + WS_SU), r, lane); else if constexpr (V_FP4) fp4_row_item<true>(a.in[9], ws + WS_TV, (float*)(ws + WS_SV), r - I_TAB, lane); else fp6_row_item(a.in[9], ws + WS_TV, (float*)(ws + WS_SV), r - I_TAB, lane); continue; } r -= 2 * I_TAB;
        if (r < I_WIN) { transpose_item_i8(a.in[10], NZ, 96, ws + WS_WIN, DM, scr, r, lane, W8_SCALE); continue; } r -= I_WIN;
        if (r < I_SQ) { transpose_item8(a.in[20], DM, 64, ws + WS_WOUT, DM, scr, r, lane, W8O_SCALE); continue; } r -= I_SQ;
        if (r < I_QKV) { transpose_item8(a.in[21], NODIN, 192, ws + WS_WQKV, DM, scr, r, lane); continue; } r -= I_QKV;
        if (r < I_SQ) { transpose_item8(a.in[23], DM, 64, ws + WS_WO, DM, scr, r, lane, W8O_SCALE); continue; } r -= I_SQ;
        if (r < I_SQ) { transpose_item_i8(a.in[6], DM, 64, ws + WS_WQ0, DM, scr, r, lane, W8_SCALE); continue; } r -= I_SQ;
        if (r < I_SQ) { transpose_item_i8(a.in[6] + (size_t)DM * DM, DM, 64, ws + WS_WQ1, DM, scr, r, lane, W8_SCALE); continue; } r -= I_SQ;
        if (r < I_POOL) { const int g = r >> 5; transpose_item(a.in[11] + g * 65536, 256, 8, (bf16*)(ws + WS_WPOOL) + g * 65536, 256, scr, r & 31, lane); continue; } r -= I_POOL;
        if (r < I_AX) { const int h = r >> 4, which = (r >> 3) & 1;
            transpose_item(a.in[which ? 17 : 15] + h * 16384, 128, 4, (bf16*)(ws + WS_WAX) + h * 32768 + which * 16384, 128, scr, r & 7, lane); continue; } r -= I_AX;
        if (r < I_WF) { bf16* WF = (bf16*)(ws + WS_WF);
            for (int k = lane; k < DM; k += 64) { const float v = a.in[21][(size_t)k * NODIN + NQKV + r]; WF[r * DM + k] = (bf16)(pk2(v, v) & 0xffffu); } continue; } r -= I_WF;
        if (r < I_KEYS) { convert_item(a.in[7], (bf16*)(ws + WS_KEYS), (size_t)r, lane); continue; } r -= I_KEYS;
        { float* LS8 = (float*)(ws + WS_LS8);
            for (int cch = lane; cch < 1024; cch += 64) { const float x = a.in[19][cch]; LS8[cch] = 8.f * (fminf(x, 0.f) - log1pf(__expf(-fabsf(x)))); } }
    }
}

__device__ __forceinline__ void ph_modulate(const float* src, const float* mod_l  , int sh_off, int sc_off, bf16* dst, unsigned char* dst8, float* rs, int lane, int wave) {
    const int gw = blockIdx.x * NWAVES + wave, NGW = gridDim.x * NWAVES;
    int cur_b = -1; f32x4 scv[8], shv[8];
    for (int t = gw; t < M; t += NGW) {
        const int b = t >> 13;
        if (b != cur_b) { cur_b = b; const float* mb = mod_l + b * 12288;
#pragma unroll
            for (int j = 0; j < 8; ++j) { scv[j] = *(const f32x4*)(mb + sc_off + 4 * lane + 256 * j) + 1.f; shv[j] = *(const f32x4*)(mb + sh_off + 4 * lane + 256 * j); } }
        const float* xr = src + (size_t)t * DM + 4 * lane; bf16* dr = dst + (size_t)t * DM + 4 * lane; f32x4 v[8]; float mx = 0.f;
#pragma unroll
        for (int j = 0; j < 8; ++j) { v[j] = *(const f32x4*)(xr + 256 * j) * scv[j] + shv[j]; uint2 o; o.x = pk2(v[j][0], v[j][1]); o.y = pk2(v[j][2], v[j][3]); *(uint2*)(dr + 256 * j) = o;
            mx = fmaxf(mx, fmaxf(fmaxf(fabsf(v[j][0]), fabsf(v[j][1])), fmaxf(fabsf(v[j][2]), fabsf(v[j][3])))); }
        mx = fmaxf(wave_max(mx), 1e-30f); const float inv = 127.f / mx; unsigned* q8 = (unsigned*)(dst8 + (size_t)t * DM) + lane;
#pragma unroll
        for (int j = 0; j < 8; ++j) q8[64 * j] = pk4_i8(v[j][0] * inv, v[j][1] * inv, v[j][2] * inv, v[j][3] * inv);
        if (lane == 0) rs[t] = mx * (1.f / 127.f);
    }
}

__device__ __forceinline__ void ld8(const bf16* p, float (&v)[8]) { const v4u u = *(const v4u*)p; v[0] = bf_lo(u.x); v[1] = bf_hi(u.x); v[2] = bf_lo(u.y); v[3] = bf_hi(u.y); v[4] = bf_lo(u.z); v[5] = bf_hi(u.z); v[6] = bf_lo(u.w); v[7] = bf_hi(u.w); }
__device__ __forceinline__ void st8(bf16* p, const float (&v)[8]) { v4u o; o.x = pk2(v[0], v[1]); o.y = pk2(v[2], v[3]); o.z = pk2(v[4], v[5]); o.w = pk2(v[6], v[7]); *(v4u*)p = o; }
__device__ __forceinline__ void ph_poolconv(const Args& a, int lane, int wave) {
    const bf16* Z = (const bf16*)(a.ws + WS_ZB); bf16* PO = (bf16*)(a.ws + WS_PO); bf16* XC = (bf16*)(a.ws + WS_XC);
    const int gw = blockIdx.x * NWAVES + wave, NGW = gridDim.x * NWAVES;
    for (int item = gw; item < 2048; item += NGW) {
        const int which = item & 3, t0 = (item >> 2) * 32, pos0 = t0 & (SEQ - 1);
        if (which < 2) {
            const int c = which * 512 + lane * 8, w = 2 << (c >> 8);
            float sum[8] = {0.f, 0.f, 0.f, 0.f, 0.f, 0.f, 0.f, 0.f};
            for (int s = 1; s < 16; ++s) if (s < w && pos0 - s >= 0) { float v[8]; ld8(Z + (size_t)(t0 - s) * NZ + c, v);
#pragma unroll
                for (int e = 0; e < 8; ++e) sum[e] += v[e]; }
            for (int i = 0; i < 32; ++i) { const int t = t0 + i, pos = pos0 + i; float cur[8], o[8]; ld8(Z + (size_t)t * NZ + c, cur);
                const float inv = 1.f / (float)(pos + 1 < w ? pos + 1 : w);
#pragma unroll
                for (int e = 0; e < 8; ++e) { sum[e] += cur[e]; o[e] = sum[e] * inv - cur[e]; }
                st8(PO + (size_t)t * 1024 + c, o);
                if (pos - w + 1 >= 0) { float old[8]; ld8(Z + (size_t)(t - w + 1) * NZ + c, old);
#pragma unroll
                    for (int e = 0; e < 8; ++e) sum[e] -= old[e]; } }
        } else {
            const int c = (which - 2) * 512 + lane * 8; const bf16* zc = Z + 1024 + c;
            float w0[8], w1[8], w2[8], w3[8], bb[8], x3[8], x2[8], x1[8];
#pragma unroll
            for (int e = 0; e < 8; ++e) { w0[e] = a.in[13][0 * 1024 + c + e]; w1[e] = a.in[13][1 * 1024 + c + e]; w2[e] = a.in[13][2 * 1024 + c + e]; w3[e] = a.in[13][3 * 1024 + c + e]; bb[e] = a.in[14][c + e]; x3[e] = 0.f; x2[e] = 0.f; x1[e] = 0.f; }
            if (pos0 >= 3) ld8(zc + (size_t)(t0 - 3) * NZ, x3);
            if (pos0 >= 2) ld8(zc + (size_t)(t0 - 2) * NZ, x2);
            if (pos0 >= 1) ld8(zc + (size_t)(t0 - 1) * NZ, x1);
            for (int i = 0; i < 32; ++i) { const int t = t0 + i; float x0[8], o[8]; ld8(zc + (size_t)t * NZ, x0);
#pragma unroll
                for (int e = 0; e < 8; ++e) { o[e] = bb[e] + w0[e] * x3[e] + w1[e] * x2[e] + w2[e] * x1[e] + w3[e] * x0[e]; x3[e] = x2[e]; x2[e] = x1[e]; x1[e] = x0[e]; }
                st8(XC + (size_t)t * 1024 + c, o); }
        }
    }
}

__device__ __forceinline__ void ph_scan_agg(const Args& a, int tid) {
    const unsigned* AD = (const unsigned*)(a.ws + WS_AF);
    float* AG = (float*)(a.ws + WS_AG); float* HG = (float*)(a.ws + WS_HG);
    for (int w = blockIdx.x; w < 256; w += gridDim.x) {
        const int st = w >> 1, c = (w & 1) * 512 + tid; const size_t base = (size_t)st * 128 * 1024 + c;
        float LA = 0.f, H = 0.f;
#pragma unroll 32
        for (int i = 0; i < 128; ++i) { const unsigned pw = AD[base + (size_t)i * 1024]; const float la = bf_lo(pw), dv = bf_hi(pw); H = __builtin_amdgcn_exp2f(la) * H + dv; LA += la; }
        AG[st * 1024 + c] = __builtin_amdgcn_exp2f(LA); HG[st * 1024 + c] = H;
    }
}
__device__ __forceinline__ void ph_scan_fin(const Args& a, int tid) {
    const unsigned* AD = (const unsigned*)(a.ws + WS_AF);
    const float* AG = (const float*)(a.ws + WS_AG); const float* HG = (const float*)(a.ws + WS_HG);
    const bf16* Z = (const bf16*)(a.ws + WS_ZB); unsigned char* YC8 = a.ws + WS_YC8;
    for (int w = blockIdx.x; w < 256; w += gridDim.x) {
        const int st = w >> 1, c = (w & 1) * 512 + tid, sin = st & 63, sb = st - sin; const size_t base = (size_t)st * 128 * 1024 + c;
        float h = 0.f;
#pragma unroll 32
        for (int s = 0; s < sin; ++s) h = AG[(sb + s) * 1024 + c] * h + HG[(sb + s) * 1024 + c];
#pragma unroll 16
        for (int i = 0; i < 128; ++i) { const size_t t = (size_t)st * 128 + i; const unsigned pw = AD[base + (size_t)i * 1024];
            h = __builtin_amdgcn_exp2f(bf_lo(pw)) * h + bf_hi(pw); const float gt = __uint_as_float((unsigned)Z[t * NZ + 2048 + c] << 16);
            YC8[t * DM + 1024 + c] = (unsigned char)(pk4_fp8(h * gelu_tanh(gt) * Y8_SCALE, 0.f, 0.f, 0.f) & 0xffu); }
    }
}

template <bool RES_MOD>
__device__ __forceinline__ void ph_ln(const bf16* Y, const float* Xin, const bf16* HBres, const float* mod_res, const float* mod_l, const float* lng, const float* lnb, bf16* H2, unsigned char* H28, float* SH, unsigned char* H6, float* HS, LAS unsigned char* lds, int lane, int wave) {
    const int gw = blockIdx.x * NWAVES + wave, NGW = gridDim.x * NWAVES;
    { LAS float* lp = (LAS float*)lds; const int t_ = wave * 64 + lane;
#pragma unroll 1
      for (int i = t_; i < 12 * 512; i += NTHREADS) { const int v = i >> 9, c4 = (i & 511) * 4; const float* src;
          if (v < 4) src = (RES_MOD ? mod_res : mod_l) + (v & 1) * 12288 + (v < 2 ? 0 : 2048);
          else if (v < 10) src = mod_l + (v & 1) * 12288 + (v < 6 ? 4096 : (v < 8 ? 6144 : 8192));
          else src = v == 10 ? lng : lnb;
          *(LAS f32x4*)(lp + v * 2048 + c4) = *(const f32x4*)(src + c4); }
      __syncthreads(); }
    const LAS float* lpf = (const LAS float*)lds;
    v4u yc[4]; f32x4 xc[8]; v4u rc[4];
    { const size_t ro = (size_t)gw * DM + 8 * lane;
#pragma unroll
      for (int j = 0; j < 4; ++j) { yc[j] = *(const v4u*)(Y + ro + 512 * j);
          if constexpr (RES_MOD) rc[j] = *(const v4u*)(HBres + ro + 512 * j); else { xc[2 * j] = *(const f32x4*)(Xin + ro + 512 * j); xc[2 * j + 1] = *(const f32x4*)(Xin + ro + 512 * j + 4); } } }
#pragma unroll 1
    for (int t = gw; t < M; t += NGW) {
        const int b = t >> 13; const LAS float* mb = lpf + b * 2048; const size_t ro = (size_t)t * DM + 8 * lane;
        int ln = lane; asm volatile("" : "+v"(ln));
        const int tn = t + NGW < M ? t + NGW : t; const size_t rn = (size_t)tn * DM + 8 * lane;
        v4u yn[4]; f32x4 xn[8]; v4u rn4[4];
#pragma unroll
        for (int j = 0; j < 4; ++j) { yn[j] = *(const v4u*)(Y + rn + 512 * j);
            if constexpr (RES_MOD) rn4[j] = *(const v4u*)(HBres + rn + 512 * j); else { xn[2 * j] = *(const f32x4*)(Xin + rn + 512 * j); xn[2 * j + 1] = *(const f32x4*)(Xin + rn + 512 * j + 4); } }
        float v[32];
#pragma unroll
        for (int j = 0; j < 4; ++j) { const v4u u = yc[j]; const float y8[8] = {bf_lo(u.x), bf_hi(u.x), bf_lo(u.y), bf_hi(u.y), bf_lo(u.z), bf_hi(u.z), bf_lo(u.w), bf_hi(u.w)};
            f32x4 xa, xb;
            if constexpr (RES_MOD) { const v4u r = rc[j]; const LAS float* mr = mb + 8 * ln + 512 * j;
                const f32x4 sa = *(const LAS f32x4*)(mr + 4096), sb = *(const LAS f32x4*)(mr + 4096 + 4), ha = *(const LAS f32x4*)(mr), hb = *(const LAS f32x4*)(mr + 4);
                const float r8[8] = {bf_lo(r.x), bf_hi(r.x), bf_lo(r.y), bf_hi(r.y), bf_lo(r.z), bf_hi(r.z), bf_lo(r.w), bf_hi(r.w)};
#pragma unroll
                for (int e = 0; e < 4; ++e) { xa[e] = (r8[e] - ha[e]) * __builtin_amdgcn_rcpf(1.f + sa[e]); xb[e] = (r8[4 + e] - hb[e]) * __builtin_amdgcn_rcpf(1.f + sb[e]); } }
            else { xa = xc[2 * j]; xb = xc[2 * j + 1]; }
            const f32x4 ga = *(const LAS f32x4*)(mb + 2 * 4096 + 8 * ln + 512 * j), gb = *(const LAS f32x4*)(mb + 2 * 4096 + 8 * ln + 512 * j + 4);
#pragma unroll
            for (int e = 0; e < 4; ++e) { v[8 * j + e] = ALPHA * xa[e] + (1.f + ga[e]) * y8[e]; v[8 * j + 4 + e] = ALPHA * xb[e] + (1.f + gb[e]) * y8[4 + e]; }
            asm volatile("" ::: "memory"); }
        float s = 0.f;
#pragma unroll
        for (int e = 0; e < 32; ++e) s += v[e];
        const float mean = wave_sum(s) * (1.f / DM); float q = 0.f;
#pragma unroll
        for (int e = 0; e < 32; ++e) { v[e] -= mean; q += v[e] * v[e]; }
        const float rstd = rsqrtf(wave_sum(q) * (1.f / DM) + LN_EPS); float hmx = 0.f;
#pragma unroll
        for (int j = 0; j < 4; ++j) { const int co = 8 * ln + 512 * j;
            const f32x4 la = *(const LAS f32x4*)(lpf + 10 * 2048 + co), lb = *(const LAS f32x4*)(lpf + 10 * 2048 + co + 4), ba = *(const LAS f32x4*)(lpf + 11 * 2048 + co), bb = *(const LAS f32x4*)(lpf + 11 * 2048 + co + 4);
            const f32x4 sa = *(const LAS f32x4*)(mb + 4 * 4096 + co), sb = *(const LAS f32x4*)(mb + 4 * 4096 + co + 4), ha = *(const LAS f32x4*)(mb + 3 * 4096 + co), hb = *(const LAS f32x4*)(mb + 3 * 4096 + co + 4);
            float h8[8];
#pragma unroll
            for (int e = 0; e < 4; ++e) { const float na = v[8 * j + e] * rstd * la[e] + ba[e], nb = v[8 * j + 4 + e] * rstd * lb[e] + bb[e];
                h8[e] = na * (1.f + sa[e]) + ha[e]; h8[4 + e] = nb * (1.f + sb[e]) + hb[e]; }
            st8(H2 + ro + 512 * j, h8);
#pragma unroll
            for (int e = 0; e < 8; ++e) { v[8 * j + e] = h8[e]; hmx = fmaxf(hmx, fabsf(h8[e])); }
            asm volatile("" ::: "memory"); }
        hmx = fmaxf(wave_max(hmx), 1e-30f); const float inv = 127.f / hmx;
#pragma unroll
        for (int j = 0; j < 4; ++j) *(v2u*)(H28 + ro + 512 * j) = (v2u){pk4_i8(v[8 * j] * inv, v[8 * j + 1] * inv, v[8 * j + 2] * inv, v[8 * j + 3] * inv), pk4_i8(v[8 * j + 4] * inv, v[8 * j + 5] * inv, v[8 * j + 6] * inv, v[8 * j + 7] * inv)};
        if (lane == 0) SH[t] = hmx * (1.f / 127.f);
        { const float inv6 = 7.5f / hmx; f32x16_t pa, pb;
#pragma unroll
          for (int i = 0; i < 16; ++i) { pa[i] = v[2 * i] * inv6; pb[i] = v[2 * i + 1] * inv6; }
          const u32x6_t pk = __builtin_amdgcn_cvt_scalef32_2xpk16_fp6_f32(pa, pb, 1.0f); unsigned char* hq = H6 + (size_t)t * 1536;
          *(v4u*)(hq + 16 * lane) = (v4u){pk[0], pk[1], pk[2], pk[3]}; *(v2u*)(hq + 1024 + 8 * lane) = (v2u){pk[4], pk[5]};
          if (lane == 0) HS[t] = hmx * (1.f / 7.5f); }
#pragma unroll
        for (int j = 0; j < 4; ++j) { yc[j] = yn[j]; if constexpr (RES_MOD) rc[j] = rn4[j]; else { xc[2 * j] = xn[2 * j]; xc[2 * j + 1] = xn[2 * j + 1]; } }
    }
}

__device__ __forceinline__ unsigned mono(float f) { const unsigned u = __float_as_uint(f); return (u & 0x80000000u) ? ~u : (u | 0x80000000u); }
__device__ __forceinline__ float unmono(unsigned u) { return __uint_as_float((u & 0x80000000u) ? (u & 0x7fffffffu) : ~u); }
__device__ __forceinline__ unsigned umax_(unsigned a, unsigned b) { return a > b ? a : b; }
__device__ __forceinline__ unsigned umin_(unsigned a, unsigned b) { return a < b ? a : b; }
template <bool DESC> __device__ __forceinline__ void bsort16(unsigned (&k)[16]) {
#pragma unroll
    for (int size = 2; size <= 16; size <<= 1)
#pragma unroll
        for (int stride = size >> 1; stride > 0; stride >>= 1)
#pragma unroll
            for (int i = 0; i < 16; ++i) { const int j = i ^ stride;
                if (j > i) { const bool first_max = (((i & size) == 0) == DESC); const unsigned hi = umax_(k[i], k[j]), lo = umin_(k[i], k[j]); k[i] = first_max ? hi : lo; k[j] = first_max ? lo : hi; } }
}
template <bool DESC> __device__ __forceinline__ void bmerge16(unsigned (&k)[16]) {
#pragma unroll
    for (int stride = 8; stride > 0; stride >>= 1)
#pragma unroll
        for (int i = 0; i < 16; ++i) { const int j = i ^ stride;
            if (j > i) { const unsigned hi = umax_(k[i], k[j]), lo = umin_(k[i], k[j]); k[i] = DESC ? hi : lo; k[j] = DESC ? lo : hi; } }
}
__device__ __forceinline__ void top16_of_64(const unsigned (&k)[64], unsigned (&o)[16]) {
    unsigned g0[16], g1[16], g2[16], g3[16];
#pragma unroll
    for (int i = 0; i < 16; ++i) { g0[i] = k[i]; g1[i] = k[16 + i]; g2[i] = k[32 + i]; g3[i] = k[48 + i]; }
    bsort16<true>(g0); bsort16<false>(g1); bsort16<true>(g2); bsort16<false>(g3);
#pragma unroll
    for (int i = 0; i < 16; ++i) { g0[i] = umax_(g0[i], g1[i]); g2[i] = umax_(g2[i], g3[i]); }
    bmerge16<true>(g0); bmerge16<false>(g2);
#pragma unroll
    for (int i = 0; i < 16; ++i) o[i] = umax_(g0[i], g2[i]);
    bmerge16<true>(o);
}
__device__ __forceinline__ int swz16(int row, int cb) { return cb ^ ((row & 15) << 4); }
__device__ __forceinline__ void ph_topk(const Args& a, int layer, LAS unsigned char* lds, int tid, int lane, int wave) {
    const bf16* QP = (const bf16*)(a.ws + WS_QP); const bf16* KEYS = (const bf16*)(a.ws + WS_KEYS) + (size_t)layer * 8 * 2 * 128 * 128;
    int* EI = (int*)(a.ws + WS_EI); float* GT = (float*)(a.ws + WS_GT); const float* SVl = (const float*)(a.ws + WS_SV) + layer * NEXP;
    LAS unsigned char* kt = lds;
    LAS unsigned* lists = (LAS unsigned*)(lds + 65536 + wave * 4096);
    const int r32 = lane & 31, hi = lane >> 5, h = blockIdx.x & 7, wgr = blockIdx.x >> 3, nwgh = gridDim.x >> 3;
    { const bf16* kh = KEYS + (size_t)h * 2 * 128 * 128;
#pragma unroll
      for (int i = 0; i < 8; ++i) { const int ch = tid + i * NTHREADS, row = ch >> 4, cb = (ch & 15) * 16;
          *(LAS v4u*)(kt + row * 256 + swz16(row, cb)) = *(const v4u*)(kh + (size_t)row * 128 + (cb >> 1)); } }
    __syncthreads();
    if (wgr < nwgh) {
#pragma unroll 1
    for (int u = wgr * NWAVES + wave; u < M / 32; u += nwgh * NWAVES) {
        const int t0 = u * 32; const bf16* qrow = QP + (size_t)(t0 + r32) * DM + h * 256 + 8 * hi;
        unsigned LL[2][16];
#pragma unroll
        for (int p = 0; p < 2; ++p) {
            bf16x8 bq[8];
#pragma unroll
            for (int sI = 0; sI < 8; ++sI) bq[sI] = *(const bf16x8*)(qrow + p * 128 + 16 * sI);
            f32x16 acc[4];
#pragma unroll
            for (int blk = 0; blk < 4; ++blk)
#pragma unroll
                for (int e = 0; e < 16; ++e) acc[blk][e] = 0.f;
#pragma unroll
            for (int sI = 0; sI < 8; ++sI)
#pragma unroll
                for (int blk = 0; blk < 4; ++blk) { const int krow = p * 128 + blk * 32 + r32;
                    const bf16x8 ak = *(const LAS bf16x8*)(kt + krow * 256 + swz16(krow, (16 * sI + 8 * hi) * 2));
                    acc[blk] = __builtin_amdgcn_mfma_f32_32x32x16_bf16(ak, bq[sI], acc[blk], 0, 0, 0); }
            unsigned kk[64], o[16];
#pragma unroll
            for (int blk = 0; blk < 4; ++blk)
#pragma unroll
                for (int e = 0; e < 16; ++e) { const int n = 32 * blk + (e & 3) + 8 * (e >> 2) + 4 * hi; kk[blk * 16 + e] = (mono(acc[blk][e]) & ~127u) | (unsigned)(127 - n); }
            top16_of_64(kk, o);
#pragma unroll
            for (int i = 0; i < 16; ++i) LL[p][i] = umax_(o[i], (unsigned)__shfl_xor((int)o[15 - i], 32));
            bmerge16<true>(LL[p]);
            if (hi == 0) { LAS v4u* lp = (LAS v4u*)(lists + (p * 32 + r32) * 16);
#pragma unroll
                for (int i = 0; i < 4; ++i) lp[i] = (v4u){LL[p][4 * i], LL[p][4 * i + 1], LL[p][4 * i + 2], LL[p][4 * i + 3]}; }
        }
        unsigned tk[16];
        { float f1[16], f2[16];
#pragma unroll
          for (int i = 0; i < 16; ++i) { f1[i] = unmono(LL[0][i] & ~127u); f2[i] = unmono(LL[1][i] & ~127u); }
          unsigned cd[32];
          {
            cd[0] = hi ? ((mono(f1[2] + f2[1]) & ~255u) | 222u) : ((mono(f1[0] + f2[0]) & ~255u) | 255u);
            cd[1] = hi ? ((mono(f1[2] + f2[2]) & ~255u) | 221u) : ((mono(f1[0] + f2[1]) & ~255u) | 254u);
            cd[2] = hi ? ((mono(f1[2] + f2[3]) & ~255u) | 220u) : ((mono(f1[0] + f2[2]) & ~255u) | 253u);
            cd[3] = hi ? ((mono(f1[2] + f2[4]) & ~255u) | 219u) : ((mono(f1[0] + f2[3]) & ~255u) | 252u);
            cd[4] = hi ? ((mono(f1[3] + f2[0]) & ~255u) | 207u) : ((mono(f1[0] + f2[4]) & ~255u) | 251u);
            cd[5] = hi ? ((mono(f1[3] + f2[1]) & ~255u) | 206u) : ((mono(f1[0] + f2[5]) & ~255u) | 250u);
            cd[6] = hi ? ((mono(f1[3] + f2[2]) & ~255u) | 205u) : ((mono(f1[0] + f2[6]) & ~255u) | 249u);
            cd[7] = hi ? ((mono(f1[3] + f2[3]) & ~255u) | 204u) : ((mono(f1[0] + f2[7]) & ~255u) | 248u);
            cd[8] = hi ? ((mono(f1[4] + f2[0]) & ~255u) | 191u) : ((mono(f1[0] + f2[8]) & ~255u) | 247u);
            cd[9] = hi ? ((mono(f1[4] + f2[1]) & ~255u) | 190u) : ((mono(f1[0] + f2[9]) & ~255u) | 246u);
            cd[10] = hi ? ((mono(f1[4] + f2[2]) & ~255u) | 189u) : ((mono(f1[0] + f2[10]) & ~255u) | 245u);
            cd[11] = hi ? ((mono(f1[5] + f2[0]) & ~255u) | 175u) : ((mono(f1[0] + f2[11]) & ~255u) | 244u);
            cd[12] = hi ? ((mono(f1[5] + f2[1]) & ~255u) | 174u) : ((mono(f1[0] + f2[12]) & ~255u) | 243u);
            cd[13] = hi ? ((mono(f1[6] + f2[0]) & ~255u) | 159u) : ((mono(f1[0] + f2[13]) & ~255u) | 242u);
            cd[14] = hi ? ((mono(f1[6] + f2[1]) & ~255u) | 158u) : ((mono(f1[0] + f2[14]) & ~255u) | 241u);
            cd[15] = hi ? ((mono(f1[7] + f2[0]) & ~255u) | 143u) : ((mono(f1[0] + f2[15]) & ~255u) | 240u);
            cd[16] = hi ? ((mono(f1[7] + f2[1]) & ~255u) | 142u) : ((mono(f1[1] + f2[0]) & ~255u) | 239u);
            cd[17] = hi ? ((mono(f1[8] + f2[0]) & ~255u) | 127u) : ((mono(f1[1] + f2[1]) & ~255u) | 238u);
            cd[18] = hi ? ((mono(f1[9] + f2[0]) & ~255u) | 111u) : ((mono(f1[1] + f2[2]) & ~255u) | 237u);
            cd[19] = hi ? ((mono(f1[10] + f2[0]) & ~255u) | 95u) : ((mono(f1[1] + f2[3]) & ~255u) | 236u);
            cd[20] = hi ? ((mono(f1[11] + f2[0]) & ~255u) | 79u) : ((mono(f1[1] + f2[4]) & ~255u) | 235u);
            cd[21] = hi ? ((mono(f1[12] + f2[0]) & ~255u) | 63u) : ((mono(f1[1] + f2[5]) & ~255u) | 234u);
            cd[22] = hi ? ((mono(f1[13] + f2[0]) & ~255u) | 47u) : ((mono(f1[1] + f2[6]) & ~255u) | 233u);
            cd[23] = hi ? ((mono(f1[14] + f2[0]) & ~255u) | 31u) : ((mono(f1[1] + f2[7]) & ~255u) | 232u);
            cd[24] = hi ? ((mono(f1[15] + f2[0]) & ~255u) | 15u) : ((mono(f1[2] + f2[0]) & ~255u) | 223u);
            cd[25] = 0u;
            cd[26] = 0u;
            cd[27] = 0u;
            cd[28] = 0u;
            cd[29] = 0u;
            cd[30] = 0u;
            cd[31] = 0u;
          }
          unsigned g0[16], g1[16];
#pragma unroll
          for (int i = 0; i < 16; ++i) { g0[i] = cd[i]; g1[i] = cd[16 + i]; }
          bsort16<true>(g0); bsort16<false>(g1);
#pragma unroll
          for (int i = 0; i < 16; ++i) g0[i] = umax_(g0[i], g1[i]);
          bmerge16<true>(g0);
#pragma unroll
          for (int i = 0; i < 16; ++i) tk[i] = umax_(g0[i], (unsigned)__shfl_xor((int)g0[15 - i], 32));
          bmerge16<true>(tk); }
        float ev[16]; const float m0 = unmono(tk[0] & ~255u); float den = 0.f;
#pragma unroll
        for (int k = 0; k < 16; ++k) { ev[k] = __expf(unmono(tk[k] & ~255u) - m0); den += ev[k]; }
        const float rden = 1.f / den;
        const LAS unsigned* L1 = lists + r32 * 16; const LAS unsigned* L2 = lists + (32 + r32) * 16;
        int ei[16];
#pragma unroll
        for (int k = 0; k < 16; ++k) { const int id = 255 - (int)(tk[k] & 255u), i = id >> 4, j = id & 15;
            const int n1 = 127 - (int)(L1[i] & 127u), n2 = 127 - (int)(L2[j] & 127u); ei[k] = n1 * 128 + n2; }
        if (hi == 0) { int* ep = EI + (size_t)(t0 + r32) * 128 + h * 16;
#pragma unroll
            for (int k = 0; k < 4; ++k) *(int4*)(ep + 4 * k) = make_int4(ei[4 * k], ei[4 * k + 1], ei[4 * k + 2], ei[4 * k + 3]); }
        else { float* gp = GT + (size_t)(t0 + r32) * 128 + h * 16; float gg[16];
#pragma unroll
            for (int k = 0; k < 16; ++k) gg[k] = ev[k] * rden * SVl[ei[k]];
#pragma unroll
            for (int k = 0; k < 4; ++k) *(f32x4*)(gp + 4 * k) = (f32x4){gg[4 * k], gg[4 * k + 1], gg[4 * k + 2], gg[4 * k + 3]}; }
    } }
    __syncthreads();
}

typedef int i32x8_t __attribute__((ext_vector_type(8)));
__device__ __forceinline__ void peer_slice(const Args& a, volatile LAS unsigned* st, int& x, int& rank, int& nrank) {
    (void)a; nrank = (int)(gridDim.x >> 3); const bool uni = st[4] != 0u;
    if (uni) { x = (int)st[3]; rank = (int)st[2]; } else { x = (int)(blockIdx.x & 7u); rank = (int)(blockIdx.x >> 3); }
    x = __builtin_amdgcn_readfirstlane(x); rank = __builtin_amdgcn_readfirstlane(rank);
}
__device__ __forceinline__ void ph_peer_u(const Args& a, int layer, volatile LAS unsigned* st, LAS unsigned char* lds, int lane, int wave) {
    int x, rank, nrank; peer_slice(a, st, x, rank, nrank); const int m16 = lane & 15, kc = lane >> 4, r8 = lane >> 3, sg = lane & 7;
    const unsigned char* TUb = a.ws + WS_TU + (size_t)layer * NEXP * ROW4 + (size_t)x * NEXP * 128;
    const unsigned char* H6 = a.ws + WS_H6 + 16 * (8 * x + kc); const int* EI = (const int*)(a.ws + WS_EI) + lane; bf16* PART = (bf16*)(a.ws + WS_PART) + x * 128 + 32 * kc;
    if (rank >= nrank) return;
    const int t0 = rank * NWAVES + wave, ts = nrank * NWAVES, nt = (M - t0 + ts - 1) / ts;
    LAS unsigned char* ub = lds + wave * 2304; LAS unsigned char* ubw = ub + r8 * 144 + 16 * sg; const LAS unsigned char* ubr = ub + m16 * 144 + 16 * kc;
    v4u U[8][2]; v4u ha[2], han[2]; v2u hb[2], hbn[2]; int en0 = 0, en1 = 0;
#pragma unroll
    for (int g = 0; g < 8; ++g) { U[g][0] = (v4u){0u, 0u, 0u, 0u}; U[g][1] = U[g][0]; }
    ha[0] = ha[1] = (v4u){0u, 0u, 0u, 0u}; hb[0] = hb[1] = (v2u){0u, 0u};
    en0 = EI[(size_t)t0 * 128]; en1 = EI[(size_t)t0 * 128 + 64];
#pragma unroll 1
    for (int k = -1; k < nt; ++k) {
        const int k2 = k + 2 < nt ? k + 2 : nt - 1, k1 = k + 1 < nt ? (k + 1 < 0 ? 0 : k + 1) : nt - 1;
        const size_t tn2 = (size_t)(t0 + ts * k2), tn1 = (size_t)(t0 + ts * k1);
        const int enn0 = EI[tn2 * 128], enn1 = EI[tn2 * 128 + 64];
        { const unsigned char* hp = H6 + tn1 * 1536;
#pragma unroll
          for (int i = 0; i < 2; ++i) { han[i] = *(const v4u*)(hp + 64 * i); hbn[i] = *(const v2u*)(hp + 1024 - 8 * (8 * x + kc) + 32 * i); } }
        bf16* pp = PART + (size_t)(t0 + ts * (k < 0 ? 0 : k)) * 1024; unsigned pv0 = 0u, pv1 = 0u;
#pragma unroll
        for (int g = 0; g < 8; ++g) {
            { f32x4 acc = {0.f, 0.f, 0.f, 0.f};
                if (k >= 0) {
                    *(LAS v4u*)ubw = U[g][0]; *(LAS v4u*)(ubw + 8 * 144) = U[g][1];
#pragma unroll
                    for (int i = 0; i < 2; ++i) { const v4u uu = *(const LAS v4u*)(ubr + 64 * i); const i32x8_t A8 = {(int)uu.x, (int)uu.y, (int)uu.z, (int)uu.w, 0, 0, 0, 0};
                        const i32x8_t B8 = {(int)ha[i].x, (int)ha[i].y, (int)ha[i].z, (int)ha[i].w, (int)hb[i].x, (int)hb[i].y, 0, 0};
                        acc = __builtin_amdgcn_mfma_scale_f32_16x16x128_f8f6f4(A8, B8, acc, 4, 2, 0, 127, 0, 127); } }
                if ((g & 1) == 0) { pv0 = pk2c(acc[0], acc[1]); pv1 = pk2c(acc[2], acc[3]); }
                else if (m16 == 0) *(v4u*)(pp + 4 * (g - 1)) = (v4u){pv0, pv1, pk2c(acc[0], acc[1]), pk2c(acc[2], acc[3])}; }
#pragma unroll
            for (int j = 0; j < 2; ++j) { const int em = __shfl(g < 4 ? en0 : en1, (g & 3) * 16 + 8 * j + r8); U[g][j] = *(const v4u*)(TUb + (unsigned)(em * 128 + 16 * sg)); }
            __builtin_amdgcn_sched_barrier(0);
        }
#pragma unroll
        for (int i = 0; i < 2; ++i) { ha[i] = han[i]; hb[i] = hbn[i]; }
        en0 = enn0; en1 = enn1;
    }
}
__device__ __forceinline__ void ph_peer_coef(const Args& a, int layer, LAS unsigned char* lds, int lane, int wave) {
    const int p0 = 16 * ((lane >> 1) & 7) + 4 * (lane >> 4) + 2 * (lane & 1);
    const int* EI = (const int*)(a.ws + WS_EI) + p0; const float* GT = (const float*)(a.ws + WS_GT) + p0; const unsigned* PART = (const unsigned*)(a.ws + WS_PART) + lane;
    const float* SU = (const float*)(a.ws + WS_SU) + layer * NEXP; const float* HS = (const float*)(a.ws + WS_HS);
    unsigned char* AR = a.ws + WS_AR; int* EQ = (int*)(a.ws + WS_EQ) + (p0 & 7) * 16 + (p0 >> 3);
    LAS float* CFL = (LAS float*)(lds + wave * 1024);
    const int gw = blockIdx.x * NWAVES + wave, NGW = gridDim.x * NWAVES;
#pragma unroll 1
    for (int t = gw; t < M; t += NGW) {
        const size_t tt = (size_t)t; const int2 ee = *(const int2*)(EI + tt * 128); const float2 gg = *(const float2*)(GT + tt * 128); const float hs = HS[t];
        unsigned P[8];
#pragma unroll
        for (int xx = 0; xx < 8; ++xx) P[xx] = PART[(tt * 8 + xx) * 64];
        const float s0 = SU[ee.x], s1 = SU[ee.y];
        const float d0 = ((bf_lo(P[0]) + bf_lo(P[1])) + (bf_lo(P[2]) + bf_lo(P[3]))) + ((bf_lo(P[4]) + bf_lo(P[5])) + (bf_lo(P[6]) + bf_lo(P[7])));
        const float d1 = ((bf_hi(P[0]) + bf_hi(P[1])) + (bf_hi(P[2]) + bf_hi(P[3]))) + ((bf_hi(P[4]) + bf_hi(P[5])) + (bf_hi(P[6]) + bf_hi(P[7])));
        const float c0 = gelu_tanh(d0 * hs * s0) * gg.x, c1 = gelu_tanh(d1 * hs * s1) * gg.y;
        EQ[tt * 128] = ee.x * 128; EQ[tt * 128 + 16] = ee.y * 128;
        const float cmx = fmaxf(wave_max(fmaxf(fabsf(c0), fabsf(c1))), 1e-30f), csc = 7.5f / cmx;
        CFL[p0] = c0 * csc; CFL[p0 + 1] = c1 * csc;
        f32x16_t pa, pb;
#pragma unroll
        for (int i = 0; i < 8; ++i) { const f32x4 c4 = *(const LAS f32x4*)(CFL + 32 * (lane & 3) + 4 * i); pa[2 * i] = c4[0]; pb[2 * i] = c4[1]; pa[2 * i + 1] = c4[2]; pb[2 * i + 1] = c4[3]; }
        const u32x6_t ph = __builtin_amdgcn_cvt_scalef32_2xpk16_fp6_f32(pa, pb, 1.0f);
        if (lane < 4) { unsigned char* rp = AR + tt * 128 + 32 * lane; *(v4u*)rp = (v4u){ph[0], ph[1], ph[2], ph[3]}; *(v4u*)(rp + 16) = (v4u){ph[4], ph[5], __float_as_uint(cmx * (1.f / 7.5f)), 0u}; }
    }
}
__device__ __forceinline__ void ph_peer_v(const Args& a, int layer, volatile LAS unsigned* st, LAS unsigned char* lds, int lane, int wave) {
    int x, rank, nrank; peer_slice(a, st, x, rank, nrank); const int q = lane >> 3, sg = lane & 7, n16 = lane & 15, kc = lane >> 4;
    const unsigned char* TVb = a.ws + WS_TV + (size_t)layer * NEXP * ROWV + (size_t)x * NEXP * 128;
    const int* EQ = (const int*)(a.ws + WS_EQ) + q * 16; const unsigned char* AR = a.ws + WS_AR + 32 * kc;
    if (rank >= nrank) return;
    const int t0 = rank * NWAVES + wave, ts = nrank * NWAVES, nt = (M - t0 + ts - 1) / ts;
    constexpr int VS = 144;
    LAS unsigned char* img = lds + wave * (128 * VS);
    LAS unsigned char* iw = img + q * VS + 16 * sg;
    const LAS unsigned char* ir = img + (32 * kc + n16) * VS;
    typedef int v2i_ __attribute__((ext_vector_type(2)));
    int inv16, ncol; bool tr_ok;
    { *(LAS v2u*)(ir) = (v2u){0x11111111u * (unsigned)n16, 0x11111111u * (unsigned)n16};
      const v2i_ ra = __builtin_amdgcn_ds_read_tr4_b64_v2i32((LAS v2i_*)ir);
      *(LAS v2u*)(ir) = (v2u){0x76543210u, 0xfedcba98u};
      const v2i_ rb = __builtin_amdgcn_ds_read_tr4_b64_v2i32((LAS v2i_*)ir);
      const unsigned r0 = (unsigned)__builtin_amdgcn_readfirstlane(ra.x), r1 = (unsigned)__builtin_amdgcn_readfirstlane(ra.y);
      ncol = rb.x & 15; inv16 = 0; unsigned seen = 0u;
#pragma unroll
      for (int e = 0; e < 16; ++e) { const int rr = (int)(((e < 8 ? r0 : r1) >> (4 * (e & 7))) & 15u); if (rr == n16) inv16 = e; seen |= 1u << rr; }
      bool ok = (unsigned)ra.x == r0 && (unsigned)ra.y == r1 && (unsigned)rb.x == 0x11111111u * (unsigned)ncol && (unsigned)rb.y == 0x11111111u * (unsigned)ncol && seen == 0xffffu;
      unsigned cols = 0u;
#pragma unroll
      for (int i = 0; i < 16; ++i) cols |= 1u << (__shfl(ncol, i) & 15);
      ok = ok && cols == 0xffffu;
      ok = ok && r0 == 0x76543210u && r1 == 0xfedcba98u && ncol == n16;
      tr_ok = __all(ok); }
    unsigned char* Y4 = a.ws + WS_Y + 256 * x + 4 * lane;
    (void)inv16;
    v4u W[16];
#pragma unroll
    for (int i = 0; i < 16; ++i) W[i] = (v4u){0u, 0u, 0u, 0u};
    v4u epn[4], ar0 = {0u, 0u, 0u, 0u}, ar1 = ar0;
#pragma unroll
    for (int j = 0; j < 4; ++j) epn[j] = (v4u){0u, 0u, 0u, 0u};
#pragma unroll
    for (int j = 0; j < 4; ++j) epn[j] = *(const v4u*)(EQ + (size_t)t0 * 128 + 4 * j);
#pragma unroll 1
    for (int k = -1; k < nt; ++k) {
        const int k2 = k + 2 < nt ? k + 2 : nt - 1, k1 = k + 1 < nt ? (k + 1 < 0 ? 0 : k + 1) : nt - 1; const size_t tn2 = (size_t)(t0 + ts * k2), tn1 = (size_t)(t0 + ts * k1);
        v4u epnn[4];
#pragma unroll
        for (int j = 0; j < 4; ++j) epnn[j] = *(const v4u*)(EQ + tn2 * 128 + 4 * j);
        const v4u arn0 = *(const v4u*)(AR + tn1 * 128), arn1 = *(const v4u*)(AR + tn1 * 128 + 16);
        int ep[16];
#pragma unroll
        for (int j = 0; j < 4; ++j) { ep[4 * j] = (int)epn[j].x; ep[4 * j + 1] = (int)epn[j].y; ep[4 * j + 2] = (int)epn[j].z; ep[4 * j + 3] = (int)epn[j].w; }
        __builtin_amdgcn_sched_barrier(0);
#pragma unroll
        for (int i = 0; i < 16; ++i) {
            *(LAS v4u*)(iw + 8 * i * VS) = W[i];
            W[i] = *(const v4u*)(TVb + (unsigned)(ep[i] + 16 * sg));
            __builtin_amdgcn_sched_barrier(0);
        }
        float yv[16];
#pragma unroll
        for (int j = 0; j < 16; ++j) yv[j] = 0.f;
        if (k >= 0) {
            i32x8_t A8 = {(int)ar0.x, (int)ar0.y, (int)ar0.z, (int)ar0.w, (int)ar1.x, (int)ar1.y, 0, 0};
            if (n16 != 0) A8 = (i32x8_t){0, 0, 0, 0, 0, 0, 0, 0};
            const float ysc = __uint_as_float(ar1.z);
#pragma unroll
            for (int j = 0; j < 16; ++j) {
                const v2i_ b0 = __builtin_amdgcn_ds_read_tr4_b64_v2i32((LAS v2i_*)(ir + 8 * j)), b1 = __builtin_amdgcn_ds_read_tr4_b64_v2i32((LAS v2i_*)(ir + 16 * VS + 8 * j));
                const i32x8_t B8 = {b0.x, b0.y, b1.x, b1.y, 0, 0, 0, 0};
                const f32x4 acc = __builtin_amdgcn_mfma_scale_f32_16x16x128_f8f6f4(A8, B8, (f32x4){0.f, 0.f, 0.f, 0.f}, 2, 4, 0, 127, 0, 127);
                yv[j] = acc[0] * ysc; }
        }
        if (!tr_ok) { _Pragma("unroll") for (int j = 0; j < 16; ++j) yv[j] = __builtin_nanf(""); }
        { LAS float* yl = (LAS float*)img;
          if (kc == 0) {
#pragma unroll
              for (int j = 0; j < 16; ++j) yl[16 * j + ncol] = yv[j]; }
          const f32x4 y4 = *(const LAS f32x4*)(yl + 4 * lane);
          *(unsigned*)(Y4 + (size_t)(t0 + ts * (k < 0 ? 0 : k)) * DM) = pk4_fp8(y4[0] * YP_SCALE, y4[1] * YP_SCALE, y4[2] * YP_SCALE, y4[3] * YP_SCALE); }
        ar0 = arn0; ar1 = arn1;
#pragma unroll
        for (int j = 0; j < 4; ++j) epn[j] = epnn[j];
    }
}
template <bool FINAL>
__device__ __forceinline__ void ph_peer_ln(const Args& a, const float* mod_l, const float* mod_next, const float* lng, const float* lnb, LAS unsigned char* lds, int lane, int wave) {
    const bf16* H2 = (const bf16*)(a.ws + WS_H2); bf16* HB = (bf16*)(a.ws + WS_HB); const unsigned char* Y = a.ws + WS_Y;
    const int gw = blockIdx.x * NWAVES + wave, NGW = gridDim.x * NWAVES;
    { LAS float* lp = (LAS float*)lds; const int t_ = wave * 64 + lane;
#pragma unroll 1
      for (int i = t_; i < 12 * 512; i += NTHREADS) { const int v = i >> 9, c4 = (i & 511) * 4; const float* src;
          if (v < 6) src = mod_l + (v & 1) * 12288 + (v < 2 ? 10240 : (v < 4 ? 8192 : 6144));
          else if (v < 10) src = mod_next + (v & 1) * 12288 + (v < 8 ? 2048 : 0);
          else src = v == 10 ? lng : lnb;
          *(LAS f32x4*)(lp + v * 2048 + c4) = *(const f32x4*)(src + c4); }
      __syncthreads(); }
#pragma unroll 1
    for (int t = gw; t < M; t += NGW) {
        const int b = t >> 13;
        float out[32];
        { unsigned lo0 = (unsigned)lane * 4u; asm volatile("" : "+v"(lo0)); const unsigned char* yrow = Y + (size_t)t * DM;
#pragma unroll
          for (int j = 0; j < 8; ++j) { const unsigned yw = *(const unsigned*)(yrow + lo0 + 256 * j); const auto ya = __builtin_amdgcn_cvt_pk_f32_fp8((int)yw, false), yb = __builtin_amdgcn_cvt_pk_f32_fp8((int)yw, true);
              out[4 * j] = ya[0] * (1.f / YP_SCALE); out[4 * j + 1] = ya[1] * (1.f / YP_SCALE); out[4 * j + 2] = yb[0] * (1.f / YP_SCALE); out[4 * j + 3] = yb[1] * (1.f / YP_SCALE); } }
        unsigned lo = (unsigned)lane * 16u; asm volatile("" : "+v"(lo));
        const LAS char* lpb = (const LAS char*)lds + b * 8192; const char* h2row = (const char*)(H2 + (size_t)t * DM);
#define LD4_(vec, j_) (*(const LAS f32x4*)(lpb + (vec) * 16384 + lo + 1024 * (j_)))
#pragma unroll
        for (int j = 0; j < 8; ++j) { const v2u hw = *(const v2u*)(h2row + (lo >> 1) + 512 * j); const float h4[4] = {bf_lo(hw.x), bf_hi(hw.x), bf_lo(hw.y), bf_hi(hw.y)};
            const f32x4 ga = LD4_(0, j), sf = LD4_(1, j), hf = LD4_(2, j);
#pragma unroll
            for (int e = 0; e < 4; ++e) { const float x1 = (h4[e] - hf[e]) * __builtin_amdgcn_rcpf(1.f + sf[e]); out[4 * j + e] = ALPHA * x1 + (1.f + ga[e]) * out[4 * j + e]; } }
        float s = 0.f;
#pragma unroll
        for (int e = 0; e < 32; ++e) s += out[e];
        const float mean = wave_sum(s) * (1.f / DM); float q2 = 0.f;
#pragma unroll
        for (int e = 0; e < 32; ++e) { out[e] -= mean; q2 += out[e] * out[e]; }
        const float rstd = rsqrtf(wave_sum(q2) * (1.f / DM) + LN_EPS);
        char* orow = (char*)(a.out + (size_t)t * DM); char* hrow = (char*)(HB + (size_t)t * DM);
        float hmx = 0.f; (void)hmx;
#pragma unroll
        for (int j = 0; j < 8; ++j) { const f32x4 la = *(const LAS f32x4*)((const LAS char*)lds + 10 * 8192 + lo + 1024 * j), ba = *(const LAS f32x4*)((const LAS char*)lds + 11 * 8192 + lo + 1024 * j); f32x4 na;
#pragma unroll
            for (int e = 0; e < 4; ++e) na[e] = out[4 * j + e] * rstd * la[e] + ba[e];
            if constexpr (FINAL) *(f32x4*)(orow + lo + 1024 * j) = na;
            else { const f32x4 sa = LD4_(3, j), ha = LD4_(4, j);
#pragma unroll
                for (int e = 0; e < 4; ++e) { const float hn = na[e] * (1.f + sa[e]) + ha[e]; out[4 * j + e] = hn; hmx = fmaxf(hmx, fabsf(hn)); }
                *(v2u*)(hrow + (lo >> 1) + 512 * j) = (v2u){pk2(out[4 * j], out[4 * j + 1]), pk2(out[4 * j + 2], out[4 * j + 3])}; } }
        if constexpr (!FINAL) {
            hmx = fmaxf(wave_max(hmx), 1e-30f); const float inv8 = 240.f / hmx; unsigned char* h8row = a.ws + WS_HB8 + (size_t)t * DM;
#pragma unroll
            for (int j = 0; j < 8; ++j) { unsigned w = 0u; w = __builtin_amdgcn_cvt_pk_fp8_f32(out[4 * j] * inv8, out[4 * j + 1] * inv8, w, false); w = __builtin_amdgcn_cvt_pk_fp8_f32(out[4 * j + 2] * inv8, out[4 * j + 3] * inv8, w, true);
                *(unsigned*)(h8row + (lo >> 2) + 256 * j) = w; }
            if (lane == 0) ((float*)(a.ws + WS_SA))[t] = hmx * (1.f / 240.f); }
#undef LD4_
    }
}

__device__ __forceinline__ void ph_forget(const Args& a, LAS unsigned char* lds, int lane, int wave) {
    const bf16* HB = (const bf16*)(a.ws + WS_HB); const bf16* WF = (const bf16*)(a.ws + WS_WF); float* LF = (float*)(a.ws + WS_LF);
    const int m16 = lane & 15, kc = lane >> 4, kh = wave & 1;
    LAS f32x4* xch = (LAS f32x4*)lds;
    for (int base = blockIdx.x * (NWAVES / 2); base < M / 16; base += gridDim.x * (NWAVES / 2)) {
        const int item = base + (wave >> 1); const bool live = item < M / 16;
        const int t0 = (live ? item : 0) * 16; f32x4 acc = {0.f, 0.f, 0.f, 0.f};
        const bf16* ap = HB + (size_t)(t0 + m16) * DM + 8 * kc + 1024 * kh; const bf16* bp = WF + (size_t)m16 * DM + 8 * kc + 1024 * kh;
#pragma unroll 16
        for (int s = 0; s < 32; ++s) { const bf16x8 av = *(const bf16x8*)(ap + 32 * s), bv = *(const bf16x8*)(bp + 32 * s); acc = __builtin_amdgcn_mfma_f32_16x16x32_bf16(av, bv, acc, 0, 0, 0); }
        xch[wave * 64 + lane] = acc;
        __syncthreads();
        if (kh == 0 && live) { const f32x4 oth = xch[(wave + 1) * 64 + lane]; const float bfv = a.in[22][m16]; f32x4 o;
#pragma unroll
            for (int r = 0; r < 4; ++r) { const float x = acc[r] + oth[r] + bfv; o[r] = fminf(x, 0.f) - log1pf(__expf(-fabsf(x))); }
            const int t = t0 + 4 * kc, b = t >> 13, pos = t & (SEQ - 1);
            *(f32x4*)(LF + (size_t)(b * 16 + m16) * SEQ + pos) = o; }
        __syncthreads();
    }
}
__device__ __forceinline__ void ph_cumsum(const Args& a, int lane, int wave) {
    const float* LF = (const float*)(a.ws + WS_LF); float* FB = (float*)(a.ws + WS_FB);
    float* FE = (float*)(a.ws + WS_FE); float* FP = (float*)(a.ws + WS_FP);
    const int gw = blockIdx.x * NWAVES + wave, NGW = gridDim.x * NWAVES;
    const int sidx = NGW >= 1056 ? gw - 1024 : gw;
    for (int seq = sidx; seq >= 0 && seq < 32; seq += NGW) {
        const float* src = LF + (size_t)seq * SEQ + lane * 128; float* dst = FB + (size_t)seq * SEQ + lane * 128;
        f32x4 vv[32];
#pragma unroll
        for (int i = 0; i < 32; ++i) vv[i] = *(const f32x4*)(src + 4 * i);
        float s = 0.f;
#pragma unroll
        for (int i = 0; i < 32; ++i) s += (vv[i][0] + vv[i][1]) + (vv[i][2] + vv[i][3]);
        float inc = s;
#pragma unroll
        for (int o = 1; o < 64; o <<= 1) { const float n = __shfl_up(inc, o); if (lane >= o) inc += n; }
        float run = inc - s;
#pragma unroll
        for (int i = 0; i < 32; ++i) { const f32x4 v = vv[i]; f32x4 o;
            run += v[0]; o[0] = run; run += v[1]; o[1] = run; run += v[2]; o[2] = run; run += v[3]; o[3] = run;
            if (i == 0 && (lane & 1) == 0) FP[seq * 32 + (lane >> 1)] = -o[0];
            if (i == 15) FE[seq * 128 + 2 * lane] = -o[3];
            if (i == 31) FE[seq * 128 + 2 * lane + 1] = -o[3];
            *(f32x4*)(dst + 4 * i) = o * (-1.f / ATT_SCALE); }
    }
    const bf16* QK = (const bf16*)(a.ws + WS_ZB);
    for (int item = gw; item < 1024; item += NGW) {
        const int seq = item >> 5, blk = item & 31, b = seq >> 4, h = seq & 15;
        const bf16* qb = QK + ((size_t)b * SEQ + (size_t)blk * 256) * DM + h * 128 + 8 * (lane & 15); const bf16* kb = qb + (size_t)M * DM;
        float mq = 0.f, mk = 0.f, md = 3.0e38f;
#pragma unroll 8
        for (int r = 0; r < 64; ++r) { const size_t ro = (size_t)(4 * r + (lane >> 4)) * DM; float vq[8], vk[8]; ld8(qb + ro, vq); ld8(kb + ro, vk);
            float sq = 0.f, sk = 0.f, sd = 0.f;
#pragma unroll
            for (int e = 0; e < 8; ++e) { sq += vq[e] * vq[e]; sk += vk[e] * vk[e]; sd += vq[e] * vk[e]; }
            sq += SWZ_XOR_(sq, 1); sk += SWZ_XOR_(sk, 1); sd += SWZ_XOR_(sd, 1); sq += SWZ_XOR_(sq, 2); sk += SWZ_XOR_(sk, 2); sd += SWZ_XOR_(sd, 2);
            sq += SWZ_XOR_(sq, 4); sk += SWZ_XOR_(sk, 4); sd += SWZ_XOR_(sd, 4); sq += SWZ_XOR_(sq, 8); sk += SWZ_XOR_(sk, 8); sd += SWZ_XOR_(sd, 8);
            mq = fmaxf(mq, sq); mk = fmaxf(mk, sk); md = fminf(md, sd); }
        mq = wave_max(mq); mk = wave_max(mk); md = -wave_max(-md);
        if (lane == 0) { ((float*)(a.ws + WS_QN))[seq * 32 + blk] = mq; ((float*)(a.ws + WS_KN))[seq * 32 + blk] = mk; ((float*)(a.ws + WS_DN))[seq * 32 + blk] = md; }
    }
}

constexpr float SKIP_T = 20.f;
__device__ __forceinline__ attn::BlockRef<__hip_bfloat16, __hip_bfloat16> attn_mkref(int L, const __hip_bfloat16* Q, const __hip_bfloat16* K, const __hip_bfloat16* V, __hip_bfloat16* O, const unsigned char* ws, int lane) {
    const int qb = 31 - (L >> 5), seq = L & 31, b = seq >> 4, h = seq & 15;
    attn::BlockRef<__hip_bfloat16, __hip_bfloat16> r; const size_t rowq = (size_t)b * SEQ + (size_t)qb * attn::QB, row0 = (size_t)b * SEQ;
    r.Q = Q + rowq * DM + h * 128; r.O = O + rowq * DM + h * 128; r.K = K + row0 * DM + h * 128; r.V = V + row0 * DM + h * 128; r.Fb = (const float*)(ws + WS_FB) + (size_t)seq * SEQ; r.P0 = qb * attn::QB; r.O8 = (unsigned char*)ws + WS_YC8 + rowq * DM + h * 128;
    const char* FE = (const char*)((const float*)(ws + WS_FE) + seq * 128); const char* KN = (const char*)((const float*)(ws + WS_KN) + seq * 32);
    unsigned l4 = (unsigned)lane * 4u; asm volatile("" : "+v"(l4));
    const float kn = wave_max((lane & 31) <= qb ? *(const float*)(KN + (l4 & 124u)) : 0.f), qn = ((const float*)(ws + WS_QN))[seq * 32 + qb], fp = ((const float*)(ws + WS_FP))[seq * 32 + qb];
    const float dn = ((const float*)(ws + WS_DN))[seq * 32 + qb];
    const float tgt = fp - (SKIP_T + (sqrtf(qn * kn) * 1.0001f - dn) * ATT_SCALE);
    const int cnt = __popcll(__ballot(*(const float*)(FE + l4) <= tgt)) + __popcll(__ballot(*(const float*)(FE + 256 + l4) <= tgt));
    r.jlo = cnt < 4 * qb ? cnt : 4 * qb;
    return r;
}
__device__ __forceinline__ void ph_attention(const Args& a, char* lds, const int tid) {
    using namespace attn;
    typedef __hip_bfloat16 T;
    const T* Q = (const T*)(a.ws + WS_ZB); const T* K = Q + (size_t)M * DM; const T* V = K + (size_t)M * DM; T* O = (T*)(a.ws + WS_YC);
    unsigned* ctr = (unsigned*)(a.ws + 32768);
    volatile int* nextw = (volatile int*)(lds + attn::LDS_BYTES);
    const int lane = tid & 63, total = 1024;
    int L = blockIdx.x; if (L >= total) return;
    BlockRef<T, T> cur = attn_mkref(L, Q, K, V, O, a.ws, lane);
    Seam<T> S;
    causal_swa_prime<T, T>(cur, SEQ, lds, S, tid);
    for (;;) {
        if (tid == 0) *nextw = (int)gridDim.x + (int)__hip_atomic_fetch_add(ctr, 1u, __ATOMIC_RELAXED, __HIP_MEMORY_SCOPE_AGENT);
        __syncthreads();
        const int Ln = __builtin_amdgcn_readfirstlane(*nextw); const bool last = Ln >= total;
        const BlockRef<T, T> nxt = last ? cur : attn_mkref(Ln, Q, K, V, O, a.ws, lane);
        causal_swa_block<T, T>(cur, nxt, SEQ, SEQ, lds, S, tid);
        if (last) break;
        cur = nxt; L = Ln;
    }
}

__global__ void __launch_bounds__(NTHREADS, 2) mk_fwd(Args a) {
    extern __shared__ __attribute__((aligned(16))) unsigned char lds_raw[];
    cg::grid_group grid = cg::this_grid();
    LAS unsigned char* lds = (LAS unsigned char*)lds_raw;
    const int wave = __builtin_amdgcn_readfirstlane((int)threadIdx.x >> 6);
    unsigned char* ws = a.ws;
    const float* MOD = (const float*)(ws + WS_MOD);
    const int lo = a.ph_lo, hi = a.ph_hi;
    XcdBarrier bar;
    { const int l0 = lane_id(); volatile LAS unsigned* st = (volatile LAS unsigned*)(lds + LDS_CTL);
      if (wave == 0 && l0 == 0) { st[0] = 0u; st[1] = 0u; }
      __syncthreads();
      bar.bar = (unsigned*)ws; bar.x = xb_xcc_id(); bar.st = st;
      if (lo == 0) { if (blockIdx.x == 0) { unsigned* z = (unsigned*)ws; const int t_ = wave * 64 + l0;
#pragma unroll 1
              for (int i = t_; i < 4096; i += NTHREADS) __hip_atomic_store(z + i, 0u, __ATOMIC_RELAXED, __HIP_MEMORY_SCOPE_AGENT);
              if (t_ == 0) __hip_atomic_store(z + 8192, 0u, __ATOMIC_RELAXED, __HIP_MEMORY_SCOPE_AGENT); } }
      else if (wave == 0 && l0 == 0) { st[2] = xb_add(&bar.bar[XB_XCNT(bar.x)], 1u); st[3] = bar.x; } }
    int ph = 0;
#define PHASE_BEGIN if (ph >= lo && ph < hi) { const int lane = lane_id(), tid = wave * 64 + lane; (void)tid; (void)lane;
#define TID tid
#define PHASE_END   if (ph + 1 < hi) { if (ph == 0) { grid.sync(); if (wave == 0 && lane_id() == 0) { bar.st[2] = xb_add(&bar.bar[XB_XCNT(bar.x)], 1u); bar.st[3] = bar.x; } } else xcd_barrier(bar, wave == 0 && lane_id() == 0);     } } ++ph;
    bf16* HB = (bf16*)(ws + WS_HB); bf16* ZB = (bf16*)(ws + WS_ZB); bf16* YC = (bf16*)(ws + WS_YC); bf16* YB = (bf16*)(ws + WS_YB);
    float* X1 = (float*)(ws + WS_X1); bf16* H2 = (bf16*)(ws + WS_H2); bf16* QP = (bf16*)(ws + WS_QP);

    PHASE_BEGIN ph_prologue(a, lds, tid, lane, wave); PHASE_END
    PHASE_BEGIN ph_modulate(a.in[0], MOD, 0, 2048, HB, ws + WS_HB8, (float*)(ws + WS_SA), lane, wave); PHASE_END
    PHASE_BEGIN { pg8::Gemm g{(const bf16*)(ws + WS_HB8), (const bf16*)(ws + WS_WIN), M, NZ, DM / 2, DM / 2, DM / 2}; pg8::StaticOrder S; S.init(M, NZ, gridDim.x, blockIdx.x);
        pg8::EpiI8RowScaleBf16 E{ZB, NZ, (const float*)(ws + WS_SA), 1.f / W8_SCALE, 0, 0}; pg8::gemm_phase<pg8::EpiI8RowScaleBf16, pg8::StaticOrder, true, true, false, true>(lds, g, S, E, TID); } PHASE_END
    PHASE_BEGIN ph_poolconv(a, lane, wave); PHASE_END
    PHASE_BEGIN {
        if (gridDim.x == 256) {
            { const int gq = blockIdx.x >> 6, pm = blockIdx.x & 63;
              pg8::Gemm g{(const bf16*)(ws + WS_PO) + gq * 256, (const bf16*)(ws + WS_WPOOL) + gq * 65536, M, 256, 256, 1024, 256}; pg8::ListOrder S{pm, 1};
              pg8::EpiScaleBf16 E{ws + WS_YC8 + gq * 256, DM, a.in[12] + gq * 256, Y8_SCALE}; pg8::gemm_phase<pg8::EpiScaleBf16, pg8::ListOrder, false, true>(lds, g, S, E, TID); }
            { const int hb = blockIdx.x >> 5, pm0 = (blockIdx.x & 31) * 2;
              int kg = 128; asm volatile("" : "+s"(kg));
              pg8::Gemm g{(const bf16*)(ws + WS_XC) + hb * 128, (const bf16*)(ws + WS_WAX) + hb * 32768, M, 256, kg, 1024, 128}; pg8::ListOrder S{pm0, 2};
              pg8::EpiGate E{(const bf16*)(ws + WS_XC), (float*)(ws + WS_AF), (float*)(ws + WS_DF), a.in[16], a.in[18], (const float*)(ws + WS_LS8), hb * 128};
              pg8::gemm_phase<pg8::EpiGate, pg8::ListOrder, false, false>(lds, g, S, E, wave * 64 + lane_id()); }
        } } PHASE_END
    PHASE_BEGIN ph_scan_agg(a, tid); PHASE_END
    PHASE_BEGIN ph_scan_fin(a, tid); PHASE_END
    PHASE_BEGIN { pg8::Gemm g{(const bf16*)(ws + WS_YC8), (const bf16*)(ws + WS_WOUT), M, DM, DM / 2, DM / 2, DM / 2}; pg8::StaticOrder S; S.init(M, DM, gridDim.x, blockIdx.x);
        pg8::EpiRowScaleBf16 E{YB, DM, nullptr, 1.f / (W8O_SCALE * Y8_SCALE), 0, 0}; pg8::gemm_phase<pg8::EpiRowScaleBf16, pg8::StaticOrder, true, true, true>(lds, g, S, E, TID); } PHASE_END
    PHASE_BEGIN ph_ln<true>(YB, nullptr, HB, MOD, MOD, a.in[4], a.in[5], H2, ws + WS_X1, (float*)(ws + WS_X1 + 64 * MiB), ws + WS_H6, (float*)(ws + WS_HS), lds, lane, wave); PHASE_END
    PHASE_BEGIN { pg8::Gemm g{(const bf16*)(ws + WS_X1), (const bf16*)(ws + WS_WQ0), M, DM, DM / 2, DM / 2, DM / 2}; pg8::StaticOrder S; S.init(M, DM, gridDim.x, blockIdx.x);
        pg8::EpiI8RowScaleBf16 E{QP, DM, (const float*)(ws + WS_X1 + 64 * MiB), 1.f / W8_SCALE, 0, 0}; pg8::gemm_phase<pg8::EpiI8RowScaleBf16, pg8::StaticOrder, true, true, false, true>(lds, g, S, E, TID); } PHASE_END
    PHASE_BEGIN ph_topk(a, 0, lds, tid, lane, wave); PHASE_END
    PHASE_BEGIN ph_peer_u(a, 0, (volatile LAS unsigned*)(lds + LDS_CTL), lds, lane, wave); PHASE_END
    PHASE_BEGIN ph_peer_coef(a, 0, lds, lane, wave); PHASE_END
    PHASE_BEGIN ph_peer_v(a, 0, (volatile LAS unsigned*)(lds + LDS_CTL), lds, lane, wave); PHASE_END
    PHASE_BEGIN ph_peer_ln<false>(a, MOD, MOD + 2 * 12288, a.in[4] + DM, a.in[5] + DM, lds, lane, wave); PHASE_END
    PHASE_BEGIN { pg8::Gemm g{(const bf16*)(ws + WS_HB8), (const bf16*)(ws + WS_WQKV), M, NQKV, DM / 2, DM / 2, DM / 2}; pg8::StaticOrder S; S.init(M, NQKV, gridDim.x, blockIdx.x);
        pg8::EpiRowScaleBf16 E{ZB, DM, (const float*)(ws + WS_SA), 1.f / W8_SCALE, DM, (size_t)M * DM}; pg8::gemm_phase<pg8::EpiRowScaleBf16, pg8::StaticOrder, true, true, true>(lds, g, S, E, TID);
        ph_forget(a, lds, lane, wave); } PHASE_END
    PHASE_BEGIN ph_cumsum(a, lane, wave); PHASE_END
    PHASE_BEGIN ph_attention(a, (char*)lds_raw, TID); PHASE_END
    PHASE_BEGIN { pg8::Gemm g{(const bf16*)(ws + WS_YC8), (const bf16*)(ws + WS_WO), M, DM, DM / 2, DM / 2, DM / 2}; pg8::StaticOrder S; S.init(M, DM, gridDim.x, blockIdx.x);
        pg8::EpiRowScaleBf16 E{YB, DM, nullptr, 1.f / (W8O_SCALE * attn::O8_SCALE), 0, 0}; pg8::gemm_phase<pg8::EpiRowScaleBf16, pg8::StaticOrder, true, true, true>(lds, g, S, E, TID); } PHASE_END
    PHASE_BEGIN ph_ln<true>(YB, nullptr, HB, MOD + 2 * 12288, MOD + 2 * 12288, a.in[4] + 2 * DM, a.in[5] + 2 * DM, H2, ws + WS_X1, (float*)(ws + WS_X1 + 64 * MiB), ws + WS_H6, (float*)(ws + WS_HS), lds, lane, wave); PHASE_END
    PHASE_BEGIN { pg8::Gemm g{(const bf16*)(ws + WS_X1), (const bf16*)(ws + WS_WQ1), M, DM, DM / 2, DM / 2, DM / 2}; pg8::StaticOrder S; S.init(M, DM, gridDim.x, blockIdx.x);
        pg8::EpiI8RowScaleBf16 E{QP, DM, (const float*)(ws + WS_X1 + 64 * MiB), 1.f / W8_SCALE, 0, 0}; pg8::gemm_phase<pg8::EpiI8RowScaleBf16, pg8::StaticOrder, true, true, false, true>(lds, g, S, E, TID); } PHASE_END
    PHASE_BEGIN ph_topk(a, 1, lds, tid, lane, wave); PHASE_END
    PHASE_BEGIN ph_peer_u(a, 1, (volatile LAS unsigned*)(lds + LDS_CTL), lds, lane, wave); PHASE_END
    PHASE_BEGIN ph_peer_coef(a, 1, lds, lane, wave); PHASE_END
    PHASE_BEGIN ph_peer_v(a, 1, (volatile LAS unsigned*)(lds + LDS_CTL), lds, lane, wave); PHASE_END
    PHASE_BEGIN ph_peer_ln<true>(a, MOD + 2 * 12288, MOD, a.in[4] + 3 * DM, a.in[5] + 3 * DM, lds, lane, wave); PHASE_END
#undef PHASE_BEGIN
#undef TID
#undef PHASE_END
}
constexpr int N_PHASES = 26;

extern "C" void kernel_launch(void* const* d_in, const int* in_sizes, int n_in, void* d_out, int out_size, void* d_ws, size_t ws_size, hipStream_t stream) {
    static int grid = 0;
    if (grid == 0) {
        int dev = 0, cus = 0, per_cu = 0;
        if (n_in != 24 || out_size != M * DM || ws_size < WS_END) { fprintf(stderr, "kernel_launch: unexpected shapes (n_in %d, out %d, ws %zu)\n", n_in, out_size, ws_size); grid = -1; return; }
        (void)hipGetDevice(&dev);
        (void)hipDeviceGetAttribute(&cus, hipDeviceAttributeMultiprocessorCount, dev);
        (void)hipFuncSetAttribute((const void*)mk_fwd, hipFuncAttributeMaxDynamicSharedMemorySize, LDS_BYTES);
        (void)hipOccupancyMaxActiveBlocksPerMultiprocessor(&per_cu, (const void*)mk_fwd, NTHREADS, LDS_BYTES);
        if (per_cu < 1) { fprintf(stderr, "kernel_launch: occupancy query reports %d blocks per CU\n", per_cu); grid = -1; return; }
        grid = cus;
        if (grid != 256) fprintf(stderr, "kernel_launch: %d CUs; phase 4 is written for 256 workgroups\n", grid);
    }
    if (grid < 0) return;
#ifdef MK_SPLIT
    if (hipMemsetAsync(d_ws, 0, 65536, stream) != hipSuccess) { fprintf(stderr, "kernel_launch: hipMemsetAsync failed\n"); return; }
#endif
    Args a{};
    for (int i = 0; i < 24; ++i) a.in[i] = (const float*)d_in[i];
    a.out = (float*)d_out; a.ws = (unsigned char*)d_ws;
#ifndef MK_SPLIT
    a.ph_lo = 0; a.ph_hi = N_PHASES;
    void* args[] = {&a};
    hipError_t e = hipLaunchCooperativeKernel((const void*)mk_fwd, dim3(grid), dim3(NTHREADS), args, LDS_BYTES, stream);
    if (e != hipSuccess) fprintf(stderr, "cooperative launch failed: %s (grid %d)\n", hipGetErrorString(e), grid);
#else
    for (int p = 0; p < N_PHASES; ++p) { a.ph_lo = p; a.ph_hi = p + 1; void* args[] = {&a};
        hipError_t e = hipLaunchCooperativeKernel((const void*)mk_fwd, dim3(grid), dim3(NTHREADS), args, LDS_BYTES, stream);
        if (e != hipSuccess) { fprintf(stderr, "launch %d failed: %s\n", p, hipGetErrorString(e)); break; } }
#endif
}
```

```cpp
#include <hip/hip_runtime.h>
#include <hip/hip_bf16.h>
#include <hip/hip_cooperative_groups.h>
#include <cstdio>
#include <cstdint>
#include <cmath>
namespace cg = cooperative_groups;
namespace pg8 {
#define PG8_LAS __attribute__((address_space(3)))
typedef unsigned short bf16_t;
typedef short bf16x8 __attribute__((ext_vector_type(8)));
typedef float f32x4 __attribute__((ext_vector_type(4)));
typedef unsigned u32x4 __attribute__((ext_vector_type(4)));
constexpr int BM = 256, BK = 64, HALF = 128, HTB = HALF * BK * 2  , STAGE_BYTES = 8 * HTB, NXCD = 8, WGM = 8;

__host__ __device__ __forceinline__ int lds_byte(int r, int c) { const int st = (r >> 4) * 2 + (c >> 5), rr = r & 15, cc = c & 31, ob = rr * 64 + cc * 2; return st * 1024 + (ob ^ (((ob >> 9) & 1) << 5)); }
__host__ __device__ __forceinline__ void stage_rc(int b, int& R, int& C) { const int st = b / 1024, sb = b % 1024, swz = sb ^ (((sb >> 9) & 1) << 5); R = (st >> 1) * 16 + swz / 64; C = (st & 1) * 32 + (swz % 64) / 2; }
__host__ __device__ __forceinline__ int perm32(int rho) { const int n = rho >> 4, i = rho & 15; return 8 * (i >> 2) + 4 * n + (i & 3); }

struct Unit { int pm, pn; };
struct Gemm { const bf16_t* A; const bf16_t* Bt; int M, N, K, lda, ldb; };

struct StaticOrder {
    int nM, nN, nwg, G, c;
    __host__ __device__ void init(int M, int N, int G_, int c_) { nM = M / BM; nN = N / BM; nwg = nM * nN; G = G_; c = c_; }
    __host__ __device__ bool next(int i, Unit& u) const {
        const long L = (long)i * G + c; if (L >= nwg) return false;
        int wgid = (int)L; { const int q = nwg / NXCD, r = nwg % NXCD, xcd = wgid % NXCD, off = wgid / NXCD; wgid = (xcd < r ? xcd * (q + 1) : r * (q + 1) + (xcd - r) * q) + off; }
        const int nig = WGM * nN, gid = wgid / nig, fm = gid * WGM, gsz = (nM - fm) < WGM ? (nM - fm) : WGM;
        u.pm = fm + ((wgid % nig) % gsz); u.pn = (wgid % nig) / gsz; return true;
    }
    __device__ __forceinline__ void a_ready(const Unit&) const {}
    __device__ __forceinline__ void done(const Unit&) const {}
};

__device__ __forceinline__ unsigned cvt_pk_bf16(float lo, float hi) { typedef float f2_ __attribute__((ext_vector_type(2))); typedef __bf16 b2_ __attribute__((ext_vector_type(2))); const f2_ f = {lo, hi}; return __builtin_bit_cast(unsigned, __builtin_convertvector(f, b2_)); }
typedef float f32x2 __attribute__((ext_vector_type(2)));
__device__ __forceinline__ f32x2 gelu_pk(f32x2 v) {
    const f32x2 av = __builtin_elementwise_abs(v), d = av * 0.2316418882f + 1.0f;
    f32x2 t; t.x = __builtin_amdgcn_rcpf(d.x); t.y = __builtin_amdgcn_rcpf(d.y);
    f32x2 q = t * 0.5307027145f + (-0.7265760135f); q = q * t + 0.7107068705f; q = q * t + (-0.142248368f); q = q * t + 0.127414796f; q = q * t;
    const f32x2 s = (v * v) * (-0.72134752044f);
    f32x2 e; e.x = __builtin_amdgcn_exp2f(s.x); e.y = __builtin_amdgcn_exp2f(s.y);
    const f32x2 m = v * (q * e), r = v - m;
    f32x2 o; o.x = v.x < 0.f ? m.x : r.x; o.y = v.y < 0.f ? m.y : r.y; return o;
}

template <int ACT  > struct EpiBf16 {
    static constexpr bool PERM = true, AFTER_DRAIN = false; static_assert(ACT == 0 || ACT == 1, "EpiBf16: ACT is 0 (none) or 1 (gelu_pk)");
    bf16_t* O; int ldc; const float* bias; int split_cols; size_t split_stride; float scale0;
    __device__ __forceinline__ void operator()(const f32x4 (&acc)[2][2][4][2], const Unit& u, int wr, int wc, int fr, int fq) const {
        const int row0 = u.pm * BM + wr * 64 + fr; int colt = u.pn * BM; bf16_t* base = O;
        float sc = 1.f; if (split_cols) { const int t = colt / split_cols; base += (size_t)t * split_stride; colt -= t * split_cols; if (t == 0) sc = scale0; }
        const int col0 = colt + wc * 32 + 8 * fq, bcol0 = u.pn * BM + wc * 32 + 8 * fq;
        f32x4 bv[2][2];
#pragma unroll
        for (int bj = 0; bj < 2; ++bj)
#pragma unroll
            for (int n = 0; n < 2; ++n) bv[bj][n] = bias ? *(const f32x4*)(bias + bcol0 + bj * HALF + 4 * n) : (f32x4){0.f, 0.f, 0.f, 0.f};
#pragma unroll
        for (int ai = 0; ai < 2; ++ai)
#pragma unroll
            for (int m = 0; m < 4; ++m) { bf16_t* rowp = base + (size_t)(row0 + ai * HALF + m * 16) * ldc + col0;
#pragma unroll
                for (int bj = 0; bj < 2; ++bj) { f32x4 v0 = acc[ai][bj][m][0] + bv[bj][0], v1 = acc[ai][bj][m][1] + bv[bj][1];
                    if (ACT == 1) { f32x2 a = gelu_pk((f32x2){v0[0], v0[1]}), b = gelu_pk((f32x2){v0[2], v0[3]}), c = gelu_pk((f32x2){v1[0], v1[1]}), d = gelu_pk((f32x2){v1[2], v1[3]});
                        v0 = (f32x4){a.x, a.y, b.x, b.y}; v1 = (f32x4){c.x, c.y, d.x, d.y}; }
                    v0 = v0 * sc; v1 = v1 * sc; u32x4 w; w.x = cvt_pk_bf16(v0[0], v0[1]); w.y = cvt_pk_bf16(v0[2], v0[3]); w.z = cvt_pk_bf16(v1[0], v1[1]); w.w = cvt_pk_bf16(v1[2], v1[3]);
                    *(u32x4*)(rowp + bj * HALF) = w; } }
    }
};

template <class Epi, class Sched, bool ALIGN_EPI = false, bool SP2 = false, bool FP8 = false, bool I8 = false>
__device__ __forceinline__ void gemm_phase(PG8_LAS unsigned char* lds, const Gemm g, const Sched& S, const Epi& E, const int tid) {
    const int wid = __builtin_amdgcn_readfirstlane(tid >> 6), lane = tid & 63, wr = wid >> 2, wc = wid & 3, fr = lane & 15, fq = lane >> 4;
    const int K = g.K, nt = K / BK;
    unsigned voffA[2], voffB[2];
#pragma unroll
    for (int i = 0; i < 2; ++i) { int R, C; stage_rc(tid * 16 + i * 8192, R, C); const int Rb = Epi::PERM ? ((R & ~31) + perm32(R & 31)) : R;
        voffA[i] = (unsigned)(R * g.lda + C) * 2u; voffB[i] = (unsigned)(Rb * g.ldb + C) * 2u; }
    const __amdgpu_buffer_rsrc_t rA = __builtin_amdgcn_make_buffer_rsrc((void*)g.A, 0, (int)((size_t)g.M * g.lda * 2), 0x00020000), rB = __builtin_amdgcn_make_buffer_rsrc((void*)g.Bt, 0, (int)((size_t)g.N * g.ldb * 2), 0x00020000);
    const size_t kstep = (size_t)(BK * 2);
    const size_t hstepA = (size_t)HALF * g.lda * 2, hstepB = (size_t)HALF * g.ldb * 2;
    const size_t tstepA = 2 * hstepA, tstepB = 2 * hstepB;
    const unsigned ldsw = (unsigned)wid * 1024u;
    const int aoffk[2] = {FP8 ? lds_byte(wr * 64 + fr, fq * 16) : lds_byte(wr * 64 + fr, fq * 8), FP8 ? lds_byte(wr * 64 + fr, fq * 16 + 8) : lds_byte(wr * 64 + fr, fq * 8) + 1024};
    const int boffk[2] = {FP8 ? lds_byte(wc * 32 + fr, fq * 16) : lds_byte(wc * 32 + fr, fq * 8), FP8 ? lds_byte(wc * 32 + fr, fq * 16 + 8) : lds_byte(wc * 32 + fr, fq * 8) + 1024};
#define PG8_SA(b, h) (((b) * 2 + (h)) * HTB)
#define PG8_SB(b, h) ((4 + (b) * 2 + (h)) * HTB)
#define PG8_STAGE(bufoff, gbase, voff, rs, gorig) do { _Pragma("unroll") for (int _i = 0; _i < 2; ++_i) \
        __builtin_amdgcn_raw_ptr_buffer_load_lds(rs, (PG8_LAS void*)(lds + (bufoff) + ldsw + _i * 8192), 16, (voff)[_i], (unsigned)((const char*)(gbase) - (const char*)(gorig)), 0, 0); } while (0)
#define PG8_LDA(dst, b, h) do { if constexpr (FP8) { _Pragma("unroll") for (int m = 0; m < 4; ++m) dst##8[m] = __builtin_shufflevector(*(const PG8_LAS bf16x8*)(lds + PG8_SA(b, h) + aoffk[0] + m * 2048), *(const PG8_LAS bf16x8*)(lds + PG8_SA(b, h) + aoffk[1] + m * 2048), 0, 1, 2, 3, 4, 5, 6, 7, 8, 9, 10, 11, 12, 13, 14, 15); } \
        else { _Pragma("unroll") for (int m = 0; m < 4; ++m) _Pragma("unroll") for (int k = 0; k < 2; ++k) dst[m][k] = *(const PG8_LAS bf16x8*)(lds + PG8_SA(b, h) + aoffk[k] + m * 2048); } } while (0)
#define PG8_LDB(dst, b, h) do { if constexpr (FP8) { _Pragma("unroll") for (int n = 0; n < 2; ++n) dst##8[n] = __builtin_shufflevector(*(const PG8_LAS bf16x8*)(lds + PG8_SB(b, h) + boffk[0] + n * 2048), *(const PG8_LAS bf16x8*)(lds + PG8_SB(b, h) + boffk[1] + n * 2048), 0, 1, 2, 3, 4, 5, 6, 7, 8, 9, 10, 11, 12, 13, 14, 15); } \
        else { _Pragma("unroll") for (int n = 0; n < 2; ++n) _Pragma("unroll") for (int k = 0; k < 2; ++k) dst[n][k] = *(const PG8_LAS bf16x8*)(lds + PG8_SB(b, h) + boffk[k] + n * 2048); } } while (0)
#define PG8_MMA(ai, bj, At, Bt) do { __builtin_amdgcn_s_setprio(1); _Pragma("unroll") for (int m = 0; m < 4; ++m) _Pragma("unroll") for (int n = 0; n < 2; ++n) { \
        if constexpr (FP8) { typedef int i32x8 __attribute__((ext_vector_type(8))); \
            acc[ai][bj][m][n] = __builtin_amdgcn_mfma_scale_f32_16x16x128_f8f6f4(__builtin_bit_cast(i32x8, Bt##8[n]), __builtin_bit_cast(i32x8, At##8[m]), acc[ai][bj][m][n], 0, 0, 0, 127, 0, 127); } \
        else if constexpr (I8) { typedef int i32x4_ __attribute__((ext_vector_type(4))); _Pragma("unroll") for (int k = 0; k < 2; ++k) \
            acc[ai][bj][m][n] = __builtin_bit_cast(f32x4, __builtin_amdgcn_mfma_i32_16x16x64_i8(__builtin_bit_cast(i32x4_, Bt[n][k]), __builtin_bit_cast(i32x4_, At[m][k]), __builtin_bit_cast(i32x4_, acc[ai][bj][m][n]), 0, 0, 0)); } \
        else { _Pragma("unroll") for (int k = 0; k < 2; ++k) acc[ai][bj][m][n] = __builtin_amdgcn_mfma_f32_16x16x32_bf16(Bt[n][k], At[m][k], acc[ai][bj][m][n], 0, 0, 0); } } \
        __builtin_amdgcn_s_setprio(0); } while (0)
#define PG8_WAIT_V(n) asm volatile("s_waitcnt vmcnt(" #n ")" ::: "memory")
#define PG8_WAIT_L(n) asm volatile("s_waitcnt lgkmcnt(" #n ")" ::: "memory")
#define PG8_BAR __builtin_amdgcn_s_barrier()
#define PG8_SCHED __builtin_amdgcn_sched_barrier(0)
    Unit cur, nxt; int ui = 0;
    if (!S.next(0, cur)) return;
    f32x4 acc[2][2][4][2];
#pragma unroll
    for (int a = 0; a < 2; ++a)
#pragma unroll
        for (int b = 0; b < 2; ++b)
#pragma unroll
            for (int m = 0; m < 4; ++m)
#pragma unroll
                for (int n = 0; n < 2; ++n) acc[a][b][m][n] = (f32x4){0.f, 0.f, 0.f, 0.f};
    bf16x8 At[4][2], B0[2][2], B1[2][2]; typedef short bf16x16 __attribute__((ext_vector_type(16))); bf16x16 At8[4], B08[2], B18[2];
    const char* cA = (const char*)g.A + (size_t)cur.pm * tstepA; const char* cB = (const char*)g.Bt + (size_t)cur.pn * tstepB;
    S.a_ready(cur);
    if constexpr (SP2) {
        PG8_STAGE(PG8_SB(0, 0), cB, voffB, rB, g.Bt); PG8_STAGE(PG8_SB(0, 1), cB + hstepB, voffB, rB, g.Bt); PG8_STAGE(PG8_SA(0, 0), cA, voffA, rA, g.A); PG8_STAGE(PG8_SA(0, 1), cA + hstepA, voffA, rA, g.A);
        if (wr == 1) PG8_BAR;
        PG8_WAIT_V(2); PG8_BAR;
        PG8_STAGE(PG8_SB(1, 0), cB + kstep, voffB, rB, g.Bt); PG8_STAGE(PG8_SA(1, 0), cA + kstep, voffA, rA, g.A); PG8_STAGE(PG8_SB(1, 1), cB + hstepB + kstep, voffB, rB, g.Bt);
        PG8_WAIT_V(6); PG8_BAR;
    } else {
        PG8_STAGE(PG8_SB(0, 0), cB, voffB, rB, g.Bt); PG8_STAGE(PG8_SA(0, 0), cA, voffA, rA, g.A); PG8_STAGE(PG8_SB(0, 1), cB + hstepB, voffB, rB, g.Bt); PG8_STAGE(PG8_SA(0, 1), cA + hstepA, voffA, rA, g.A);
        if (wr == 1) PG8_BAR;
        PG8_WAIT_V(4); PG8_BAR;
        PG8_STAGE(PG8_SB(1, 0), cB + kstep, voffB, rB, g.Bt); PG8_STAGE(PG8_SA(1, 0), cA + kstep, voffA, rA, g.A); PG8_STAGE(PG8_SB(1, 1), cB + hstepB + kstep, voffB, rB, g.Bt);
        PG8_WAIT_V(6); PG8_BAR;
    }
    for (;;) {
        const bool has_next = S.next(ui + 1, nxt);
        const char* nA = has_next ? (const char*)g.A + (size_t)nxt.pm * tstepA : cA; const char* nB = has_next ? (const char*)g.Bt + (size_t)nxt.pn * tstepB : cB;
        for (int t = 0; t < nt; t += 2) {
            const bool last = (t == nt - 2);
            const char* a1 = cA + (size_t)(t + 1) * kstep;
            const char* a2 = last ? nA : cA + (size_t)(t + 2) * kstep; const char* b2 = last ? nB : cB + (size_t)(t + 2) * kstep;
            const char* a3 = a2 + kstep; const char* b3 = b2 + kstep;
            if (last && has_next) S.a_ready(nxt);
            if constexpr (SP2) {
            PG8_LDB(B0, 0, 0); PG8_LDB(B1, 0, 1); PG8_SCHED; PG8_LDA(At, 0, 0); PG8_STAGE(PG8_SA(1, 1), a1 + hstepA, voffA, rA, g.A);
            PG8_WAIT_V(8); PG8_WAIT_L(0); PG8_BAR; PG8_MMA(0, 0, At, B0); PG8_MMA(0, 1, At, B1); PG8_BAR; PG8_SCHED;
            PG8_LDA(At, 0, 1); PG8_STAGE(PG8_SB(0, 0), b2, voffB, rB, g.Bt); PG8_STAGE(PG8_SB(0, 1), b2 + hstepB, voffB, rB, g.Bt); PG8_STAGE(PG8_SA(0, 0), a2, voffA, rA, g.A);
            PG8_WAIT_V(8); PG8_WAIT_L(0); PG8_BAR; PG8_MMA(1, 0, At, B0); PG8_MMA(1, 1, At, B1); PG8_BAR; PG8_SCHED;
            PG8_LDB(B0, 1, 0); PG8_LDB(B1, 1, 1); PG8_SCHED; PG8_LDA(At, 1, 0); PG8_STAGE(PG8_SA(0, 1), a2 + hstepA, voffA, rA, g.A);
            PG8_WAIT_V(8); PG8_WAIT_L(0); PG8_BAR; PG8_MMA(0, 0, At, B0); PG8_MMA(0, 1, At, B1); PG8_BAR; PG8_SCHED;
            PG8_LDA(At, 1, 1); PG8_STAGE(PG8_SB(1, 0), b3, voffB, rB, g.Bt); PG8_STAGE(PG8_SB(1, 1), b3 + hstepB, voffB, rB, g.Bt); PG8_STAGE(PG8_SA(1, 0), a3, voffA, rA, g.A);
            PG8_WAIT_V(8); PG8_WAIT_L(0); PG8_BAR; PG8_MMA(1, 0, At, B0); PG8_MMA(1, 1, At, B1); PG8_BAR; PG8_SCHED;
            } else {
            PG8_LDB(B0, 0, 0); PG8_SCHED; PG8_LDA(At, 0, 0); PG8_STAGE(PG8_SA(1, 1), a1 + hstepA, voffA, rA, g.A);
            PG8_WAIT_L(8); PG8_BAR; PG8_WAIT_L(0); PG8_MMA(0, 0, At, B0); PG8_BAR; PG8_SCHED;
            PG8_LDB(B1, 0, 1); PG8_STAGE(PG8_SB(0, 0), b2, voffB, rB, g.Bt);
            PG8_BAR; PG8_WAIT_L(0); PG8_MMA(0, 1, At, B1); PG8_BAR;
            PG8_LDA(At, 0, 1); PG8_STAGE(PG8_SA(0, 0), a2, voffA, rA, g.A);
            PG8_BAR; PG8_WAIT_L(0); PG8_MMA(1, 0, At, B0); PG8_BAR; PG8_SCHED;
            PG8_STAGE(PG8_SB(0, 1), b2 + hstepB, voffB, rB, g.Bt);
            PG8_WAIT_V(6); PG8_BAR; PG8_MMA(1, 1, At, B1); PG8_BAR;
            PG8_LDB(B0, 1, 0); PG8_SCHED; PG8_LDA(At, 1, 0); PG8_STAGE(PG8_SA(0, 1), a2 + hstepA, voffA, rA, g.A);
            PG8_WAIT_L(8); PG8_BAR; PG8_WAIT_L(0); PG8_MMA(0, 0, At, B0); PG8_BAR; PG8_SCHED;
            PG8_LDB(B1, 1, 1); PG8_STAGE(PG8_SB(1, 0), b3, voffB, rB, g.Bt);
            PG8_BAR; PG8_WAIT_L(0); PG8_MMA(0, 1, At, B1); PG8_BAR;
            PG8_LDA(At, 1, 1); PG8_STAGE(PG8_SA(1, 0), a3, voffA, rA, g.A);
            PG8_BAR; PG8_WAIT_L(0); PG8_MMA(1, 0, At, B0); PG8_BAR; PG8_SCHED;
            PG8_STAGE(PG8_SB(1, 1), b3 + hstepB, voffB, rB, g.Bt);
            PG8_WAIT_V(6); PG8_BAR; PG8_MMA(1, 1, At, B1); PG8_BAR;
            }
        }
        if constexpr (ALIGN_EPI) { if (wr == 0) PG8_BAR; }
        if constexpr (!Epi::AFTER_DRAIN) { E(acc, cur, wr, wc, fr, fq); S.done(cur); }
        if (!has_next) break;
#pragma unroll
        for (int a = 0; a < 2; ++a)
#pragma unroll
            for (int b = 0; b < 2; ++b)
#pragma unroll
                for (int m = 0; m < 4; ++m)
#pragma unroll
                    for (int n = 0; n < 2; ++n) acc[a][b][m][n] = (f32x4){0.f, 0.f, 0.f, 0.f};
        cur = nxt; cA = nA; cB = nB; ++ui;
        if constexpr (ALIGN_EPI) { if (wr == 1) PG8_BAR; }
    }
    PG8_WAIT_V(0);
    if constexpr (!ALIGN_EPI) { if (wr == 0) PG8_BAR; }
    PG8_BAR;
    if constexpr (Epi::AFTER_DRAIN) { E.fused(acc, cur, wr, wc, fr, fq, lds, wid, lane); S.done(cur); }
#undef PG8_SA
#undef PG8_SB
#undef PG8_STAGE
#undef PG8_LDA
#undef PG8_LDB
#undef PG8_MMA
#undef PG8_WAIT_V
#undef PG8_WAIT_L
#undef PG8_BAR
#undef PG8_SCHED
}
}

namespace attn {
constexpr float SCALE = 0.08838834764831845f;
constexpr int D = 128, PITCH = 2048;
constexpr float THR = 8.f; constexpr bool WSKIP = true; constexpr bool O_FP8 = true; constexpr float O8_SCALE = 16.f;
constexpr int NW = 8, QBLK = 32, KVBLK = 64, QB = NW * QBLK;
constexpr int SHM_V = KVBLK * D * 2, SHM_K = KVBLK * D * 2;
constexpr int LDS_BIAS = 2 * SHM_V + 2 * SHM_K + NW * 64 * 4;
constexpr int LDS_BYTES = LDS_BIAS + 2 * 256;
using bf16 = __hip_bfloat16;
typedef short bf16x8 __attribute__((ext_vector_type(8)));
typedef short s16x4 __attribute__((ext_vector_type(4)));
typedef float f32x16 __attribute__((ext_vector_type(16)));
typedef float f32x4 __attribute__((ext_vector_type(4)));
typedef unsigned u32x4 __attribute__((ext_vector_type(4)));
template <class A, class Bt> struct same_t { static constexpr bool v = false; };
template <class A> struct same_t<A, A> { static constexpr bool v = true; };

#define KSWZ(row, colB) ((row) * 256 + ((colB) ^ (((row) & 7) << 4)))
#define SBAR() __builtin_amdgcn_sched_barrier(0)
__device__ __forceinline__ int v_st(int k, int c) { const int kk = (k & ~0xC) | ((k & 4) << 1) | ((k & 8) >> 1); return ((kk >> 3) * 4 + (c >> 5)) * 512 + ((kk & 7) * 32 + (c & 31)) * 2; }
__device__ __forceinline__ int v_rd_base(int lane) { return ((lane & 3) << 3) | (((lane >> 2) & 3) << 6) | (((lane >> 4) & 1) << 5) | (((lane >> 5) & 1) << 8); }
constexpr int v_rd_off(int d0, int ks, int half) { return d0 * 512 + ks * 4096 + half * 2048; }
__device__ __forceinline__ int crow(int r, int hi) { return (r & 3) + 8 * (r >> 2) + 4 * hi; }
__device__ __forceinline__ unsigned cvtpk(float lo, float hi) {
    typedef float f2_ __attribute__((ext_vector_type(2))); typedef __bf16 b2_ __attribute__((ext_vector_type(2))); const f2_ f = {lo, hi}; return __builtin_bit_cast(unsigned, __builtin_convertvector(f, b2_));
}
__device__ __forceinline__ bf16x8 pack8(f32x4 a, f32x4 b) {
    u32x4 w = {cvtpk(a[0], a[1]), cvtpk(a[2], a[3]), cvtpk(b[0], b[1]), cvtpk(b[2], b[3])};
    return *reinterpret_cast<bf16x8*>(&w);
}
template <class T> __device__ __forceinline__ bf16x8 load8(const T* p) {
    if constexpr (same_t<T, float>::v) { return pack8(*(const f32x4*)p, *(const f32x4*)(p + 4)); }
    else { return *reinterpret_cast<const bf16x8*>(p); }
}
__device__ __forceinline__ void mask_tile(f32x16& p0, f32x16& p1, int dq, unsigned W) {
    const float NEG = -__builtin_inff();
#pragma unroll
    for (int r = 0; r < 16; ++r) {
        const int c = (r & 3) + 8 * (r >> 2);
        if ((unsigned)(dq - c) >= W) p0[r] = NEG;
        if ((unsigned)(dq - c - 32) >= W) p1[r] = NEG;
    }
}
constexpr float DEAD_T = 20.f;
__device__ __forceinline__ void partialSM(f32x16& p0, f32x16& p1, float& m_reg, float& mn, float& alpha, bool& dead) {
    float pmax = p0[0]; for (int r = 1; r < 16; ++r) pmax = fmaxf(pmax, p0[r]); for (int r = 0; r < 16; ++r) pmax = fmaxf(pmax, p1[r]);
    { auto rr = __builtin_amdgcn_permlane32_swap(__float_as_uint(pmax), __float_as_uint(pmax), false, false);
      pmax = fmaxf(__uint_as_float(rr[0]), __uint_as_float(rr[1])); }
    constexpr float C2 = 1.4426950408889634f * SCALE;
    dead = __all((pmax - m_reg) * SCALE < -DEAD_T);
    if (dead) { mn = m_reg; alpha = 1.f; return; }
    if (__builtin_expect(__all((pmax - m_reg) * SCALE <= THR), 1)) { mn = m_reg; alpha = 1.f; }
    else { mn = fmaxf(m_reg, pmax); alpha = __builtin_amdgcn_exp2f((m_reg - mn) * C2); m_reg = mn; }
    const float mnL = -mn * C2;
    for (int r = 0; r < 16; ++r) p0[r] = fmaf(p0[r], C2, mnL); for (int r = 0; r < 16; ++r) p1[r] = fmaf(p1[r], C2, mnL);
    for (int r = 0; r < 16; ++r) p0[r] = __builtin_amdgcn_exp2f(p0[r]);
}
__device__ __forceinline__ void finishSM(f32x16& p0, f32x16& p1, float alpha, float& l_reg, bf16x8& pa0, bf16x8& pa1, bf16x8& pa2, bf16x8& pa3) {
    for (int r = 0; r < 16; ++r) p1[r] = __builtin_amdgcn_exp2f(p1[r]);
    float ps = 0; for (int r = 0; r < 16; ++r) ps += p0[r]; for (int r = 0; r < 16; ++r) ps += p1[r];
    { auto rr = __builtin_amdgcn_permlane32_swap(__float_as_uint(ps), __float_as_uint(ps), false, false);
      ps = __uint_as_float(rr[0]) + __uint_as_float(rr[1]); }
    l_reg = l_reg * alpha + ps;
#define PK4(P, B_, OUT) do { unsigned a0 = cvtpk(P[B_+0], P[B_+1]), a1 = cvtpk(P[B_+2], P[B_+3]);                          \
        unsigned b0 = cvtpk(P[B_+4], P[B_+5]), b1 = cvtpk(P[B_+6], P[B_+7]);                                             \
        auto r0 = __builtin_amdgcn_permlane32_swap(a0, b0, false, false); auto r1 = __builtin_amdgcn_permlane32_swap(a1, b1, false, false); \
        u32x4 w = {r0[0], r1[0], r0[1], r1[1]}; OUT = *reinterpret_cast<bf16x8*>(&w); } while (0)
    PK4(p0, 0, pa0); PK4(p0, 8, pa1); PK4(p1, 0, pa2); PK4(p1, 8, pa3);
#undef PK4
}
template <int KB, bool SK>
__device__ __forceinline__ void qkt(f32x16& p0, f32x16& p1, const char* K_lds, int r32, int hi, const bf16x8* qr, bool act) {
    const float* bl = (const float*)(K_lds - 2 * SHM_V + LDS_BIAS + KB * 256) + 4 * hi;
    if (SK && !act) { const float NEG = -__builtin_inff();
#pragma unroll
        for (int r = 0; r < 16; ++r) { p0[r] = NEG; p1[r] = NEG; } return; }
#pragma unroll
    for (int g_ = 0; g_ < 4; ++g_) { const f32x4 b0_ = *(const f32x4*)(bl + 8 * g_), b1_ = *(const f32x4*)(bl + 32 + 8 * g_);
#pragma unroll
        for (int e_ = 0; e_ < 4; ++e_) { p0[4 * g_ + e_] = b0_[e_]; p1[4 * g_ + e_] = b1_[e_]; } }
    const char* kb[4];
#pragma unroll
    for (int dd = 0; dd < 4; ++dd) kb[dd] = K_lds + KB * SHM_K + KSWZ(r32, (dd * 16 + hi * 8) * 2);
#pragma unroll
    for (int d0 = 0; d0 < 8; ++d0) { const char* a = kb[d0 & 3] + (d0 >> 2) * 128;
        bf16x8 b0 = *reinterpret_cast<const bf16x8*>(a);
        bf16x8 b1 = *reinterpret_cast<const bf16x8*>(a + 32 * 256);
        p0 = __builtin_amdgcn_mfma_f32_32x32x16_bf16(b0, qr[d0], p0, 0, 0, 0);
        p1 = __builtin_amdgcn_mfma_f32_32x32x16_bf16(b1, qr[d0], p1, 0, 0, 0); }
}
template <int VB, bool SK>
__device__ __forceinline__ void pv_tile(f32x16* o, int vb0, bf16x8 pa0, bf16x8 pa1, bf16x8 pa2, bf16x8 pa3, bool act) {
    if (SK && !act) return;
#define TRRD(dst, off) asm volatile("ds_read_b64_tr_b16 %0, %1 offset:%2" : "=&v"(dst) : "v"(vb0), "i"(off) : "memory")
#define PV_D0(d0) do { s16x4 l0, l1, l2, l3, h0, h1, h2, h3; constexpr int b_ = VB * SHM_V + v_rd_off(d0, 0, 0);     \
        TRRD(l0, b_); TRRD(h0, b_ + 2048); TRRD(l1, b_ + 4096); TRRD(h1, b_ + 6144); TRRD(l2, b_ + 8192); TRRD(h2, b_ + 10240); TRRD(l3, b_ + 12288); TRRD(h3, b_ + 14336); \
        asm volatile("s_waitcnt lgkmcnt(0)" ::: "memory"); SBAR();                 \
        o[d0] = __builtin_amdgcn_mfma_f32_32x32x16_bf16(pa0, (bf16x8){l0[0], l0[1], l0[2], l0[3], h0[0], h0[1], h0[2], h0[3]}, o[d0], 0, 0, 0);   \
        o[d0] = __builtin_amdgcn_mfma_f32_32x32x16_bf16(pa1, (bf16x8){l1[0], l1[1], l1[2], l1[3], h1[0], h1[1], h1[2], h1[3]}, o[d0], 0, 0, 0);   \
        o[d0] = __builtin_amdgcn_mfma_f32_32x32x16_bf16(pa2, (bf16x8){l2[0], l2[1], l2[2], l2[3], h2[0], h2[1], h2[2], h2[3]}, o[d0], 0, 0, 0);   \
        o[d0] = __builtin_amdgcn_mfma_f32_32x32x16_bf16(pa3, (bf16x8){l3[0], l3[1], l3[2], l3[3], h3[0], h3[1], h3[2], h3[3]}, o[d0], 0, 0, 0); } while (0)
    PV_D0(0); PV_D0(1); PV_D0(2); PV_D0(3);
#undef PV_D0
#undef TRRD
}

template <class TIn, class TOut> struct BlockRef { const TIn* Q; const TIn* K; const TIn* V; TOut* O; const float* Fb; int P0; int jlo; unsigned char* O8; };
template <class TIn> struct Seam {
    bf16x8 qr[8];
    bf16x8 st_v0, st_v1, st_k0, st_k1; f32x4 sf0, sf1, sf2, sf3;
    f32x4 tq[16];
};
__device__ __forceinline__ int swa_jlo(int P0, int W) { const int lowk = P0 - W + 1; return lowk > 0 ? lowk / KVBLK : 0; }
#define ROW(p, k0, rr) ((const TIn*)((const char*)(p) + (unsigned)((((k0) + (rr)) * PITCH + sc) * (int)sizeof(TIn))))
#define VMW() asm volatile("s_waitcnt vmcnt(0)" ::: "memory")
#define VMWN(n) asm volatile("s_waitcnt vmcnt(%0)" :: "i"(n) : "memory")
#define SLOAD_H(Kp, Vp, Fp, bb, k0) do { S.st_v0 = load8<TIn>(ROW(Vp, k0, sr)); S.st_v1 = load8<TIn>(ROW(Vp, k0, 32 + sr));              \
                         S.st_k0 = load8<TIn>(ROW(Kp, k0, sr)); S.st_k1 = load8<TIn>(ROW(Kp, k0, 32 + sr));                          \
                         if (wid == 0) __builtin_amdgcn_global_load_lds((const unsigned*)((Fp) + (k0) + lane), (__attribute__((address_space(3))) unsigned*)(lds + LDS_BIAS + (bb) * 256), 4, 0, 0); } while (0)
#define SWRITE_HK(bf) do { int t_ = tid; asm volatile("" : "+v"(t_)); const int kws_ = KSWZ(t_ >> 4, (t_ & 15) * 16);     \
        *(bf16x8*)(K_lds + (bf) * SHM_K + kws_) = S.st_k0; *(bf16x8*)(K_lds + (bf) * SHM_K + kws_ + 32 * 256) = S.st_k1; } while (0)
#define SWRITE_HV(bf) do { int t_ = tid; asm volatile("" : "+v"(t_)); const int vst0_ = v_st(t_ >> 4, (t_ & 15) * 8), vst1_ = v_st(32 + (t_ >> 4), (t_ & 15) * 8); \
        *(bf16x8*)(V_lds + (bf) * SHM_V + vst0_) = S.st_v0; *(bf16x8*)(V_lds + (bf) * SHM_V + vst1_) = S.st_v1; } while (0)
#define SWRITE_H(bf) do { SWRITE_HV(bf); SWRITE_HK(bf); } while (0)
#define SLOAD_F(p, k0) do { S.sf0 = *(const f32x4*)ROW(p, k0, sr); S.sf1 = *(const f32x4*)(ROW(p, k0, sr) + 4);                \
                            S.sf2 = *(const f32x4*)ROW(p, k0, 32 + sr); S.sf3 = *(const f32x4*)(ROW(p, k0, 32 + sr) + 4); } while (0)
#define SWRITE_KF(bf) do { *(bf16x8*)(K_lds + (bf) * SHM_K + kws) = pack8(S.sf0, S.sf1); *(bf16x8*)(K_lds + (bf) * SHM_K + kws + 32 * 256) = pack8(S.sf2, S.sf3); } while (0)
#define SWRITE_VF(bf) do { *(bf16x8*)(V_lds + (bf) * SHM_V + vst0) = pack8(S.sf0, S.sf1); *(bf16x8*)(V_lds + (bf) * SHM_V + vst1) = pack8(S.sf2, S.sf3); } while (0)
template <class TIn, class TOut>
__device__ __forceinline__ void causal_swa_prime(const BlockRef<TIn, TOut>& cur, int W, char* lds, Seam<TIn>& S, const int tid) {
    constexpr bool F32 = same_t<TIn, float>::v;
    const int wid = __builtin_amdgcn_readfirstlane(tid >> 6), lane = tid & 63, r32 = lane & 31, hi = lane >> 5;
    const int sr = tid >> 4, sc = (tid & 15) * 8, kws = KSWZ(sr, sc * 2); char* K_lds = lds + 2 * SHM_V;
    const int kb0 = ((cur.P0 + QB - 1) / KVBLK) * KVBLK;
    for (int d0 = 0; d0 < 8; ++d0) S.qr[d0] = load8<TIn>(cur.Q + (size_t)(wid * QBLK + r32) * PITCH + d0 * 16 + hi * 8);
    if constexpr (F32) { SLOAD_F((const float*)cur.K, kb0); VMW(); SWRITE_KF(0); SBAR(); SLOAD_F((const float*)cur.V, kb0); }
    else { SLOAD_H(cur.K, cur.V, cur.Fb, 0, kb0); VMW(); SWRITE_HK(0); }
    __syncthreads();
}
template <class TIn, class TOut>
__device__ __forceinline__ void causal_swa_block(const BlockRef<TIn, TOut>& cur, const BlockRef<TIn, TOut>& nxt, int skv, int W, char* lds, Seam<TIn>& S, const int tid) {
    constexpr bool F32 = same_t<TIn, float>::v;
    const int wid = __builtin_amdgcn_readfirstlane(tid >> 6), lane = tid & 63, r32 = lane & 31, hi = lane >> 5;
    const int j_lo = cur.jlo;
    int j_hi = (cur.P0 + QB - 1) / KVBLK + 1; if (j_hi > skv / KVBLK) j_hi = skv / KVBLK;
    const int NT = j_hi - j_lo;
    const int kbn = ((nxt.P0 + QB - 1) / KVBLK) * KVBLK;
    const int qlo = cur.P0 + wid * QBLK, qm = qlo + r32 - 4 * hi;
    char* V_lds = lds; char* K_lds = lds + 2 * SHM_V;
    float* ws = (float*)(lds + 2 * SHM_V + 2 * SHM_K) + wid * 64; float* li_l = ws, * al_l = ws + 32;
    float m_reg = -1e30f, l_reg = 0; f32x16 o[4] = {};
    const int sr = tid >> 4, sc = (tid & 15) * 8, vst0 = v_st(sr, sc), vst1 = v_st(32 + sr, sc), kws = KSWZ(sr, sc * 2);
    const int vb0 = (int)(uintptr_t)V_lds + v_rd_base(lane);
    const TIn* Kh = cur.K; const TIn* Vh = cur.V;
#define RESC(a) do { if (__any((a) < 1.f)) { if (hi == 0) al_l[r32] = (a); asm volatile("s_waitcnt lgkmcnt(0)" ::: "memory");              \
                     for (int d_ = 0; d_ < 4; ++d_) for (int r = 0; r < 16; ++r) o[d_][r] *= al_l[crow(r, hi)]; } } while (0)
#define KBASE(t) ((j_hi - 1 - (t)) * KVBLK)
#define ACT(t) (KBASE(t) <= qlo + QBLK - 1 && KBASE(t) + KVBLK - 1 >= qlo - W + 1)
#define MASKT(P0_, P1_, t) do { const int kb_ = KBASE(t); if ((!SK || ACT(t)) && (kb_ + KVBLK - 1 > qlo || kb_ <= qlo + QBLK - 1 - W)) mask_tile(P0_, P1_, qm - kb_, (unsigned)W); } while (0)
    constexpr int NQL = F32 ? 16 : 8;
    constexpr bool SK = WSKIP && !F32;
#define SEAM_K0() do { VMWN(NQL); if constexpr (F32) { SWRITE_KF(0); SBAR(); SLOAD_F((const float*)nxt.V, kbn); } else { SWRITE_HK(0); } SBAR(); } while (0)
    f32x16 pA0, pA1, pB0, pB1; float mnA, mnB, alA, alB; bf16x8 pa0, pa1, pa2, pa3; bool deadA = false, deadB = false;
    if constexpr (F32) { VMW(); SWRITE_VF(0); SBAR(); } else { SWRITE_HV(0); SBAR(); }
    if (NT > 1) { if constexpr (F32) SLOAD_F((const float*)Kh, KBASE(1)); else SLOAD_H(Kh, Vh, cur.Fb, 1, KBASE(1)); }
    SBAR(); qkt<0, SK>(pA0, pA1, K_lds, r32, hi, S.qr, ACT(0));
    if constexpr (F32) { if (NT > 1) { VMW(); SWRITE_KF(1); SBAR(); SLOAD_F((const float*)Vh, KBASE(1)); } }
    MASKT(pA0, pA1, 0); partialSM(pA0, pA1, m_reg, mnA, alA, deadA);
    if (NT > 1) { VMW(); if constexpr (F32) { SWRITE_VF(1); SBAR(); if (NT > 2) SLOAD_F((const float*)Kh, KBASE(2)); } else SWRITE_H(1); }
    __syncthreads();
#define HALF_STEP(PX0, PX1, mnX, alX, deadX, PY0, PY1, alY, deadY, t, KB, VB, SB) do {                                                      \
        SBAR(); qkt<KB, SK>(PX0, PX1, K_lds, r32, hi, S.qr, ACT(t));                                             \
        if (!deadY) finishSM(PY0, PY1, alY, l_reg, pa0, pa1, pa2, pa3); SBAR();                                               \
        if ((t) + 1 < NT) { if constexpr (F32) { VMW(); SWRITE_KF(SB); SBAR(); SLOAD_F((const float*)Vh, KBASE((t) + 1)); }  \
                            else { SLOAD_H(Kh, Vh, cur.Fb, SB, KBASE((t) + 1)); } SBAR(); }                                               \
        pv_tile<VB, SK>(o, vb0, pa0, pa1, pa2, pa3, ACT((t) - 1) && !deadY); MASKT(PX0, PX1, (t)); partialSM(PX0, PX1, m_reg, mnX, alX, deadX);                                        \
        __syncthreads();                                                                                                      \
        if ((t) + 1 < NT) { VMW(); if constexpr (F32) { SWRITE_VF(SB); SBAR(); if ((t) + 2 < NT) SLOAD_F((const float*)Kh, KBASE((t) + 2)); } \
                            else { SWRITE_H(SB); } }                                                                          \
        RESC(alX); __syncthreads(); } while (0)
    for (int t = 1; t + 1 < NT; t += 2) {
        HALF_STEP(pB0, pB1, mnB, alB, deadB, pA0, pA1, alA, deadA, t, 1, 0, 0);
        HALF_STEP(pA0, pA1, mnA, alA, deadA, pB0, pB1, alB, deadB, t + 1, 0, 1, 1);
    }
    const bool even = (NT & 1) == 0;
    if (even) { SBAR(); qkt<1, SK>(pB0, pB1, K_lds, r32, hi, S.qr, ACT(NT - 1)); SBAR(); }
#define QROW(e) (nxt.Q + (size_t)(wid * QBLK + r32) * PITCH + ((e) >> 1) * 16 + hi * 8 + ((e) & 1) * 4)
    if constexpr (F32) { SLOAD_F((const float*)nxt.K, kbn); SBAR();
#pragma unroll
        for (int e = 0; e < 8; ++e) S.tq[e] = *(const f32x4*)QROW(e); }
    else { SLOAD_H(nxt.K, nxt.V, nxt.Fb, 0, kbn); SBAR();
#pragma unroll
        for (int d0 = 0; d0 < 8; ++d0) S.qr[d0] = load8<TIn>(nxt.Q + (size_t)(wid * QBLK + r32) * PITCH + d0 * 16 + hi * 8); }
    SBAR();
    if (!deadA) finishSM(pA0, pA1, alA, l_reg, pa0, pa1, pa2, pa3); SBAR();
    if constexpr (F32) {
#pragma unroll
        for (int e = 8; e < 16; ++e) S.tq[e] = *(const f32x4*)QROW(e); SBAR(); }
#undef QROW
    pv_tile<0, SK>(o, vb0, pa0, pa1, pa2, pa3, ACT(even ? NT - 2 : NT - 1) && !deadA);
    if (even) { MASKT(pB0, pB1, NT - 1); partialSM(pB0, pB1, m_reg, mnB, alB, deadB); __syncthreads(); RESC(alB);
        if (!deadB) finishSM(pB0, pB1, alB, l_reg, pa0, pa1, pa2, pa3); SBAR(); pv_tile<1, SK>(o, vb0, pa0, pa1, pa2, pa3, ACT(NT - 1) && !deadB); }
    SBAR(); SEAM_K0();
    if (hi == 0) li_l[r32] = l_reg; asm volatile("s_waitcnt lgkmcnt(0)" ::: "memory");
    float rli[16];
#pragma unroll
    for (int r = 0; r < 16; ++r) rli[r] = __builtin_amdgcn_rcpf(li_l[crow(r, hi)]);
    TOut* Ow = cur.O + (size_t)(wid * QBLK) * PITCH;
#pragma unroll
    for (int r = 0; r < 16; ++r) { const int orow = crow(r, hi);
#pragma unroll
        for (int d0 = 0; d0 < 4; ++d0) { const float v = o[d0][r] * rli[r];
            if constexpr (same_t<TOut, float>::v) { Ow[(size_t)orow * PITCH + d0 * 32 + r32] = v; }
            else if constexpr (O_FP8) { const float vs = fminf(fmaxf(v * O8_SCALE, -440.f), 440.f), t1 = __shfl_xor(vs, 1), t2 = __shfl_xor(vs, 2), t3 = __shfl_xor(t1, 2);
                   unsigned w8 = 0u; w8 = __builtin_amdgcn_cvt_pk_fp8_f32(vs, t1, w8, false); w8 = __builtin_amdgcn_cvt_pk_fp8_f32(t2, t3, w8, true);
                   if ((r32 & 3) == 0) *(unsigned*)(cur.O8 + (size_t)(wid * QBLK + orow) * PITCH + d0 * 32 + r32) = w8; }
            else { const float vn = __shfl_xor(v, 1);
                   if ((r32 & 1) == 0) *(unsigned*)(Ow + (size_t)orow * PITCH + d0 * 32 + r32) = cvtpk(v, vn); } } }
    if constexpr (F32) {
#pragma unroll
        for (int d0 = 0; d0 < 8; ++d0) S.qr[d0] = pack8(S.tq[2 * d0], S.tq[2 * d0 + 1]); }
    __syncthreads();
#undef RESC
#undef KBASE
#undef ACT
#undef MASKT
#undef SEAM_K0
#undef HALF_STEP
}
#undef ROW
#undef VMW
#undef VMWN
#undef SLOAD_H
#undef SWRITE_HK
#undef SWRITE_HV
#undef SWRITE_H
#undef SLOAD_F
#undef SWRITE_KF
#undef SWRITE_VF


enum { ORDER_NATURAL = 0, ORDER_REVERSED = 1, ORDER_PAIRED = 2, ORDER_XCD = 4 };
__host__ __device__ inline int swa_nramp(int nqb, int W, int qoff) { const int t = W - 1 - qoff; const int n = t < 0 ? 0 : t / QB + 1; return n > nqb ? nqb : n; }
__host__ __device__ inline int swa_nx(int nqb, int nramp, int order) { return (order & ORDER_PAIRED) ? (nramp + 1) / 2 + (nqb - nramp) : nqb; }
struct SwaItem { int bh, qb0, qb1; };
__device__ __forceinline__ SwaItem swa_decode(int L, int nb, int nh, int nhkv, int nqb, int nx, int nramp, int order) {
    const int G = nh / nhkv; SwaItem it; int x;
    if ((order & ORDER_XCD) && (nb * nhkv) % 8 == 0) { const int xcd = L & 7, k = L >> 3, per = G * nx, gi = k / per, r = k - gi * per;
        it.bh = (gi * 8 + xcd) * G + r / nx; x = r % nx; }
    else { it.bh = L / nx; x = L - it.bh * nx; }
    if (order & ORDER_PAIRED) { const int ns = nqb - nramp;
        if (x < ns) { it.qb0 = it.qb1 = nqb - 1 - x; } else { it.qb0 = x - ns; it.qb1 = nramp - 1 - it.qb0; } }
    else { it.qb0 = it.qb1 = ((order & 3) == ORDER_REVERSED) ? nqb - 1 - x : x; }
    return it;
}

}

namespace pg8 {
struct ListOrder {
    int pm0, n;
    __device__ bool next(int i, Unit& u) const { if (i >= n) return false; u.pm = pm0 + i; u.pn = 0; return true; }
    __device__ __forceinline__ void a_ready(const Unit&) const {}
    __device__ __forceinline__ void done(const Unit&) const {}
};
struct EpiScaleBf16 {
    static constexpr bool PERM = true, AFTER_DRAIN = false;
    unsigned char* O; int ldc; const float* colscale; float os;
    __device__ __forceinline__ void operator()(const f32x4 (&acc)[2][2][4][2], const Unit& u, int wr, int wc, int fr, int fq) const {
        const int row0 = u.pm * BM + wr * 64 + fr; int col0 = u.pn * BM + wc * 32 + 8 * fq; asm volatile("" : "+v"(col0));
        f32x4 sv[2][2];
#pragma unroll
        for (int bj = 0; bj < 2; ++bj)
#pragma unroll
            for (int n = 0; n < 2; ++n) sv[bj][n] = *(const f32x4*)(colscale + col0 + bj * HALF + 4 * n) * os;
#pragma unroll
        for (int ai = 0; ai < 2; ++ai)
#pragma unroll
            for (int m = 0; m < 4; ++m) { unsigned char* rowp = O + (size_t)(row0 + ai * HALF + m * 16) * ldc + col0;
#pragma unroll
                for (int bj = 0; bj < 2; ++bj) { const f32x4 v0 = acc[ai][bj][m][0] * sv[bj][0], v1 = acc[ai][bj][m][1] * sv[bj][1];
                    unsigned w0 = 0u, w1 = 0u;
                    w0 = __builtin_amdgcn_cvt_pk_fp8_f32(fminf(fmaxf(v0[0], -440.f), 440.f), fminf(fmaxf(v0[1], -440.f), 440.f), w0, false); w0 = __builtin_amdgcn_cvt_pk_fp8_f32(fminf(fmaxf(v0[2], -440.f), 440.f), fminf(fmaxf(v0[3], -440.f), 440.f), w0, true);
                    w1 = __builtin_amdgcn_cvt_pk_fp8_f32(fminf(fmaxf(v1[0], -440.f), 440.f), fminf(fmaxf(v1[1], -440.f), 440.f), w1, false); w1 = __builtin_amdgcn_cvt_pk_fp8_f32(fminf(fmaxf(v1[2], -440.f), 440.f), fminf(fmaxf(v1[3], -440.f), 440.f), w1, true);
                    typedef unsigned u32x2_ __attribute__((ext_vector_type(2))); *(u32x2_*)(rowp + bj * HALF) = (u32x2_){w0, w1}; } }
    }
};
struct EpiRowScaleBf16 {
    static constexpr bool PERM = true, AFTER_DRAIN = false;
    bf16_t* O; int ldc; const float* rs; float cs; int split_cols; size_t split_stride;
    __device__ __forceinline__ void operator()(const f32x4 (&acc)[2][2][4][2], const Unit& u, int wr, int wc, int fr, int fq) const {
        int ln_; asm volatile("v_mbcnt_lo_u32_b32 %0, -1, 0\n\tv_mbcnt_hi_u32_b32 %0, -1, %0" : "=v"(ln_));
        (void)fr; (void)fq; const int row0 = u.pm * BM + wr * 64 + (ln_ & 15); int colt = u.pn * BM; bf16_t* base = O;
        if (split_cols) { const int t = colt / split_cols; base += (size_t)t * split_stride; colt -= t * split_cols; }
        const int col0 = colt + wc * 32 + 8 * (ln_ >> 4);
#pragma unroll
        for (int ai = 0; ai < 2; ++ai)
#pragma unroll
            for (int m = 0; m < 4; ++m) { const int row = row0 + ai * HALF + m * 16; const float sc = rs ? rs[row] * cs : cs; bf16_t* rowp = base + (size_t)row * ldc + col0;
#pragma unroll
                for (int bj = 0; bj < 2; ++bj) { const f32x4 v0 = acc[ai][bj][m][0] * sc, v1 = acc[ai][bj][m][1] * sc;
                    u32x4 w; w.x = cvt_pk_bf16(v0[0], v0[1]); w.y = cvt_pk_bf16(v0[2], v0[3]); w.z = cvt_pk_bf16(v1[0], v1[1]); w.w = cvt_pk_bf16(v1[2], v1[3]);
                    *(u32x4*)(rowp + bj * HALF) = w; } }
    }
};
struct EpiRowScaleF8 {
    static constexpr bool PERM = true, AFTER_DRAIN = false;
    unsigned char* O; int ldc; const float* rs; float cs; int split_cols; size_t split_stride;
    __device__ __forceinline__ void operator()(const f32x4 (&acc)[2][2][4][2], const Unit& u, int wr, int wc, int fr, int fq) const {
        int ln_; asm volatile("v_mbcnt_lo_u32_b32 %0, -1, 0\n\tv_mbcnt_hi_u32_b32 %0, -1, %0" : "=v"(ln_));
        (void)fr; (void)fq; const int row0 = u.pm * BM + wr * 64 + (ln_ & 15); const int colt = u.pn * BM; unsigned char* base = O;
        const int col0 = colt + wc * 32 + 8 * (ln_ >> 4);
#pragma unroll
        for (int ai = 0; ai < 2; ++ai)
#pragma unroll
            for (int m = 0; m < 4; ++m) { const int row = row0 + ai * HALF + m * 16; const float sc = rs ? rs[row] * cs : cs; unsigned char* rowp = base + (size_t)row * ldc + col0;
#pragma unroll
                for (int bj = 0; bj < 2; ++bj) { const f32x4 v0 = acc[ai][bj][m][0] * sc, v1 = acc[ai][bj][m][1] * sc; unsigned w0 = 0u, w1 = 0u;
                    w0 = __builtin_amdgcn_cvt_pk_fp8_f32(v0[0], v0[1], w0, false); w0 = __builtin_amdgcn_cvt_pk_fp8_f32(v0[2], v0[3], w0, true);
                    w1 = __builtin_amdgcn_cvt_pk_fp8_f32(v1[0], v1[1], w1, false); w1 = __builtin_amdgcn_cvt_pk_fp8_f32(v1[2], v1[3], w1, true);
                    typedef unsigned u32x2_ __attribute__((ext_vector_type(2))); *(u32x2_*)(rowp + bj * HALF) = (u32x2_){w0, w1}; } }
    }
};
struct EpiI8RowScaleBf16 {
    static constexpr bool PERM = true, AFTER_DRAIN = false;
    bf16_t* O; int ldc; const float* rs; float cs; int split_cols; size_t split_stride;
    __device__ __forceinline__ void operator()(const f32x4 (&acc)[2][2][4][2], const Unit& u, int wr, int wc, int fr, int fq) const {
        int ln_; asm volatile("v_mbcnt_lo_u32_b32 %0, -1, 0\n\tv_mbcnt_hi_u32_b32 %0, -1, %0" : "=v"(ln_));
        (void)fr; (void)fq; const int row0 = u.pm * BM + wr * 64 + (ln_ & 15); int colt = u.pn * BM; bf16_t* base = O;
        if (split_cols) { const int t = colt / split_cols; base += (size_t)t * split_stride; colt -= t * split_cols; }
        const int col0 = colt + wc * 32 + 8 * (ln_ >> 4);
#pragma unroll
        for (int ai = 0; ai < 2; ++ai)
#pragma unroll
            for (int m = 0; m < 4; ++m) { const int row = row0 + ai * HALF + m * 16; const float sc = rs[row] * cs; bf16_t* rowp = base + (size_t)row * ldc + col0;
#pragma unroll
                for (int bj = 0; bj < 2; ++bj) { typedef int i32x4_ __attribute__((ext_vector_type(4))); const i32x4_ i0 = __builtin_bit_cast(i32x4_, acc[ai][bj][m][0]), i1 = __builtin_bit_cast(i32x4_, acc[ai][bj][m][1]);
                    u32x4 w; w.x = cvt_pk_bf16((float)i0[0] * sc, (float)i0[1] * sc); w.y = cvt_pk_bf16((float)i0[2] * sc, (float)i0[3] * sc); w.z = cvt_pk_bf16((float)i1[0] * sc, (float)i1[1] * sc); w.w = cvt_pk_bf16((float)i1[2] * sc, (float)i1[3] * sc);
                    *(u32x4*)(rowp + bj * HALF) = w; } }
    }
};
struct EpiGate {
    static constexpr bool PERM = false, AFTER_DRAIN = false;
    const bf16_t* XC; float* AF; float* DF; const float* b_a; const float* b_x; const float* ls8; int cbase;
    __device__ __forceinline__ void operator()(const f32x4 (&acc)[2][2][4][2], const Unit& u, int wr, int wc, int fr, int fq) const {
        const unsigned row0 = (unsigned)(u.pm * BM + wr * 64 + fr);
#pragma unroll
        for (int n = 0; n < 2; ++n) { unsigned c = (unsigned)(cbase + wc * 32 + 16 * n + 4 * fq); asm volatile("" : "+v"(c));
            const f32x4 ba = *(const f32x4*)(b_a + c), bx = *(const f32x4*)(b_x + c), l8 = *(const f32x4*)(ls8 + c) * 1.4426950408889634f;
#pragma unroll
            for (int ai = 0; ai < 2; ++ai)
#pragma unroll
                for (int m = 0; m < 4; ++m) { const unsigned off = (row0 + ai * HALF + m * 16) * 1024u + c;
                    const f32x4 pr = acc[ai][0][m][n] + ba, pi = acc[ai][1][m][n] + bx;
                    const uint2 xr = *(const uint2*)((const char*)XC + off * 2u);
                    const float xc[4] = {__uint_as_float(xr.x << 16), __uint_as_float(xr.x & 0xffff0000u), __uint_as_float(xr.y << 16), __uint_as_float(xr.y & 0xffff0000u)};
                    u32x4 pw;
#pragma unroll
                    for (int e = 0; e < 4; ++e) { const float r = __builtin_amdgcn_rcpf(1.f + __builtin_amdgcn_exp2f(-1.4426950408889634f * pr[e])), ig = __builtin_amdgcn_rcpf(1.f + __builtin_amdgcn_exp2f(-1.4426950408889634f * pi[e]));
                        const float la = r * l8[e]; const float a = __builtin_amdgcn_exp2f(la); const float mult = __builtin_amdgcn_sqrtf(fmaxf(1.f - a * a, 0.f)); pw[e] = cvt_pk_bf16(la, mult * ig * xc[e]); }
                    *(u32x4*)((char*)AF + off * 4u) = pw; asm volatile("" ::: "memory"); } }
    }
};
}

#define LAS __attribute__((address_space(3)))
typedef unsigned short bf16;
typedef unsigned v4u __attribute__((ext_vector_type(4)));
typedef unsigned v2u __attribute__((ext_vector_type(2)));
typedef float f32x4 __attribute__((ext_vector_type(4)));
typedef float f32x16 __attribute__((ext_vector_type(16)));
typedef short bf16x8 __attribute__((ext_vector_type(8)));

constexpr int NTHREADS = 512, NWAVES = 8;
constexpr int LDS_BYTES = 155648 + 256, LDS_CTL = 155648;
constexpr int BATCH = 2, SEQ = 8192, DM = 2048, M = BATCH * SEQ, NEXP = 16384;
constexpr int NZ = 3072, NQKV = 6144, NODIN = 6160;
constexpr int ROW6 = 1536;
constexpr bool V_FP4 = true;
constexpr int ROWV = V_FP4 ? 1024 : ROW6;
constexpr int ROW4 = 1024;
constexpr float ALPHA = 1.4142135623730951f, LN_EPS = 1e-5f;
constexpr float ATT_SCALE = 0.08838834764831845f;

constexpr size_t MiB = 1u << 20;
constexpr size_t WS_MOD = 1 * MiB;
constexpr size_t WS_LS8 = 1 * MiB + 512 * 1024;
constexpr size_t WS_WIN = 2 * MiB, WS_WOUT = 14 * MiB, WS_WQKV = 22 * MiB, WS_WO = 46 * MiB, WS_WQ0 = 54 * MiB, WS_WQ1 = 62 * MiB;
constexpr size_t WS_KEYS = 70 * MiB, WS_WPOOL = 71 * MiB, WS_WAX = 71 * MiB + 512 * 1024, WS_WF = 72 * MiB;
constexpr size_t WS_FE = 77 * MiB, WS_FP = 77 * MiB + 64 * 1024, WS_KN = 77 * MiB + 128 * 1024, WS_QN = 77 * MiB + 192 * 1024, WS_DN = 77 * MiB + 256 * 1024;
constexpr size_t WS_AG = 73 * MiB, WS_HG = 73 * MiB + 512 * 1024, WS_LF = 74 * MiB, WS_FB = 75 * MiB;
constexpr size_t WS_SU = 76 * MiB, WS_SV = 76 * MiB + 128 * 1024;
constexpr size_t WS_HB8 = 208 * MiB, WS_SA = 79 * MiB;
constexpr float YP_SCALE = 64.f;
constexpr float YB_SCALE = 16.f;
constexpr float W8O_SCALE = 2048.f, Y8_SCALE = 16.f;
constexpr size_t WS_YC8 = 240 * MiB;
constexpr float W8_SCALE = 1024.f;
constexpr size_t WS_PART = 400 * MiB;
constexpr size_t WS_AR = 496 * MiB, WS_EQ = 500 * MiB;
constexpr size_t WS_Y = 592 * MiB;
constexpr size_t WS_H6 = 752 * MiB, WS_HS = 785 * MiB;
constexpr size_t WS_TU = 80 * MiB, WS_TV = 144 * MiB;
constexpr size_t WS_HB = 336 * MiB, WS_ZB = 400 * MiB, WS_YC = 592 * MiB, WS_YB = 656 * MiB, WS_X1 = 720 * MiB, WS_H2 = 848 * MiB, WS_QP = 912 * MiB;
constexpr size_t WS_EI = 976 * MiB, WS_GT = 984 * MiB, WS_END = 992 * MiB;
constexpr size_t WS_AF = WS_H2, WS_DF = WS_QP;
constexpr size_t WS_PO = WS_YB, WS_XC = WS_YB + 32 * MiB;

struct Args { const float* in[24]; float* out; unsigned char* ws; int ph_lo, ph_hi; };

__device__ __forceinline__ float bf_lo(unsigned u) { return __uint_as_float(u << 16); }
__device__ __forceinline__ float bf_hi(unsigned u) { return __uint_as_float(u & 0xffff0000u); }
__device__ __forceinline__ unsigned pk2(float lo, float hi) { return pg8::cvt_pk_bf16(lo, hi); }
__device__ __forceinline__ unsigned pk2c(float lo, float hi) { typedef float f2_ __attribute__((ext_vector_type(2))); typedef __bf16 b2_ __attribute__((ext_vector_type(2))); const f2_ f = {lo, hi}; return __builtin_bit_cast(unsigned, __builtin_convertvector(f, b2_)); }
#define SWZ_XOR_(v, m) __uint_as_float((unsigned)__builtin_amdgcn_ds_swizzle((int)__float_as_uint(v), ((m) << 10) | 0x1f))
__device__ __forceinline__ float wave_sum(float v) {
    v += SWZ_XOR_(v, 1); v += SWZ_XOR_(v, 2); v += SWZ_XOR_(v, 4); v += SWZ_XOR_(v, 8); v += SWZ_XOR_(v, 16);
    const auto rr = __builtin_amdgcn_permlane32_swap(__float_as_uint(v), __float_as_uint(v), false, false);
    return __uint_as_float(rr[0]) + __uint_as_float(rr[1]);
}
__device__ __forceinline__ float wave_max(float v) {
    v = fmaxf(v, SWZ_XOR_(v, 1)); v = fmaxf(v, SWZ_XOR_(v, 2)); v = fmaxf(v, SWZ_XOR_(v, 4)); v = fmaxf(v, SWZ_XOR_(v, 8)); v = fmaxf(v, SWZ_XOR_(v, 16));
    const auto rr = __builtin_amdgcn_permlane32_swap(__float_as_uint(v), __float_as_uint(v), false, false);
    return fmaxf(__uint_as_float(rr[0]), __uint_as_float(rr[1]));
}
__device__ __forceinline__ float gelu_tanh(float x) { const float y = 0.7978845608028654f * (x + 0.044715f * x * x * x); return x * __builtin_amdgcn_rcpf(1.f + __builtin_amdgcn_exp2f(-2.8853900817779268f * y)); }
#define LDS_WAIT() asm volatile("s_waitcnt lgkmcnt(0)" ::: "memory")
__device__ __forceinline__ int lane_id() { int l; asm volatile("v_mbcnt_lo_u32_b32 %0, -1, 0\n\tv_mbcnt_hi_u32_b32 %0, -1, %0" : "=v"(l)); return l; }


#define XB_TMO      128
#define XB_XCNT(j)  (256  + 64 * (j))
#define XB_XSUB(j)  (1280 + 64 * (j))
#define XB_XGEN(j)  (2304 + 64 * (j))
#define XB_TOP      3328
#define XB_TOPGEN   3392
#define XCD_BAR_WORDS 3456
#define XB_SPIN_CAP (1u << 22)
__device__ __forceinline__ unsigned xb_ld(unsigned* p)              { return __hip_atomic_load(p, __ATOMIC_RELAXED, __HIP_MEMORY_SCOPE_AGENT); }
__device__ __forceinline__ unsigned xb_add(unsigned* p, unsigned v) { return __hip_atomic_fetch_add(p, v, __ATOMIC_RELAXED, __HIP_MEMORY_SCOPE_AGENT); }
__device__ __forceinline__ unsigned xb_xcc_id() { return (unsigned)__builtin_amdgcn_s_getreg((3 << 11) | 20) & 0xFu; }
#define XB_SPIN(cond, bar) do { unsigned _sp = 0; while (cond) { __builtin_amdgcn_s_sleep(1); \
    if ((++_sp & 255u) == 0u) { if (xb_ld(&(bar)[XB_TMO])) break; if (_sp > XB_SPIN_CAP) { atomicAdd(&(bar)[XB_TMO], 1u); break; } } } } while (0)
struct XcdBarrier { unsigned* bar; unsigned x; volatile LAS unsigned* st; };
__device__ __forceinline__ XcdBarrier xcd_barrier_post(unsigned* bar, volatile LAS unsigned* st, bool t0) {
    XcdBarrier b; b.bar = bar; b.x = xb_xcc_id(); b.st = st;
    if (t0) { st[2] = xb_add(&bar[XB_XCNT(b.x)], 1u); st[3] = b.x; }
    return b;
}
__device__ __forceinline__ void xcd_barrier_complete(unsigned* bar, unsigned x, unsigned& nloc, unsigned& nx, unsigned& uni) {
    const unsigned G = gridDim.x * gridDim.y * gridDim.z;
    unsigned sum, cnt, mine, sp = 0u;
    for (;;) {
        sum = 0u; cnt = 0u; mine = 0u; uni = (G & 7u) == 0u ? 1u : 0u;
#pragma unroll
        for (unsigned j = 0; j < 16; ++j) { const unsigned c = xb_ld(&bar[XB_XCNT(j)]); sum += c; cnt += (c > 0u) ? 1u : 0u; mine = (j == x) ? c : mine; uni = (c == (j < 8u ? (G >> 3) : 0u)) ? uni : 0u; }
        if (sum == G) break;
        __builtin_amdgcn_s_sleep(1);
        if ((++sp & 255u) == 0u) { if (xb_ld(&bar[XB_TMO])) break; if (sp > XB_SPIN_CAP) { atomicAdd(&bar[XB_TMO], 1u); break; } }
    }
    nloc = mine > 0u ? mine : 1u; nx = cnt > 0u ? cnt : 1u;
}
__device__ __forceinline__ void xcd_barrier(const XcdBarrier& b, bool t0) {
    asm volatile("s_waitcnt vmcnt(0)" ::: "memory");
    __syncthreads();
    if (t0) {
        unsigned* bar = b.bar;
        __builtin_amdgcn_s_waitcnt(0);
        unsigned nloc = b.st[0], nx = b.st[1];
        if (nloc == 0u) { unsigned uni; xcd_barrier_complete(bar, b.x, nloc, nx, uni); b.st[0] = nloc; b.st[1] = nx; b.st[4] = uni; }
        const unsigned old = xb_add(&bar[XB_XSUB(b.x)], 1u);
        const unsigned gen = old / nloc;
        if (old + 1u == (gen + 1u) * nloc) {
            __builtin_amdgcn_fence(__ATOMIC_RELEASE, "agent");
            asm volatile("s_waitcnt vmcnt(0)" ::: "memory");
            const unsigned og = xb_add(&bar[XB_TOP], 1u);
            const unsigned tg = og / nx;
            if (og + 1u == (tg + 1u) * nx) xb_add(&bar[XB_TOPGEN], 1u);
            else XB_SPIN(xb_ld(&bar[XB_TOPGEN]) == tg, bar);
            __builtin_amdgcn_fence(__ATOMIC_ACQUIRE, "agent");
            xb_add(&bar[XB_XGEN(b.x)], 1u);
            asm volatile("s_waitcnt vmcnt(0)" ::: "memory");
        } else {
            XB_SPIN(xb_ld(&bar[XB_XGEN(b.x)]) == gen, bar);
            __builtin_amdgcn_fence(__ATOMIC_ACQUIRE, "agent");
            asm volatile("s_waitcnt vmcnt(0)" ::: "memory");
        }
    }
    __syncthreads();
}

__device__ __forceinline__ void transpose_item(const float* W, int ldw, int nblk, bf16* WT, int K, LAS float* scr, int item, int lane) {
    const int kb = item / nblk, nb = item % nblk, k0 = 64 * kb, n0 = 32 * nb;
#pragma unroll 8
    for (int i = 0; i < 32; ++i) { const int kk = 2 * i + (lane >> 5); scr[kk * 33 + (lane & 31)] = W[(size_t)(k0 + kk) * ldw + n0 + (lane & 31)]; }
    LDS_WAIT(); asm volatile("" ::: "memory");
    const int c = lane & 7;
#pragma unroll
    for (int j = 0; j < 4; ++j) { const int n = (lane >> 3) + 8 * j; const LAS float* s = scr + (8 * c) * 33 + n;
        v4u o; o.x = pk2(s[0 * 33], s[1 * 33]); o.y = pk2(s[2 * 33], s[3 * 33]); o.z = pk2(s[4 * 33], s[5 * 33]); o.w = pk2(s[6 * 33], s[7 * 33]);
        *(v4u*)(WT + (size_t)(n0 + n) * K + k0 + 8 * c) = o; }
    LDS_WAIT(); asm volatile("" ::: "memory");
}
__device__ __forceinline__ unsigned pk4_i8(float a, float b, float c, float d) {
    const int ia = (int)rintf(fminf(fmaxf(a, -127.f), 127.f)), ib = (int)rintf(fminf(fmaxf(b, -127.f), 127.f)), ic = (int)rintf(fminf(fmaxf(c, -127.f), 127.f)), id = (int)rintf(fminf(fmaxf(d, -127.f), 127.f));
    return ((unsigned)ia & 0xffu) | (((unsigned)ib & 0xffu) << 8) | (((unsigned)ic & 0xffu) << 16) | ((unsigned)id << 24);
}
__device__ __forceinline__ void transpose_item_i8(const float* W, int ldw, int nblk, unsigned char* WT, int K, LAS float* scr, int item, int lane, float wscale) {
    const int kb = item / nblk, nb = item % nblk, k0 = 64 * kb, n0 = 32 * nb;
#pragma unroll 8
    for (int i = 0; i < 32; ++i) { const int kk = 2 * i + (lane >> 5); scr[kk * 33 + (lane & 31)] = W[(size_t)(k0 + kk) * ldw + n0 + (lane & 31)] * wscale; }
    LDS_WAIT(); asm volatile("" ::: "memory");
    const int c = lane & 7;
#pragma unroll
    for (int j = 0; j < 4; ++j) { const int n = (lane >> 3) + 8 * j; const LAS float* sp = scr + (8 * c) * 33 + n;
        *(v2u*)(WT + (size_t)(n0 + n) * K + k0 + 8 * c) = (v2u){pk4_i8(sp[0 * 33], sp[1 * 33], sp[2 * 33], sp[3 * 33]), pk4_i8(sp[4 * 33], sp[5 * 33], sp[6 * 33], sp[7 * 33])}; }
    LDS_WAIT(); asm volatile("" ::: "memory");
}
__device__ __forceinline__ float cl8(float x) { return fminf(fmaxf(x, -440.f), 440.f); }
__device__ __forceinline__ unsigned pk4_fp8(float a, float b, float c, float d) { unsigned w = 0u; w = __builtin_amdgcn_cvt_pk_fp8_f32(cl8(a), cl8(b), w, false); w = __builtin_amdgcn_cvt_pk_fp8_f32(cl8(c), cl8(d), w, true); return w; }
__device__ __forceinline__ void transpose_item8(const float* W, int ldw, int nblk, unsigned char* WT, int K, LAS float* scr, int item, int lane, float wscale = W8_SCALE) {
    const int kb = item / nblk, nb = item % nblk, k0 = 64 * kb, n0 = 32 * nb;
#pragma unroll 8
    for (int i = 0; i < 32; ++i) { const int kk = 2 * i + (lane >> 5); scr[kk * 33 + (lane & 31)] = W[(size_t)(k0 + kk) * ldw + n0 + (lane & 31)] * wscale; }
    LDS_WAIT(); asm volatile("" ::: "memory");
    const int c = lane & 7;
#pragma unroll
    for (int j = 0; j < 4; ++j) { const int n = (lane >> 3) + 8 * j; const LAS float* sp = scr + (8 * c) * 33 + n; unsigned w0 = 0u, w1 = 0u;
        w0 = __builtin_amdgcn_cvt_pk_fp8_f32(cl8(sp[0 * 33]), cl8(sp[1 * 33]), w0, false); w0 = __builtin_amdgcn_cvt_pk_fp8_f32(cl8(sp[2 * 33]), cl8(sp[3 * 33]), w0, true);
        w1 = __builtin_amdgcn_cvt_pk_fp8_f32(cl8(sp[4 * 33]), cl8(sp[5 * 33]), w1, false); w1 = __builtin_amdgcn_cvt_pk_fp8_f32(cl8(sp[6 * 33]), cl8(sp[7 * 33]), w1, true);
        *(v2u*)(WT + (size_t)(n0 + n) * K + k0 + 8 * c) = (v2u){w0, w1}; }
    LDS_WAIT(); asm volatile("" ::: "memory");
}
__device__ __forceinline__ void convert_item(const float* src, bf16* dst, size_t item, int lane) {
    const size_t base = item * 4096 + (size_t)lane * 8;
#pragma unroll
    for (int j = 0; j < 8; ++j) { const f32x4 a = *(const f32x4*)(src + base + j * 512), b = *(const f32x4*)(src + base + j * 512 + 4);
        v4u o; o.x = pk2(a[0], a[1]); o.y = pk2(a[2], a[3]); o.z = pk2(b[0], b[1]); o.w = pk2(b[2], b[3]);
        *(v4u*)(dst + base + j * 512) = o; }
}
__device__ __forceinline__ void fp8_row_item(const float* src, unsigned char* dst, float* scale, int row, int lane) {
    const float* p = src + (size_t)row * DM + 4 * lane; f32x4 v[8]; float mx = 0.f;
#pragma unroll
    for (int j = 0; j < 8; ++j) { v[j] = *(const f32x4*)(p + 256 * j); mx = fmaxf(mx, fmaxf(fmaxf(fabsf(v[j][0]), fabsf(v[j][1])), fmaxf(fabsf(v[j][2]), fabsf(v[j][3])))); }
    mx = fmaxf(wave_max(mx), 1e-30f); const float inv = 240.f / mx;
    unsigned* q = (unsigned*)(dst + (size_t)row * DM) + lane;
#pragma unroll
    for (int j = 0; j < 8; ++j) { unsigned w = 0u; w = __builtin_amdgcn_cvt_pk_fp8_f32(v[j][0] * inv, v[j][1] * inv, w, false); w = __builtin_amdgcn_cvt_pk_fp8_f32(v[j][2] * inv, v[j][3] * inv, w, true); q[64 * j] = w; }
    if (lane == 0) scale[row] = mx * (1.f / 240.f);
}
typedef float f32x16_t __attribute__((ext_vector_type(16)));
typedef float f32x32_t __attribute__((ext_vector_type(32)));
typedef unsigned u32x6_t __attribute__((ext_vector_type(6)));
typedef unsigned u32x3_t __attribute__((ext_vector_type(3)));
__device__ __forceinline__ void fp6_pack_block(const float (&v)[32], u32x6_t& p, unsigned& ebyte) {
    float mx = 0.f;
#pragma unroll
    for (int i = 0; i < 32; ++i) mx = fmaxf(mx, fabsf(v[i]));
    int ex = (int)((__float_as_uint(mx * (1.f / 7.5f)) + 0x7fffffu) >> 23) - 127; ex = ex < -126 ? -126 : (ex > 127 ? 127 : ex);
    const float inv = __uint_as_float((unsigned)(127 - ex) << 23);
    f32x16_t a, b;
#pragma unroll
    for (int i = 0; i < 16; ++i) { a[i] = v[2 * i] * inv; b[i] = v[2 * i + 1] * inv; }
    p = __builtin_amdgcn_cvt_scalef32_2xpk16_fp6_f32(a, b, 1.0f); ebyte = (unsigned)(ex + 127);
}
__device__ __forceinline__ void fp6_row_item(const float* src, unsigned char* dst, float* sdst, int row, int lane) {
    const float* p = src + (size_t)row * DM + 4 * lane; float v[32]; float mx = 0.f;
#pragma unroll
    for (int j = 0; j < 8; ++j) { const f32x4 x = *(const f32x4*)(p + 256 * j); v[4 * j] = x[0]; v[4 * j + 1] = x[1]; v[4 * j + 2] = x[2]; v[4 * j + 3] = x[3]; }
#pragma unroll
    for (int i = 0; i < 32; ++i) mx = fmaxf(mx, fabsf(v[i]));
    mx = fmaxf(wave_max(mx), 1e-30f);
    const float inv = 7.5f / mx;
    f32x16_t a, b;
#pragma unroll
    for (int i = 0; i < 16; ++i) { a[i] = v[2 * i] * inv; b[i] = v[2 * i + 1] * inv; }
    const u32x6_t pk = __builtin_amdgcn_cvt_scalef32_2xpk16_fp6_f32(a, b, 1.0f);
    unsigned char* q = dst + (size_t)row * ROW6;
    *(v4u*)(q + 16 * lane) = (v4u){pk[0], pk[1], pk[2], pk[3]}; *(v2u*)(q + 1024 + 8 * lane) = (v2u){pk[4], pk[5]};
    if (lane == 0) sdst[row] = mx * (1.f / 7.5f);
}
template <bool VORD>
__device__ __forceinline__ void fp4_row_item(const float* src, unsigned char* dst, float* sdst, int row, int lane) {
    const float* p = src + (size_t)row * DM + (VORD ? 32 : 8) * lane; float v[32]; float ss = 0.f;
    if constexpr (VORD) {
#pragma unroll
        for (int j = 0; j < 8; ++j) { const f32x4 x = *(const f32x4*)(p + 4 * j); v[4 * j] = x[0]; v[4 * j + 1] = x[1]; v[4 * j + 2] = x[2]; v[4 * j + 3] = x[3]; } }
    else
#pragma unroll
    for (int j = 0; j < 4; ++j) { const f32x4 x = *(const f32x4*)(p + 512 * j), y = *(const f32x4*)(p + 512 * j + 4); v[8 * j] = x[0]; v[8 * j + 1] = x[1]; v[8 * j + 2] = x[2]; v[8 * j + 3] = x[3]; v[8 * j + 4] = y[0]; v[8 * j + 5] = y[1]; v[8 * j + 6] = y[2]; v[8 * j + 7] = y[3]; }
#pragma unroll
    for (int i = 0; i < 32; ++i) ss += v[i] * v[i];
    const float sc = fmaxf(0.5f * sqrtf(wave_sum(ss) * (1.f / DM)), 1e-30f), inv = 1.f / sc;
    unsigned w[4] = {0u, 0u, 0u, 0u};
#pragma unroll
    for (int d = 0; d < 4; ++d) {
        w[d] = __builtin_amdgcn_cvt_scalef32_pk_fp4_f32(w[d], v[8 * d] * inv, v[8 * d + 1] * inv, 1.0f, 0);
        w[d] = __builtin_amdgcn_cvt_scalef32_pk_fp4_f32(w[d], v[8 * d + 2] * inv, v[8 * d + 3] * inv, 1.0f, 1);
        w[d] = __builtin_amdgcn_cvt_scalef32_pk_fp4_f32(w[d], v[8 * d + 4] * inv, v[8 * d + 5] * inv, 1.0f, 2);
        w[d] = __builtin_amdgcn_cvt_scalef32_pk_fp4_f32(w[d], v[8 * d + 6] * inv, v[8 * d + 7] * inv, 1.0f, 3); }
    unsigned char* q = dst + (size_t)(row / NEXP) * NEXP * ROW4 + ((size_t)(lane >> 3) * NEXP + (size_t)(row % NEXP)) * 128 + 16 * (lane & 7);
    *(v4u*)q = (v4u){w[0], w[1], w[2], w[3]};
    if (lane == 0) sdst[row] = sc;
}
__device__ __forceinline__ void ph_prologue(const Args& a, LAS unsigned char* lds, int tid, int lane, int wave) {
    unsigned char* ws = a.ws;
    if (blockIdx.x < 192) {
        LAS float* cact = (LAS float*)lds;
        LAS float* red = (LAS float*)(lds + 16384);
        for (int i = tid; i < 2 * DM; i += NTHREADS) { const float cv = a.in[1][i]; cact[i] = cv / (1.f + __expf(-cv)); }
        __syncthreads();
        const int item = blockIdx.x, l = item / 96, col0 = (item % 96) * 128, rsub = lane >> 5, c4 = lane & 31;
        const float* W = a.in[2] + (size_t)l * DM * 12288 + col0 + 4 * c4;
        f32x4 acc0 = {0.f, 0.f, 0.f, 0.f}, acc1 = {0.f, 0.f, 0.f, 0.f};
#pragma unroll 8
        for (int i = 0; i < 128; ++i) { const int k = wave * 256 + 2 * i + rsub; const f32x4 w = *(const f32x4*)(W + (size_t)k * 12288);
            acc0 += w * cact[k]; acc1 += w * cact[DM + k]; }
#pragma unroll
        for (int e = 0; e < 4; ++e) { acc0[e] += __shfl_xor(acc0[e], 32); acc1[e] += __shfl_xor(acc1[e], 32); }
        if (rsub == 0) {
#pragma unroll
            for (int e = 0; e < 4; ++e) { red[(wave * 2 + 0) * 128 + 4 * c4 + e] = acc0[e]; red[(wave * 2 + 1) * 128 + 4 * c4 + e] = acc1[e]; } }
        __syncthreads();
        if (tid < 256) { const int b = tid >> 7, col = tid & 127; float s = 0.f;
#pragma unroll
            for (int w8 = 0; w8 < 8; ++w8) s += red[(w8 * 2 + b) * 128 + col];
            s += a.in[3][l * 12288 + col0 + col];
            ((float*)(ws + WS_MOD))[(size_t)(l * 2 + b) * 12288 + col0 + col] = s; }
        __syncthreads();
    }
    LAS float* scr = (LAS float*)(lds + wave * 16384);
    const int gw = blockIdx.x * NWAVES + wave, NGW = gridDim.x * NWAVES;
    constexpr int I_WIN = 32 * 96, I_SQ = 32 * 64, I_QKV = 32 * 192, I_POOL = 4 * 32, I_AX = 16 * 8, I_WF = 16, I_KEYS = 128, I_TAB = 2 * NEXP, I_LS = 1;
    constexpr int NITEMS = I_WIN + 4 * I_SQ + I_QKV + I_POOL + I_AX + I_WF + I_KEYS + 2 * I_TAB + I_LS;
    for (int it = gw; it < NITEMS; it += NGW) {
        int r = it;
        if (r < 2 * I_TAB) { if (r < I_TAB) fp4_row_item<false>(a.in[8], ws + WS_TU, (float*)(ws + WS_SU), r, lane); else if constexpr (V_FP4) fp4_row_item<true>(a.in[9], ws + WS_TV, (float*)(ws + WS_SV), r - I_TAB, lane); else fp6_row_item(a.in[9], ws + WS_TV, (float*)(ws + WS_SV), r - I_TAB, lane); continue; } r -= 2 * I_TAB;
        if (r < I_WIN) { transpose_item_i8(a.in[10], NZ, 96, ws + WS_WIN, DM, scr, r, lane, W8_SCALE); continue; } r -= I_WIN;
        if (r < I_SQ) { transpose_item8(a.in[20], DM, 64, ws + WS_WOUT, DM, scr, r, lane, W8O_SCALE); continue; } r -= I_SQ;
        if (r < I_QKV) { transpose_item_i8(a.in[21], NODIN, 192, ws + WS_WQKV, DM, scr, r, lane, W8_SCALE); continue; } r -= I_QKV;
        if (r < I_SQ) { transpose_item8(a.in[23], DM, 64, ws + WS_WO, DM, scr, r, lane, W8O_SCALE); continue; } r -= I_SQ;
        if (r < I_SQ) { transpose_item_i8(a.in[6], DM, 64, ws + WS_WQ0, DM, scr, r, lane, W8_SCALE); continue; } r -= I_SQ;
        if (r < I_SQ) { transpose_item_i8(a.in[6] + (size_t)DM * DM, DM, 64, ws + WS_WQ1, DM, scr, r, lane, W8_SCALE); continue; } r -= I_SQ;
        if (r < I_POOL) { const int g = r >> 5; transpose_item(a.in[11] + g * 65536, 256, 8, (bf16*)(ws + WS_WPOOL) + g * 65536, 256, scr, r & 31, lane); continue; } r -= I_POOL;
        if (r < I_AX) { const int h = r >> 4, which = (r >> 3) & 1;
            transpose_item(a.in[which ? 17 : 15] + h * 16384, 128, 4, (bf16*)(ws + WS_WAX) + h * 32768 + which * 16384, 128, scr, r & 7, lane); continue; } r -= I_AX;
        if (r < I_WF) { bf16* WF = (bf16*)(ws + WS_WF);
            for (int k = lane; k < DM; k += 64) { const float v = a.in[21][(size_t)k * NODIN + NQKV + r]; WF[r * DM + k] = (bf16)(pk2(v, v) & 0xffffu); } continue; } r -= I_WF;
        if (r < I_KEYS) { convert_item(a.in[7], (bf16*)(ws + WS_KEYS), (size_t)r, lane); continue; } r -= I_KEYS;
        { float* LS8 = (float*)(ws + WS_LS8);
            for (int cch = lane; cch < 1024; cch += 64) { const float x = a.in[19][cch]; LS8[cch] = 8.f * (fminf(x, 0.f) - log1pf(__expf(-fabsf(x)))); } }
    }
}

__device__ __forceinline__ void ph_modulate(const float* src, const float* mod_l  , int sh_off, int sc_off, bf16* dst, unsigned char* dst8, float* rs, int lane, int wave) {
    const int gw = blockIdx.x * NWAVES + wave, NGW = gridDim.x * NWAVES;
    int cur_b = -1; f32x4 scv[8], shv[8];
    for (int t = gw; t < M; t += NGW) {
        const int b = t >> 13;
        if (b != cur_b) { cur_b = b; const float* mb = mod_l + b * 12288;
#pragma unroll
            for (int j = 0; j < 8; ++j) { scv[j] = *(const f32x4*)(mb + sc_off + 4 * lane + 256 * j) + 1.f; shv[j] = *(const f32x4*)(mb + sh_off + 4 * lane + 256 * j); } }
        const float* xr = src + (size_t)t * DM + 4 * lane; f32x4 v[8]; float mx = 0.f;
#pragma unroll
        for (int j = 0; j < 8; ++j) { v[j] = *(const f32x4*)(xr + 256 * j) * scv[j] + shv[j];
            mx = fmaxf(mx, fmaxf(fmaxf(fabsf(v[j][0]), fabsf(v[j][1])), fmaxf(fabsf(v[j][2]), fabsf(v[j][3])))); }
        mx = fmaxf(wave_max(mx), 1e-30f); const float inv = 127.f / mx; unsigned* q8 = (unsigned*)(dst8 + (size_t)t * DM) + lane;
#pragma unroll
        for (int j = 0; j < 8; ++j) q8[64 * j] = pk4_i8(v[j][0] * inv, v[j][1] * inv, v[j][2] * inv, v[j][3] * inv);
        if (lane == 0) rs[t] = mx * (1.f / 127.f);
    }
}

__device__ __forceinline__ void ld8(const bf16* p, float (&v)[8]) { const v4u u = *(const v4u*)p; v[0] = bf_lo(u.x); v[1] = bf_hi(u.x); v[2] = bf_lo(u.y); v[3] = bf_hi(u.y); v[4] = bf_lo(u.z); v[5] = bf_hi(u.z); v[6] = bf_lo(u.w); v[7] = bf_hi(u.w); }
__device__ __forceinline__ void st8(bf16* p, const float (&v)[8]) { v4u o; o.x = pk2(v[0], v[1]); o.y = pk2(v[2], v[3]); o.z = pk2(v[4], v[5]); o.w = pk2(v[6], v[7]); *(v4u*)p = o; }
__device__ __forceinline__ void ph_poolconv(const Args& a, int lane, int wave) {
    const bf16* Z = (const bf16*)(a.ws + WS_ZB); bf16* PO = (bf16*)(a.ws + WS_PO); bf16* XC = (bf16*)(a.ws + WS_XC);
    const int gw = blockIdx.x * NWAVES + wave, NGW = gridDim.x * NWAVES;
    for (int item = gw; item < 2048; item += NGW) {
        const int which = item & 3, t0 = (item >> 2) * 32, pos0 = t0 & (SEQ - 1);
        if (which < 2) {
            const int c = which * 512 + lane * 8, w = 2 << (c >> 8);
            float sum[8] = {0.f, 0.f, 0.f, 0.f, 0.f, 0.f, 0.f, 0.f};
            for (int s = 1; s < 16; ++s) if (s < w && pos0 - s >= 0) { float v[8]; ld8(Z + (size_t)(t0 - s) * NZ + c, v);
#pragma unroll
                for (int e = 0; e < 8; ++e) sum[e] += v[e]; }
            for (int i = 0; i < 32; ++i) { const int t = t0 + i, pos = pos0 + i; float cur[8], o[8]; ld8(Z + (size_t)t * NZ + c, cur);
                const float inv = 1.f / (float)(pos + 1 < w ? pos + 1 : w);
#pragma unroll
                for (int e = 0; e < 8; ++e) { sum[e] += cur[e]; o[e] = sum[e] * inv - cur[e]; }
                st8(PO + (size_t)t * 1024 + c, o);
                if (pos - w + 1 >= 0) { float old[8]; ld8(Z + (size_t)(t - w + 1) * NZ + c, old);
#pragma unroll
                    for (int e = 0; e < 8; ++e) sum[e] -= old[e]; } }
        } else {
            const int c = (which - 2) * 512 + lane * 8; const bf16* zc = Z + 1024 + c;
            float w0[8], w1[8], w2[8], w3[8], bb[8], x3[8], x2[8], x1[8];
#pragma unroll
            for (int e = 0; e < 8; ++e) { w0[e] = a.in[13][0 * 1024 + c + e]; w1[e] = a.in[13][1 * 1024 + c + e]; w2[e] = a.in[13][2 * 1024 + c + e]; w3[e] = a.in[13][3 * 1024 + c + e]; bb[e] = a.in[14][c + e]; x3[e] = 0.f; x2[e] = 0.f; x1[e] = 0.f; }
            if (pos0 >= 3) ld8(zc + (size_t)(t0 - 3) * NZ, x3);
            if (pos0 >= 2) ld8(zc + (size_t)(t0 - 2) * NZ, x2);
            if (pos0 >= 1) ld8(zc + (size_t)(t0 - 1) * NZ, x1);
            for (int i = 0; i < 32; ++i) { const int t = t0 + i; float x0[8], o[8]; ld8(zc + (size_t)t * NZ, x0);
#pragma unroll
                for (int e = 0; e < 8; ++e) { o[e] = bb[e] + w0[e] * x3[e] + w1[e] * x2[e] + w2[e] * x1[e] + w3[e] * x0[e]; x3[e] = x2[e]; x2[e] = x1[e]; x1[e] = x0[e]; }
                st8(XC + (size_t)t * 1024 + c, o); }
        }
    }
}

__device__ __forceinline__ void ph_scan_agg(const Args& a, int tid) {
    const unsigned* AD = (const unsigned*)(a.ws + WS_AF);
    float* AG = (float*)(a.ws + WS_AG); float* HG = (float*)(a.ws + WS_HG);
    for (int w = blockIdx.x; w < 256; w += gridDim.x) {
        const int st = w >> 1, c = (w & 1) * 512 + tid; const size_t base = (size_t)st * 128 * 1024 + c;
        float LA = 0.f, H = 0.f;
#pragma unroll 32
        for (int i = 0; i < 128; ++i) { const unsigned pw = AD[base + (size_t)i * 1024]; const float la = bf_lo(pw), dv = bf_hi(pw); H = __builtin_amdgcn_exp2f(la) * H + dv; LA += la; }
        AG[st * 1024 + c] = __builtin_amdgcn_exp2f(LA); HG[st * 1024 + c] = H;
    }
}
__device__ __forceinline__ void ph_scan_fin(const Args& a, int tid) {
    const unsigned* AD = (const unsigned*)(a.ws + WS_AF);
    const float* AG = (const float*)(a.ws + WS_AG); const float* HG = (const float*)(a.ws + WS_HG);
    const bf16* Z = (const bf16*)(a.ws + WS_ZB); unsigned char* YC8 = a.ws + WS_YC8;
    for (int w = blockIdx.x; w < 256; w += gridDim.x) {
        const int st = w >> 1, c = (w & 1) * 512 + tid, sin = st & 63, sb = st - sin; const size_t base = (size_t)st * 128 * 1024 + c;
        float h = 0.f;
#pragma unroll 32
        for (int s = 0; s < sin; ++s) h = AG[(sb + s) * 1024 + c] * h + HG[(sb + s) * 1024 + c];
#pragma unroll 16
        for (int i = 0; i < 128; ++i) { const size_t t = (size_t)st * 128 + i; const unsigned pw = AD[base + (size_t)i * 1024];
            h = __builtin_amdgcn_exp2f(bf_lo(pw)) * h + bf_hi(pw); const float gt = __uint_as_float((unsigned)Z[t * NZ + 2048 + c] << 16);
            YC8[t * DM + 1024 + c] = (unsigned char)(pk4_fp8(h * gelu_tanh(gt) * Y8_SCALE, 0.f, 0.f, 0.f) & 0xffu); }
    }
}

template <bool RES_MOD, bool RES_I8 = false>
__device__ __forceinline__ void ph_ln(const float* RS8, const unsigned char* Y  , const float* Xin, const bf16* HBres, const float* mod_res, const float* mod_l, const float* lng, const float* lnb, bf16* H2, unsigned char* H28, float* SH, unsigned char* H6, float* HS, LAS unsigned char* lds, int lane, int wave) {
    const int gw = blockIdx.x * NWAVES + wave, NGW = gridDim.x * NWAVES;
    { LAS float* lp = (LAS float*)lds; const int t_ = wave * 64 + lane;
#pragma unroll 1
      for (int i = t_; i < 10 * 512; i += NTHREADS) { const int v = i >> 9, c4 = (i & 511) * 4, k = v >> 1; const float* mr = (RES_MOD ? mod_res : mod_l) + (v & 1) * 12288; const float* ml = mod_l + (v & 1) * 12288; f32x4 o;
          if (k < 2) { const f32x4 ha = *(const f32x4*)(mr + c4), sa = *(const f32x4*)(mr + 2048 + c4);
#pragma unroll
              for (int e = 0; e < 4; ++e) { const float inv = ALPHA / (1.f + sa[e]); o[e] = k == 0 ? ha[e] * inv : inv; } }
          else if (k == 2) { const f32x4 g = *(const f32x4*)(ml + 4096 + c4);
#pragma unroll
              for (int e = 0; e < 4; ++e) o[e] = (1.f + g[e]) * (1.f / YB_SCALE); }
          else { const f32x4 hf = *(const f32x4*)(ml + 6144 + c4), sf = *(const f32x4*)(ml + 8192 + c4), la = *(const f32x4*)(lng + c4), ba = *(const f32x4*)(lnb + c4);
#pragma unroll
              for (int e = 0; e < 4; ++e) o[e] = k == 3 ? ba[e] * (1.f + sf[e]) + hf[e] : la[e] * (1.f + sf[e]); }
          *(LAS f32x4*)(lp + v * 2048 + c4) = o; }
      __syncthreads(); }
    const LAS float* lpf = (const LAS float*)lds;
    v2u yc[4]; f32x4 xc[8]; v4u rc[4];
    { const size_t ro = (size_t)gw * DM + 8 * lane;
#pragma unroll
      for (int j = 0; j < 4; ++j) { yc[j] = *(const v2u*)(Y + ro + 512 * j);
          if constexpr (RES_MOD && RES_I8) { const v2u q = *(const v2u*)((const unsigned char*)HBres + ro + 512 * j); rc[j] = (v4u){q.x, q.y, 0u, 0u}; }
          else if constexpr (RES_MOD) rc[j] = *(const v4u*)(HBres + ro + 512 * j); else { xc[2 * j] = *(const f32x4*)(Xin + ro + 512 * j); xc[2 * j + 1] = *(const f32x4*)(Xin + ro + 512 * j + 4); } } }
#pragma unroll 1
    for (int t = gw; t < M; t += NGW) {
        const int b = t >> 13; const LAS float* mb = lpf + b * 2048; const size_t ro = (size_t)t * DM + 8 * lane;
        int ln = lane; asm volatile("" : "+v"(ln));
        const int tn = t + NGW < M ? t + NGW : t; const size_t rn = (size_t)tn * DM + 8 * lane;
        v2u yn[4]; f32x4 xn[8]; v4u rn4[4];
#pragma unroll
        for (int j = 0; j < 4; ++j) { yn[j] = *(const v2u*)(Y + rn + 512 * j);
            if constexpr (RES_MOD && RES_I8) { const v2u q = *(const v2u*)((const unsigned char*)HBres + rn + 512 * j); rn4[j] = (v4u){q.x, q.y, 0u, 0u}; }
            else if constexpr (RES_MOD) rn4[j] = *(const v4u*)(HBres + rn + 512 * j); else { xn[2 * j] = *(const f32x4*)(Xin + rn + 512 * j); xn[2 * j + 1] = *(const f32x4*)(Xin + rn + 512 * j + 4); } }
        float rsc = 0.f; if constexpr (RES_I8) rsc = RS8[t];
        float v[32];
#pragma unroll
        for (int j = 0; j < 4; ++j) { const v2u u = yc[j];
            const auto y0 = __builtin_amdgcn_cvt_pk_f32_fp8((int)u.x, false), y1 = __builtin_amdgcn_cvt_pk_f32_fp8((int)u.x, true), y2 = __builtin_amdgcn_cvt_pk_f32_fp8((int)u.y, false), y3 = __builtin_amdgcn_cvt_pk_f32_fp8((int)u.y, true);
            const float y8[8] = {y0[0], y0[1], y1[0], y1[1], y2[0], y2[1], y3[0], y3[1]};
            f32x4 xa, xb;
            if constexpr (RES_MOD) { const v4u r = rc[j]; const LAS float* mr = mb + 8 * ln + 512 * j;
                const f32x4 sa = *(const LAS f32x4*)(mr + 4096), sb = *(const LAS f32x4*)(mr + 4096 + 4), ha = *(const LAS f32x4*)(mr), hb = *(const LAS f32x4*)(mr + 4);
                float r8[8];
                if constexpr (RES_I8) { r8[0] = (float)((int)(r.x << 24) >> 24) * rsc; r8[1] = (float)((int)(r.x << 16) >> 24) * rsc; r8[2] = (float)((int)(r.x << 8) >> 24) * rsc; r8[3] = (float)((int)r.x >> 24) * rsc;
                    r8[4] = (float)((int)(r.y << 24) >> 24) * rsc; r8[5] = (float)((int)(r.y << 16) >> 24) * rsc; r8[6] = (float)((int)(r.y << 8) >> 24) * rsc; r8[7] = (float)((int)r.y >> 24) * rsc; }
                else { r8[0] = bf_lo(r.x); r8[1] = bf_hi(r.x); r8[2] = bf_lo(r.y); r8[3] = bf_hi(r.y); r8[4] = bf_lo(r.z); r8[5] = bf_hi(r.z); r8[6] = bf_lo(r.w); r8[7] = bf_hi(r.w); }
#pragma unroll
                for (int e = 0; e < 4; ++e) { xa[e] = r8[e] * sa[e] - ha[e]; xb[e] = r8[4 + e] * sb[e] - hb[e]; } }
            else { xa = xc[2 * j] * ALPHA; xb = xc[2 * j + 1] * ALPHA; }
            const f32x4 ga = *(const LAS f32x4*)(mb + 2 * 4096 + 8 * ln + 512 * j), gb = *(const LAS f32x4*)(mb + 2 * 4096 + 8 * ln + 512 * j + 4);
#pragma unroll
            for (int e = 0; e < 4; ++e) { v[8 * j + e] = xa[e] + ga[e] * y8[e]; v[8 * j + 4 + e] = xb[e] + gb[e] * y8[4 + e]; }
            asm volatile("" ::: "memory"); }
        float s = 0.f;
#pragma unroll
        for (int e = 0; e < 32; ++e) s += v[e];
        const float mean = wave_sum(s) * (1.f / DM); float q = 0.f;
#pragma unroll
        for (int e = 0; e < 32; ++e) { v[e] -= mean; q += v[e] * v[e]; }
        const float rstd = rsqrtf(wave_sum(q) * (1.f / DM) + LN_EPS); float hmx = 0.f;
#pragma unroll
        for (int j = 0; j < 4; ++j) { const int co = 8 * ln + 512 * j;
            const f32x4 la = *(const LAS f32x4*)(mb + 4 * 4096 + co), lb = *(const LAS f32x4*)(mb + 4 * 4096 + co + 4), ba = *(const LAS f32x4*)(mb + 3 * 4096 + co), bb = *(const LAS f32x4*)(mb + 3 * 4096 + co + 4);
            float h8[8];
#pragma unroll
            for (int e = 0; e < 4; ++e) { h8[e] = v[8 * j + e] * rstd * la[e] + ba[e]; h8[4 + e] = v[8 * j + 4 + e] * rstd * lb[e] + bb[e]; }
#pragma unroll
            for (int e = 0; e < 8; ++e) { v[8 * j + e] = h8[e]; hmx = fmaxf(hmx, fabsf(h8[e])); }
            asm volatile("" ::: "memory"); }
        hmx = fmaxf(wave_max(hmx), 1e-30f); const float inv = 127.f / hmx;
#pragma unroll
        for (int j = 0; j < 4; ++j) *(v2u*)(H28 + ro + 512 * j) = (v2u){pk4_i8(v[8 * j] * inv, v[8 * j + 1] * inv, v[8 * j + 2] * inv, v[8 * j + 3] * inv), pk4_i8(v[8 * j + 4] * inv, v[8 * j + 5] * inv, v[8 * j + 6] * inv, v[8 * j + 7] * inv)};
        if (lane == 0) SH[t] = hmx * (1.f / 127.f);
        { const float inv6 = 7.5f / hmx; f32x16_t pa, pb;
#pragma unroll
          for (int i = 0; i < 16; ++i) { pa[i] = v[2 * i] * inv6; pb[i] = v[2 * i + 1] * inv6; }
          const u32x6_t pk = __builtin_amdgcn_cvt_scalef32_2xpk16_fp6_f32(pa, pb, 1.0f); unsigned char* hq = H6 + (size_t)t * 1536;
          *(v4u*)(hq + 16 * lane) = (v4u){pk[0], pk[1], pk[2], pk[3]}; *(v2u*)(hq + 1024 + 8 * lane) = (v2u){pk[4], pk[5]};
          if (lane == 0) HS[t] = hmx * (1.f / 7.5f); }
#pragma unroll
        for (int j = 0; j < 4; ++j) { yc[j] = yn[j]; if constexpr (RES_MOD) rc[j] = rn4[j]; else { xc[2 * j] = xn[2 * j]; xc[2 * j + 1] = xn[2 * j + 1]; } }
    }
}

__device__ __forceinline__ unsigned mono(float f) { const unsigned u = __float_as_uint(f); return (u & 0x80000000u) ? ~u : (u | 0x80000000u); }
__device__ __forceinline__ float unmono(unsigned u) { return __uint_as_float((u & 0x80000000u) ? (u & 0x7fffffffu) : ~u); }
__device__ __forceinline__ unsigned umax_(unsigned a, unsigned b) { return a > b ? a : b; }
__device__ __forceinline__ unsigned umin_(unsigned a, unsigned b) { return a < b ? a : b; }
template <bool DESC> __device__ __forceinline__ void bsort16(unsigned (&k)[16]) {
#pragma unroll
    for (int size = 2; size <= 16; size <<= 1)
#pragma unroll
        for (int stride = size >> 1; stride > 0; stride >>= 1)
#pragma unroll
            for (int i = 0; i < 16; ++i) { const int j = i ^ stride;
                if (j > i) { const bool first_max = (((i & size) == 0) == DESC); const unsigned hi = umax_(k[i], k[j]), lo = umin_(k[i], k[j]); k[i] = first_max ? hi : lo; k[j] = first_max ? lo : hi; } }
}
template <bool DESC> __device__ __forceinline__ void bmerge16(unsigned (&k)[16]) {
#pragma unroll
    for (int stride = 8; stride > 0; stride >>= 1)
#pragma unroll
        for (int i = 0; i < 16; ++i) { const int j = i ^ stride;
            if (j > i) { const unsigned hi = umax_(k[i], k[j]), lo = umin_(k[i], k[j]); k[i] = DESC ? hi : lo; k[j] = DESC ? lo : hi; } }
}
__device__ __forceinline__ void top16_of_64(const unsigned (&k)[64], unsigned (&o)[16]) {
    unsigned g0[16], g1[16], g2[16], g3[16];
#pragma unroll
    for (int i = 0; i < 16; ++i) { g0[i] = k[i]; g1[i] = k[16 + i]; g2[i] = k[32 + i]; g3[i] = k[48 + i]; }
    bsort16<true>(g0); bsort16<false>(g1); bsort16<true>(g2); bsort16<false>(g3);
#pragma unroll
    for (int i = 0; i < 16; ++i) { g0[i] = umax_(g0[i], g1[i]); g2[i] = umax_(g2[i], g3[i]); }
    bmerge16<true>(g0); bmerge16<false>(g2);
#pragma unroll
    for (int i = 0; i < 16; ++i) o[i] = umax_(g0[i], g2[i]);
    bmerge16<true>(o);
}
__device__ __forceinline__ int swz16(int row, int cb) { return cb ^ ((row & 15) << 4); }
__device__ __forceinline__ void ph_topk(const Args& a, int layer, LAS unsigned char* lds, int tid, int lane, int wave) {
    const bf16* QP = (const bf16*)(a.ws + WS_QP); const bf16* KEYS = (const bf16*)(a.ws + WS_KEYS) + (size_t)layer * 8 * 2 * 128 * 128;
    int* EI = (int*)(a.ws + WS_EI); float* GT = (float*)(a.ws + WS_GT); const float* SVl = (const float*)(a.ws + WS_SV) + layer * NEXP;
    LAS unsigned char* kt = lds;
    LAS unsigned* lists = (LAS unsigned*)(lds + 65536 + wave * 4096);
    const int r32 = lane & 31, hi = lane >> 5, h = blockIdx.x & 7, wgr = blockIdx.x >> 3, nwgh = gridDim.x >> 3;
    { const bf16* kh = KEYS + (size_t)h * 2 * 128 * 128;
#pragma unroll
      for (int i = 0; i < 8; ++i) { const int ch = tid + i * NTHREADS, row = ch >> 4, cb = (ch & 15) * 16;
          *(LAS v4u*)(kt + row * 256 + swz16(row, cb)) = *(const v4u*)(kh + (size_t)row * 128 + (cb >> 1)); } }
    __syncthreads();
    if (wgr < nwgh) {
#pragma unroll 1
    for (int u = wgr * NWAVES + wave; u < M / 32; u += nwgh * NWAVES) {
        const int t0 = u * 32; const bf16* qrow = QP + (size_t)(t0 + r32) * DM + h * 256 + 8 * hi;
        unsigned LL[2][16];
#pragma unroll
        for (int p = 0; p < 2; ++p) {
            bf16x8 bq[8];
#pragma unroll
            for (int sI = 0; sI < 8; ++sI) bq[sI] = *(const bf16x8*)(qrow + p * 128 + 16 * sI);
            f32x16 acc[4];
#pragma unroll
            for (int blk = 0; blk < 4; ++blk)
#pragma unroll
                for (int e = 0; e < 16; ++e) acc[blk][e] = 0.f;
#pragma unroll
            for (int sI = 0; sI < 8; ++sI)
#pragma unroll
                for (int blk = 0; blk < 4; ++blk) { const int krow = p * 128 + blk * 32 + r32;
                    const bf16x8 ak = *(const LAS bf16x8*)(kt + krow * 256 + swz16(krow, (16 * sI + 8 * hi) * 2));
                    acc[blk] = __builtin_amdgcn_mfma_f32_32x32x16_bf16(ak, bq[sI], acc[blk], 0, 0, 0); }
            unsigned kk[64], o[16];
#pragma unroll
            for (int blk = 0; blk < 4; ++blk)
#pragma unroll
                for (int e = 0; e < 16; ++e) { const int n = 32 * blk + (e & 3) + 8 * (e >> 2) + 4 * hi; kk[blk * 16 + e] = (mono(acc[blk][e]) & ~127u) | (unsigned)(127 - n); }
            top16_of_64(kk, o);
#pragma unroll
            for (int i = 0; i < 16; ++i) LL[p][i] = umax_(o[i], (unsigned)__shfl_xor((int)o[15 - i], 32));
            bmerge16<true>(LL[p]);
            if (hi == 0) { LAS v4u* lp = (LAS v4u*)(lists + (p * 32 + r32) * 16);
#pragma unroll
                for (int i = 0; i < 4; ++i) lp[i] = (v4u){LL[p][4 * i], LL[p][4 * i + 1], LL[p][4 * i + 2], LL[p][4 * i + 3]}; }
        }
        unsigned tk[16];
        { float f1[16], f2[16];
#pragma unroll
          for (int i = 0; i < 16; ++i) { f1[i] = unmono(LL[0][i] & ~127u); f2[i] = unmono(LL[1][i] & ~127u); }
          unsigned cd[32];
          {
            cd[0] = hi ? ((mono(f1[2] + f2[1]) & ~255u) | 222u) : ((mono(f1[0] + f2[0]) & ~255u) | 255u);
            cd[1] = hi ? ((mono(f1[2] + f2[2]) & ~255u) | 221u) : ((mono(f1[0] + f2[1]) & ~255u) | 254u);
            cd[2] = hi ? ((mono(f1[2] + f2[3]) & ~255u) | 220u) : ((mono(f1[0] + f2[2]) & ~255u) | 253u);
            cd[3] = hi ? ((mono(f1[2] + f2[4]) & ~255u) | 219u) : ((mono(f1[0] + f2[3]) & ~255u) | 252u);
            cd[4] = hi ? ((mono(f1[3] + f2[0]) & ~255u) | 207u) : ((mono(f1[0] + f2[4]) & ~255u) | 251u);
            cd[5] = hi ? ((mono(f1[3] + f2[1]) & ~255u) | 206u) : ((mono(f1[0] + f2[5]) & ~255u) | 250u);
            cd[6] = hi ? ((mono(f1[3] + f2[2]) & ~255u) | 205u) : ((mono(f1[0] + f2[6]) & ~255u) | 249u);
            cd[7] = hi ? ((mono(f1[3] + f2[3]) & ~255u) | 204u) : ((mono(f1[0] + f2[7]) & ~255u) | 248u);
            cd[8] = hi ? ((mono(f1[4] + f2[0]) & ~255u) | 191u) : ((mono(f1[0] + f2[8]) & ~255u) | 247u);
            cd[9] = hi ? ((mono(f1[4] + f2[1]) & ~255u) | 190u) : ((mono(f1[0] + f2[9]) & ~255u) | 246u);
            cd[10] = hi ? ((mono(f1[4] + f2[2]) & ~255u) | 189u) : ((mono(f1[0] + f2[10]) & ~255u) | 245u);
            cd[11] = hi ? ((mono(f1[5] + f2[0]) & ~255u) | 175u) : ((mono(f1[0] + f2[11]) & ~255u) | 244u);
            cd[12] = hi ? ((mono(f1[5] + f2[1]) & ~255u) | 174u) : ((mono(f1[0] + f2[12]) & ~255u) | 243u);
            cd[13] = hi ? ((mono(f1[6] + f2[0]) & ~255u) | 159u) : ((mono(f1[0] + f2[13]) & ~255u) | 242u);
            cd[14] = hi ? ((mono(f1[6] + f2[1]) & ~255u) | 158u) : ((mono(f1[0] + f2[14]) & ~255u) | 241u);
            cd[15] = hi ? ((mono(f1[7] + f2[0]) & ~255u) | 143u) : ((mono(f1[0] + f2[15]) & ~255u) | 240u);
            cd[16] = hi ? ((mono(f1[7] + f2[1]) & ~255u) | 142u) : ((mono(f1[1] + f2[0]) & ~255u) | 239u);
            cd[17] = hi ? ((mono(f1[8] + f2[0]) & ~255u) | 127u) : ((mono(f1[1] + f2[1]) & ~255u) | 238u);
            cd[18] = hi ? ((mono(f1[9] + f2[0]) & ~255u) | 111u) : ((mono(f1[1] + f2[2]) & ~255u) | 237u);
            cd[19] = hi ? ((mono(f1[10] + f2[0]) & ~255u) | 95u) : ((mono(f1[1] + f2[3]) & ~255u) | 236u);
            cd[20] = hi ? ((mono(f1[11] + f2[0]) & ~255u) | 79u) : ((mono(f1[1] + f2[4]) & ~255u) | 235u);
            cd[21] = hi ? ((mono(f1[12] + f2[0]) & ~255u) | 63u) : ((mono(f1[1] + f2[5]) & ~255u) | 234u);
            cd[22] = hi ? ((mono(f1[13] + f2[0]) & ~255u) | 47u) : ((mono(f1[1] + f2[6]) & ~255u) | 233u);
            cd[23] = hi ? ((mono(f1[14] + f2[0]) & ~255u) | 31u) : ((mono(f1[1] + f2[7]) & ~255u) | 232u);
            cd[24] = hi ? ((mono(f1[15] + f2[0]) & ~255u) | 15u) : ((mono(f1[2] + f2[0]) & ~255u) | 223u);
            cd[25] = 0u;
            cd[26] = 0u;
            cd[27] = 0u;
            cd[28] = 0u;
            cd[29] = 0u;
            cd[30] = 0u;
            cd[31] = 0u;
          }
          unsigned g0[16], g1[16];
#pragma unroll
          for (int i = 0; i < 16; ++i) { g0[i] = cd[i]; g1[i] = cd[16 + i]; }
          bsort16<true>(g0); bsort16<false>(g1);
#pragma unroll
          for (int i = 0; i < 16; ++i) g0[i] = umax_(g0[i], g1[i]);
          bmerge16<true>(g0);
#pragma unroll
          for (int i = 0; i < 16; ++i) tk[i] = umax_(g0[i], (unsigned)__shfl_xor((int)g0[15 - i], 32));
          bmerge16<true>(tk); }
        float ev[16]; const float m0 = unmono(tk[0] & ~255u); float den = 0.f;
#pragma unroll
        for (int k = 0; k < 16; ++k) { ev[k] = __expf(unmono(tk[k] & ~255u) - m0); den += ev[k]; }
        const float rden = 1.f / den;
        const LAS unsigned* L1 = lists + r32 * 16; const LAS unsigned* L2 = lists + (32 + r32) * 16;
        int ei[16];
#pragma unroll
        for (int k = 0; k < 16; ++k) { const int id = 255 - (int)(tk[k] & 255u), i = id >> 4, j = id & 15;
            const int n1 = 127 - (int)(L1[i] & 127u), n2 = 127 - (int)(L2[j] & 127u); ei[k] = n1 * 128 + n2; }
        if (hi == 0) { int* ep = EI + (size_t)(t0 + r32) * 128 + h * 16;
#pragma unroll
            for (int k = 0; k < 4; ++k) *(int4*)(ep + 4 * k) = make_int4(ei[4 * k], ei[4 * k + 1], ei[4 * k + 2], ei[4 * k + 3]); }
        else { float* gp = GT + (size_t)(t0 + r32) * 128 + h * 16; float gg[16];
#pragma unroll
            for (int k = 0; k < 16; ++k) gg[k] = ev[k] * rden * SVl[ei[k]];
#pragma unroll
            for (int k = 0; k < 4; ++k) *(f32x4*)(gp + 4 * k) = (f32x4){gg[4 * k], gg[4 * k + 1], gg[4 * k + 2], gg[4 * k + 3]}; }
    } }
    __syncthreads();
}

typedef int i32x8_t __attribute__((ext_vector_type(8)));
__device__ __forceinline__ void peer_slice(const Args& a, volatile LAS unsigned* st, int& x, int& rank, int& nrank) {
    (void)a; nrank = (int)(gridDim.x >> 3); const bool uni = st[4] != 0u;
    if (uni) { x = (int)st[3]; rank = (int)st[2]; } else { x = (int)(blockIdx.x & 7u); rank = (int)(blockIdx.x >> 3); }
    x = __builtin_amdgcn_readfirstlane(x); rank = __builtin_amdgcn_readfirstlane(rank);
}
__device__ __forceinline__ void ph_peer_u(const Args& a, int layer, volatile LAS unsigned* st, LAS unsigned char* lds, int lane, int wave) {
    int x, rank, nrank; peer_slice(a, st, x, rank, nrank); const int m16 = lane & 15, kc = lane >> 4, r8 = lane >> 3, sg = lane & 7;
    const unsigned char* TUb = a.ws + WS_TU + (size_t)layer * NEXP * ROW4 + (size_t)x * NEXP * 128;
    const unsigned char* H6 = a.ws + WS_H6 + 16 * (8 * x + kc); const int* EI = (const int*)(a.ws + WS_EI) + lane; bf16* PART = (bf16*)(a.ws + WS_PART) + x * 128 + 32 * kc;
    if (rank >= nrank) return;
    const int t0 = rank * NWAVES + wave, ts = nrank * NWAVES, nt = (M - t0 + ts - 1) / ts;
    LAS unsigned char* ub = lds + wave * 2304; LAS unsigned char* ubw = ub + r8 * 144 + 16 * sg; const LAS unsigned char* ubr = ub + m16 * 144 + 16 * kc;
    v4u U[8][2]; v4u ha[2], han[2]; v2u hb[2], hbn[2]; int en0 = 0, en1 = 0;
#pragma unroll
    for (int g = 0; g < 8; ++g) { U[g][0] = (v4u){0u, 0u, 0u, 0u}; U[g][1] = U[g][0]; }
    ha[0] = ha[1] = (v4u){0u, 0u, 0u, 0u}; hb[0] = hb[1] = (v2u){0u, 0u};
    en0 = EI[(size_t)t0 * 128]; en1 = EI[(size_t)t0 * 128 + 64];
#pragma unroll 1
    for (int k = -1; k < nt; ++k) {
        const int k2 = k + 2 < nt ? k + 2 : nt - 1, k1 = k + 1 < nt ? (k + 1 < 0 ? 0 : k + 1) : nt - 1;
        const size_t tn2 = (size_t)(t0 + ts * k2), tn1 = (size_t)(t0 + ts * k1);
        const int enn0 = EI[tn2 * 128], enn1 = EI[tn2 * 128 + 64];
        { const unsigned char* hp = H6 + tn1 * 1536;
#pragma unroll
          for (int i = 0; i < 2; ++i) { han[i] = *(const v4u*)(hp + 64 * i); hbn[i] = *(const v2u*)(hp + 1024 - 8 * (8 * x + kc) + 32 * i); } }
        bf16* pp = PART + (size_t)(t0 + ts * (k < 0 ? 0 : k)) * 1024; unsigned pv0 = 0u, pv1 = 0u;
#pragma unroll
        for (int g = 0; g < 8; ++g) {
            { f32x4 acc = {0.f, 0.f, 0.f, 0.f};
                if (k >= 0) {
                    *(LAS v4u*)ubw = U[g][0]; *(LAS v4u*)(ubw + 8 * 144) = U[g][1];
#pragma unroll
                    for (int i = 0; i < 2; ++i) { const v4u uu = *(const LAS v4u*)(ubr + 64 * i); const i32x8_t A8 = {(int)uu.x, (int)uu.y, (int)uu.z, (int)uu.w, 0, 0, 0, 0};
                        const i32x8_t B8 = {(int)ha[i].x, (int)ha[i].y, (int)ha[i].z, (int)ha[i].w, (int)hb[i].x, (int)hb[i].y, 0, 0};
                        acc = __builtin_amdgcn_mfma_scale_f32_16x16x128_f8f6f4(A8, B8, acc, 4, 2, 0, 127, 0, 127); } }
                if ((g & 1) == 0) { pv0 = pk2c(acc[0], acc[1]); pv1 = pk2c(acc[2], acc[3]); }
                else if (m16 == 0) *(v4u*)(pp + 4 * (g - 1)) = (v4u){pv0, pv1, pk2c(acc[0], acc[1]), pk2c(acc[2], acc[3])}; }
#pragma unroll
            for (int j = 0; j < 2; ++j) { const int em = __shfl(g < 4 ? en0 : en1, (g & 3) * 16 + 8 * j + r8); U[g][j] = *(const v4u*)(TUb + (unsigned)(em * 128 + 16 * sg)); }
            __builtin_amdgcn_sched_barrier(0);
        }
#pragma unroll
        for (int i = 0; i < 2; ++i) { ha[i] = han[i]; hb[i] = hbn[i]; }
        en0 = enn0; en1 = enn1;
    }
}
__device__ __forceinline__ void ph_peer_coef(const Args& a, int layer, LAS unsigned char* lds, int lane, int wave) {
    const int p0 = 16 * ((lane >> 1) & 7) + 4 * (lane >> 4) + 2 * (lane & 1);
    const int* EI = (const int*)(a.ws + WS_EI) + p0; const float* GT = (const float*)(a.ws + WS_GT) + p0; const unsigned* PART = (const unsigned*)(a.ws + WS_PART) + lane;
    const float* SU = (const float*)(a.ws + WS_SU) + layer * NEXP; const float* HS = (const float*)(a.ws + WS_HS);
    unsigned char* AR = a.ws + WS_AR; int* EQ = (int*)(a.ws + WS_EQ) + (p0 & 7) * 16 + (p0 >> 3);
    LAS float* CFL = (LAS float*)(lds + wave * 1024);
    const int gw = blockIdx.x * NWAVES + wave, NGW = gridDim.x * NWAVES;
#pragma unroll 1
    for (int t = gw; t < M; t += NGW) {
        const size_t tt = (size_t)t; const int2 ee = *(const int2*)(EI + tt * 128); const float2 gg = *(const float2*)(GT + tt * 128); const float hs = HS[t];
        unsigned P[8];
#pragma unroll
        for (int xx = 0; xx < 8; ++xx) P[xx] = PART[(tt * 8 + xx) * 64];
        const float s0 = SU[ee.x], s1 = SU[ee.y];
        const float d0 = ((bf_lo(P[0]) + bf_lo(P[1])) + (bf_lo(P[2]) + bf_lo(P[3]))) + ((bf_lo(P[4]) + bf_lo(P[5])) + (bf_lo(P[6]) + bf_lo(P[7])));
        const float d1 = ((bf_hi(P[0]) + bf_hi(P[1])) + (bf_hi(P[2]) + bf_hi(P[3]))) + ((bf_hi(P[4]) + bf_hi(P[5])) + (bf_hi(P[6]) + bf_hi(P[7])));
        const float c0 = gelu_tanh(d0 * hs * s0) * gg.x, c1 = gelu_tanh(d1 * hs * s1) * gg.y;
        EQ[tt * 128] = ee.x * 128; EQ[tt * 128 + 16] = ee.y * 128;
        const float cmx = fmaxf(wave_max(fmaxf(fabsf(c0), fabsf(c1))), 1e-30f), csc = 7.5f / cmx;
        CFL[p0] = c0 * csc; CFL[p0 + 1] = c1 * csc;
        f32x16_t pa, pb;
#pragma unroll
        for (int i = 0; i < 8; ++i) { const f32x4 c4 = *(const LAS f32x4*)(CFL + 32 * (lane & 3) + 4 * i); pa[2 * i] = c4[0]; pb[2 * i] = c4[1]; pa[2 * i + 1] = c4[2]; pb[2 * i + 1] = c4[3]; }
        const u32x6_t ph = __builtin_amdgcn_cvt_scalef32_2xpk16_fp6_f32(pa, pb, 1.0f);
        if (lane < 4) { unsigned char* rp = AR + tt * 128 + 32 * lane; *(v4u*)rp = (v4u){ph[0], ph[1], ph[2], ph[3]}; *(v4u*)(rp + 16) = (v4u){ph[4], ph[5], __float_as_uint(cmx * (1.f / 7.5f)), 0u}; }
    }
}
__device__ __forceinline__ void ph_peer_v(const Args& a, int layer, volatile LAS unsigned* st, LAS unsigned char* lds, int lane, int wave) {
    int x, rank, nrank; peer_slice(a, st, x, rank, nrank); const int q = lane >> 3, sg = lane & 7, n16 = lane & 15, kc = lane >> 4;
    const unsigned char* TVb = a.ws + WS_TV + (size_t)layer * NEXP * ROWV + (size_t)x * NEXP * 128;
    const int* EQ = (const int*)(a.ws + WS_EQ) + q * 16; const unsigned char* AR = a.ws + WS_AR + 32 * kc;
    if (rank >= nrank) return;
    const int t0 = rank * NWAVES + wave, ts = nrank * NWAVES, nt = (M - t0 + ts - 1) / ts;
    constexpr int VS = 144;
    LAS unsigned char* img = lds + wave * (128 * VS);
    LAS unsigned char* iw = img + q * VS + 16 * sg;
    const LAS unsigned char* ir = img + (32 * kc + n16) * VS;
    typedef int v2i_ __attribute__((ext_vector_type(2)));
    int inv16, ncol; bool tr_ok;
    { *(LAS v2u*)(ir) = (v2u){0x11111111u * (unsigned)n16, 0x11111111u * (unsigned)n16};
      const v2i_ ra = __builtin_amdgcn_ds_read_tr4_b64_v2i32((LAS v2i_*)ir);
      *(LAS v2u*)(ir) = (v2u){0x76543210u, 0xfedcba98u};
      const v2i_ rb = __builtin_amdgcn_ds_read_tr4_b64_v2i32((LAS v2i_*)ir);
      const unsigned r0 = (unsigned)__builtin_amdgcn_readfirstlane(ra.x), r1 = (unsigned)__builtin_amdgcn_readfirstlane(ra.y);
      ncol = rb.x & 15; inv16 = 0; unsigned seen = 0u;
#pragma unroll
      for (int e = 0; e < 16; ++e) { const int rr = (int)(((e < 8 ? r0 : r1) >> (4 * (e & 7))) & 15u); if (rr == n16) inv16 = e; seen |= 1u << rr; }
      bool ok = (unsigned)ra.x == r0 && (unsigned)ra.y == r1 && (unsigned)rb.x == 0x11111111u * (unsigned)ncol && (unsigned)rb.y == 0x11111111u * (unsigned)ncol && seen == 0xffffu;
      unsigned cols = 0u;
#pragma unroll
      for (int i = 0; i < 16; ++i) cols |= 1u << (__shfl(ncol, i) & 15);
      ok = ok && cols == 0xffffu;
      ok = ok && r0 == 0x76543210u && r1 == 0xfedcba98u && ncol == n16;
      tr_ok = __all(ok); }
    unsigned char* Y4 = a.ws + WS_Y + 256 * x + 4 * lane;
    (void)inv16;
    v4u W[16];
#pragma unroll
    for (int i = 0; i < 16; ++i) W[i] = (v4u){0u, 0u, 0u, 0u};
    v4u epn[4], ar0 = {0u, 0u, 0u, 0u}, ar1 = ar0;
#pragma unroll
    for (int j = 0; j < 4; ++j) epn[j] = (v4u){0u, 0u, 0u, 0u};
#pragma unroll
    for (int j = 0; j < 4; ++j) epn[j] = *(const v4u*)(EQ + (size_t)t0 * 128 + 4 * j);
#pragma unroll 1
    for (int k = -1; k < nt; ++k) {
        const int k2 = k + 2 < nt ? k + 2 : nt - 1, k1 = k + 1 < nt ? (k + 1 < 0 ? 0 : k + 1) : nt - 1; const size_t tn2 = (size_t)(t0 + ts * k2), tn1 = (size_t)(t0 + ts * k1);
        v4u epnn[4];
#pragma unroll
        for (int j = 0; j < 4; ++j) epnn[j] = *(const v4u*)(EQ + tn2 * 128 + 4 * j);
        const v4u arn0 = *(const v4u*)(AR + tn1 * 128), arn1 = *(const v4u*)(AR + tn1 * 128 + 16);
        int ep[16];
#pragma unroll
        for (int j = 0; j < 4; ++j) { ep[4 * j] = (int)epn[j].x; ep[4 * j + 1] = (int)epn[j].y; ep[4 * j + 2] = (int)epn[j].z; ep[4 * j + 3] = (int)epn[j].w; }
        __builtin_amdgcn_sched_barrier(0);
#pragma unroll
        for (int i = 0; i < 16; ++i) {
            *(LAS v4u*)(iw + 8 * i * VS) = W[i];
            W[i] = *(const v4u*)(TVb + (unsigned)(ep[i] + 16 * sg));
            __builtin_amdgcn_sched_barrier(0);
        }
        float yv[16];
#pragma unroll
        for (int j = 0; j < 16; ++j) yv[j] = 0.f;
        if (k >= 0) {
            i32x8_t A8 = {(int)ar0.x, (int)ar0.y, (int)ar0.z, (int)ar0.w, (int)ar1.x, (int)ar1.y, 0, 0};
            if (n16 != 0) A8 = (i32x8_t){0, 0, 0, 0, 0, 0, 0, 0};
            const float ysc = __uint_as_float(ar1.z);
#pragma unroll
            for (int j = 0; j < 16; ++j) {
                const v2i_ b0 = __builtin_amdgcn_ds_read_tr4_b64_v2i32((LAS v2i_*)(ir + 8 * j)), b1 = __builtin_amdgcn_ds_read_tr4_b64_v2i32((LAS v2i_*)(ir + 16 * VS + 8 * j));
                const i32x8_t B8 = {b0.x, b0.y, b1.x, b1.y, 0, 0, 0, 0};
                const f32x4 acc = __builtin_amdgcn_mfma_scale_f32_16x16x128_f8f6f4(A8, B8, (f32x4){0.f, 0.f, 0.f, 0.f}, 2, 4, 0, 127, 0, 127);
                yv[j] = acc[0] * ysc; }
        }
        if (!tr_ok) { _Pragma("unroll") for (int j = 0; j < 16; ++j) yv[j] = __builtin_nanf(""); }
        { LAS float* yl = (LAS float*)img;
          if (kc == 0) {
#pragma unroll
              for (int j = 0; j < 16; ++j) yl[16 * j + ncol] = yv[j]; }
          const f32x4 y4 = *(const LAS f32x4*)(yl + 4 * lane);
          *(unsigned*)(Y4 + (size_t)(t0 + ts * (k < 0 ? 0 : k)) * DM) = pk4_fp8(y4[0] * YP_SCALE, y4[1] * YP_SCALE, y4[2] * YP_SCALE, y4[3] * YP_SCALE); }
        ar0 = arn0; ar1 = arn1;
#pragma unroll
        for (int j = 0; j < 4; ++j) epn[j] = epnn[j];
    }
}
template <bool FINAL>
__device__ __forceinline__ void ph_peer_ln(const Args& a, const float* mod_l, const float* mod_next, const float* lng, const float* lnb, LAS unsigned char* lds, int lane, int wave) {
    const unsigned char* Y = a.ws + WS_Y;
    const int gw = blockIdx.x * NWAVES + wave, NGW = gridDim.x * NWAVES;
    { LAS float* lp = (LAS float*)lds; const int t_ = wave * 64 + lane;
#pragma unroll 1
      for (int i = t_; i < 12 * 512; i += NTHREADS) { const int v = i >> 9, c4 = (i & 511) * 4, k = v >> 1; const float* ml = mod_l + (v & 1) * 12288; const float* mn = mod_next + (v & 1) * 12288; f32x4 o;
          if (k == 0) { const f32x4 g = *(const f32x4*)(ml + 10240 + c4);
#pragma unroll
              for (int e = 0; e < 4; ++e) o[e] = (1.f + g[e]) * (1.f / YP_SCALE); }
          else if (k < 3) { const f32x4 sf = *(const f32x4*)(ml + 8192 + c4), hf = *(const f32x4*)(ml + 6144 + c4);
#pragma unroll
              for (int e = 0; e < 4; ++e) { const float inv = ALPHA / (1.f + sf[e]); o[e] = k == 1 ? inv : hf[e] * inv; } }
          else if (k < 5) { const f32x4 sm = *(const f32x4*)(mn + 2048 + c4), hm = *(const f32x4*)(mn + c4), la = *(const f32x4*)(lng + c4), ba = *(const f32x4*)(lnb + c4);
#pragma unroll
              for (int e = 0; e < 4; ++e) o[e] = k == 3 ? la[e] * (1.f + sm[e]) : ba[e] * (1.f + sm[e]) + hm[e]; }
          else o = *(const f32x4*)((v == 10 ? lng : lnb) + c4);
          *(LAS f32x4*)(lp + v * 2048 + c4) = o; }
      __syncthreads(); }
#pragma unroll 1
    for (int t = gw; t < M; t += NGW) {
        const int b = t >> 13;
        float out[32];
        { unsigned lo0 = (unsigned)lane * 4u; asm volatile("" : "+v"(lo0)); const unsigned char* yrow = Y + (size_t)t * DM;
#pragma unroll
          for (int j = 0; j < 8; ++j) { const unsigned yw = *(const unsigned*)(yrow + lo0 + 256 * j); const auto ya = __builtin_amdgcn_cvt_pk_f32_fp8((int)yw, false), yb = __builtin_amdgcn_cvt_pk_f32_fp8((int)yw, true);
              out[4 * j] = ya[0]; out[4 * j + 1] = ya[1]; out[4 * j + 2] = yb[0]; out[4 * j + 3] = yb[1]; } }
        unsigned lo = (unsigned)lane * 16u; asm volatile("" : "+v"(lo));
        const LAS char* lpb = (const LAS char*)lds + b * 8192; const unsigned char* h8r = a.ws + WS_X1 + (size_t)t * DM; const float shs = ((const float*)(a.ws + WS_X1 + 64 * MiB))[t];
#define LD4_(vec, j_) (*(const LAS f32x4*)(lpb + (vec) * 16384 + lo + 1024 * (j_)))
#pragma unroll
        for (int j = 0; j < 8; ++j) { const unsigned hw = *(const unsigned*)(h8r + (lo >> 2) + 256 * j);
            const float h4[4] = {(float)((int)(hw << 24) >> 24) * shs, (float)((int)(hw << 16) >> 24) * shs, (float)((int)(hw << 8) >> 24) * shs, (float)((int)hw >> 24) * shs};
            const f32x4 ga = LD4_(0, j), sf = LD4_(1, j), hf = LD4_(2, j);
#pragma unroll
            for (int e = 0; e < 4; ++e) out[4 * j + e] = h4[e] * sf[e] - hf[e] + ga[e] * out[4 * j + e]; }
        float s = 0.f;
#pragma unroll
        for (int e = 0; e < 32; ++e) s += out[e];
        const float mean = wave_sum(s) * (1.f / DM); float q2 = 0.f;
#pragma unroll
        for (int e = 0; e < 32; ++e) { out[e] -= mean; q2 += out[e] * out[e]; }
        const float rstd = rsqrtf(wave_sum(q2) * (1.f / DM) + LN_EPS);
        char* orow = (char*)(a.out + (size_t)t * DM);
        float hmx = 0.f; (void)hmx;
#pragma unroll
        for (int j = 0; j < 8; ++j) { f32x4 la, ba;
            if constexpr (FINAL) { la = *(const LAS f32x4*)((const LAS char*)lds + 10 * 8192 + lo + 1024 * j); ba = *(const LAS f32x4*)((const LAS char*)lds + 11 * 8192 + lo + 1024 * j); } else { la = LD4_(3, j); ba = LD4_(4, j); }
            f32x4 na;
#pragma unroll
            for (int e = 0; e < 4; ++e) na[e] = out[4 * j + e] * rstd * la[e] + ba[e];
            if constexpr (FINAL) *(f32x4*)(orow + lo + 1024 * j) = na;
            else {
#pragma unroll
                for (int e = 0; e < 4; ++e) { const float hn = na[e]; out[4 * j + e] = hn; hmx = fmaxf(hmx, fabsf(hn)); } } }
        if constexpr (!FINAL) {
            hmx = fmaxf(wave_max(hmx), 1e-30f); const float inv8 = 127.f / hmx; unsigned char* h8row = a.ws + WS_HB8 + (size_t)t * DM;
#pragma unroll
            for (int j = 0; j < 8; ++j) *(unsigned*)(h8row + (lo >> 2) + 256 * j) = pk4_i8(out[4 * j] * inv8, out[4 * j + 1] * inv8, out[4 * j + 2] * inv8, out[4 * j + 3] * inv8);
            if (lane == 0) ((float*)(a.ws + WS_SA))[t] = hmx * (1.f / 127.f); }
#undef LD4_
    }
}

__device__ __forceinline__ void ph_forget(const Args& a, LAS unsigned char* lds, int lane, int wave) {
    const unsigned char* H8 = a.ws + WS_HB8; const float* SA = (const float*)(a.ws + WS_SA); const bf16* WF = (const bf16*)(a.ws + WS_WF); float* LF = (float*)(a.ws + WS_LF);
    const int m16 = lane & 15, kc = lane >> 4, kh = wave & 1;
    LAS f32x4* xch = (LAS f32x4*)lds;
    for (int base = blockIdx.x * (NWAVES / 2); base < M / 16; base += gridDim.x * (NWAVES / 2)) {
        const int item = base + (wave >> 1); const bool live = item < M / 16;
        const int t0 = (live ? item : 0) * 16; f32x4 acc = {0.f, 0.f, 0.f, 0.f};
        const unsigned char* ap = H8 + (size_t)(t0 + m16) * DM + 8 * kc + 1024 * kh; const bf16* bp = WF + (size_t)m16 * DM + 8 * kc + 1024 * kh;
#pragma unroll 16
        for (int s = 0; s < 32; ++s) { const v2u q = *(const v2u*)(ap + 32 * s); const bf16x8 bv = *(const bf16x8*)(bp + 32 * s);
            v4u w; w.x = pk2((float)((int)(q.x << 24) >> 24), (float)((int)(q.x << 16) >> 24)); w.y = pk2((float)((int)(q.x << 8) >> 24), (float)((int)q.x >> 24));
            w.z = pk2((float)((int)(q.y << 24) >> 24), (float)((int)(q.y << 16) >> 24)); w.w = pk2((float)((int)(q.y << 8) >> 24), (float)((int)q.y >> 24));
            acc = __builtin_amdgcn_mfma_f32_16x16x32_bf16(__builtin_bit_cast(bf16x8, w), bv, acc, 0, 0, 0); }
        xch[wave * 64 + lane] = acc;
        __syncthreads();
        if (kh == 0 && live) { const f32x4 oth = xch[(wave + 1) * 64 + lane]; const float bfv = a.in[22][m16]; f32x4 o;
            const f32x4 rsv = *(const f32x4*)(SA + t0 + 4 * kc);
#pragma unroll
            for (int r = 0; r < 4; ++r) { const float x = (acc[r] + oth[r]) * rsv[r] + bfv; o[r] = fminf(x, 0.f) - log1pf(__expf(-fabsf(x))); }
            const int t = t0 + 4 * kc, b = t >> 13, pos = t & (SEQ - 1);
            *(f32x4*)(LF + (size_t)(b * 16 + m16) * SEQ + pos) = o; }
        __syncthreads();
    }
}
__device__ __forceinline__ void ph_cumsum(const Args& a, int lane, int wave) {
    const float* LF = (const float*)(a.ws + WS_LF); float* FB = (float*)(a.ws + WS_FB);
    float* FE = (float*)(a.ws + WS_FE); float* FP = (float*)(a.ws + WS_FP);
    const int gw = blockIdx.x * NWAVES + wave, NGW = gridDim.x * NWAVES;
    const int sidx = NGW >= 1056 ? gw - 1024 : gw;
    for (int seq = sidx; seq >= 0 && seq < 32; seq += NGW) {
        const float* src = LF + (size_t)seq * SEQ + lane * 128; float* dst = FB + (size_t)seq * SEQ + lane * 128;
        f32x4 vv[32];
#pragma unroll
        for (int i = 0; i < 32; ++i) vv[i] = *(const f32x4*)(src + 4 * i);
        float s = 0.f;
#pragma unroll
        for (int i = 0; i < 32; ++i) s += (vv[i][0] + vv[i][1]) + (vv[i][2] + vv[i][3]);
        float inc = s;
#pragma unroll
        for (int o = 1; o < 64; o <<= 1) { const float n = __shfl_up(inc, o); if (lane >= o) inc += n; }
        float run = inc - s;
#pragma unroll
        for (int i = 0; i < 32; ++i) { const f32x4 v = vv[i]; f32x4 o;
            run += v[0]; o[0] = run; run += v[1]; o[1] = run; run += v[2]; o[2] = run; run += v[3]; o[3] = run;
            if (i == 0 && (lane & 1) == 0) FP[seq * 32 + (lane >> 1)] = -o[0];
            if (i == 15) FE[seq * 128 + 2 * lane] = -o[3];
            if (i == 31) FE[seq * 128 + 2 * lane + 1] = -o[3];
            *(f32x4*)(dst + 4 * i) = o * (-1.f / ATT_SCALE); }
    }
    const bf16* QK = (const bf16*)(a.ws + WS_ZB);
    for (int item = gw; item < 1024; item += NGW) {
        const int seq = item >> 5, blk = item & 31, b = seq >> 4, h = seq & 15;
        const bf16* qb = QK + ((size_t)b * SEQ + (size_t)blk * 256) * DM + h * 128 + 8 * (lane & 15); const bf16* kb = qb + (size_t)M * DM;
        float mq = 0.f, mk = 0.f, md = 3.0e38f;
#pragma unroll 8
        for (int r = 0; r < 64; ++r) { const size_t ro = (size_t)(4 * r + (lane >> 4)) * DM; float vq[8], vk[8]; ld8(qb + ro, vq); ld8(kb + ro, vk);
            float sq = 0.f, sk = 0.f, sd = 0.f;
#pragma unroll
            for (int e = 0; e < 8; ++e) { sq += vq[e] * vq[e]; sk += vk[e] * vk[e]; sd += vq[e] * vk[e]; }
            sq += SWZ_XOR_(sq, 1); sk += SWZ_XOR_(sk, 1); sd += SWZ_XOR_(sd, 1); sq += SWZ_XOR_(sq, 2); sk += SWZ_XOR_(sk, 2); sd += SWZ_XOR_(sd, 2);
            sq += SWZ_XOR_(sq, 4); sk += SWZ_XOR_(sk, 4); sd += SWZ_XOR_(sd, 4); sq += SWZ_XOR_(sq, 8); sk += SWZ_XOR_(sk, 8); sd += SWZ_XOR_(sd, 8);
            mq = fmaxf(mq, sq); mk = fmaxf(mk, sk); md = fminf(md, sd); }
        mq = wave_max(mq); mk = wave_max(mk); md = -wave_max(-md);
        if (lane == 0) { ((float*)(a.ws + WS_QN))[seq * 32 + blk] = mq; ((float*)(a.ws + WS_KN))[seq * 32 + blk] = mk; ((float*)(a.ws + WS_DN))[seq * 32 + blk] = md; }
    }
}

constexpr float SKIP_T = 20.f;
__device__ __forceinline__ attn::BlockRef<__hip_bfloat16, __hip_bfloat16> attn_mkref(int L, const __hip_bfloat16* Q, const __hip_bfloat16* K, const __hip_bfloat16* V, __hip_bfloat16* O, const unsigned char* ws, int lane) {
    const int qb = 31 - (L >> 5), seq = L & 31, b = seq >> 4, h = seq & 15;
    attn::BlockRef<__hip_bfloat16, __hip_bfloat16> r; const size_t rowq = (size_t)b * SEQ + (size_t)qb * attn::QB, row0 = (size_t)b * SEQ;
    r.Q = Q + rowq * DM + h * 128; r.O = O + rowq * DM + h * 128; r.K = K + row0 * DM + h * 128; r.V = V + row0 * DM + h * 128; r.Fb = (const float*)(ws + WS_FB) + (size_t)seq * SEQ; r.P0 = qb * attn::QB; r.O8 = (unsigned char*)ws + WS_YC8 + rowq * DM + h * 128;
    const char* FE = (const char*)((const float*)(ws + WS_FE) + seq * 128); const char* KN = (const char*)((const float*)(ws + WS_KN) + seq * 32);
    unsigned l4 = (unsigned)lane * 4u; asm volatile("" : "+v"(l4));
    const float kn = wave_max((lane & 31) <= qb ? *(const float*)(KN + (l4 & 124u)) : 0.f), qn = ((const float*)(ws + WS_QN))[seq * 32 + qb], fp = ((const float*)(ws + WS_FP))[seq * 32 + qb];
    const float dn = ((const float*)(ws + WS_DN))[seq * 32 + qb];
    const float tgt = fp - (SKIP_T + (sqrtf(qn * kn) * 1.0001f - dn) * ATT_SCALE);
    const int cnt = __popcll(__ballot(*(const float*)(FE + l4) <= tgt)) + __popcll(__ballot(*(const float*)(FE + 256 + l4) <= tgt));
    r.jlo = cnt < 4 * qb ? cnt : 4 * qb;
    return r;
}
__device__ __forceinline__ void ph_attention(const Args& a, char* lds, const int tid) {
    using namespace attn;
    typedef __hip_bfloat16 T;
    const T* Q = (const T*)(a.ws + WS_ZB); const T* K = Q + (size_t)M * DM; const T* V = K + (size_t)M * DM; T* O = (T*)(a.ws + WS_YC);
    unsigned* ctr = (unsigned*)(a.ws + 32768);
    volatile int* nextw = (volatile int*)(lds + attn::LDS_BYTES);
    const int lane = tid & 63, total = 1024;
    int L = blockIdx.x; if (L >= total) return;
    BlockRef<T, T> cur = attn_mkref(L, Q, K, V, O, a.ws, lane);
    Seam<T> S;
    causal_swa_prime<T, T>(cur, SEQ, lds, S, tid);
    for (;;) {
        if (tid == 0) *nextw = (int)gridDim.x + (int)__hip_atomic_fetch_add(ctr, 1u, __ATOMIC_RELAXED, __HIP_MEMORY_SCOPE_AGENT);
        __syncthreads();
        const int Ln = __builtin_amdgcn_readfirstlane(*nextw); const bool last = Ln >= total;
        const BlockRef<T, T> nxt = last ? cur : attn_mkref(Ln, Q, K, V, O, a.ws, lane);
        causal_swa_block<T, T>(cur, nxt, SEQ, SEQ, lds, S, tid);
        if (last) break;
        cur = nxt; L = Ln;
    }
}

__global__ void __launch_bounds__(NTHREADS, 2) mk_fwd(Args a) {
    extern __shared__ __attribute__((aligned(16))) unsigned char lds_raw[];
    cg::grid_group grid = cg::this_grid();
    LAS unsigned char* lds = (LAS unsigned char*)lds_raw;
    const int wave = __builtin_amdgcn_readfirstlane((int)threadIdx.x >> 6);
    unsigned char* ws = a.ws;
    const float* MOD = (const float*)(ws + WS_MOD);
    const int lo = a.ph_lo, hi = a.ph_hi;
    XcdBarrier bar;
    { const int l0 = lane_id(); volatile LAS unsigned* st = (volatile LAS unsigned*)(lds + LDS_CTL);
      if (wave == 0 && l0 == 0) { st[0] = 0u; st[1] = 0u; }
      __syncthreads();
      bar.bar = (unsigned*)ws; bar.x = xb_xcc_id(); bar.st = st;
      if (lo == 0) { if (blockIdx.x == 0) { unsigned* z = (unsigned*)ws; const int t_ = wave * 64 + l0;
#pragma unroll 1
              for (int i = t_; i < 4096; i += NTHREADS) __hip_atomic_store(z + i, 0u, __ATOMIC_RELAXED, __HIP_MEMORY_SCOPE_AGENT);
              if (t_ == 0) __hip_atomic_store(z + 8192, 0u, __ATOMIC_RELAXED, __HIP_MEMORY_SCOPE_AGENT); } }
      else if (wave == 0 && l0 == 0) { st[2] = xb_add(&bar.bar[XB_XCNT(bar.x)], 1u); st[3] = bar.x; } }
    int ph = 0;
#define PHASE_BEGIN if (ph >= lo && ph < hi) { const int lane = lane_id(), tid = wave * 64 + lane; (void)tid; (void)lane;
#define TID tid
#define PHASE_END   if (ph + 1 < hi) { if (ph == 0) { grid.sync(); if (wave == 0 && lane_id() == 0) { bar.st[2] = xb_add(&bar.bar[XB_XCNT(bar.x)], 1u); bar.st[3] = bar.x; } } else xcd_barrier(bar, wave == 0 && lane_id() == 0);     } } ++ph;
    bf16* HB = (bf16*)(ws + WS_HB); bf16* ZB = (bf16*)(ws + WS_ZB); bf16* YC = (bf16*)(ws + WS_YC); bf16* YB = (bf16*)(ws + WS_YB);
    float* X1 = (float*)(ws + WS_X1); bf16* H2 = (bf16*)(ws + WS_H2); bf16* QP = (bf16*)(ws + WS_QP);

    PHASE_BEGIN ph_prologue(a, lds, tid, lane, wave); PHASE_END
    PHASE_BEGIN ph_modulate(a.in[0], MOD, 0, 2048, HB, ws + WS_HB8, (float*)(ws + WS_SA), lane, wave); PHASE_END
    PHASE_BEGIN { pg8::Gemm g{(const bf16*)(ws + WS_HB8), (const bf16*)(ws + WS_WIN), M, NZ, DM / 2, DM / 2, DM / 2}; pg8::StaticOrder S; S.init(M, NZ, gridDim.x, blockIdx.x);
        pg8::EpiI8RowScaleBf16 E{ZB, NZ, (const float*)(ws + WS_SA), 1.f / W8_SCALE, 0, 0}; pg8::gemm_phase<pg8::EpiI8RowScaleBf16, pg8::StaticOrder, true, true, false, true>(lds, g, S, E, TID); } PHASE_END
    PHASE_BEGIN ph_poolconv(a, lane, wave); PHASE_END
    PHASE_BEGIN {
        if (gridDim.x == 256) {
            { const int gq = blockIdx.x >> 6, pm = blockIdx.x & 63;
              pg8::Gemm g{(const bf16*)(ws + WS_PO) + gq * 256, (const bf16*)(ws + WS_WPOOL) + gq * 65536, M, 256, 256, 1024, 256}; pg8::ListOrder S{pm, 1};
              pg8::EpiScaleBf16 E{ws + WS_YC8 + gq * 256, DM, a.in[12] + gq * 256, Y8_SCALE}; pg8::gemm_phase<pg8::EpiScaleBf16, pg8::ListOrder, false, true>(lds, g, S, E, TID); }
            { const int hb = blockIdx.x >> 5, pm0 = (blockIdx.x & 31) * 2;
              int kg = 128; asm volatile("" : "+s"(kg));
              pg8::Gemm g{(const bf16*)(ws + WS_XC) + hb * 128, (const bf16*)(ws + WS_WAX) + hb * 32768, M, 256, kg, 1024, 128}; pg8::ListOrder S{pm0, 2};
              pg8::EpiGate E{(const bf16*)(ws + WS_XC), (float*)(ws + WS_AF), (float*)(ws + WS_DF), a.in[16], a.in[18], (const float*)(ws + WS_LS8), hb * 128};
              pg8::gemm_phase<pg8::EpiGate, pg8::ListOrder, false, false>(lds, g, S, E, wave * 64 + lane_id()); }
        } } PHASE_END
    PHASE_BEGIN ph_scan_agg(a, tid); PHASE_END
    PHASE_BEGIN ph_scan_fin(a, tid); PHASE_END
    PHASE_BEGIN { pg8::Gemm g{(const bf16*)(ws + WS_YC8), (const bf16*)(ws + WS_WOUT), M, DM, DM / 2, DM / 2, DM / 2}; pg8::StaticOrder S; S.init(M, DM, gridDim.x, blockIdx.x);
        pg8::EpiRowScaleF8 E{(unsigned char*)YB, DM, nullptr, YB_SCALE / (W8O_SCALE * Y8_SCALE), 0, 0}; pg8::gemm_phase<pg8::EpiRowScaleF8, pg8::StaticOrder, true, true, true>(lds, g, S, E, TID); } PHASE_END
    PHASE_BEGIN ph_ln<true, true>((const float*)(ws + WS_SA), (const unsigned char*)YB, nullptr, (const bf16*)(ws + WS_HB8), MOD, MOD, a.in[4], a.in[5], H2, ws + WS_X1, (float*)(ws + WS_X1 + 64 * MiB), ws + WS_H6, (float*)(ws + WS_HS), lds, lane, wave); PHASE_END
    PHASE_BEGIN { pg8::Gemm g{(const bf16*)(ws + WS_X1), (const bf16*)(ws + WS_WQ0), M, DM, DM / 2, DM / 2, DM / 2}; pg8::StaticOrder S; S.init(M, DM, gridDim.x, blockIdx.x);
        pg8::EpiI8RowScaleBf16 E{QP, DM, (const float*)(ws + WS_X1 + 64 * MiB), 1.f / W8_SCALE, 0, 0}; pg8::gemm_phase<pg8::EpiI8RowScaleBf16, pg8::StaticOrder, true, true, false, true>(lds, g, S, E, TID); } PHASE_END
    PHASE_BEGIN ph_topk(a, 0, lds, tid, lane, wave); PHASE_END
    PHASE_BEGIN ph_peer_u(a, 0, (volatile LAS unsigned*)(lds + LDS_CTL), lds, lane, wave); PHASE_END
    PHASE_BEGIN ph_peer_coef(a, 0, lds, lane, wave); PHASE_END
    PHASE_BEGIN ph_peer_v(a, 0, (volatile LAS unsigned*)(lds + LDS_CTL), lds, lane, wave); PHASE_END
    PHASE_BEGIN ph_peer_ln<false>(a, MOD, MOD + 2 * 12288, a.in[4] + DM, a.in[5] + DM, lds, lane, wave); PHASE_END
    PHASE_BEGIN { pg8::Gemm g{(const bf16*)(ws + WS_HB8), (const bf16*)(ws + WS_WQKV), M, NQKV, DM / 2, DM / 2, DM / 2}; pg8::StaticOrder S; S.init(M, NQKV, gridDim.x, blockIdx.x);
        pg8::EpiI8RowScaleBf16 E{ZB, DM, (const float*)(ws + WS_SA), 1.f / W8_SCALE, DM, (size_t)M * DM}; pg8::gemm_phase<pg8::EpiI8RowScaleBf16, pg8::StaticOrder, true, true, false, true>(lds, g, S, E, TID);
        ph_forget(a, lds, lane, wave); } PHASE_END
    PHASE_BEGIN ph_cumsum(a, lane, wave); PHASE_END
    PHASE_BEGIN ph_attention(a, (char*)lds_raw, TID); PHASE_END
    PHASE_BEGIN { pg8::Gemm g{(const bf16*)(ws + WS_YC8), (const bf16*)(ws + WS_WO), M, DM, DM / 2, DM / 2, DM / 2}; pg8::StaticOrder S; S.init(M, DM, gridDim.x, blockIdx.x);
        pg8::EpiRowScaleF8 E{(unsigned char*)YB, DM, nullptr, YB_SCALE / (W8O_SCALE * attn::O8_SCALE), 0, 0}; pg8::gemm_phase<pg8::EpiRowScaleF8, pg8::StaticOrder, true, true, true>(lds, g, S, E, TID); } PHASE_END
    PHASE_BEGIN ph_ln<true, true>((const float*)(ws + WS_SA), (const unsigned char*)YB, nullptr, (const bf16*)(ws + WS_HB8), MOD + 2 * 12288, MOD + 2 * 12288, a.in[4] + 2 * DM, a.in[5] + 2 * DM, H2, ws + WS_X1, (float*)(ws + WS_X1 + 64 * MiB), ws + WS_H6, (float*)(ws + WS_HS), lds, lane, wave); PHASE_END
    PHASE_BEGIN { pg8::Gemm g{(const bf16*)(ws + WS_X1), (const bf16*)(ws + WS_WQ1), M, DM, DM / 2, DM / 2, DM / 2}; pg8::StaticOrder S; S.init(M, DM, gridDim.x, blockIdx.x);
        pg8::EpiI8RowScaleBf16 E{QP, DM, (const float*)(ws + WS_X1 + 64 * MiB), 1.f / W8_SCALE, 0, 0}; pg8::gemm_phase<pg8::EpiI8RowScaleBf16, pg8::StaticOrder, true, true, false, true>(lds, g, S, E, TID); } PHASE_END
    PHASE_BEGIN ph_topk(a, 1, lds, tid, lane, wave); PHASE_END
    PHASE_BEGIN ph_peer_u(a, 1, (volatile LAS unsigned*)(lds + LDS_CTL), lds, lane, wave); PHASE_END
    PHASE_BEGIN ph_peer_coef(a, 1, lds, lane, wave); PHASE_END
    PHASE_BEGIN ph_peer_v(a, 1, (volatile LAS unsigned*)(lds + LDS_CTL), lds, lane, wave); PHASE_END
    PHASE_BEGIN ph_peer_ln<true>(a, MOD + 2 * 12288, MOD, a.in[4] + 3 * DM, a.in[5] + 3 * DM, lds, lane, wave); PHASE_END
#undef PHASE_BEGIN
#undef TID
#undef PHASE_END
}
constexpr int N_PHASES = 26;

extern "C" void kernel_launch(void* const* d_in, const int* in_sizes, int n_in, void* d_out, int out_size, void* d_ws, size_t ws_size, hipStream_t stream) {
    static int grid = 0;
    if (grid == 0) {
        int dev = 0, cus = 0, per_cu = 0;
        if (n_in != 24 || out_size != M * DM || ws_size < WS_END) { fprintf(stderr, "kernel_launch: unexpected shapes (n_in %d, out %d, ws %zu)\n", n_in, out_size, ws_size); grid = -1; return; }
        (void)hipGetDevice(&dev);
        (void)hipDeviceGetAttribute(&cus, hipDeviceAttributeMultiprocessorCount, dev);
        (void)hipFuncSetAttribute((const void*)mk_fwd, hipFuncAttributeMaxDynamicSharedMemorySize, LDS_BYTES);
        (void)hipOccupancyMaxActiveBlocksPerMultiprocessor(&per_cu, (const void*)mk_fwd, NTHREADS, LDS_BYTES);
        if (per_cu < 1) { fprintf(stderr, "kernel_launch: occupancy query reports %d blocks per CU\n", per_cu); grid = -1; return; }
        grid = cus;
        if (grid != 256) fprintf(stderr, "kernel_launch: %d CUs; phase 4 is written for 256 workgroups\n", grid);
    }
    if (grid < 0) return;
#ifdef MK_SPLIT
    if (hipMemsetAsync(d_ws, 0, 65536, stream) != hipSuccess) { fprintf(stderr, "kernel_launch: hipMemsetAsync failed\n"); return; }
#endif
    Args a{};
    for (int i = 0; i < 24; ++i) a.in[i] = (const float*)d_in[i];
    a.out = (float*)d_out; a.ws = (unsigned char*)d_ws;
#ifndef MK_SPLIT
    a.ph_lo = 0; a.ph_hi = N_PHASES;
    void* args[] = {&a};
    hipError_t e = hipLaunchCooperativeKernel((const void*)mk_fwd, dim3(grid), dim3(NTHREADS), args, LDS_BYTES, stream);
    if (e != hipSuccess) fprintf(stderr, "cooperative launch failed: %s (grid %d)\n", hipGetErrorString(e), grid);
#else
    for (int p = 0; p < N_PHASES; ++p) { a.ph_lo = p; a.ph_hi = p + 1; void* args[] = {&a};
        hipError_t e = hipLaunchCooperativeKernel((const void*)mk_fwd, dim3(grid), dim3(NTHREADS), args, LDS_BYTES, stream);
        if (e != hipSuccess) { fprintf(stderr, "launch %d failed: %s\n", p, hipGetErrorString(e)); break; } }
#endif
}
```
